# Optimizing an MI355X kernel written in HIP

```python
import math
import jax
import jax.numpy as jnp
from jax import lax
import numpy as np

D_MODEL = 1024
BATCH = 2
SEQ = 8192
DEPTH = 2

GRID_W = 64
CTX_LEN = 256

DA_HEADS = 4
DA_DIM = 64
DA_VDIM = 2 * DA_DIM
DA_WIDTH = DA_HEADS * DA_VDIM
QUERY_BLOCK = 128
ROPE_BASE = 10000.0
POOL_WINDOWS = (2, 4, 8, 16)
POOL_GROUP = 64
POOL_WIDTH = len(POOL_WINDOWS) * POOL_GROUP
RET_HEADS = 4
RET_DK = 64
RET_DV = 64
RET_WIDTH = RET_HEADS * RET_DV
RET_CHUNK = 128
MIX_WIDTH = DA_WIDTH + POOL_WIDTH + RET_WIDTH
IN_SIZES = (DA_HEADS * 2 * DA_DIM, DA_HEADS * 2 * DA_DIM, DA_WIDTH,
            POOL_WIDTH,
            RET_HEADS * RET_DK, RET_HEADS * RET_DK, RET_WIDTH, RET_WIDTH)
IN_WIDTH = sum(IN_SIZES)
IN_OFFSETS = tuple(int(v) for v in np.cumsum(IN_SIZES)[:-1])
N_EXPERTS = 256
TOP_K = 8
N_GROUPS = 8
TOPK_GROUPS = 4
EXPERT_HIDDEN = 256
SHARED_HIDDEN = 256
ROUTED_SCALE = 2.5
MOE_BLOCK = 128
DN_ALPHA = (2.0 * DEPTH) ** 0.25
DN_BETA = (8.0 * DEPTH) ** -0.25
LN_EPS = 1e-6
RMS_EPS = 1e-5

kernel_name = 'hybrid_diffattn_pool_retention_moe_dit'


def layer_norm(x, gain=None, bias=None):
    xf = x.astype(jnp.float32)
    mu = jnp.mean(xf, axis=-1, keepdims=True)
    var = jnp.mean(jnp.square(xf - mu), axis=-1, keepdims=True)
    y = (xf - mu) * lax.rsqrt(var + LN_EPS)
    if gain is not None:
        y = y * gain.astype(jnp.float32) + bias.astype(jnp.float32)
    return y.astype(x.dtype)


def rms_norm(x):
    xf = x.astype(jnp.float32)
    return (xf * lax.rsqrt(jnp.mean(xf * xf, axis=-1, keepdims=True) + RMS_EPS)).astype(x.dtype)


def modulate(x, shift, scale):
    return layer_norm(x) * (1.0 + scale) + shift


def swiglu(x, w_gate_up, w_down):
    g, u = jnp.split(x @ w_gate_up, 2, axis=-1)
    return (jax.nn.silu(g) * u) @ w_down


def axial_rope_tables(n):
    rows = n // GRID_W
    row = jnp.repeat(jnp.arange(rows, dtype=jnp.float32), GRID_W)
    col = jnp.tile(jnp.arange(GRID_W, dtype=jnp.float32), rows)
    nf = DA_DIM // 4
    freqs = ROPE_BASE ** (-jnp.arange(nf, dtype=jnp.float32) / nf)
    ang = jnp.stack([row[:, None] * freqs, col[:, None] * freqs], axis=1)
    return jnp.cos(ang), jnp.sin(ang)


def apply_axial_rope(t, cos, sin):
    xa = t.reshape(t.shape[:-1] + (2, 2, DA_DIM // 4))
    x1, x2 = xa[..., 0, :], xa[..., 1, :]
    cs = cos[None, :, None, None].astype(t.dtype)
    sn = sin[None, :, None, None].astype(t.dtype)
    return jnp.stack([x1 * cs - x2 * sn, x1 * sn + x2 * cs], axis=-2).reshape(t.shape)


def diff_softmax_attend(q, keys, vals, lam):
    s = jnp.einsum('bqhmd,bkhmd->bhmqk', q, keys).astype(jnp.float32) * (DA_DIM ** -0.5)
    p = jax.nn.softmax(s, axis=-1)
    a = (p[:, :, 0] - lam * p[:, :, 1]).astype(vals.dtype)
    return jnp.einsum('bhqk,bkhe->bqhe', a, vals)


def pool_mixer(u, pool_w, pool_scale):
    bsz, n, _ = u.shape
    ug = u.reshape(bsz, n, len(POOL_WINDOWS), POOL_GROUP)
    cs = jnp.concatenate([jnp.zeros((bsz, 1) + ug.shape[2:], jnp.float32),
                          jnp.cumsum(ug.astype(jnp.float32), axis=1)], axis=1)
    t = jnp.arange(n)
    means = []
    for gi, w in enumerate(POOL_WINDOWS):
        lo = jnp.clip(t - w // 2, 0, n)
        hi = jnp.clip(t + w - w // 2, 0, n)
        means.append((cs[:, hi, gi] - cs[:, lo, gi]) / (hi - lo).astype(jnp.float32)[None, :, None])
    mean = jnp.stack(means, axis=2).astype(u.dtype)
    y = jnp.einsum('bngc,gce->bnge', mean - ug, pool_w)
    return y.reshape(bsz, n, POOL_WIDTH) * pool_scale


def retention_chunked(q, k, v, log_gamma, state0):
    bsz, n, nh, _ = q.shape
    nc = n // RET_CHUNK
    to_chunks = lambda t: t.reshape(bsz, nc, RET_CHUNK, nh, t.shape[-1]).transpose(1, 0, 3, 2, 4)
    idx = jnp.arange(RET_CHUNK, dtype=jnp.float32)
    diff = idx[:, None] - idx[None, :]
    dmat = jnp.exp(jnp.where(diff >= 0, diff * log_gamma[:, None, None], -jnp.inf)).astype(q.dtype)
    q_decay = jnp.exp((idx + 1.0)[None, :] * log_gamma[:, None]).astype(q.dtype)[..., None]
    k_decay = jnp.exp((RET_CHUNK - 1.0 - idx)[None, :] * log_gamma[:, None]).astype(q.dtype)[..., None]
    chunk_decay = jnp.exp(RET_CHUNK * log_gamma).astype(q.dtype)[:, None, None]

    def step(state, inp):
        qc, kc, vc = inp
        intra = jnp.einsum('bhid,bhjd->bhij', qc, kc) * dmat
        o = jnp.einsum('bhij,bhjv->bhiv', intra, vc) + jnp.einsum('bhid,bhdv->bhiv', qc * q_decay, state)
        state = state * chunk_decay + jnp.einsum('bhjd,bhjv->bhdv', kc * k_decay, vc)
        return state, o

    state, o = lax.scan(step, state0, (to_chunks(q), to_chunks(k), to_chunks(v)))
    return o.transpose(1, 0, 3, 2, 4).reshape(bsz, n, nh, v.shape[-1]), state


def retention_state(k, v, log_gamma):
    n = k.shape[1]
    w = jnp.exp((n - 1.0 - jnp.arange(n, dtype=jnp.float32))[None, :] * log_gamma[:, None]).astype(k.dtype)
    return jnp.einsum('bnhd,hn,bnhv->bhdv', k, w, v)


def token_mixer(h, hc, w_in, w_out, lam_vec, lambda_init, pool_w, pool_scale, log_decay, cos, sin, need_ctx):
    bsz, n, _ = h.shape
    m = hc.shape[1]
    dq, dk, dv, pu, rq, rk, rv, rg = jnp.split(h @ w_in, IN_OFFSETS, axis=-1)
    dqc, dkc, dvc, puc, rqc, rkc, rvc, rgc = jnp.split(hc @ w_in, IN_OFFSETS, axis=-1)

    qk_heads = lambda t: t.reshape(t.shape[:2] + (DA_HEADS, 2, DA_DIM))
    lam_f = lam_vec.astype(jnp.float32)
    lam = jnp.exp(jnp.sum(lam_f[0] * lam_f[1])) - jnp.exp(jnp.sum(lam_f[2] * lam_f[3])) + lambda_init
    q = apply_axial_rope(qk_heads(dq), cos, sin)
    k = apply_axial_rope(qk_heads(dk), cos, sin)
    kc = qk_heads(dkc)
    vc = dvc.reshape(bsz, m, DA_HEADS, DA_VDIM)
    keys = jnp.concatenate([kc, k], axis=1)
    vals = jnp.concatenate([vc, dv.reshape(bsz, n, DA_HEADS, DA_VDIM)], axis=1)
    q_blocks = q.reshape(bsz, n // QUERY_BLOCK, QUERY_BLOCK, DA_HEADS, 2, DA_DIM).swapaxes(0, 1)
    da = lax.map(lambda qb: diff_softmax_attend(qb, keys, vals, lam), q_blocks)
    da = da.swapaxes(0, 1).reshape(bsz, n, DA_HEADS, DA_VDIM)
    da_out = lambda o: (rms_norm(o) * (1.0 - lambda_init)).reshape(o.shape[:2] + (DA_WIDTH,))

    ret_heads = lambda t, d: t.reshape(t.shape[:2] + (RET_HEADS, d))
    qr = ret_heads(rq, RET_DK)
    kr = ret_heads(rk, RET_DK) * RET_DK ** -0.5
    vr = ret_heads(rv, RET_DV)
    krc = ret_heads(rkc, RET_DK) * RET_DK ** -0.5
    vrc = ret_heads(rvc, RET_DV)
    lg_f = -jnp.exp(log_decay[0].astype(jnp.float32))
    lg_b = -jnp.exp(log_decay[1].astype(jnp.float32))
    flip = lambda t: jnp.flip(t, axis=1)
    ret_out = lambda o, g: layer_norm(o).reshape(o.shape[:2] + (RET_WIDTH,)) * jax.nn.silu(g)
    if need_ctx:
        zero = jnp.zeros((bsz, RET_HEADS, RET_DK, RET_DV), h.dtype)
        qrc = ret_heads(rqc, RET_DK)
        oc_f, s_f = retention_chunked(qrc, krc, vrc, lg_f, zero)
        oc_b, s_b = retention_chunked(flip(qrc), flip(krc), flip(vrc), lg_b, zero)
    else:
        s_f = retention_state(krc, vrc, lg_f)
        s_b = retention_state(flip(krc), flip(vrc), lg_b)
    o_f, _ = retention_chunked(qr, kr, vr, lg_f, s_f)
    o_b, _ = retention_chunked(flip(qr), flip(kr), flip(vr), lg_b, s_b)

    y = jnp.concatenate([da_out(da), pool_mixer(pu, pool_w, pool_scale),
                         ret_out(o_f + flip(o_b), rg)], axis=-1) @ w_out
    if not need_ctx:
        return y, None
    dac = diff_softmax_attend(qk_heads(dqc), kc, vc, lam)
    yc = jnp.concatenate([da_out(dac), pool_mixer(puc, pool_w, pool_scale),
                          ret_out(oc_f + flip(oc_b), rgc)], axis=-1) @ w_out
    return y, yc


def routed_moe(tokens, w_router, router_bias, w_gu, w_dn, ws_gu, ws_dn):
    n_tok, d = tokens.shape
    scores = jax.nn.sigmoid((tokens @ w_router).astype(jnp.float32))
    grouped = (scores + router_bias.astype(jnp.float32)).reshape(n_tok, N_GROUPS, N_EXPERTS // N_GROUPS)
    group_score = jnp.sum(lax.top_k(grouped, 2)[0], axis=-1)
    top_groups = lax.top_k(group_score, TOPK_GROUPS)[1]
    group_ok = jnp.any(top_groups[:, :, None] == jnp.arange(N_GROUPS), axis=1)
    masked = jnp.where(group_ok[:, :, None], grouped, -jnp.inf).reshape(n_tok, N_EXPERTS)
    expert_idx = lax.top_k(masked, TOP_K)[1]
    gate = jnp.take_along_axis(scores, expert_idx, axis=1)
    gate = gate / jnp.sum(gate, axis=-1, keepdims=True) * ROUTED_SCALE

    n_asg = n_tok * TOP_K
    flat_e = expert_idx.reshape(-1)
    order = jnp.argsort(flat_e)
    sorted_e = flat_e[order]
    counts = jnp.bincount(flat_e, length=N_EXPERTS)
    padded = (counts + MOE_BLOCK - 1) // MOE_BLOCK * MOE_BLOCK
    pad_end = jnp.cumsum(padded)
    dest = (pad_end - padded)[sorted_e] + jnp.arange(n_asg) - (jnp.cumsum(counts) - counts)[sorted_e]
    n_blocks = -(-n_asg // MOE_BLOCK) + N_EXPERTS
    n_rows = n_blocks * MOE_BLOCK
    row_tok = jnp.full((n_rows,), n_tok, dtype=jnp.int32).at[dest].set((order // TOP_K).astype(jnp.int32))
    row_gate = jnp.zeros((n_rows,), tokens.dtype).at[dest].set(gate.reshape(-1)[order].astype(tokens.dtype))
    block_expert = jnp.minimum(jnp.searchsorted(pad_end, jnp.arange(n_blocks) * MOE_BLOCK, side='right'),
                               N_EXPERTS - 1)
    tokens_pad = jnp.concatenate([tokens, jnp.zeros((1, d), tokens.dtype)], axis=0)

    def expert_block(args):
        rows, wts, e = args
        return swiglu(tokens_pad[rows], w_gu[e], w_dn[e]) * wts[:, None]

    y_rows = lax.map(expert_block, (row_tok.reshape(n_blocks, MOE_BLOCK),
                                    row_gate.reshape(n_blocks, MOE_BLOCK), block_expert))
    routed = jax.ops.segment_sum(y_rows.reshape(n_rows, d), row_tok, num_segments=n_tok + 1)[:n_tok]
    return routed + swiglu(tokens, ws_gu, ws_dn)


def setup_inputs(seed: int = 0) -> dict:
    key = jax.random.key(seed)
    ks = jax.random.split(key, 20)
    nrm = jax.random.normal
    D = D_MODEL
    base_decay = jnp.log(-jnp.log1p(-(2.0 ** (-5.0 - jnp.arange(RET_HEADS, dtype=jnp.float32)))))
    return {
        'x': nrm(ks[0], (BATCH, SEQ, D), jnp.float32),
        'c': nrm(ks[1], (BATCH, D), jnp.float32),
        'ctx': nrm(ks[2], (BATCH, CTX_LEN, D), jnp.float32),
        'c_ctx': nrm(ks[3], (D,), jnp.float32),
        'w_mod': nrm(ks[4], (DEPTH, D, 6 * D), jnp.float32) * (0.5 * D ** -0.5),
        'b_mod': 0.02 * nrm(ks[5], (DEPTH, 6 * D), jnp.float32),
        'w_in': nrm(ks[6], (DEPTH, D, IN_WIDTH), jnp.float32) * D ** -0.5,
        'w_out': nrm(ks[7], (DEPTH, MIX_WIDTH, D), jnp.float32) * (MIX_WIDTH ** -0.5 * DN_BETA),
        'diff_lambda': 0.1 * nrm(ks[8], (DEPTH, 4, DA_DIM), jnp.float32),
        'pool_w': nrm(ks[9], (DEPTH, len(POOL_WINDOWS), POOL_GROUP, POOL_GROUP), jnp.float32) * POOL_GROUP ** -0.5,
        'pool_scale': 1.0 + 0.1 * nrm(ks[10], (DEPTH, POOL_WIDTH), jnp.float32),
        'ret_log_decay': base_decay + 0.1 * nrm(ks[11], (DEPTH, 2, RET_HEADS), jnp.float32),
        'ln_g': 1.0 + 0.1 * nrm(ks[12], (DEPTH, 2, D), jnp.float32),
        'ln_b': 0.02 * nrm(ks[13], (DEPTH, 2, D), jnp.float32),
        'w_router': nrm(ks[14], (DEPTH, D, N_EXPERTS), jnp.float32) * D ** -0.5,
        'router_bias': 0.01 * nrm(ks[15], (DEPTH, N_EXPERTS), jnp.float32),
        'w_expert_gate_up': nrm(ks[16], (DEPTH, N_EXPERTS, D, 2 * EXPERT_HIDDEN), jnp.float32) * D ** -0.5,
        'w_expert_down': nrm(ks[17], (DEPTH, N_EXPERTS, EXPERT_HIDDEN, D), jnp.float32) * (EXPERT_HIDDEN ** -0.5 * DN_BETA),
        'w_shared_gate_up': nrm(ks[18], (DEPTH, D, 2 * SHARED_HIDDEN), jnp.float32) * D ** -0.5,
        'w_shared_down': nrm(ks[19], (DEPTH, SHARED_HIDDEN, D), jnp.float32) * (SHARED_HIDDEN ** -0.5 * DN_BETA),
    }


def reference(x, c, ctx, c_ctx, w_mod, b_mod, w_in, w_out, diff_lambda, pool_w, pool_scale, ret_log_decay,
              ln_g, ln_b, w_router, router_bias, w_expert_gate_up, w_expert_down, w_shared_gate_up, w_shared_down):
    bsz, n, d = x.shape
    cos, sin = axial_rope_tables(n)
    silu_c = jax.nn.silu(c)
    silu_cc = jax.nn.silu(c_ctx)
    xc = ctx
    for l in range(DEPTH):
        need_ctx = l < DEPTH - 1
        mod = jnp.split((silu_c @ w_mod[l] + b_mod[l])[:, None, :], 6, axis=-1)
        modc = jnp.split((silu_cc @ w_mod[l] + b_mod[l])[None, None, :], 6, axis=-1)
        lambda_init = 0.8 - 0.6 * math.exp(-0.3 * l)

        y, yc = token_mixer(modulate(x, mod[0], mod[1]), modulate(xc, modc[0], modc[1]), w_in[l], w_out[l],
                            diff_lambda[l], lambda_init, pool_w[l], pool_scale[l], ret_log_decay[l],
                            cos, sin, need_ctx)
        x = layer_norm(DN_ALPHA * x + mod[2] * y, ln_g[l, 0], ln_b[l, 0])
        if need_ctx:
            xc = layer_norm(DN_ALPHA * xc + modc[2] * yc, ln_g[l, 0], ln_b[l, 0])

        tok = modulate(x, mod[3], mod[4]).reshape(-1, d)
        if need_ctx:
            tok = jnp.concatenate([tok, modulate(xc, modc[3], modc[4]).reshape(-1, d)], axis=0)
        f = routed_moe(tok, w_router[l], router_bias[l], w_expert_gate_up[l], w_expert_down[l],
                       w_shared_gate_up[l], w_shared_down[l])
        x = layer_norm(DN_ALPHA * x + mod[5] * f[:bsz * n].reshape(bsz, n, d), ln_g[l, 1], ln_b[l, 1])
        if need_ctx:
            xc = layer_norm(DN_ALPHA * xc + modc[5] * f[bsz * n:].reshape(xc.shape), ln_g[l, 1], ln_b[l, 1])
    return x
```

```cpp
#include <hip/hip_runtime.h>
#include <stdint.h>
#include <stdio.h>

#ifndef N_LAUNCH_PER_PHASE
#define N_LAUNCH_PER_PHASE 0
#endif

#define LAS __attribute__((address_space(3)))
#define DI __device__ __forceinline__
typedef unsigned short bf16_t;
typedef short bf16x8 __attribute__((ext_vector_type(8)));
typedef float f32x2 __attribute__((ext_vector_type(2)));
typedef float f32x4 __attribute__((ext_vector_type(4)));
typedef float f32x16 __attribute__((ext_vector_type(16)));
typedef unsigned u32x2 __attribute__((ext_vector_type(2)));
typedef unsigned u32x4 __attribute__((ext_vector_type(4)));
typedef __bf16 bf16v2 __attribute__((ext_vector_type(2)));

constexpr int NB = 2, NLAT = 8192, NCTX = 256, NT = NLAT + NCTX  , MROWS = NB * NT  ;
constexpr int DM = 1024, INW = 2816, NEXP = 256, TOPK = 8, NASG = MROWS * TOPK  ;
constexpr int NCHUNK = NT / 128;
constexpr float DN_ALPHA = 1.41421356237f;
constexpr float LN_EPS = 1e-6f, RMS_EPS = 1e-5f;
constexpr float LOG2E = 1.44269504089f;
constexpr float QSCALE = 0.125f * LOG2E;
constexpr int NTHREADS = 512;
constexpr int LDS_BYTES = 98304;

constexpr int C_DQ = 0, C_DK = 512, C_DV = 1024, C_PU = 1536, C_RQ = 1792, C_RK = 2048, C_RV = 2304, C_RG = 2560;

constexpr size_t al256(size_t x) { return (x + 255) & ~(size_t)255; }
constexpr size_t WS_CTL = 0;
constexpr size_t CTL_BYTES = 65536;
constexpr size_t CTL_COUNTS = 16384;
constexpr size_t CTL_CURSOR = CTL_COUNTS + 2048;
constexpr size_t CTL_NTILES = CTL_CURSOR + 2048;
constexpr size_t WS_MODV = WS_CTL + CTL_BYTES;
constexpr size_t WS_ROPE = al256(WS_MODV + 2 * 3 * 6144 * 4);
constexpr size_t WS_SCAL = al256(WS_ROPE + 128 * 16 * 8);
constexpr size_t WS_WIN = al256(WS_SCAL + 2 * 16 * 4);
constexpr size_t WS_WOUT = al256(WS_WIN + (size_t)2 * INW * DM * 2);
constexpr size_t WS_WR = al256(WS_WOUT + (size_t)2 * DM * DM * 2);
constexpr size_t WS_WSGU = al256(WS_WR + (size_t)2 * 256 * DM * 2);
constexpr size_t WS_WSDN = al256(WS_WSGU + (size_t)2 * 512 * DM * 2);
constexpr size_t WS_WEGU = al256(WS_WSDN + (size_t)2 * DM * 256 * 2);
constexpr size_t WS_WEDN = al256(WS_WEGU + (size_t)2 * 256 * 512 * DM * 2);
constexpr size_t WS_XA = al256(WS_WEDN + (size_t)2 * 256 * DM * 256 * 2);
constexpr size_t WS_XB = al256(WS_XA + (size_t)MROWS * DM * 4);
constexpr size_t WS_V1 = al256(WS_XB + (size_t)MROWS * DM * 4);
constexpr size_t WS_H = al256(WS_V1 + (size_t)MROWS * DM * 4);
constexpr size_t WS_TOK = al256(WS_H + (size_t)MROWS * DM * 2);
constexpr size_t WS_P = al256(WS_TOK + (size_t)MROWS * DM * 2);
constexpr size_t WS_VT = al256(WS_P + (size_t)MROWS * INW * 2);
constexpr size_t WS_RKT = al256(WS_VT + (size_t)NB * 4 * 128 * NT * 2);
constexpr size_t WS_RVT = al256(WS_RKT + (size_t)NB * 4 * 64 * NT * 2);
constexpr size_t WS_MIX = al256(WS_RVT + (size_t)NB * 4 * 64 * NT * 2);
constexpr size_t ST_BYTES = (size_t)NB * 4 * NCHUNK * 4096 * 4;
constexpr size_t WS_UF = al256(WS_MIX + (size_t)MROWS * DM * 2);
constexpr size_t WS_UB = al256(WS_UF + ST_BYTES);
constexpr size_t WS_SF = al256(WS_UB + ST_BYTES);
constexpr size_t WS_SB = al256(WS_SF + ST_BYTES);
constexpr size_t WS_LOGIT = al256(WS_SB + ST_BYTES);
constexpr size_t WS_EIDX = al256(WS_LOGIT + (size_t)MROWS * 256 * 4);
constexpr size_t WS_GATE = al256(WS_EIDX + (size_t)NASG * 4);
constexpr size_t WS_SORT = al256(WS_GATE + (size_t)NASG * 4);
constexpr size_t WS_TILES = al256(WS_SORT + (size_t)NASG * 4);
constexpr size_t WS_HBUF = al256(WS_TILES + 2048 * 16);
constexpr size_t WS_HSH = al256(WS_HBUF + (size_t)(NASG + 128) * 256 * 2);
constexpr size_t WS_YSLOT = al256(WS_HSH + (size_t)MROWS * 256 * 2);
constexpr size_t WS_YSH = al256(WS_YSLOT + (size_t)NASG * DM * 2);
constexpr size_t WS_END = al256(WS_YSH + (size_t)MROWS * DM * 2);

struct Params {
    const float *x, *c, *ctx, *c_ctx, *w_mod, *b_mod, *w_in, *w_out, *diff_lambda, *pool_w, *pool_scale, *ret_log_decay, *ln_g, *ln_b,
        *w_router, *router_bias, *w_egu, *w_edn, *w_sgu, *w_sdn;
    float* out;
    unsigned char* ws;
    int ph_lo, ph_hi;
};


DI Params launder(const Params& a) {
    Params r = a;
    unsigned long long* d = (unsigned long long*)&r;
#pragma unroll
    for (int i = 0; i < 22; ++i) asm volatile("" : "+s"(d[i]));
    return r;
}
DI int launder_s(int v) { asm volatile("" : "+s"(v)); return v; }
DI int tid_() { int t = threadIdx.x; asm volatile("" : "+v"(t)); return t; }
DI int bid_() { int t = blockIdx.x; asm volatile("" : "+s"(t)); return t; }

#define XB_TMO      128
#define XB_XCNT(j)  (256  + 64 * (j))
#define XB_XSUB(j)  (1280 + 64 * (j))
#define XB_XGEN(j)  (2304 + 64 * (j))
#define XB_TOP      3328
#define XB_TOPGEN   3392
#define XCD_BAR_WORDS 3456
#define XB_SPIN_CAP (1u << 20)

__device__ __forceinline__ unsigned xb_ld(unsigned* p)              { return __hip_atomic_load(p, __ATOMIC_RELAXED, __HIP_MEMORY_SCOPE_AGENT); }
__device__ __forceinline__ unsigned xb_add(unsigned* p, unsigned v) { return __hip_atomic_fetch_add(p, v, __ATOMIC_RELAXED, __HIP_MEMORY_SCOPE_AGENT); }
__device__ __forceinline__ unsigned xb_xcc_id() { return (unsigned)__builtin_amdgcn_s_getreg((3 << 11) | 20) & 0xFu; }
#define XB_SPIN(cond, bar) do { unsigned _sp = 0; while (cond) { __builtin_amdgcn_s_sleep(1); \
    if ((++_sp & 255u) == 0u) { if (xb_ld(&(bar)[XB_TMO])) break; if (_sp > XB_SPIN_CAP) { atomicAdd(&(bar)[XB_TMO], 1u); break; } } } } while (0)

struct XcdBarrier { unsigned* bar; unsigned x; volatile LAS unsigned* st; };

__device__ __forceinline__ XcdBarrier xcd_barrier_post(unsigned* bar, volatile LAS unsigned* st) {
    XcdBarrier b; b.bar = bar; b.x = xb_xcc_id(); b.st = st;
    if (threadIdx.x == 0) (void)xb_add(&bar[XB_XCNT(b.x)], 1u);
    return b;
}
__device__ __forceinline__ void xcd_barrier_complete(unsigned* bar, unsigned x, unsigned& nloc, unsigned& nx) {
    const unsigned G = gridDim.x * gridDim.y * gridDim.z;
    unsigned sum, cnt, mine, sp = 0u;
    for (;;) {
        sum = 0u; cnt = 0u; mine = 0u;
#pragma unroll
        for (unsigned j = 0; j < 16; ++j) { const unsigned c = xb_ld(&bar[XB_XCNT(j)]); sum += c; cnt += (c > 0u) ? 1u : 0u; mine = (j == x) ? c : mine; }
        if (sum == G) break;
        __builtin_amdgcn_s_sleep(1);
        if ((++sp & 255u) == 0u) { if (xb_ld(&bar[XB_TMO])) break; if (sp > XB_SPIN_CAP) { atomicAdd(&bar[XB_TMO], 1u); break; } }
    }
    nloc = mine > 0u ? mine : 1u; nx = cnt > 0u ? cnt : 1u;
}
__device__ __forceinline__ void xcd_barrier(const XcdBarrier& b) {
    asm volatile("s_waitcnt vmcnt(0)" ::: "memory");
    __syncthreads();
    if (threadIdx.x == 0) {
        unsigned* bar = b.bar;
        __builtin_amdgcn_s_waitcnt(0);
        unsigned nloc = b.st[0], nx = b.st[1];
        if (nloc == 0u) { xcd_barrier_complete(bar, b.x, nloc, nx); b.st[0] = nloc; b.st[1] = nx; }
        const unsigned old = xb_add(&bar[XB_XSUB(b.x)], 1u);
        const unsigned gen = old / nloc;
        if (old + 1u == (gen + 1u) * nloc) {
            __builtin_amdgcn_fence(__ATOMIC_RELEASE, "agent");
            asm volatile("s_waitcnt vmcnt(0)" ::: "memory");
            const unsigned og = xb_add(&bar[XB_TOP], 1u);
            const unsigned tg = og / nx;
            if (og + 1u == (tg + 1u) * nx) xb_add(&bar[XB_TOPGEN], 1u);
            else XB_SPIN(xb_ld(&bar[XB_TOPGEN]) == tg, bar);
            __builtin_amdgcn_fence(__ATOMIC_ACQUIRE, "agent");
            xb_add(&bar[XB_XGEN(b.x)], 1u);
            asm volatile("s_waitcnt vmcnt(0)" ::: "memory");
        } else {
            XB_SPIN(xb_ld(&bar[XB_XGEN(b.x)]) == gen, bar);
            __builtin_amdgcn_fence(__ATOMIC_ACQUIRE, "agent");
            asm volatile("s_waitcnt vmcnt(0)" ::: "memory");
        }
    }
    __syncthreads();
}

DI unsigned pk_bf16(float a, float b) { f32x2 v = {a, b}; bf16v2 r = __builtin_convertvector(v, bf16v2); return __builtin_bit_cast(unsigned, r); }
DI bf16_t to_bf16(float a) { return (bf16_t)(pk_bf16(a, 0.f) & 0xffffu); }
DI float bf_lo(unsigned u) { return __uint_as_float(u << 16); }
DI float bf_hi(unsigned u) { return __uint_as_float(u & 0xffff0000u); }
DI float bf2f(bf16_t h) { return __uint_as_float(((unsigned)h) << 16); }
DI float wave_sum(float v) {
#pragma unroll
    for (int o = 32; o; o >>= 1) v += __shfl_xor(v, o);
    return v;
}
DI float fast_exp2(float x) { return __builtin_amdgcn_exp2f(x); }
DI float silu_f(float x) { return x / (1.f + __expf(-x)); }
DI bf16x8 as_bf16x8(u32x4 v) { return __builtin_bit_cast(bf16x8, v); }
#define MFMA32(a, b, c) __builtin_amdgcn_mfma_f32_32x32x16_bf16((a), (b), (c), 0, 0, 0)
#define MFMA16(a, b, c) __builtin_amdgcn_mfma_f32_16x16x32_bf16((a), (b), (c), 0, 0, 0)

DI int row_sel(int r) { const int b = r >= NT; const int p = r - b * NT; return p < NCTX ? 2 : b; }

DI int swz_off(int row, int chunk) { return row * 128 + ((chunk ^ ((row >> 1) & 7)) << 4); }

template <class Epi>
DI void gemm128(const bf16_t* a0, const bf16_t* a1, const bf16_t* b0, const bf16_t* b1, int nk, LAS unsigned char* lds, const Epi& epi) {
    const int tid = tid_(), lane = tid & 63, wid = tid >> 6, wr = wid >> 2, wc = wid & 3, fr = lane & 15, fq = lane >> 4;
    const int lrow = tid >> 3, lch = tid & 7;
    f32x4 acc[4][2];
#pragma unroll
    for (int m = 0; m < 4; ++m)
#pragma unroll
        for (int n = 0; n < 2; ++n) acc[m][n] = (f32x4){0.f, 0.f, 0.f, 0.f};
    const u32x4 z4 = {0u, 0u, 0u, 0u};
    u32x4 ra0 = a0 ? *(const u32x4*)a0 : z4, ra1 = a1 ? *(const u32x4*)a1 : z4, rb0 = b0 ? *(const u32x4*)b0 : z4, rb1 = b1 ? *(const u32x4*)b1 : z4;
    const int wo0 = swz_off(lrow, lch), wo1 = swz_off(lrow + 64, lch);
    *(LAS u32x4*)(lds + wo0) = ra0; *(LAS u32x4*)(lds + wo1) = ra1;
    *(LAS u32x4*)(lds + 16384 + wo0) = rb0; *(LAS u32x4*)(lds + 16384 + wo1) = rb1;
    __syncthreads();
    for (int kt = 0; kt < nk; ++kt) {
        const bool more = kt + 1 < nk;
        if (more) {
            const int ko = (kt + 1) * 64;
            ra0 = a0 ? *(const u32x4*)(a0 + ko) : z4; ra1 = a1 ? *(const u32x4*)(a1 + ko) : z4;
            rb0 = b0 ? *(const u32x4*)(b0 + ko) : z4; rb1 = b1 ? *(const u32x4*)(b1 + ko) : z4;
        }
        LAS unsigned char* A = lds + (kt & 1) * 32768;
        LAS unsigned char* B = A + 16384;
#pragma unroll
        for (int kk = 0; kk < 2; ++kk) {
            bf16x8 af[4], bfr[2];
#pragma unroll
            for (int m = 0; m < 4; ++m) af[m] = *(LAS bf16x8*)(A + swz_off(wr * 64 + m * 16 + fr, kk * 4 + fq));
#pragma unroll
            for (int n = 0; n < 2; ++n) bfr[n] = *(LAS bf16x8*)(B + swz_off(wc * 32 + n * 16 + fr, kk * 4 + fq));
#pragma unroll
            for (int m = 0; m < 4; ++m)
#pragma unroll
                for (int n = 0; n < 2; ++n) acc[m][n] = MFMA16(af[m], bfr[n], acc[m][n]);
        }
        if (more) {
            LAS unsigned char* A2 = lds + ((kt + 1) & 1) * 32768;
            *(LAS u32x4*)(A2 + wo0) = ra0; *(LAS u32x4*)(A2 + wo1) = ra1;
            *(LAS u32x4*)(A2 + 16384 + wo0) = rb0; *(LAS u32x4*)(A2 + 16384 + wo1) = rb1;
        }
        __syncthreads();
    }
    epi(acc, wr, wc, fr, fq);
}

DI int perm_gu(int n) { const int f = n >> 8, jj = n & 255; return ((jj >> 4) << 5) + (f << 4) + (jj & 15); }
DI void conv_unit(const float* src, int N, int K, bf16_t* dst, int k0, int n0, bool perm, LAS unsigned char* lds) {
    LAS float* tl = (LAS float*)lds;
    const int tid = tid_();
#pragma unroll
    for (int i = 0; i < 8; ++i) {
        const int kk = (tid >> 6) + 8 * i, nn = (tid & 63) * 4;
        const f32x4 v = *(const f32x4*)(src + (size_t)(k0 + kk) * N + n0 + nn);
        tl[kk * 257 + nn] = v[0]; tl[kk * 257 + nn + 1] = v[1]; tl[kk * 257 + nn + 2] = v[2]; tl[kk * 257 + nn + 3] = v[3];
    }
    __syncthreads();
    const int n = tid >> 1, kh = (tid & 1) * 32;
    const int nd = perm ? perm_gu(n0 + n) : (n0 + n);
    bf16_t* d = dst + (size_t)nd * K + k0 + kh;
#pragma unroll
    for (int q = 0; q < 4; ++q) {
        u32x4 w;
#pragma unroll
        for (int j = 0; j < 4; ++j) w[j] = pk_bf16(tl[(kh + q * 8 + 2 * j) * 257 + n], tl[(kh + q * 8 + 2 * j + 1) * 257 + n]);
        *(u32x4*)(d + q * 8) = w;
    }
    __syncthreads();
}

DI void phase_convert(const Params& p0, LAS unsigned char* lds) {
    const Params p = launder(p0);
    constexpr int U_IN = 176, U_OUT = 64, U_R = 16, U_SGU = 32, U_SDN = 16, U_EGU = 256 * 32, U_EDN = 256 * 16;
    constexpr int U_L = U_IN + U_OUT + U_R + U_SGU + U_SDN + U_EGU + U_EDN;
    for (int u = bid_(); u < 2 * U_L; u += gridDim.x) {
        const int l = u / U_L; int v = u % U_L;
        if (v < U_IN) { conv_unit(p.w_in + (size_t)l * DM * INW, INW, DM, (bf16_t*)(p.ws + WS_WIN) + (size_t)l * INW * DM, (v / 11) * 64, (v % 11) * 256, false, lds); continue; }
        v -= U_IN;
        if (v < U_OUT) { conv_unit(p.w_out + (size_t)l * DM * DM, DM, DM, (bf16_t*)(p.ws + WS_WOUT) + (size_t)l * DM * DM, (v / 4) * 64, (v % 4) * 256, false, lds); continue; }
        v -= U_OUT;
        if (v < U_R) { conv_unit(p.w_router + (size_t)l * DM * 256, 256, DM, (bf16_t*)(p.ws + WS_WR) + (size_t)l * 256 * DM, v * 64, 0, false, lds); continue; }
        v -= U_R;
        if (v < U_SGU) { conv_unit(p.w_sgu + (size_t)l * DM * 512, 512, DM, (bf16_t*)(p.ws + WS_WSGU) + (size_t)l * 512 * DM, (v / 2) * 64, (v % 2) * 256, true, lds); continue; }
        v -= U_SGU;
        if (v < U_SDN) { conv_unit(p.w_sdn + (size_t)l * 256 * DM, DM, 256, (bf16_t*)(p.ws + WS_WSDN) + (size_t)l * DM * 256, (v / 4) * 64, (v % 4) * 256, false, lds); continue; }
        v -= U_SDN;
        if (v < U_EGU) { const int e = v / 32, w = v % 32;
            conv_unit(p.w_egu + ((size_t)l * NEXP + e) * DM * 512, 512, DM, (bf16_t*)(p.ws + WS_WEGU) + ((size_t)l * NEXP + e) * 512 * DM, (w / 2) * 64, (w % 2) * 256, true, lds); continue; }
        v -= U_EGU;
        { const int e = v / 16, w = v % 16;
            conv_unit(p.w_edn + ((size_t)l * NEXP + e) * 256 * DM, DM, 256, (bf16_t*)(p.ws + WS_WEDN) + ((size_t)l * NEXP + e) * DM * 256, (w / 4) * 64, (w % 4) * 256, false, lds); }
    }
}

DI void phase_mod(const Params& p0, LAS unsigned char* lds) {
    const Params p = launder(p0);
    LAS float* sc = (LAS float*)lds;
    LAS float* red = sc + 3 * 1024;
    const int tid = tid_();
    float* modv = (float*)(p.ws + WS_MODV);
    for (int u = bid_(); u < 193; u += gridDim.x) {
        if (u == 192) {
            float* rope = (float*)(p.ws + WS_ROPE);
            for (int i = tid; i < 128 * 16; i += NTHREADS) {
                const int pos = i >> 4, f = i & 15;
                const float freq = powf(10000.0f, -(float)f / 16.0f);
                const float ang = (float)pos * freq;
                rope[2 * i] = cosf(ang); rope[2 * i + 1] = sinf(ang);
            }
            float* scal = (float*)(p.ws + WS_SCAL);
            if (tid < 2) {
                const int l = tid;
                const float* dl = p.diff_lambda + l * 256;
                float s01 = 0.f, s23 = 0.f;
                for (int i = 0; i < 64; ++i) { s01 += dl[i] * dl[64 + i]; s23 += dl[128 + i] * dl[192 + i]; }
                const float lambda_init = 0.8f - 0.6f * expf(-0.3f * (float)l);
                scal[l * 16 + 0] = expf(s01) - expf(s23) + lambda_init;
                scal[l * 16 + 1] = 1.0f - lambda_init;
                for (int h = 0; h < 4; ++h) {
                    scal[l * 16 + 2 + h] = -expf(p.ret_log_decay[l * 8 + h]) * LOG2E;
                    scal[l * 16 + 6 + h] = -expf(p.ret_log_decay[l * 8 + 4 + h]) * LOG2E;
                }
            }
            continue;
        }
        const int l = u / 96, n0 = (u % 96) * 64;
        for (int i = tid; i < 3 * 1024; i += NTHREADS) {
            const int s = i >> 10, k = i & 1023;
            const float v = s < 2 ? p.c[s * 1024 + k] : p.c_ctx[k];
            sc[i] = silu_f(v);
        }
        __syncthreads();
        const int kq = tid >> 6, nl = tid & 63;
        const float* w = p.w_mod + (size_t)l * DM * 6144 + n0 + nl;
        float a0 = 0.f, a1 = 0.f, a2 = 0.f;
        for (int k = kq * 128; k < kq * 128 + 128; ++k) {
            const float wv = w[(size_t)k * 6144];
            a0 += sc[k] * wv; a1 += sc[1024 + k] * wv; a2 += sc[2048 + k] * wv;
        }
        red[(kq * 3 + 0) * 64 + nl] = a0; red[(kq * 3 + 1) * 64 + nl] = a1; red[(kq * 3 + 2) * 64 + nl] = a2;
        __syncthreads();
        if (tid < 192) {
            const int s = tid >> 6, n = tid & 63;
            float v = 0.f;
            for (int q = 0; q < 8; ++q) v += red[(q * 3 + s) * 64 + n];
            modv[((size_t)l * 3 + s) * 6144 + n0 + n] = v + p.b_mod[l * 6144 + n0 + n];
        }
        __syncthreads();
    }
}

DI void ln_stats(const f32x4 (&v)[4], float& mu, float& rstd) {
    float s = 0.f;
#pragma unroll
    for (int i = 0; i < 4; ++i) s += (v[i][0] + v[i][1]) + (v[i][2] + v[i][3]);
    mu = wave_sum(s) * (1.0f / 1024.0f);
    float q = 0.f;
#pragma unroll
    for (int i = 0; i < 4; ++i)
#pragma unroll
        for (int j = 0; j < 4; ++j) { const float d = v[i][j] - mu; q += d * d; }
    rstd = rsqrtf(wave_sum(q) * (1.0f / 1024.0f) + LN_EPS);
}
DI void modulate_store(const f32x4 (&v)[4], const float* shift, const float* scale, bf16_t* dst, int lane) {
    float mu, rstd; ln_stats(v, mu, rstd);
#pragma unroll
    for (int i = 0; i < 4; ++i) {
        const int c = lane * 4 + i * 256;
        const f32x4 sh = *(const f32x4*)(shift + c), scv = *(const f32x4*)(scale + c);
        float o[4];
#pragma unroll
        for (int j = 0; j < 4; ++j) o[j] = (v[i][j] - mu) * rstd * (1.0f + scv[j]) + sh[j];
        u32x2 w = {pk_bf16(o[0], o[1]), pk_bf16(o[2], o[3])};
        *(u32x2*)(dst + c) = w;
    }
}

DI void phase_ln0(const Params& p0) {
    const Params p = launder(p0);
    const int lane = tid_() & 63, wid = tid_() >> 6;
    float* XA = (float*)(p.ws + WS_XA);
    bf16_t* H = (bf16_t*)(p.ws + WS_H);
    const float* modv = (const float*)(p.ws + WS_MODV);
    for (int r = bid_() * 8 + wid; r < MROWS; r += gridDim.x * 8) {
        const int b = r >= NT, pp = r - b * NT;
        const float* src = pp < NCTX ? p.ctx + ((size_t)b * NCTX + pp) * DM : p.x + ((size_t)b * NLAT + (pp - NCTX)) * DM;
        f32x4 v[4];
#pragma unroll
        for (int i = 0; i < 4; ++i) { v[i] = *(const f32x4*)(src + lane * 4 + i * 256); *(f32x4*)(XA + (size_t)r * DM + lane * 4 + i * 256) = v[i]; }
        const float* mv = modv + (size_t)(0 * 3 + (pp < NCTX ? 2 : b)) * 6144;
        modulate_store(v, mv, mv + 1024, H + (size_t)r * DM, lane);
    }
}

DI void phase_inproj(const Params& p0, int l, LAS unsigned char* lds) {
    const Params p = launder(p0); l = launder_s(l);
    const bf16_t* H = (const bf16_t*)(p.ws + WS_H);
    const bf16_t* W = (const bf16_t*)(p.ws + WS_WIN) + (size_t)l * INW * DM;
    bf16_t* P = (bf16_t*)(p.ws + WS_P);
    bf16_t* VT = (bf16_t*)(p.ws + WS_VT);
    bf16_t* RKT = (bf16_t*)(p.ws + WS_RKT);
    bf16_t* RVT = (bf16_t*)(p.ws + WS_RVT);
    const f32x2* rope = (const f32x2*)(p.ws + WS_ROPE);
    const int lrow = tid_() >> 3, lch = tid_() & 7;
    constexpr int NTN = INW / 128;
    for (int u = bid_(); u < (MROWS / 128) * NTN; u += gridDim.x) {
        const int tm = u / NTN, tn = u % NTN;
        const bf16_t* a0 = H + (size_t)(tm * 128 + lrow) * DM + lch * 8;
        const bf16_t* b0 = W + (size_t)(tn * 128 + lrow) * DM + lch * 8;
        auto epi = [&](const f32x4 (&acc)[4][2], int wr, int wc, int fr, int fq) {
            const int c0 = tn * 128 + wc * 32;
            const int rbase = tm * 128 + wr * 64;
            if (c0 < C_DV) {
                const float qs = c0 < C_DK ? QSCALE : 1.0f;
                const int axis = (c0 >> 5) & 1;
#pragma unroll
                for (int m = 0; m < 4; ++m)
#pragma unroll
                    for (int j = 0; j < 4; ++j) {
                        const int row = rbase + m * 16 + fq * 4 + j;
                        const int b = row >= NT, pp = row - b * NT;
                        float x1 = acc[m][0][j], x2 = acc[m][1][j], o1 = x1, o2 = x2;
                        if (pp >= NCTX) {
                            const int t = pp - NCTX;
                            const int pos = axis ? (t & 63) : (t >> 6);
                            const f32x2 cs = rope[pos * 16 + fr];
                            o1 = x1 * cs[0] - x2 * cs[1]; o2 = x1 * cs[1] + x2 * cs[0];
                        }
                        P[(size_t)row * INW + c0 + fr] = to_bf16(o1 * qs);
                        P[(size_t)row * INW + c0 + 16 + fr] = to_bf16(o2 * qs);
                    }
            } else {
                const float sc = (c0 >= C_RK && c0 < C_RV) ? 0.125f : 1.0f;
#pragma unroll
                for (int m = 0; m < 4; ++m) {
                    const int row0 = rbase + m * 16 + fq * 4;
                    const int b = row0 >= NT, pp0 = row0 - b * NT;
#pragma unroll
                    for (int n = 0; n < 2; ++n) {
                        const int c = c0 + n * 16 + fr;
                        float o[4];
#pragma unroll
                        for (int j = 0; j < 4; ++j) { o[j] = acc[m][n][j] * sc; P[(size_t)(row0 + j) * INW + c] = to_bf16(o[j]); }
                        bf16_t* tp = nullptr;
                        if (c0 < C_PU) { const int cc = c - C_DV; tp = VT + ((size_t)(b * 4 + (cc >> 7)) * 128 + (cc & 127)) * NT + pp0; }
                        else if (c0 >= C_RK && c0 < C_RV) { const int cc = c - C_RK; tp = RKT + ((size_t)(b * 4 + (cc >> 6)) * 64 + (cc & 63)) * NT + pp0; }
                        else if (c0 >= C_RV && c0 < C_RG) { const int cc = c - C_RV; tp = RVT + ((size_t)(b * 4 + (cc >> 6)) * 64 + (cc & 63)) * NT + pp0; }
                        if (tp) { u32x2 w = {pk_bf16(o[0], o[1]), pk_bf16(o[2], o[3])}; *(u32x2*)tp = w; }
                    }
                }
            }
        };
        gemm128(a0, a0 + (size_t)64 * DM, b0, b0 + (size_t)64 * DM, DM / 64, lds, epi);
    }
}

DI void phase_ret_sum_pool(const Params& p0, int l, LAS unsigned char* lds) {
    const Params p = launder(p0); l = launder_s(l);
    const int tid = tid_(), lane = tid & 63, wid = tid >> 6, fr = lane & 15, g = lane >> 4;
    const float* scal = (const float*)(p.ws + WS_SCAL) + l * 16;
    const bf16_t* RKT = (const bf16_t*)(p.ws + WS_RKT);
    const bf16_t* RVT = (const bf16_t*)(p.ws + WS_RVT);
    float* UF = (float*)(p.ws + WS_UF);
    float* UB = (float*)(p.ws + WS_UB);
    for (int u = bid_(); u < NB * 4 * NCHUNK; u += gridDim.x) {
        const int c = u % NCHUNK, bh = u / NCHUNK, h = bh & 3;
        const int dir = wid >> 2, eb = wid & 3;
        const float l2 = dir ? scal[6 + h] : scal[2 + h];
        const bf16_t* vrow = RVT + ((size_t)bh * 64 + eb * 16 + fr) * NT + c * 128;
        f32x4 acc[4];
#pragma unroll
        for (int db = 0; db < 4; ++db) acc[db] = (f32x4){0.f, 0.f, 0.f, 0.f};
#pragma unroll
        for (int ks = 0; ks < 4; ++ks) {
            const int j0 = ks * 32 + 8 * g;
            const bf16x8 af = *(const bf16x8*)(vrow + j0);
            float w[8];
#pragma unroll
            for (int jj = 0; jj < 8; ++jj) { const int j = j0 + jj; w[jj] = fast_exp2((dir ? (float)j : (float)(127 - j)) * l2); }
#pragma unroll
            for (int db = 0; db < 4; ++db) {
                const u32x4 kr = *(const u32x4*)(RKT + ((size_t)bh * 64 + db * 16 + fr) * NT + c * 128 + j0);
                u32x4 kw;
#pragma unroll
                for (int q = 0; q < 4; ++q) kw[q] = pk_bf16(bf_lo(kr[q]) * w[2 * q], bf_hi(kr[q]) * w[2 * q + 1]);
                acc[db] = MFMA16(af, as_bf16x8(kw), acc[db]);
            }
        }
        const int cidx = dir ? (c >= 2 ? c - 2 : 64 + c) : c;
        float* U = (dir ? UB : UF) + ((size_t)bh * NCHUNK + cidx) * 4096;
#pragma unroll
        for (int db = 0; db < 4; ++db)
#pragma unroll
            for (int j = 0; j < 4; ++j) U[(eb * 16 + 4 * g + j) * 64 + db * 16 + fr] = acc[db][j];
    }
    LAS float* ul = (LAS float*)lds;
    LAS float* dT = ul + 48 * 256;
    const bf16_t* P = (const bf16_t*)(p.ws + WS_P);
    bf16_t* MIX = (bf16_t*)(p.ws + WS_MIX);
    const float* pw = p.pool_w + (size_t)l * 4 * 64 * 64;
    const float* ps = p.pool_scale + l * 256;
    for (int u = bid_(); u < MROWS / 32; u += gridDim.x) {
        const int r0 = u * 32;
        const int b = r0 >= NT, pp0 = r0 - b * NT;
        const int s0 = pp0 < NCTX ? b * NT : b * NT + NCTX, s1 = pp0 < NCTX ? b * NT + NCTX : (b + 1) * NT;
        __syncthreads();
        for (int i = tid; i < 48 * 64; i += NTHREADS) {
            const int rr = i >> 6, c4 = (i & 63) * 4;
            const int row = r0 - 8 + rr;
            f32x4 v = {0.f, 0.f, 0.f, 0.f};
            if (row >= s0 && row < s1) { const u32x2 w = *(const u32x2*)(P + (size_t)row * INW + C_PU + c4); v = (f32x4){bf_lo(w[0]), bf_hi(w[0]), bf_lo(w[1]), bf_hi(w[1])}; }
            *(LAS f32x4*)(ul + rr * 256 + c4) = v;
        }
        __syncthreads();
        for (int i = tid; i < 32 * 256; i += NTHREADS) {
            const int rr = i >> 8, c = i & 255, gi = c >> 6;
            const int w = 2 << gi;
            const int row = r0 + rr;
            int lo = row - w / 2, hi = row + w - w / 2;
            lo = lo < s0 ? s0 : lo; hi = hi > s1 ? s1 : hi;
            float s = 0.f;
            for (int q = lo; q < hi; ++q) s += ul[(q - r0 + 8) * 256 + c];
            dT[c * 36 + rr] = s / (float)(hi - lo) - ul[(rr + 8) * 256 + c];
        }
        __syncthreads();
        {
            const int oc = tid & 255, rh = (tid >> 8) * 16, gi = oc >> 6, e = oc & 63;
            float acc[16];
#pragma unroll
            for (int i = 0; i < 16; ++i) acc[i] = 0.f;
            for (int c = 0; c < 64; ++c) {
                const float wv = pw[(gi * 64 + c) * 64 + e];
                const LAS float* dr = dT + (gi * 64 + c) * 36 + rh;
#pragma unroll
                for (int i = 0; i < 4; ++i) { const f32x4 d = *(const LAS f32x4*)(dr + 4 * i); acc[4 * i] += d[0] * wv; acc[4 * i + 1] += d[1] * wv; acc[4 * i + 2] += d[2] * wv; acc[4 * i + 3] += d[3] * wv; }
            }
            const float sc = ps[oc];
#pragma unroll
            for (int i = 0; i < 16; ++i) MIX[(size_t)(r0 + rh + i) * DM + 512 + oc] = to_bf16(acc[i] * sc);
        }
    }
    __syncthreads();
}

DI void phase_ret_scan(const Params& p0, int l) {
    const Params p = launder(p0); l = launder_s(l);
    const float* scal = (const float*)(p.ws + WS_SCAL) + l * 16;
    const float* UF = (const float*)(p.ws + WS_UF); const float* UB = (const float*)(p.ws + WS_UB);
    float* SF = (float*)(p.ws + WS_SF); float* SB = (float*)(p.ws + WS_SB);
    for (int i = bid_() * NTHREADS + tid_(); i < 2 * NB * 4 * 4096; i += gridDim.x * NTHREADS) {
        const int dir = i / (NB * 4 * 4096), rem = i % (NB * 4 * 4096), bh = rem >> 12, el = rem & 4095, h = bh & 3;
        const float G = fast_exp2(128.0f * (dir ? scal[6 + h] : scal[2 + h]));
        float S = 0.f;
        if (dir == 0) { for (int c = 0; c < NCHUNK; ++c) { const size_t o = ((size_t)bh * NCHUNK + c) * 4096 + el; SF[o] = S; S = S * G + UF[o]; } }
        else { for (int c = NCHUNK - 1; c >= 0; --c) { const size_t o = ((size_t)bh * NCHUNK + c) * 4096 + el; SB[o] = S; S = S * G + UB[o]; } }
    }
}

DI void attn_unit(const Params& p, int b, int h, int q_p0, int ntile, float lam, float oscale, LAS unsigned char* lds) {
    const int tid = tid_(), lane = tid & 63, wid = tid >> 6, map = wid >> 2, wq = wid & 3, r = lane & 31, hh = lane >> 5;
    const bf16_t* P = (const bf16_t*)(p.ws + WS_P);
    const bf16_t* VT = (const bf16_t*)(p.ws + WS_VT);
    bf16_t* MIX = (bf16_t*)(p.ws + WS_MIX);
    const size_t rowbase = (size_t)b * NT;
    const int qrow = q_p0 + wq * 32 + r;
    bf16x8 qf[4];
#pragma unroll
    for (int ks = 0; ks < 4; ++ks) qf[ks] = *(const bf16x8*)(P + (rowbase + qrow) * INW + C_DQ + h * 128 + map * 64 + ks * 16 + hh * 8);
    f32x16 o[4];
#pragma unroll
    for (int eb = 0; eb < 4; ++eb)
#pragma unroll
        for (int i = 0; i < 16; ++i) o[eb][i] = 0.f;
    float m_run = -1e30f, l_run = 0.f;
    const int kkey = tid >> 4, kch = tid & 15, ve = tid >> 3, vch = tid & 7;
    const bf16_t* kg = P + (rowbase + kkey) * INW + C_DK + h * 128 + kch * 8;
    const bf16_t* vg = VT + ((size_t)(b * 4 + h) * 128 + ve) * NT + vch * 8;
    const int kw0 = kkey * 256 + ((kch ^ (kkey & 15)) << 4), kw1 = (kkey + 32) * 256 + ((kch ^ (kkey & 15)) << 4);
    const int vw0 = 16384 + ve * 136 + vch * 16, vw1 = 16384 + (ve + 64) * 136 + vch * 16;
    u32x4 rk0, rk1, rv0, rv1;
    rk0 = *(const u32x4*)kg; rk1 = *(const u32x4*)(kg + (size_t)32 * INW);
    rv0 = *(const u32x4*)vg; rv1 = *(const u32x4*)(vg + (size_t)64 * NT);
    __syncthreads();
    {
        LAS unsigned char* L = lds;
        *(LAS u32x4*)(L + kw0) = rk0; *(LAS u32x4*)(L + kw1) = rk1;
        *(LAS u32x2*)(L + vw0) = (u32x2){rv0[0], rv0[1]}; *(LAS u32x2*)(L + vw0 + 8) = (u32x2){rv0[2], rv0[3]};
        *(LAS u32x2*)(L + vw1) = (u32x2){rv1[0], rv1[1]}; *(LAS u32x2*)(L + vw1 + 8) = (u32x2){rv1[2], rv1[3]};
    }
    __syncthreads();
    for (int kt = 0; kt < ntile; ++kt) {
        const bool more = kt + 1 < ntile;
        if (more) {
            const bf16_t* kg2 = kg + (size_t)(kt + 1) * 64 * INW;
            const bf16_t* vg2 = vg + (kt + 1) * 64;
            rk0 = *(const u32x4*)kg2; rk1 = *(const u32x4*)(kg2 + (size_t)32 * INW);
            rv0 = *(const u32x4*)vg2; rv1 = *(const u32x4*)(vg2 + (size_t)64 * NT);
        }
        LAS unsigned char* L = lds + (kt & 1) * 33792;
        f32x16 s0, s1;
#pragma unroll
        for (int i = 0; i < 16; ++i) { s0[i] = 0.f; s1[i] = 0.f; }
#pragma unroll
        for (int ks = 0; ks < 4; ++ks) {
            const int ch = map * 8 + ks * 2 + hh;
            const int off = r * 256 + ((ch ^ (r & 15)) << 4);
            const bf16x8 a0 = *(LAS bf16x8*)(L + off);
            const bf16x8 a1 = *(LAS bf16x8*)(L + off + 32 * 256);
            s0 = MFMA32(a0, qf[ks], s0);
            s1 = MFMA32(a1, qf[ks], s1);
        }
        float mx = s0[0];
#pragma unroll
        for (int i = 1; i < 16; ++i) mx = fmaxf(mx, s0[i]);
#pragma unroll
        for (int i = 0; i < 16; ++i) mx = fmaxf(mx, s1[i]);
        mx = fmaxf(mx, __shfl_xor(mx, 32));
        const float m_new = fmaxf(m_run, mx);
        const float alpha = fast_exp2(m_run - m_new);
        m_run = m_new;
        float rs = 0.f;
#pragma unroll
        for (int i = 0; i < 16; ++i) { s0[i] = fast_exp2(s0[i] - m_new); rs += s0[i]; }
#pragma unroll
        for (int i = 0; i < 16; ++i) { s1[i] = fast_exp2(s1[i] - m_new); rs += s1[i]; }
        l_run = l_run * alpha + rs;
#pragma unroll
        for (int eb = 0; eb < 4; ++eb)
#pragma unroll
            for (int i = 0; i < 16; ++i) o[eb][i] *= alpha;
#pragma unroll
        for (int s = 0; s < 4; ++s) {
            u32x4 pw;
#pragma unroll
            for (int q = 0; q < 4; ++q) pw[q] = (s >> 1) ? pk_bf16(s1[(s & 1) * 8 + 2 * q], s1[(s & 1) * 8 + 2 * q + 1]) : pk_bf16(s0[(s & 1) * 8 + 2 * q], s0[(s & 1) * 8 + 2 * q + 1]);
            const bf16x8 pb = as_bf16x8(pw);
            const int key0 = (s >> 1) * 32 + (s & 1) * 16 + 4 * hh;
#pragma unroll
            for (int eb = 0; eb < 4; ++eb) {
                const LAS unsigned char* vp = L + 16384 + (eb * 32 + r) * 136 + key0 * 2;
                const u32x2 v0 = *(const LAS u32x2*)vp, v1 = *(const LAS u32x2*)(vp + 16);
                const u32x4 va = {v0[0], v0[1], v1[0], v1[1]};
                o[eb] = MFMA32(as_bf16x8(va), pb, o[eb]);
            }
        }
        if (more) {
            LAS unsigned char* L2 = lds + ((kt + 1) & 1) * 33792;
            *(LAS u32x4*)(L2 + kw0) = rk0; *(LAS u32x4*)(L2 + kw1) = rk1;
            *(LAS u32x2*)(L2 + vw0) = (u32x2){rv0[0], rv0[1]}; *(LAS u32x2*)(L2 + vw0 + 8) = (u32x2){rv0[2], rv0[3]};
            *(LAS u32x2*)(L2 + vw1) = (u32x2){rv1[0], rv1[1]}; *(LAS u32x2*)(L2 + vw1 + 8) = (u32x2){rv1[2], rv1[3]};
        }
        __syncthreads();
    }
    const float lt = l_run + __shfl_xor(l_run, 32);
    const float inv = 1.0f / lt;
    LAS float* X = (LAS float*)lds;
    if (map == 1) {
#pragma unroll
        for (int eb = 0; eb < 4; ++eb)
#pragma unroll
            for (int i = 0; i < 16; ++i) X[(wq * 64 + eb * 16 + i) * 64 + lane] = o[eb][i] * inv;
    }
    __syncthreads();
    if (map == 0) {
        float ss = 0.f;
#pragma unroll
        for (int eb = 0; eb < 4; ++eb)
#pragma unroll
            for (int i = 0; i < 16; ++i) { const float v = o[eb][i] * inv - lam * X[(wq * 64 + eb * 16 + i) * 64 + lane]; o[eb][i] = v; ss += v * v; }
        ss += __shfl_xor(ss, 32);
        const float sc = rsqrtf(ss * (1.0f / 128.0f) + RMS_EPS) * oscale;
        bf16_t* dst = MIX + (rowbase + qrow) * DM + h * 128;
#pragma unroll
        for (int eb = 0; eb < 4; ++eb)
#pragma unroll
            for (int q = 0; q < 4; ++q) {
                const int e = eb * 32 + 8 * q + 4 * hh;
                u32x2 w = {pk_bf16(o[eb][4 * q] * sc, o[eb][4 * q + 1] * sc), pk_bf16(o[eb][4 * q + 2] * sc, o[eb][4 * q + 3] * sc)};
                *(u32x2*)(dst + e) = w;
            }
    }
    __syncthreads();
}

DI void ret_unit(const Params& p, int l, int b, int h, int c) {
    const int tid = tid_(), lane = tid & 63, wid = tid >> 6, fr = lane & 15, g = lane >> 4;
    const float* scal = (const float*)(p.ws + WS_SCAL) + l * 16;
    const float lf2 = scal[2 + h], lb2 = scal[6 + h];
    const bf16_t* P = (const bf16_t*)(p.ws + WS_P);
    const bf16_t* RVT = (const bf16_t*)(p.ws + WS_RVT);
    const float* SF = (const float*)(p.ws + WS_SF); const float* SB = (const float*)(p.ws + WS_SB);
    bf16_t* MIX = (bf16_t*)(p.ws + WS_MIX);
    const int bh = b * 4 + h;
    const size_t row0 = (size_t)b * NT + c * 128;
    const int iloc = wid * 16 + fr;
    u32x4 qraw[2];
#pragma unroll
    for (int ks = 0; ks < 2; ++ks) qraw[ks] = *(const u32x4*)(P + (row0 + iloc) * INW + C_RQ + h * 64 + ks * 32 + 8 * g);
    f32x4 st[8];
#pragma unroll
    for (int jb = 0; jb < 8; ++jb) {
        st[jb] = (f32x4){0.f, 0.f, 0.f, 0.f};
#pragma unroll
        for (int ks = 0; ks < 2; ++ks) {
            const bf16x8 kf = *(const bf16x8*)(P + (row0 + jb * 16 + fr) * INW + C_RK + h * 64 + ks * 32 + 8 * g);
            st[jb] = MFMA16(kf, as_bf16x8(qraw[ks]), st[jb]);
        }
    }
#pragma unroll
    for (int jb = 0; jb < 8; ++jb)
#pragma unroll
        for (int q = 0; q < 4; ++q) {
            const int j = jb * 16 + 4 * g + q;
            const int d = iloc - j;
            const float w = d > 0 ? fast_exp2((float)d * lf2) : (d < 0 ? fast_exp2((float)(-d) * lb2) : 2.0f);
            st[jb][q] *= w;
        }
    f32x4 ot[4];
#pragma unroll
    for (int eb = 0; eb < 4; ++eb) ot[eb] = (f32x4){0.f, 0.f, 0.f, 0.f};
#pragma unroll
    for (int jj = 0; jj < 4; ++jj) {
        const u32x4 pw = {pk_bf16(st[2 * jj][0], st[2 * jj][1]), pk_bf16(st[2 * jj][2], st[2 * jj][3]), pk_bf16(st[2 * jj + 1][0], st[2 * jj + 1][1]), pk_bf16(st[2 * jj + 1][2], st[2 * jj + 1][3])};
#pragma unroll
        for (int eb = 0; eb < 4; ++eb) {
            const bf16_t* vp = RVT + ((size_t)bh * 64 + eb * 16 + fr) * NT + c * 128 + jj * 32 + 4 * g;
            const u32x2 v0 = *(const u32x2*)vp, v1 = *(const u32x2*)(vp + 16);
            const u32x4 va = {v0[0], v0[1], v1[0], v1[1]};
            ot[eb] = MFMA16(as_bf16x8(va), as_bf16x8(pw), ot[eb]);
        }
    }
    const float df = fast_exp2((float)(iloc + 1) * lf2), db = fast_exp2((float)(128 - iloc) * lb2);
    const int vc = c >= 2 ? c - 2 : 64 + c;
    const float* sf = SF + ((size_t)bh * NCHUNK + c) * 4096;
    const float* sb = SB + ((size_t)bh * NCHUNK + vc) * 4096;
#pragma unroll
    for (int ks = 0; ks < 2; ++ks) {
        u32x4 qf, qb;
#pragma unroll
        for (int q = 0; q < 4; ++q) { const float a = bf_lo(qraw[ks][q]), bb = bf_hi(qraw[ks][q]); qf[q] = pk_bf16(a * df, bb * df); qb[q] = pk_bf16(a * db, bb * db); }
#pragma unroll
        for (int eb = 0; eb < 4; ++eb) {
            const float* s1 = sf + (eb * 16 + fr) * 64 + ks * 32 + 8 * g;
            const float* s2 = sb + (eb * 16 + fr) * 64 + ks * 32 + 8 * g;
            const f32x4 a0 = *(const f32x4*)s1, a1 = *(const f32x4*)(s1 + 4), c0 = *(const f32x4*)s2, c1 = *(const f32x4*)(s2 + 4);
            const u32x4 sa = {pk_bf16(a0[0], a0[1]), pk_bf16(a0[2], a0[3]), pk_bf16(a1[0], a1[1]), pk_bf16(a1[2], a1[3])};
            const u32x4 sc = {pk_bf16(c0[0], c0[1]), pk_bf16(c0[2], c0[3]), pk_bf16(c1[0], c1[1]), pk_bf16(c1[2], c1[3])};
            ot[eb] = MFMA16(as_bf16x8(sa), as_bf16x8(qf), ot[eb]);
            ot[eb] = MFMA16(as_bf16x8(sc), as_bf16x8(qb), ot[eb]);
        }
    }
    float s = 0.f;
#pragma unroll
    for (int eb = 0; eb < 4; ++eb) s += (ot[eb][0] + ot[eb][1]) + (ot[eb][2] + ot[eb][3]);
    s += __shfl_xor(s, 16); s += __shfl_xor(s, 32);
    const float mu = s * (1.0f / 64.0f);
    float q2 = 0.f;
#pragma unroll
    for (int eb = 0; eb < 4; ++eb)
#pragma unroll
        for (int q = 0; q < 4; ++q) { const float d = ot[eb][q] - mu; q2 += d * d; }
    q2 += __shfl_xor(q2, 16); q2 += __shfl_xor(q2, 32);
    const float rstd = rsqrtf(q2 * (1.0f / 64.0f) + LN_EPS);
#pragma unroll
    for (int eb = 0; eb < 4; ++eb) {
        const int e = eb * 16 + 4 * g;
        const u32x2 gw = *(const u32x2*)(P + (row0 + iloc) * INW + C_RG + h * 64 + e);
        const float g0 = bf_lo(gw[0]), g1 = bf_hi(gw[0]), g2 = bf_lo(gw[1]), g3 = bf_hi(gw[1]);
        u32x2 w = {pk_bf16((ot[eb][0] - mu) * rstd * silu_f(g0), (ot[eb][1] - mu) * rstd * silu_f(g1)),
                   pk_bf16((ot[eb][2] - mu) * rstd * silu_f(g2), (ot[eb][3] - mu) * rstd * silu_f(g3))};
        *(u32x2*)(MIX + (row0 + iloc) * DM + 768 + h * 64 + e) = w;
    }
}

DI void phase_attn(const Params& p0, int l, LAS unsigned char* lds) {
    const Params p = launder(p0); l = launder_s(l);
    const float* scal = (const float*)(p.ws + WS_SCAL) + l * 16;
    const float lam = scal[0], oscale = scal[1];
    const int nunits = NB * 4 * 64 + (l == 0 ? NB * 4 * 2 : 0);
    for (int u = bid_(); u < nunits; u += gridDim.x) {
        int b, h, q0, ntile;
        if (u < NB * 4 * 64) { const int qt = u & 63; h = (u >> 6) & 3; b = u >> 8; q0 = NCTX + qt * 128; ntile = NT / 64; }
        else { const int v = u - NB * 4 * 64; const int qt = v & 1; h = (v >> 1) & 3; b = v >> 3; q0 = qt * 128; ntile = NCTX / 64; }
        attn_unit(p, b, h, q0, ntile, lam, oscale, lds);
    }
}
DI void phase_ret(const Params& p0, int l) {
    const Params p = launder(p0); l = launder_s(l);
    for (int u = bid_(); u < NB * 4 * NCHUNK; u += gridDim.x) {
        const int c = u % NCHUNK, bh = u / NCHUNK;
        if (l == 1 && c < 2) continue;
        ret_unit(p, l, bh >> 2, bh & 3, c);
    }
}

DI void phase_outproj(const Params& p0, int l, LAS unsigned char* lds) {
    const Params p = launder(p0); l = launder_s(l);
    const float* Xin = (const float*)(p.ws + WS_XA);
    const bf16_t* A = (const bf16_t*)(p.ws + WS_MIX);
    const bf16_t* W = (const bf16_t*)(p.ws + WS_WOUT) + (size_t)l * DM * DM;
    float* V1 = (float*)(p.ws + WS_V1);
    const float* modv = (const float*)(p.ws + WS_MODV) + (size_t)l * 3 * 6144;
    const int lrow = tid_() >> 3, lch = tid_() & 7;
    for (int u = bid_(); u < (MROWS / 128) * 8; u += gridDim.x) {
        const int tm = u >> 3, tn = u & 7;
        const bf16_t* a0 = A + (size_t)(tm * 128 + lrow) * DM + lch * 8;
        const bf16_t* b0 = W + (size_t)(tn * 128 + lrow) * DM + lch * 8;
        auto epi = [&](const f32x4 (&acc)[4][2], int wr, int wc, int fr, int fq) {
#pragma unroll
            for (int m = 0; m < 4; ++m)
#pragma unroll
                for (int j = 0; j < 4; ++j) {
                    const int row = tm * 128 + wr * 64 + m * 16 + fq * 4 + j;
                    const float* g2 = modv + (size_t)row_sel(row) * 6144 + 2 * 1024;
#pragma unroll
                    for (int n = 0; n < 2; ++n) {
                        const int c = tn * 128 + wc * 32 + n * 16 + fr;
                        V1[(size_t)row * DM + c] = DN_ALPHA * Xin[(size_t)row * DM + c] + g2[c] * acc[m][n][j];
                    }
                }
        };
        gemm128(a0, a0 + (size_t)64 * DM, b0, b0 + (size_t)64 * DM, DM / 64, lds, epi);
    }
}

DI void phase_ln_mid(const Params& p0, int l) {
    const Params p = launder(p0); l = launder_s(l);
    float* Xout = (float*)(p.ws + WS_XB);
    const int lane = tid_() & 63, wid = tid_() >> 6;
    const float* V1 = (const float*)(p.ws + WS_V1);
    bf16_t* TOK = (bf16_t*)(p.ws + WS_TOK);
    const float* modv = (const float*)(p.ws + WS_MODV) + (size_t)l * 3 * 6144;
    const float* lg = p.ln_g + (size_t)(l * 2 + 0) * DM; const float* lb = p.ln_b + (size_t)(l * 2 + 0) * DM;
    for (int r = bid_() * 8 + wid; r < MROWS; r += gridDim.x * 8) {
        f32x4 v[4];
#pragma unroll
        for (int i = 0; i < 4; ++i) v[i] = *(const f32x4*)(V1 + (size_t)r * DM + lane * 4 + i * 256);
        float mu, rstd; ln_stats(v, mu, rstd);
#pragma unroll
        for (int i = 0; i < 4; ++i) {
            const int c = lane * 4 + i * 256;
            const f32x4 gg = *(const f32x4*)(lg + c), bb = *(const f32x4*)(lb + c);
#pragma unroll
            for (int j = 0; j < 4; ++j) v[i][j] = (v[i][j] - mu) * rstd * gg[j] + bb[j];
            *(f32x4*)(Xout + (size_t)r * DM + c) = v[i];
        }
        const float* mv = modv + (size_t)row_sel(r) * 6144;
        modulate_store(v, mv + 3 * 1024, mv + 4 * 1024, TOK + (size_t)r * DM, lane);
    }
}

DI void phase_router(const Params& p0, int l, LAS unsigned char* lds) {
    const Params p = launder(p0); l = launder_s(l);
    const bf16_t* A = (const bf16_t*)(p.ws + WS_TOK);
    const bf16_t* W = (const bf16_t*)(p.ws + WS_WR) + (size_t)l * 256 * DM;
    float* LG = (float*)(p.ws + WS_LOGIT);
    const int lrow = tid_() >> 3, lch = tid_() & 7;
    for (int u = bid_(); u < (MROWS / 128) * 2; u += gridDim.x) {
        const int tm = u >> 1, tn = u & 1;
        const bf16_t* a0 = A + (size_t)(tm * 128 + lrow) * DM + lch * 8;
        const bf16_t* b0 = W + (size_t)(tn * 128 + lrow) * DM + lch * 8;
        auto epi = [&](const f32x4 (&acc)[4][2], int wr, int wc, int fr, int fq) {
#pragma unroll
            for (int m = 0; m < 4; ++m)
#pragma unroll
                for (int j = 0; j < 4; ++j)
#pragma unroll
                    for (int n = 0; n < 2; ++n)
                        LG[(size_t)(tm * 128 + wr * 64 + m * 16 + fq * 4 + j) * 256 + tn * 128 + wc * 32 + n * 16 + fr] = acc[m][n][j];
        };
        gemm128(a0, a0 + (size_t)64 * DM, b0, b0 + (size_t)64 * DM, DM / 64, lds, epi);
    }
}

DI void phase_topk(const Params& p0, int l) {
    const Params p = launder(p0); l = launder_s(l);
    const int lane = tid_() & 63, wid = tid_() >> 6;
    const float* LG = (const float*)(p.ws + WS_LOGIT);
    const float* bias = p.router_bias + l * 256;
    int* EIDX = (int*)(p.ws + WS_EIDX); float* GATE = (float*)(p.ws + WS_GATE);
    int* counts = (int*)(p.ws + CTL_COUNTS) + l * 256;
    const f32x4 bv = *(const f32x4*)(bias + lane * 4);
    for (int r = bid_() * 8 + wid; r < MROWS; r += gridDim.x * 8) {
        const f32x4 lg = *(const f32x4*)(LG + (size_t)r * 256 + lane * 4);
        float sc[4], gv[4];
#pragma unroll
        for (int i = 0; i < 4; ++i) { sc[i] = 1.0f / (1.0f + __expf(-lg[i])); gv[i] = sc[i] + bv[i]; }
        float a1 = fmaxf(gv[0], gv[1]), a2 = fminf(gv[0], gv[1]);
        { const float b1 = fmaxf(gv[2], gv[3]), b2 = fminf(gv[2], gv[3]); const float n1 = fmaxf(a1, b1), n2 = fmaxf(fminf(a1, b1), fmaxf(a2, b2)); a1 = n1; a2 = n2; }
#pragma unroll
        for (int o = 1; o < 8; o <<= 1) { const float b1 = __shfl_xor(a1, o), b2 = __shfl_xor(a2, o); const float n1 = fmaxf(a1, b1), n2 = fmaxf(fminf(a1, b1), fmaxf(a2, b2)); a1 = n1; a2 = n2; }
        const float gs = a1 + a2;
        const int myg = lane >> 3;
        int rank = 0;
#pragma unroll
        for (int g2 = 0; g2 < 8; ++g2) { const float o = __shfl(gs, g2 * 8); rank += (o > gs || (o == gs && g2 < myg)) ? 1 : 0; }
        const bool ok = rank < 4;
        float cv[4];
#pragma unroll
        for (int i = 0; i < 4; ++i) cv[i] = ok ? gv[i] : -INFINITY;
        float ssum = 0.f; float mysc = 0.f; int myidx = 0;
        for (int k = 0; k < TOPK; ++k) {
            float bvl = cv[0]; int bi = 0;
#pragma unroll
            for (int i = 1; i < 4; ++i) if (cv[i] > bvl) { bvl = cv[i]; bi = i; }
            int gi = lane * 4 + bi;
#pragma unroll
            for (int o = 1; o < 64; o <<= 1) {
                const float ov = __shfl_xor(bvl, o); const int oi = __shfl_xor(gi, o);
                if (ov > bvl || (ov == bvl && oi < gi)) { bvl = ov; gi = oi; }
            }
            const int owner = gi >> 2, oi = gi & 3;
            float s_own = 0.f;
#pragma unroll
            for (int i = 0; i < 4; ++i) if (i == oi) s_own = sc[i];
            const float ssel = __shfl(s_own, owner);
            if (lane == owner) {
#pragma unroll
                for (int i = 0; i < 4; ++i) if (i == oi) cv[i] = -INFINITY;
            }
            ssum += ssel;
            if (lane == k) { mysc = ssel; myidx = gi; }
        }
        if (lane < TOPK) {
            EIDX[(size_t)r * 8 + lane] = myidx;
            GATE[(size_t)r * 8 + lane] = mysc / ssum * 2.5f;
            atomicAdd(&counts[myidx], 1);
        }
    }
}

DI void phase_scatter(const Params& p0, int l, LAS unsigned char* lds) {
    const Params p = launder(p0); l = launder_s(l);
    LAS int* off = (LAS int*)lds;
    LAS int* toff = off + 260;
    const int tid = tid_();
    const int* counts = (const int*)(p.ws + CTL_COUNTS) + l * 256;
    int* cursor = (int*)(p.ws + CTL_CURSOR) + l * 256;
    int* ntl = (int*)(p.ws + CTL_NTILES) + l;
    int* TILES = (int*)(p.ws + WS_TILES);
    const int* EIDX = (const int*)(p.ws + WS_EIDX);
    int* SORT = (int*)(p.ws + WS_SORT);
    if (tid == 0) {
        int a = 0, t = 0;
        for (int e = 0; e < 256; ++e) { off[e] = a; toff[e] = t; const int c = __hip_atomic_load(counts + e, __ATOMIC_RELAXED, __HIP_MEMORY_SCOPE_AGENT); a += c; t += (c + 127) >> 7; }
        off[256] = a; toff[256] = t;
    }
    __syncthreads();
    if (bid_() == 0) {
        if (tid < 256) {
            const int e = tid, c = off[e + 1] - off[e], nt = toff[e + 1] - toff[e];
            for (int t = 0; t < nt; ++t) { int* T = TILES + (size_t)(toff[e] + t) * 4; T[0] = e; T[1] = off[e] + t * 128; T[2] = (c - t * 128) < 128 ? (c - t * 128) : 128; T[3] = 0; }
        }
        if (tid == 0) *ntl = toff[256];
    }
    for (int a = bid_() * NTHREADS + tid; a < NASG; a += gridDim.x * NTHREADS) {
        const int e = EIDX[a];
        const int pos = off[e] + atomicAdd(&cursor[e], 1);
        SORT[pos] = a;
    }
    __syncthreads();
}

DI void phase_moe_up(const Params& p0, int l, LAS unsigned char* lds) {
    const Params p = launder(p0); l = launder_s(l);
    const bf16_t* TOK = (const bf16_t*)(p.ws + WS_TOK);
    const bf16_t* WE = (const bf16_t*)(p.ws + WS_WEGU) + (size_t)l * NEXP * 512 * DM;
    const bf16_t* WS_ = (const bf16_t*)(p.ws + WS_WSGU) + (size_t)l * 512 * DM;
    bf16_t* HB = (bf16_t*)(p.ws + WS_HBUF); bf16_t* HS = (bf16_t*)(p.ws + WS_HSH);
    const int* TILES = (const int*)(p.ws + WS_TILES);
    const int* SORT = (const int*)(p.ws + WS_SORT);
    const int ntl = *((const int*)(p.ws + CTL_NTILES) + l);
    const int lrow = tid_() >> 3, lch = tid_() & 7;
    const int nunits = ntl * 4 + (MROWS / 128) * 4;
    for (int u = bid_(); u < nunits; u += gridDim.x) {
        const bf16_t *a0, *a1, *b0; bf16_t* hout; int nr, nt;
        if (u < ntl * 4) {
            const int t = u >> 2; nt = u & 3;
            const int e = TILES[t * 4], r0 = TILES[t * 4 + 1]; nr = TILES[t * 4 + 2];
            a0 = lrow < nr ? TOK + (size_t)(SORT[r0 + lrow] >> 3) * DM + lch * 8 : nullptr;
            a1 = lrow + 64 < nr ? TOK + (size_t)(SORT[r0 + lrow + 64] >> 3) * DM + lch * 8 : nullptr;
            b0 = WE + ((size_t)e * 512 + nt * 128 + lrow) * DM + lch * 8;
            hout = HB + (size_t)r0 * 256;
        } else {
            const int v = u - ntl * 4, tm = v >> 2; nt = v & 3; nr = 128;
            a0 = TOK + (size_t)(tm * 128 + lrow) * DM + lch * 8; a1 = a0 + (size_t)64 * DM;
            b0 = WS_ + (size_t)(nt * 128 + lrow) * DM + lch * 8;
            hout = HS + (size_t)tm * 128 * 256;
        }
        auto epi = [&](const f32x4 (&acc)[4][2], int wr, int wc, int fr, int fq) {
#pragma unroll
            for (int m = 0; m < 4; ++m)
#pragma unroll
                for (int j = 0; j < 4; ++j) {
                    const int row = wr * 64 + m * 16 + fq * 4 + j;
                    if (row < nr) hout[(size_t)row * 256 + nt * 64 + wc * 16 + fr] = to_bf16(silu_f(acc[m][0][j]) * acc[m][1][j]);
                }
        };
        gemm128(a0, a1, b0, b0 + (size_t)64 * DM, DM / 64, lds, epi);
    }
}

DI void phase_moe_down(const Params& p0, int l, LAS unsigned char* lds) {
    const Params p = launder(p0); l = launder_s(l);
    const bf16_t* WE = (const bf16_t*)(p.ws + WS_WEDN) + (size_t)l * NEXP * DM * 256;
    const bf16_t* WS_ = (const bf16_t*)(p.ws + WS_WSDN) + (size_t)l * DM * 256;
    const bf16_t* HB = (const bf16_t*)(p.ws + WS_HBUF); const bf16_t* HS = (const bf16_t*)(p.ws + WS_HSH);
    bf16_t* YSL = (bf16_t*)(p.ws + WS_YSLOT); bf16_t* YSH = (bf16_t*)(p.ws + WS_YSH);
    const int* TILES = (const int*)(p.ws + WS_TILES);
    const int* SORT = (const int*)(p.ws + WS_SORT);
    const int ntl = *((const int*)(p.ws + CTL_NTILES) + l);
    const int lrow = tid_() >> 3, lch = tid_() & 7;
    const int nunits = ntl * 8 + (MROWS / 128) * 8;
    for (int u = bid_(); u < nunits; u += gridDim.x) {
        const bf16_t *a0, *a1, *b0; int nr, nt, r0; bool routed;
        if (u < ntl * 8) {
            const int t = u >> 3; nt = u & 7; routed = true;
            const int e = TILES[t * 4]; r0 = TILES[t * 4 + 1]; nr = TILES[t * 4 + 2];
            a0 = lrow < nr ? HB + (size_t)(r0 + lrow) * 256 + lch * 8 : nullptr;
            a1 = lrow + 64 < nr ? HB + (size_t)(r0 + lrow + 64) * 256 + lch * 8 : nullptr;
            b0 = WE + ((size_t)e * DM + nt * 128 + lrow) * 256 + lch * 8;
        } else {
            const int v = u - ntl * 8; r0 = (v >> 3) * 128; nt = v & 7; nr = 128; routed = false;
            a0 = HS + (size_t)(r0 + lrow) * 256 + lch * 8; a1 = a0 + (size_t)64 * 256;
            b0 = WS_ + (size_t)(nt * 128 + lrow) * 256 + lch * 8;
        }
        auto epi = [&](const f32x4 (&acc)[4][2], int wr, int wc, int fr, int fq) {
#pragma unroll
            for (int m = 0; m < 4; ++m)
#pragma unroll
                for (int j = 0; j < 4; ++j) {
                    const int row = wr * 64 + m * 16 + fq * 4 + j;
                    if (row < nr) {
                        bf16_t* dst = routed ? YSL + (size_t)SORT[r0 + row] * DM : YSH + (size_t)(r0 + row) * DM;
#pragma unroll
                        for (int n = 0; n < 2; ++n) dst[nt * 128 + wc * 32 + n * 16 + fr] = to_bf16(acc[m][n][j]);
                    }
                }
        };
        gemm128(a0, a1, b0, b0 + (size_t)64 * 256, 256 / 64, lds, epi);
    }
}

DI void phase_combine(const Params& p0, int l) {
    const Params p = launder(p0); l = launder_s(l);
    const float* X1 = (const float*)(p.ws + WS_XB); float* Xnext = (float*)(p.ws + WS_XA);
    const int lane = tid_() & 63, wid = tid_() >> 6;
    const bf16_t* YSL = (const bf16_t*)(p.ws + WS_YSLOT); const bf16_t* YSH = (const bf16_t*)(p.ws + WS_YSH);
    const float* GATE = (const float*)(p.ws + WS_GATE);
    const float* modv = (const float*)(p.ws + WS_MODV);
    const float* lg = p.ln_g + (size_t)(l * 2 + 1) * DM; const float* lb = p.ln_b + (size_t)(l * 2 + 1) * DM;
    bf16_t* H = (bf16_t*)(p.ws + WS_H);
    for (int r = bid_() * 8 + wid; r < MROWS; r += gridDim.x * 8) {
        const int b = r >= NT, pp = r - b * NT;
        if (l == 1 && pp < NCTX) continue;
        const int sel = pp < NCTX ? 2 : b;
        float gt[8];
#pragma unroll
        for (int k = 0; k < 8; ++k) gt[k] = GATE[(size_t)r * 8 + k];
        const float* g5 = modv + ((size_t)l * 3 + sel) * 6144 + 5 * 1024;
        f32x4 v[4];
#pragma unroll
        for (int i = 0; i < 4; ++i) {
            const int c = lane * 4 + i * 256;
            const u32x2 sw = *(const u32x2*)(YSH + (size_t)r * DM + c);
            float f0 = bf_lo(sw[0]), f1 = bf_hi(sw[0]), f2 = bf_lo(sw[1]), f3 = bf_hi(sw[1]);
#pragma unroll
            for (int k = 0; k < 8; ++k) {
                const u32x2 w = *(const u32x2*)(YSL + ((size_t)r * 8 + k) * DM + c);
                f0 += gt[k] * bf_lo(w[0]); f1 += gt[k] * bf_hi(w[0]); f2 += gt[k] * bf_lo(w[1]); f3 += gt[k] * bf_hi(w[1]);
            }
            const f32x4 xv = *(const f32x4*)(X1 + (size_t)r * DM + c), gv = *(const f32x4*)(g5 + c);
            v[i] = (f32x4){DN_ALPHA * xv[0] + gv[0] * f0, DN_ALPHA * xv[1] + gv[1] * f1, DN_ALPHA * xv[2] + gv[2] * f2, DN_ALPHA * xv[3] + gv[3] * f3};
        }
        float mu, rstd; ln_stats(v, mu, rstd);
#pragma unroll
        for (int i = 0; i < 4; ++i) {
            const int c = lane * 4 + i * 256;
            const f32x4 gg = *(const f32x4*)(lg + c), bb = *(const f32x4*)(lb + c);
#pragma unroll
            for (int j = 0; j < 4; ++j) v[i][j] = (v[i][j] - mu) * rstd * gg[j] + bb[j];
            if (l == 1) *(f32x4*)(p.out + ((size_t)b * NLAT + (pp - NCTX)) * DM + c) = v[i];
            else *(f32x4*)(Xnext + (size_t)r * DM + c) = v[i];
        }
        if (l == 0) { const float* mv = modv + ((size_t)1 * 3 + sel) * 6144; modulate_store(v, mv, mv + 1024, H + (size_t)r * DM, lane); }
    }
}

constexpr int PH_PER_LAYER = 12, N_PHASES = 3 + 2 * PH_PER_LAYER;
__global__ void __launch_bounds__(NTHREADS, 2) mega(Params p) {
    extern __shared__ __attribute__((aligned(16))) unsigned char lds_raw[];
    LAS unsigned char* lds = (LAS unsigned char*)lds_raw;
    volatile LAS unsigned* bst = (volatile LAS unsigned*)(lds + LDS_BYTES - 16);
    if (threadIdx.x == 0) { bst[0] = 0u; bst[1] = 0u; bst[2] = 0u; bst[3] = 0u; }
    __syncthreads();
    const int lo = p.ph_lo, hi = p.ph_hi;
    XcdBarrier bar; bar.bar = (unsigned*)(p.ws + WS_CTL); bar.x = 0; bar.st = bst;
    if (hi - lo > 1) bar = xcd_barrier_post((unsigned*)(p.ws + WS_CTL), bst);
#ifndef ONLY_PHASE
#define ONLY_PHASE -1
#endif
#define IN(k) (lo <= (k) && (k) < hi)
#define ON(pid) (ONLY_PHASE < 0 || ONLY_PHASE == (pid))
#define SEAM(k) do { if (IN(k) && IN((k) + 1)) xcd_barrier(bar); } while (0)
    if (ON(0) && IN(0)) phase_convert(p, lds);
    SEAM(0);
    if (ON(1) && IN(1)) phase_mod(p, lds);
    SEAM(1);
    if (ON(2) && IN(2)) phase_ln0(p);
    SEAM(2);
    for (int l = 0; l < 2; ++l) {
        const int k0 = 3 + l * PH_PER_LAYER;
        if (ON(3) && IN(k0 + 0)) phase_inproj(p, l, lds);
        SEAM(k0 + 0);
        if (ON(4) && IN(k0 + 1)) phase_ret_sum_pool(p, l, lds);
        SEAM(k0 + 1);
        if (ON(5) && IN(k0 + 2)) phase_ret_scan(p, l);
        SEAM(k0 + 2);
        if (ON(6) && IN(k0 + 3)) { phase_attn(p, l, lds); phase_ret(p, l); }
        SEAM(k0 + 3);
        if (ON(7) && IN(k0 + 4)) phase_outproj(p, l, lds);
        SEAM(k0 + 4);
        if (ON(8) && IN(k0 + 5)) phase_ln_mid(p, l);
        SEAM(k0 + 5);
        if (ON(9) && IN(k0 + 6)) phase_router(p, l, lds);
        SEAM(k0 + 6);
        if (ON(10) && IN(k0 + 7)) phase_topk(p, l);
        SEAM(k0 + 7);
        if (ON(11) && IN(k0 + 8)) phase_scatter(p, l, lds);
        SEAM(k0 + 8);
        if (ON(12) && IN(k0 + 9)) phase_moe_up(p, l, lds);
        SEAM(k0 + 9);
        if (ON(13) && IN(k0 + 10)) phase_moe_down(p, l, lds);
        SEAM(k0 + 10);
        if (ON(14) && IN(k0 + 11)) phase_combine(p, l);
        if (l == 0) SEAM(k0 + 11);
    }
#undef IN
#undef SEAM
}

extern "C" void kernel_launch(void* const* d_in, const int* in_sizes, int n_in, void* d_out, int out_size, void* d_ws, size_t ws_size, hipStream_t stream) {
    static int grid = 0;
    if (grid == 0) {
        if (n_in != 20 || ws_size < WS_END || out_size != NB * NLAT * DM) { fprintf(stderr, "kernel_launch: unexpected shapes (n_in %d, ws %zu need %zu, out %d)\n", n_in, ws_size, (size_t)WS_END, out_size); grid = -1; return; }
        int dev = 0, cus = 0, per_cu = 0;
        hipGetDevice(&dev); hipDeviceGetAttribute(&cus, hipDeviceAttributeMultiprocessorCount, dev);
        if (hipFuncSetAttribute((const void*)mega, hipFuncAttributeMaxDynamicSharedMemorySize, LDS_BYTES) != hipSuccess) { fprintf(stderr, "kernel_launch: hipFuncSetAttribute failed\n"); grid = -1; return; }
        if (hipOccupancyMaxActiveBlocksPerMultiprocessor(&per_cu, (const void*)mega, NTHREADS, LDS_BYTES) != hipSuccess || per_cu < 1) { fprintf(stderr, "kernel_launch: occupancy query says %d\n", per_cu); }
        (void)hipGetLastError();
        grid = cus > 0 ? cus : 256;
    }
    if (grid < 0) return;
    hipMemsetAsync((char*)d_ws + WS_CTL, 0, CTL_BYTES, stream);
    Params p{};
    p.x = (const float*)d_in[0]; p.c = (const float*)d_in[1]; p.ctx = (const float*)d_in[2]; p.c_ctx = (const float*)d_in[3];
    p.w_mod = (const float*)d_in[4]; p.b_mod = (const float*)d_in[5]; p.w_in = (const float*)d_in[6]; p.w_out = (const float*)d_in[7];
    p.diff_lambda = (const float*)d_in[8]; p.pool_w = (const float*)d_in[9]; p.pool_scale = (const float*)d_in[10]; p.ret_log_decay = (const float*)d_in[11];
    p.ln_g = (const float*)d_in[12]; p.ln_b = (const float*)d_in[13]; p.w_router = (const float*)d_in[14]; p.router_bias = (const float*)d_in[15];
    p.w_egu = (const float*)d_in[16]; p.w_edn = (const float*)d_in[17]; p.w_sgu = (const float*)d_in[18]; p.w_sdn = (const float*)d_in[19];
    p.out = (float*)d_out; p.ws = (unsigned char*)d_ws;
#if N_LAUNCH_PER_PHASE
    for (int k = 0; k < N_PHASES; ++k) { p.ph_lo = k; p.ph_hi = k + 1; hipLaunchKernelGGL(mega, dim3(grid), dim3(NTHREADS), LDS_BYTES, stream, p); }
#else
    p.ph_lo = 0; p.ph_hi = N_PHASES;
    hipLaunchKernelGGL(mega, dim3(grid), dim3(NTHREADS), LDS_BYTES, stream, p);
#endif
}
```

```cpp
#include <hip/hip_runtime.h>
#include <stdint.h>
#include <stdio.h>

#ifndef N_LAUNCH_PER_PHASE
#define N_LAUNCH_PER_PHASE 0
#endif

#define LAS __attribute__((address_space(3)))
#define DI __device__ __forceinline__
typedef unsigned short bf16_t;
typedef short bf16x8 __attribute__((ext_vector_type(8)));
typedef float f32x2 __attribute__((ext_vector_type(2)));
typedef float f32x4 __attribute__((ext_vector_type(4)));
typedef float f32x16 __attribute__((ext_vector_type(16)));
typedef unsigned u32x2 __attribute__((ext_vector_type(2)));
typedef unsigned u32x4 __attribute__((ext_vector_type(4)));
typedef __bf16 bf16v2 __attribute__((ext_vector_type(2)));

constexpr int NB = 2, NLAT = 8192, NCTX = 256, NT = NLAT + NCTX  , MROWS = NB * NT  ;
constexpr int DM = 1024, INW = 2816, NEXP = 256, TOPK = 8, NASG = MROWS * TOPK  ;
constexpr int NCHUNK = NT / 128;
constexpr float DN_ALPHA = 1.41421356237f;
constexpr float LN_EPS = 1e-6f, RMS_EPS = 1e-5f;
constexpr float LOG2E = 1.44269504089f;
constexpr float QSCALE = 0.125f * LOG2E;
constexpr int NTHREADS = 512;
constexpr int LDS_BYTES = 155648;

constexpr int C_DQ = 0, C_DK = 512, C_DV = 1024, C_PU = 1536, C_RQ = 1792, C_RK = 2048, C_RV = 2304, C_RG = 2560;

constexpr size_t al256(size_t x) { return (x + 255) & ~(size_t)255; }
constexpr size_t WS_CTL = 0;
constexpr size_t CTL_BYTES = 65536;
constexpr size_t CTL_COUNTS = 16384;
constexpr size_t CTL_CURSOR = CTL_COUNTS + 2048;
constexpr size_t CTL_NTILES = CTL_CURSOR + 2048;
constexpr size_t WS_MODV = WS_CTL + CTL_BYTES;
constexpr size_t WS_ROPE = al256(WS_MODV + 2 * 3 * 6144 * 4);
constexpr size_t WS_SCAL = al256(WS_ROPE + 128 * 16 * 8);
constexpr size_t WS_WIN = al256(WS_SCAL + 2 * 16 * 4);
constexpr size_t WS_WOUT = al256(WS_WIN + (size_t)2 * INW * DM * 2);
constexpr size_t WS_WR = al256(WS_WOUT + (size_t)2 * DM * DM * 2);
constexpr size_t WS_XA = al256(WS_WR + (size_t)2 * 256 * DM * 2);
constexpr size_t WS_XB = al256(WS_XA + (size_t)MROWS * DM * 4);
constexpr size_t WS_V1 = al256(WS_XB + (size_t)MROWS * DM * 4);
constexpr size_t WS_H = al256(WS_V1 + (size_t)MROWS * DM * 4);
constexpr size_t WS_TOK = al256(WS_H + (size_t)MROWS * DM * 2);
constexpr size_t WS_P = al256(WS_TOK + (size_t)MROWS * DM * 2);
constexpr size_t WS_VT = al256(WS_P + (size_t)MROWS * INW * 2);
constexpr size_t WS_RKT = al256(WS_VT + (size_t)NB * 4 * 128 * NT * 2);
constexpr size_t WS_RVT = al256(WS_RKT + (size_t)NB * 4 * 64 * NT * 2);
constexpr size_t WS_MIX = al256(WS_RVT + (size_t)NB * 4 * 64 * NT * 2);
constexpr size_t ST_BYTES = (size_t)NB * 4 * NCHUNK * 4096 * 4;
constexpr size_t WS_UF = al256(WS_MIX + (size_t)MROWS * DM * 2);
constexpr size_t WS_UB = al256(WS_UF + ST_BYTES);
constexpr size_t WS_SF = al256(WS_UB + ST_BYTES);
constexpr size_t WS_SB = al256(WS_SF + ST_BYTES);
constexpr size_t WS_LOGIT = al256(WS_SB + ST_BYTES);
constexpr size_t WS_EIDX = al256(WS_LOGIT + (size_t)MROWS * 256 * 4);
constexpr size_t WS_GATE = al256(WS_EIDX + (size_t)NASG * 4);
constexpr size_t WS_SORT = al256(WS_GATE + (size_t)NASG * 4);
constexpr size_t WS_RANK = al256(WS_SORT + (size_t)NASG * 4);
constexpr size_t WS_HIST = al256(WS_RANK + (size_t)NASG * 4);
constexpr size_t WS_TILES = al256(WS_HIST + (size_t)1024 * 256 * 4);
constexpr size_t WS_YSLOT = al256(WS_TILES + 2048 * 16);
constexpr size_t WS_YSH = al256(WS_YSLOT + (size_t)NASG * DM * 2);
constexpr size_t WS_END = al256(WS_YSH + (size_t)MROWS * DM * 2);

struct Params {
    const float *x, *c, *ctx, *c_ctx, *w_mod, *b_mod, *w_in, *w_out, *diff_lambda, *pool_w, *pool_scale, *ret_log_decay, *ln_g, *ln_b,
        *w_router, *router_bias, *w_egu, *w_edn, *w_sgu, *w_sdn;
    float* out;
    unsigned char* ws;
    int ph_lo, ph_hi;
};


DI Params launder(const Params& a) {
    Params r = a;
    unsigned long long* d = (unsigned long long*)&r;
#pragma unroll
    for (int i = 0; i < 22; ++i) asm volatile("" : "+s"(d[i]));
    return r;
}
DI int launder_s(int v) { asm volatile("" : "+s"(v)); return v; }
DI int tid_() { int t = threadIdx.x; asm volatile("" : "+v"(t)); return t; }
DI int bid_() { int t = blockIdx.x; asm volatile("" : "+s"(t)); return t; }

#define XB_TMO      128
#define XB_XCNT(j)  (256  + 64 * (j))
#define XB_XSUB(j)  (1280 + 64 * (j))
#define XB_XGEN(j)  (2304 + 64 * (j))
#define XB_TOP      3328
#define XB_TOPGEN   3392
#define XCD_BAR_WORDS 3456
#define XB_SPIN_CAP (1u << 20)

__device__ __forceinline__ unsigned xb_ld(unsigned* p)              { return __hip_atomic_load(p, __ATOMIC_RELAXED, __HIP_MEMORY_SCOPE_AGENT); }
__device__ __forceinline__ unsigned xb_add(unsigned* p, unsigned v) { return __hip_atomic_fetch_add(p, v, __ATOMIC_RELAXED, __HIP_MEMORY_SCOPE_AGENT); }
__device__ __forceinline__ unsigned xb_xcc_id() { return (unsigned)__builtin_amdgcn_s_getreg((3 << 11) | 20) & 0xFu; }
#define XB_SPIN(cond, bar) do { unsigned _sp = 0; while (cond) { __builtin_amdgcn_s_sleep(1); \
    if ((++_sp & 255u) == 0u) { if (xb_ld(&(bar)[XB_TMO])) break; if (_sp > XB_SPIN_CAP) { atomicAdd(&(bar)[XB_TMO], 1u); break; } } } } while (0)

struct XcdBarrier { unsigned* bar; unsigned x; volatile LAS unsigned* st; };

__device__ __forceinline__ XcdBarrier xcd_barrier_post(unsigned* bar, volatile LAS unsigned* st) {
    XcdBarrier b; b.bar = bar; b.x = xb_xcc_id(); b.st = st;
    if (threadIdx.x == 0) (void)xb_add(&bar[XB_XCNT(b.x)], 1u);
    return b;
}
__device__ __forceinline__ void xcd_barrier_complete(unsigned* bar, unsigned x, unsigned& nloc, unsigned& nx) {
    const unsigned G = gridDim.x * gridDim.y * gridDim.z;
    unsigned sum, cnt, mine, sp = 0u;
    for (;;) {
        sum = 0u; cnt = 0u; mine = 0u;
#pragma unroll
        for (unsigned j = 0; j < 16; ++j) { const unsigned c = xb_ld(&bar[XB_XCNT(j)]); sum += c; cnt += (c > 0u) ? 1u : 0u; mine = (j == x) ? c : mine; }
        if (sum == G) break;
        __builtin_amdgcn_s_sleep(1);
        if ((++sp & 255u) == 0u) { if (xb_ld(&bar[XB_TMO])) break; if (sp > XB_SPIN_CAP) { atomicAdd(&bar[XB_TMO], 1u); break; } }
    }
    nloc = mine > 0u ? mine : 1u; nx = cnt > 0u ? cnt : 1u;
}
__device__ __forceinline__ void xcd_barrier(const XcdBarrier& b) {
    asm volatile("s_waitcnt vmcnt(0)" ::: "memory");
    __syncthreads();
    if (threadIdx.x == 0) {
        unsigned* bar = b.bar;
        __builtin_amdgcn_s_waitcnt(0);
        unsigned nloc = b.st[0], nx = b.st[1];
        if (nloc == 0u) { xcd_barrier_complete(bar, b.x, nloc, nx); b.st[0] = nloc; b.st[1] = nx; }
        const unsigned old = xb_add(&bar[XB_XSUB(b.x)], 1u);
        const unsigned gen = old / nloc;
        if (old + 1u == (gen + 1u) * nloc) {
            __builtin_amdgcn_fence(__ATOMIC_RELEASE, "agent");
            asm volatile("s_waitcnt vmcnt(0)" ::: "memory");
            const unsigned og = xb_add(&bar[XB_TOP], 1u);
            const unsigned tg = og / nx;
            if (og + 1u == (tg + 1u) * nx) xb_add(&bar[XB_TOPGEN], 1u);
            else XB_SPIN(xb_ld(&bar[XB_TOPGEN]) == tg, bar);
            __builtin_amdgcn_fence(__ATOMIC_ACQUIRE, "agent");
            xb_add(&bar[XB_XGEN(b.x)], 1u);
            asm volatile("s_waitcnt vmcnt(0)" ::: "memory");
        } else {
            XB_SPIN(xb_ld(&bar[XB_XGEN(b.x)]) == gen, bar);
            __builtin_amdgcn_fence(__ATOMIC_ACQUIRE, "agent");
            asm volatile("s_waitcnt vmcnt(0)" ::: "memory");
        }
    }
    __syncthreads();
}

DI unsigned pk_bf16(float a, float b) { f32x2 v = {a, b}; bf16v2 r = __builtin_convertvector(v, bf16v2); return __builtin_bit_cast(unsigned, r); }
DI bf16_t to_bf16(float a) { return (bf16_t)(pk_bf16(a, 0.f) & 0xffffu); }
DI float bf_lo(unsigned u) { return __uint_as_float(u << 16); }
DI float bf_hi(unsigned u) { return __uint_as_float(u & 0xffff0000u); }
DI float bf2f(bf16_t h) { return __uint_as_float(((unsigned)h) << 16); }
DI float wave_sum(float v) {
#pragma unroll
    for (int o = 32; o; o >>= 1) v += __shfl_xor(v, o);
    return v;
}
DI float fast_exp2(float x) { return __builtin_amdgcn_exp2f(x); }
DI float silu_f(float x) { return x / (1.f + __expf(-x)); }
DI bf16x8 as_bf16x8(u32x4 v) { return __builtin_bit_cast(bf16x8, v); }
#define MFMA32(a, b, c) __builtin_amdgcn_mfma_f32_32x32x16_bf16((a), (b), (c), 0, 0, 0)
#define MFMA16(a, b, c) __builtin_amdgcn_mfma_f32_16x16x32_bf16((a), (b), (c), 0, 0, 0)

DI int row_sel(int r) { const int b = r >= NT; const int p = r - b * NT; return p < NCTX ? 2 : b; }

DI int swz_off(int row, int chunk) { return row * 128 + ((chunk ^ ((row >> 1) & 7)) << 4); }

template <class Epi>
DI void gemm128(const bf16_t* a0, const bf16_t* a1, const bf16_t* b0, const bf16_t* b1, int nk, LAS unsigned char* lds, const Epi& epi) {
    const int tid = tid_(), lane = tid & 63, wid = tid >> 6, wr = wid >> 2, wc = wid & 3, fr = lane & 15, fq = lane >> 4;
    const int lrow = tid >> 3, lch = tid & 7;
    f32x4 acc[4][2];
#pragma unroll
    for (int m = 0; m < 4; ++m)
#pragma unroll
        for (int n = 0; n < 2; ++n) acc[m][n] = (f32x4){0.f, 0.f, 0.f, 0.f};
    const u32x4 z4 = {0u, 0u, 0u, 0u};
    u32x4 ra0 = a0 ? *(const u32x4*)a0 : z4, ra1 = a1 ? *(const u32x4*)a1 : z4, rb0 = b0 ? *(const u32x4*)b0 : z4, rb1 = b1 ? *(const u32x4*)b1 : z4;
    const int wo0 = swz_off(lrow, lch), wo1 = swz_off(lrow + 64, lch);
    *(LAS u32x4*)(lds + wo0) = ra0; *(LAS u32x4*)(lds + wo1) = ra1;
    *(LAS u32x4*)(lds + 16384 + wo0) = rb0; *(LAS u32x4*)(lds + 16384 + wo1) = rb1;
    __syncthreads();
    for (int kt = 0; kt < nk; ++kt) {
        const bool more = kt + 1 < nk;
        if (more) {
            const int ko = (kt + 1) * 64;
            ra0 = a0 ? *(const u32x4*)(a0 + ko) : z4; ra1 = a1 ? *(const u32x4*)(a1 + ko) : z4;
            rb0 = b0 ? *(const u32x4*)(b0 + ko) : z4; rb1 = b1 ? *(const u32x4*)(b1 + ko) : z4;
        }
        LAS unsigned char* A = lds + (kt & 1) * 32768;
        LAS unsigned char* B = A + 16384;
#pragma unroll
        for (int kk = 0; kk < 2; ++kk) {
            bf16x8 af[4], bfr[2];
#pragma unroll
            for (int m = 0; m < 4; ++m) af[m] = *(LAS bf16x8*)(A + swz_off(wr * 64 + m * 16 + fr, kk * 4 + fq));
#pragma unroll
            for (int n = 0; n < 2; ++n) bfr[n] = *(LAS bf16x8*)(B + swz_off(wc * 32 + n * 16 + fr, kk * 4 + fq));
#pragma unroll
            for (int m = 0; m < 4; ++m)
#pragma unroll
                for (int n = 0; n < 2; ++n) acc[m][n] = MFMA16(af[m], bfr[n], acc[m][n]);
        }
        if (more) {
            LAS unsigned char* A2 = lds + ((kt + 1) & 1) * 32768;
            *(LAS u32x4*)(A2 + wo0) = ra0; *(LAS u32x4*)(A2 + wo1) = ra1;
            *(LAS u32x4*)(A2 + 16384 + wo0) = rb0; *(LAS u32x4*)(A2 + 16384 + wo1) = rb1;
        }
        __syncthreads();
    }
    epi(acc, wr, wc, fr, fq);
}

DI int perm_gu(int n) { const int f = n >> 8, jj = n & 255; return ((jj >> 4) << 5) + (f << 4) + (jj & 15); }
DI void conv_unit(const float* src, int N, int K, bf16_t* dst, int k0, int n0, bool perm, LAS unsigned char* lds) {
    LAS float* tl = (LAS float*)lds;
    const int tid = tid_();
#pragma unroll
    for (int i = 0; i < 8; ++i) {
        const int kk = (tid >> 6) + 8 * i, nn = (tid & 63) * 4;
        const f32x4 v = *(const f32x4*)(src + (size_t)(k0 + kk) * N + n0 + nn);
        tl[kk * 257 + nn] = v[0]; tl[kk * 257 + nn + 1] = v[1]; tl[kk * 257 + nn + 2] = v[2]; tl[kk * 257 + nn + 3] = v[3];
    }
    __syncthreads();
    const int n = tid >> 1, kh = (tid & 1) * 32;
    const int nd = perm ? perm_gu(n0 + n) : (n0 + n);
    bf16_t* d = dst + (size_t)nd * K + k0 + kh;
#pragma unroll
    for (int q = 0; q < 4; ++q) {
        u32x4 w;
#pragma unroll
        for (int j = 0; j < 4; ++j) w[j] = pk_bf16(tl[(kh + q * 8 + 2 * j) * 257 + n], tl[(kh + q * 8 + 2 * j + 1) * 257 + n]);
        *(u32x4*)(d + q * 8) = w;
    }
    __syncthreads();
}

DI void phase_convert(const Params& p0, LAS unsigned char* lds) {
    const Params p = launder(p0);
    constexpr int U_IN = 176, U_OUT = 64, U_R = 16;
    constexpr int U_L = U_IN + U_OUT + U_R;
    for (int u = bid_(); u < 2 * U_L; u += gridDim.x) {
        const int l = u / U_L; int v = u % U_L;
        if (v < U_IN) { conv_unit(p.w_in + (size_t)l * DM * INW, INW, DM, (bf16_t*)(p.ws + WS_WIN) + (size_t)l * INW * DM, (v / 11) * 64, (v % 11) * 256, false, lds); continue; }
        v -= U_IN;
        if (v < U_OUT) { conv_unit(p.w_out + (size_t)l * DM * DM, DM, DM, (bf16_t*)(p.ws + WS_WOUT) + (size_t)l * DM * DM, (v / 4) * 64, (v % 4) * 256, false, lds); continue; }
        v -= U_OUT;
        conv_unit(p.w_router + (size_t)l * DM * 256, 256, DM, (bf16_t*)(p.ws + WS_WR) + (size_t)l * 256 * DM, v * 64, 0, false, lds);
    }
}

DI void phase_mod(const Params& p0, LAS unsigned char* lds) {
    const Params p = launder(p0);
    LAS float* sc = (LAS float*)lds;
    LAS float* red = sc + 3 * 1024;
    const int tid = tid_();
    float* modv = (float*)(p.ws + WS_MODV);
    for (int u = bid_(); u < 193; u += gridDim.x) {
        if (u == 192) {
            float* rope = (float*)(p.ws + WS_ROPE);
            for (int i = tid; i < 128 * 16; i += NTHREADS) {
                const int pos = i >> 4, f = i & 15;
                const float freq = powf(10000.0f, -(float)f / 16.0f);
                const float ang = (float)pos * freq;
                rope[2 * i] = cosf(ang); rope[2 * i + 1] = sinf(ang);
            }
            float* scal = (float*)(p.ws + WS_SCAL);
            if (tid < 2) {
                const int l = tid;
                const float* dl = p.diff_lambda + l * 256;
                float s01 = 0.f, s23 = 0.f;
                for (int i = 0; i < 64; ++i) { s01 += dl[i] * dl[64 + i]; s23 += dl[128 + i] * dl[192 + i]; }
                const float lambda_init = 0.8f - 0.6f * expf(-0.3f * (float)l);
                scal[l * 16 + 0] = expf(s01) - expf(s23) + lambda_init;
                scal[l * 16 + 1] = 1.0f - lambda_init;
                for (int h = 0; h < 4; ++h) {
                    scal[l * 16 + 2 + h] = -expf(p.ret_log_decay[l * 8 + h]) * LOG2E;
                    scal[l * 16 + 6 + h] = -expf(p.ret_log_decay[l * 8 + 4 + h]) * LOG2E;
                }
            }
            continue;
        }
        const int l = u / 96, n0 = (u % 96) * 64;
        for (int i = tid; i < 3 * 1024; i += NTHREADS) {
            const int s = i >> 10, k = i & 1023;
            const float v = s < 2 ? p.c[s * 1024 + k] : p.c_ctx[k];
            sc[i] = silu_f(v);
        }
        __syncthreads();
        const int kq = tid >> 6, nl = tid & 63;
        const float* w = p.w_mod + (size_t)l * DM * 6144 + n0 + nl;
        float a0 = 0.f, a1 = 0.f, a2 = 0.f;
        for (int k = kq * 128; k < kq * 128 + 128; ++k) {
            const float wv = w[(size_t)k * 6144];
            a0 += sc[k] * wv; a1 += sc[1024 + k] * wv; a2 += sc[2048 + k] * wv;
        }
        red[(kq * 3 + 0) * 64 + nl] = a0; red[(kq * 3 + 1) * 64 + nl] = a1; red[(kq * 3 + 2) * 64 + nl] = a2;
        __syncthreads();
        if (tid < 192) {
            const int s = tid >> 6, n = tid & 63;
            float v = 0.f;
            for (int q = 0; q < 8; ++q) v += red[(q * 3 + s) * 64 + n];
            modv[((size_t)l * 3 + s) * 6144 + n0 + n] = v + p.b_mod[l * 6144 + n0 + n];
        }
        __syncthreads();
    }
}

DI void ln_stats(const f32x4 (&v)[4], float& mu, float& rstd) {
    float s = 0.f;
#pragma unroll
    for (int i = 0; i < 4; ++i) s += (v[i][0] + v[i][1]) + (v[i][2] + v[i][3]);
    mu = wave_sum(s) * (1.0f / 1024.0f);
    float q = 0.f;
#pragma unroll
    for (int i = 0; i < 4; ++i)
#pragma unroll
        for (int j = 0; j < 4; ++j) { const float d = v[i][j] - mu; q += d * d; }
    rstd = rsqrtf(wave_sum(q) * (1.0f / 1024.0f) + LN_EPS);
}
DI void modulate_store(const f32x4 (&v)[4], const float* shift, const float* scale, bf16_t* dst, int lane) {
    float mu, rstd; ln_stats(v, mu, rstd);
#pragma unroll
    for (int i = 0; i < 4; ++i) {
        const int c = lane * 4 + i * 256;
        const f32x4 sh = *(const f32x4*)(shift + c), scv = *(const f32x4*)(scale + c);
        float o[4];
#pragma unroll
        for (int j = 0; j < 4; ++j) o[j] = (v[i][j] - mu) * rstd * (1.0f + scv[j]) + sh[j];
        u32x2 w = {pk_bf16(o[0], o[1]), pk_bf16(o[2], o[3])};
        *(u32x2*)(dst + c) = w;
    }
}

DI void phase_ln0(const Params& p0) {
    const Params p = launder(p0);
    const int lane = tid_() & 63, wid = tid_() >> 6;
    float* XA = (float*)(p.ws + WS_XA);
    bf16_t* H = (bf16_t*)(p.ws + WS_H);
    const float* modv = (const float*)(p.ws + WS_MODV);
    for (int r = bid_() * 8 + wid; r < MROWS; r += gridDim.x * 8) {
        const int b = r >= NT, pp = r - b * NT;
        const float* src = pp < NCTX ? p.ctx + ((size_t)b * NCTX + pp) * DM : p.x + ((size_t)b * NLAT + (pp - NCTX)) * DM;
        f32x4 v[4];
#pragma unroll
        for (int i = 0; i < 4; ++i) { v[i] = *(const f32x4*)(src + lane * 4 + i * 256); *(f32x4*)(XA + (size_t)r * DM + lane * 4 + i * 256) = v[i]; }
        const float* mv = modv + (size_t)(0 * 3 + (pp < NCTX ? 2 : b)) * 6144;
        modulate_store(v, mv, mv + 1024, H + (size_t)r * DM, lane);
    }
}

DI void phase_inproj(const Params& p0, int l, LAS unsigned char* lds) {
    const Params p = launder(p0); l = launder_s(l);
    const bf16_t* H = (const bf16_t*)(p.ws + WS_H);
    const bf16_t* W = (const bf16_t*)(p.ws + WS_WIN) + (size_t)l * INW * DM;
    bf16_t* P = (bf16_t*)(p.ws + WS_P);
    bf16_t* VT = (bf16_t*)(p.ws + WS_VT);
    bf16_t* RKT = (bf16_t*)(p.ws + WS_RKT);
    bf16_t* RVT = (bf16_t*)(p.ws + WS_RVT);
    const f32x2* rope = (const f32x2*)(p.ws + WS_ROPE);
    const int lrow = tid_() >> 3, lch = tid_() & 7;
    constexpr int NTN = INW / 128;
    for (int u = bid_(); u < (MROWS / 128) * NTN; u += gridDim.x) {
        const int tm = u / NTN, tn = u % NTN;
        const bf16_t* a0 = H + (size_t)(tm * 128 + lrow) * DM + lch * 8;
        const bf16_t* b0 = W + (size_t)(tn * 128 + lrow) * DM + lch * 8;
        auto epi = [&](const f32x4 (&acc)[4][2], int wr, int wc, int fr, int fq) {
            const int c0 = tn * 128 + wc * 32;
            const int rbase = tm * 128 + wr * 64;
            if (c0 < C_DV) {
                const float qs = c0 < C_DK ? QSCALE : 1.0f;
                const int axis = (c0 >> 5) & 1;
#pragma unroll
                for (int m = 0; m < 4; ++m)
#pragma unroll
                    for (int j = 0; j < 4; ++j) {
                        const int row = rbase + m * 16 + fq * 4 + j;
                        const int b = row >= NT, pp = row - b * NT;
                        float x1 = acc[m][0][j], x2 = acc[m][1][j], o1 = x1, o2 = x2;
                        if (pp >= NCTX) {
                            const int t = pp - NCTX;
                            const int pos = axis ? (t & 63) : (t >> 6);
                            const f32x2 cs = rope[pos * 16 + fr];
                            o1 = x1 * cs[0] - x2 * cs[1]; o2 = x1 * cs[1] + x2 * cs[0];
                        }
                        P[(size_t)row * INW + c0 + fr] = to_bf16(o1 * qs);
                        P[(size_t)row * INW + c0 + 16 + fr] = to_bf16(o2 * qs);
                    }
            } else {
                const float sc = (c0 >= C_RK && c0 < C_RV) ? 0.125f : 1.0f;
#pragma unroll
                for (int m = 0; m < 4; ++m) {
                    const int row0 = rbase + m * 16 + fq * 4;
                    const int b = row0 >= NT, pp0 = row0 - b * NT;
#pragma unroll
                    for (int n = 0; n < 2; ++n) {
                        const int c = c0 + n * 16 + fr;
                        float o[4];
#pragma unroll
                        for (int j = 0; j < 4; ++j) { o[j] = acc[m][n][j] * sc; P[(size_t)(row0 + j) * INW + c] = to_bf16(o[j]); }
                        bf16_t* tp = nullptr;
                        if (c0 < C_PU) { const int cc = c - C_DV; tp = VT + ((size_t)(b * 4 + (cc >> 7)) * 128 + (cc & 127)) * NT + pp0; }
                        else if (c0 >= C_RK && c0 < C_RV) { const int cc = c - C_RK; tp = RKT + ((size_t)(b * 4 + (cc >> 6)) * 64 + (cc & 63)) * NT + pp0; }
                        else if (c0 >= C_RV && c0 < C_RG) { const int cc = c - C_RV; tp = RVT + ((size_t)(b * 4 + (cc >> 6)) * 64 + (cc & 63)) * NT + pp0; }
                        if (tp) { u32x2 w = {pk_bf16(o[0], o[1]), pk_bf16(o[2], o[3])}; *(u32x2*)tp = w; }
                    }
                }
            }
        };
        gemm128(a0, a0 + (size_t)64 * DM, b0, b0 + (size_t)64 * DM, DM / 64, lds, epi);
    }
}

DI void phase_ret_sum_pool(const Params& p0, int l, LAS unsigned char* lds) {
    const Params p = launder(p0); l = launder_s(l);
    const int tid = tid_(), lane = tid & 63, wid = tid >> 6, fr = lane & 15, g = lane >> 4;
    const float* scal = (const float*)(p.ws + WS_SCAL) + l * 16;
    const bf16_t* RKT = (const bf16_t*)(p.ws + WS_RKT);
    const bf16_t* RVT = (const bf16_t*)(p.ws + WS_RVT);
    float* UF = (float*)(p.ws + WS_UF);
    float* UB = (float*)(p.ws + WS_UB);
    for (int u = bid_(); u < NB * 4 * NCHUNK; u += gridDim.x) {
        const int c = u % NCHUNK, bh = u / NCHUNK, h = bh & 3;
        const int dir = wid >> 2, eb = wid & 3;
        const float l2 = dir ? scal[6 + h] : scal[2 + h];
        const bf16_t* vrow = RVT + ((size_t)bh * 64 + eb * 16 + fr) * NT + c * 128;
        f32x4 acc[4];
#pragma unroll
        for (int db = 0; db < 4; ++db) acc[db] = (f32x4){0.f, 0.f, 0.f, 0.f};
#pragma unroll
        for (int ks = 0; ks < 4; ++ks) {
            const int j0 = ks * 32 + 8 * g;
            const bf16x8 af = *(const bf16x8*)(vrow + j0);
            float w[8];
#pragma unroll
            for (int jj = 0; jj < 8; ++jj) { const int j = j0 + jj; w[jj] = fast_exp2((dir ? (float)j : (float)(127 - j)) * l2); }
#pragma unroll
            for (int db = 0; db < 4; ++db) {
                const u32x4 kr = *(const u32x4*)(RKT + ((size_t)bh * 64 + db * 16 + fr) * NT + c * 128 + j0);
                u32x4 kw;
#pragma unroll
                for (int q = 0; q < 4; ++q) kw[q] = pk_bf16(bf_lo(kr[q]) * w[2 * q], bf_hi(kr[q]) * w[2 * q + 1]);
                acc[db] = MFMA16(af, as_bf16x8(kw), acc[db]);
            }
        }
        const int cidx = dir ? (c >= 2 ? c - 2 : 64 + c) : c;
        float* U = (dir ? UB : UF) + ((size_t)bh * NCHUNK + cidx) * 4096;
#pragma unroll
        for (int db = 0; db < 4; ++db)
#pragma unroll
            for (int j = 0; j < 4; ++j) U[(eb * 16 + 4 * g + j) * 64 + db * 16 + fr] = acc[db][j];
    }
    LAS float* ul = (LAS float*)lds;
    LAS float* dT = ul + 48 * 256;
    const bf16_t* P = (const bf16_t*)(p.ws + WS_P);
    bf16_t* MIX = (bf16_t*)(p.ws + WS_MIX);
    const float* pw = p.pool_w + (size_t)l * 4 * 64 * 64;
    const float* ps = p.pool_scale + l * 256;
    for (int u = bid_(); u < MROWS / 32; u += gridDim.x) {
        const int r0 = u * 32;
        const int b = r0 >= NT, pp0 = r0 - b * NT;
        const int s0 = pp0 < NCTX ? b * NT : b * NT + NCTX, s1 = pp0 < NCTX ? b * NT + NCTX : (b + 1) * NT;
        __syncthreads();
        for (int i = tid; i < 48 * 64; i += NTHREADS) {
            const int rr = i >> 6, c4 = (i & 63) * 4;
            const int row = r0 - 8 + rr;
            f32x4 v = {0.f, 0.f, 0.f, 0.f};
            if (row >= s0 && row < s1) { const u32x2 w = *(const u32x2*)(P + (size_t)row * INW + C_PU + c4); v = (f32x4){bf_lo(w[0]), bf_hi(w[0]), bf_lo(w[1]), bf_hi(w[1])}; }
            *(LAS f32x4*)(ul + rr * 256 + c4) = v;
        }
        __syncthreads();
        for (int i = tid; i < 32 * 256; i += NTHREADS) {
            const int rr = i >> 8, c = i & 255, gi = c >> 6;
            const int w = 2 << gi;
            const int row = r0 + rr;
            int lo = row - w / 2, hi = row + w - w / 2;
            lo = lo < s0 ? s0 : lo; hi = hi > s1 ? s1 : hi;
            float s = 0.f;
            for (int q = lo; q < hi; ++q) s += ul[(q - r0 + 8) * 256 + c];
            dT[c * 36 + rr] = s / (float)(hi - lo) - ul[(rr + 8) * 256 + c];
        }
        __syncthreads();
        {
            const int oc = tid & 255, rh = (tid >> 8) * 16, gi = oc >> 6, e = oc & 63;
            float acc[16];
#pragma unroll
            for (int i = 0; i < 16; ++i) acc[i] = 0.f;
            for (int c = 0; c < 64; ++c) {
                const float wv = pw[(gi * 64 + c) * 64 + e];
                const LAS float* dr = dT + (gi * 64 + c) * 36 + rh;
#pragma unroll
                for (int i = 0; i < 4; ++i) { const f32x4 d = *(const LAS f32x4*)(dr + 4 * i); acc[4 * i] += d[0] * wv; acc[4 * i + 1] += d[1] * wv; acc[4 * i + 2] += d[2] * wv; acc[4 * i + 3] += d[3] * wv; }
            }
            const float sc = ps[oc];
#pragma unroll
            for (int i = 0; i < 16; ++i) MIX[(size_t)(r0 + rh + i) * DM + 512 + oc] = to_bf16(acc[i] * sc);
        }
    }
    __syncthreads();
}

DI void phase_ret_scan(const Params& p0, int l) {
    const Params p = launder(p0); l = launder_s(l);
    const float* scal = (const float*)(p.ws + WS_SCAL) + l * 16;
    const float* UF = (const float*)(p.ws + WS_UF); const float* UB = (const float*)(p.ws + WS_UB);
    float* SF = (float*)(p.ws + WS_SF); float* SB = (float*)(p.ws + WS_SB);
    for (int i = bid_() * NTHREADS + tid_(); i < 2 * NB * 4 * 4096; i += gridDim.x * NTHREADS) {
        const int dir = i / (NB * 4 * 4096), rem = i % (NB * 4 * 4096), bh = rem >> 12, el = rem & 4095, h = bh & 3;
        const float G = fast_exp2(128.0f * (dir ? scal[6 + h] : scal[2 + h]));
        float S = 0.f;
        if (dir == 0) { for (int c = 0; c < NCHUNK; ++c) { const size_t o = ((size_t)bh * NCHUNK + c) * 4096 + el; SF[o] = S; S = S * G + UF[o]; } }
        else { for (int c = NCHUNK - 1; c >= 0; --c) { const size_t o = ((size_t)bh * NCHUNK + c) * 4096 + el; SB[o] = S; S = S * G + UB[o]; } }
    }
}

DI void attn_unit(const Params& p, int b, int h, int q_p0, int ntile, float lam, float oscale, LAS unsigned char* lds) {
    const int tid = tid_(), lane = tid & 63, wid = tid >> 6, map = wid >> 2, wq = wid & 3, r = lane & 31, hh = lane >> 5;
    const bf16_t* P = (const bf16_t*)(p.ws + WS_P);
    const bf16_t* VT = (const bf16_t*)(p.ws + WS_VT);
    bf16_t* MIX = (bf16_t*)(p.ws + WS_MIX);
    const size_t rowbase = (size_t)b * NT;
    const int qrow = q_p0 + wq * 32 + r;
    bf16x8 qf[4];
#pragma unroll
    for (int ks = 0; ks < 4; ++ks) qf[ks] = *(const bf16x8*)(P + (rowbase + qrow) * INW + C_DQ + h * 128 + map * 64 + ks * 16 + hh * 8);
    f32x16 o[4];
#pragma unroll
    for (int eb = 0; eb < 4; ++eb)
#pragma unroll
        for (int i = 0; i < 16; ++i) o[eb][i] = 0.f;
    float m_run = -1e30f, l_run = 0.f;
    const int kkey = tid >> 4, kch = tid & 15, ve = tid >> 3, vch = tid & 7;
    const bf16_t* kg = P + (rowbase + kkey) * INW + C_DK + h * 128 + kch * 8;
    const bf16_t* vg = VT + ((size_t)(b * 4 + h) * 128 + ve) * NT + vch * 8;
    const int kw0 = kkey * 256 + ((kch ^ (kkey & 15)) << 4), kw1 = (kkey + 32) * 256 + ((kch ^ (kkey & 15)) << 4);
    const int vw0 = 16384 + ve * 136 + vch * 16, vw1 = 16384 + (ve + 64) * 136 + vch * 16;
    u32x4 rk0, rk1, rv0, rv1;
    rk0 = *(const u32x4*)kg; rk1 = *(const u32x4*)(kg + (size_t)32 * INW);
    rv0 = *(const u32x4*)vg; rv1 = *(const u32x4*)(vg + (size_t)64 * NT);
    __syncthreads();
    {
        LAS unsigned char* L = lds;
        *(LAS u32x4*)(L + kw0) = rk0; *(LAS u32x4*)(L + kw1) = rk1;
        *(LAS u32x2*)(L + vw0) = (u32x2){rv0[0], rv0[1]}; *(LAS u32x2*)(L + vw0 + 8) = (u32x2){rv0[2], rv0[3]};
        *(LAS u32x2*)(L + vw1) = (u32x2){rv1[0], rv1[1]}; *(LAS u32x2*)(L + vw1 + 8) = (u32x2){rv1[2], rv1[3]};
    }
    __syncthreads();
    for (int kt = 0; kt < ntile; ++kt) {
        const bool more = kt + 1 < ntile;
        if (more) {
            const bf16_t* kg2 = kg + (size_t)(kt + 1) * 64 * INW;
            const bf16_t* vg2 = vg + (kt + 1) * 64;
            rk0 = *(const u32x4*)kg2; rk1 = *(const u32x4*)(kg2 + (size_t)32 * INW);
            rv0 = *(const u32x4*)vg2; rv1 = *(const u32x4*)(vg2 + (size_t)64 * NT);
        }
        LAS unsigned char* L = lds + (kt & 1) * 33792;
        f32x16 s0, s1;
#pragma unroll
        for (int i = 0; i < 16; ++i) { s0[i] = 0.f; s1[i] = 0.f; }
#pragma unroll
        for (int ks = 0; ks < 4; ++ks) {
            const int ch = map * 8 + ks * 2 + hh;
            const int off = r * 256 + ((ch ^ (r & 15)) << 4);
            const bf16x8 a0 = *(LAS bf16x8*)(L + off);
            const bf16x8 a1 = *(LAS bf16x8*)(L + off + 32 * 256);
            s0 = MFMA32(a0, qf[ks], s0);
            s1 = MFMA32(a1, qf[ks], s1);
        }
        float mx = s0[0];
#pragma unroll
        for (int i = 1; i < 16; ++i) mx = fmaxf(mx, s0[i]);
#pragma unroll
        for (int i = 0; i < 16; ++i) mx = fmaxf(mx, s1[i]);
        mx = fmaxf(mx, __shfl_xor(mx, 32));
        const float m_new = fmaxf(m_run, mx);
        const float alpha = fast_exp2(m_run - m_new);
        m_run = m_new;
        float rs = 0.f;
#pragma unroll
        for (int i = 0; i < 16; ++i) { s0[i] = fast_exp2(s0[i] - m_new); rs += s0[i]; }
#pragma unroll
        for (int i = 0; i < 16; ++i) { s1[i] = fast_exp2(s1[i] - m_new); rs += s1[i]; }
        l_run = l_run * alpha + rs;
#pragma unroll
        for (int eb = 0; eb < 4; ++eb)
#pragma unroll
            for (int i = 0; i < 16; ++i) o[eb][i] *= alpha;
#pragma unroll
        for (int s = 0; s < 4; ++s) {
            u32x4 pw;
#pragma unroll
            for (int q = 0; q < 4; ++q) pw[q] = (s >> 1) ? pk_bf16(s1[(s & 1) * 8 + 2 * q], s1[(s & 1) * 8 + 2 * q + 1]) : pk_bf16(s0[(s & 1) * 8 + 2 * q], s0[(s & 1) * 8 + 2 * q + 1]);
            const bf16x8 pb = as_bf16x8(pw);
            const int key0 = (s >> 1) * 32 + (s & 1) * 16 + 4 * hh;
#pragma unroll
            for (int eb = 0; eb < 4; ++eb) {
                const LAS unsigned char* vp = L + 16384 + (eb * 32 + r) * 136 + key0 * 2;
                const u32x2 v0 = *(const LAS u32x2*)vp, v1 = *(const LAS u32x2*)(vp + 16);
                const u32x4 va = {v0[0], v0[1], v1[0], v1[1]};
                o[eb] = MFMA32(as_bf16x8(va), pb, o[eb]);
            }
        }
        if (more) {
            LAS unsigned char* L2 = lds + ((kt + 1) & 1) * 33792;
            *(LAS u32x4*)(L2 + kw0) = rk0; *(LAS u32x4*)(L2 + kw1) = rk1;
            *(LAS u32x2*)(L2 + vw0) = (u32x2){rv0[0], rv0[1]}; *(LAS u32x2*)(L2 + vw0 + 8) = (u32x2){rv0[2], rv0[3]};
            *(LAS u32x2*)(L2 + vw1) = (u32x2){rv1[0], rv1[1]}; *(LAS u32x2*)(L2 + vw1 + 8) = (u32x2){rv1[2], rv1[3]};
        }
        __syncthreads();
    }
    const float lt = l_run + __shfl_xor(l_run, 32);
    const float inv = 1.0f / lt;
    LAS float* X = (LAS float*)lds;
    if (map == 1) {
#pragma unroll
        for (int eb = 0; eb < 4; ++eb)
#pragma unroll
            for (int i = 0; i < 16; ++i) X[(wq * 64 + eb * 16 + i) * 64 + lane] = o[eb][i] * inv;
    }
    __syncthreads();
    if (map == 0) {
        float ss = 0.f;
#pragma unroll
        for (int eb = 0; eb < 4; ++eb)
#pragma unroll
            for (int i = 0; i < 16; ++i) { const float v = o[eb][i] * inv - lam * X[(wq * 64 + eb * 16 + i) * 64 + lane]; o[eb][i] = v; ss += v * v; }
        ss += __shfl_xor(ss, 32);
        const float sc = rsqrtf(ss * (1.0f / 128.0f) + RMS_EPS) * oscale;
        bf16_t* dst = MIX + (rowbase + qrow) * DM + h * 128;
#pragma unroll
        for (int eb = 0; eb < 4; ++eb)
#pragma unroll
            for (int q = 0; q < 4; ++q) {
                const int e = eb * 32 + 8 * q + 4 * hh;
                u32x2 w = {pk_bf16(o[eb][4 * q] * sc, o[eb][4 * q + 1] * sc), pk_bf16(o[eb][4 * q + 2] * sc, o[eb][4 * q + 3] * sc)};
                *(u32x2*)(dst + e) = w;
            }
    }
    __syncthreads();
}

DI void ret_unit(const Params& p, int l, int b, int h, int c) {
    const int tid = tid_(), lane = tid & 63, wid = tid >> 6, fr = lane & 15, g = lane >> 4;
    const float* scal = (const float*)(p.ws + WS_SCAL) + l * 16;
    const float lf2 = scal[2 + h], lb2 = scal[6 + h];
    const bf16_t* P = (const bf16_t*)(p.ws + WS_P);
    const bf16_t* RVT = (const bf16_t*)(p.ws + WS_RVT);
    const float* SF = (const float*)(p.ws + WS_SF); const float* SB = (const float*)(p.ws + WS_SB);
    bf16_t* MIX = (bf16_t*)(p.ws + WS_MIX);
    const int bh = b * 4 + h;
    const size_t row0 = (size_t)b * NT + c * 128;
    const int iloc = wid * 16 + fr;
    u32x4 qraw[2];
#pragma unroll
    for (int ks = 0; ks < 2; ++ks) qraw[ks] = *(const u32x4*)(P + (row0 + iloc) * INW + C_RQ + h * 64 + ks * 32 + 8 * g);
    f32x4 st[8];
#pragma unroll
    for (int jb = 0; jb < 8; ++jb) {
        st[jb] = (f32x4){0.f, 0.f, 0.f, 0.f};
#pragma unroll
        for (int ks = 0; ks < 2; ++ks) {
            const bf16x8 kf = *(const bf16x8*)(P + (row0 + jb * 16 + fr) * INW + C_RK + h * 64 + ks * 32 + 8 * g);
            st[jb] = MFMA16(kf, as_bf16x8(qraw[ks]), st[jb]);
        }
    }
#pragma unroll
    for (int jb = 0; jb < 8; ++jb)
#pragma unroll
        for (int q = 0; q < 4; ++q) {
            const int j = jb * 16 + 4 * g + q;
            const int d = iloc - j;
            const float w = d > 0 ? fast_exp2((float)d * lf2) : (d < 0 ? fast_exp2((float)(-d) * lb2) : 2.0f);
            st[jb][q] *= w;
        }
    f32x4 ot[4];
#pragma unroll
    for (int eb = 0; eb < 4; ++eb) ot[eb] = (f32x4){0.f, 0.f, 0.f, 0.f};
#pragma unroll
    for (int jj = 0; jj < 4; ++jj) {
        const u32x4 pw = {pk_bf16(st[2 * jj][0], st[2 * jj][1]), pk_bf16(st[2 * jj][2], st[2 * jj][3]), pk_bf16(st[2 * jj + 1][0], st[2 * jj + 1][1]), pk_bf16(st[2 * jj + 1][2], st[2 * jj + 1][3])};
#pragma unroll
        for (int eb = 0; eb < 4; ++eb) {
            const bf16_t* vp = RVT + ((size_t)bh * 64 + eb * 16 + fr) * NT + c * 128 + jj * 32 + 4 * g;
            const u32x2 v0 = *(const u32x2*)vp, v1 = *(const u32x2*)(vp + 16);
            const u32x4 va = {v0[0], v0[1], v1[0], v1[1]};
            ot[eb] = MFMA16(as_bf16x8(va), as_bf16x8(pw), ot[eb]);
        }
    }
    const float df = fast_exp2((float)(iloc + 1) * lf2), db = fast_exp2((float)(128 - iloc) * lb2);
    const int vc = c >= 2 ? c - 2 : 64 + c;
    const float* sf = SF + ((size_t)bh * NCHUNK + c) * 4096;
    const float* sb = SB + ((size_t)bh * NCHUNK + vc) * 4096;
#pragma unroll
    for (int ks = 0; ks < 2; ++ks) {
        u32x4 qf, qb;
#pragma unroll
        for (int q = 0; q < 4; ++q) { const float a = bf_lo(qraw[ks][q]), bb = bf_hi(qraw[ks][q]); qf[q] = pk_bf16(a * df, bb * df); qb[q] = pk_bf16(a * db, bb * db); }
#pragma unroll
        for (int eb = 0; eb < 4; ++eb) {
            const float* s1 = sf + (eb * 16 + fr) * 64 + ks * 32 + 8 * g;
            const float* s2 = sb + (eb * 16 + fr) * 64 + ks * 32 + 8 * g;
            const f32x4 a0 = *(const f32x4*)s1, a1 = *(const f32x4*)(s1 + 4), c0 = *(const f32x4*)s2, c1 = *(const f32x4*)(s2 + 4);
            const u32x4 sa = {pk_bf16(a0[0], a0[1]), pk_bf16(a0[2], a0[3]), pk_bf16(a1[0], a1[1]), pk_bf16(a1[2], a1[3])};
            const u32x4 sc = {pk_bf16(c0[0], c0[1]), pk_bf16(c0[2], c0[3]), pk_bf16(c1[0], c1[1]), pk_bf16(c1[2], c1[3])};
            ot[eb] = MFMA16(as_bf16x8(sa), as_bf16x8(qf), ot[eb]);
            ot[eb] = MFMA16(as_bf16x8(sc), as_bf16x8(qb), ot[eb]);
        }
    }
    float s = 0.f;
#pragma unroll
    for (int eb = 0; eb < 4; ++eb) s += (ot[eb][0] + ot[eb][1]) + (ot[eb][2] + ot[eb][3]);
    s += __shfl_xor(s, 16); s += __shfl_xor(s, 32);
    const float mu = s * (1.0f / 64.0f);
    float q2 = 0.f;
#pragma unroll
    for (int eb = 0; eb < 4; ++eb)
#pragma unroll
        for (int q = 0; q < 4; ++q) { const float d = ot[eb][q] - mu; q2 += d * d; }
    q2 += __shfl_xor(q2, 16); q2 += __shfl_xor(q2, 32);
    const float rstd = rsqrtf(q2 * (1.0f / 64.0f) + LN_EPS);
#pragma unroll
    for (int eb = 0; eb < 4; ++eb) {
        const int e = eb * 16 + 4 * g;
        const u32x2 gw = *(const u32x2*)(P + (row0 + iloc) * INW + C_RG + h * 64 + e);
        const float g0 = bf_lo(gw[0]), g1 = bf_hi(gw[0]), g2 = bf_lo(gw[1]), g3 = bf_hi(gw[1]);
        u32x2 w = {pk_bf16((ot[eb][0] - mu) * rstd * silu_f(g0), (ot[eb][1] - mu) * rstd * silu_f(g1)),
                   pk_bf16((ot[eb][2] - mu) * rstd * silu_f(g2), (ot[eb][3] - mu) * rstd * silu_f(g3))};
        *(u32x2*)(MIX + (row0 + iloc) * DM + 768 + h * 64 + e) = w;
    }
}

DI void phase_attn(const Params& p0, int l, LAS unsigned char* lds) {
    const Params p = launder(p0); l = launder_s(l);
    const float* scal = (const float*)(p.ws + WS_SCAL) + l * 16;
    const float lam = scal[0], oscale = scal[1];
    const int nunits = NB * 4 * 64 + (l == 0 ? NB * 4 * 2 : 0);
    for (int u = bid_(); u < nunits; u += gridDim.x) {
        int b, h, q0, ntile;
        if (u < NB * 4 * 64) { const int qt = u & 63; h = (u >> 6) & 3; b = u >> 8; q0 = NCTX + qt * 128; ntile = NT / 64; }
        else { const int v = u - NB * 4 * 64; const int qt = v & 1; h = (v >> 1) & 3; b = v >> 3; q0 = qt * 128; ntile = NCTX / 64; }
        attn_unit(p, b, h, q0, ntile, lam, oscale, lds);
    }
}
DI void phase_ret(const Params& p0, int l) {
    const Params p = launder(p0); l = launder_s(l);
    for (int u = bid_(); u < NB * 4 * NCHUNK; u += gridDim.x) {
        const int c = u % NCHUNK, bh = u / NCHUNK;
        if (l == 1 && c < 2) continue;
        ret_unit(p, l, bh >> 2, bh & 3, c);
    }
}

DI void phase_outproj(const Params& p0, int l, LAS unsigned char* lds) {
    const Params p = launder(p0); l = launder_s(l);
    const float* Xin = (const float*)(p.ws + WS_XA);
    const bf16_t* A = (const bf16_t*)(p.ws + WS_MIX);
    const bf16_t* W = (const bf16_t*)(p.ws + WS_WOUT) + (size_t)l * DM * DM;
    float* V1 = (float*)(p.ws + WS_V1);
    const float* modv = (const float*)(p.ws + WS_MODV) + (size_t)l * 3 * 6144;
    const int lrow = tid_() >> 3, lch = tid_() & 7;
    for (int u = bid_(); u < (MROWS / 128) * 8; u += gridDim.x) {
        const int tm = u >> 3, tn = u & 7;
        const bf16_t* a0 = A + (size_t)(tm * 128 + lrow) * DM + lch * 8;
        const bf16_t* b0 = W + (size_t)(tn * 128 + lrow) * DM + lch * 8;
        auto epi = [&](const f32x4 (&acc)[4][2], int wr, int wc, int fr, int fq) {
#pragma unroll
            for (int m = 0; m < 4; ++m)
#pragma unroll
                for (int j = 0; j < 4; ++j) {
                    const int row = tm * 128 + wr * 64 + m * 16 + fq * 4 + j;
                    const float* g2 = modv + (size_t)row_sel(row) * 6144 + 2 * 1024;
#pragma unroll
                    for (int n = 0; n < 2; ++n) {
                        const int c = tn * 128 + wc * 32 + n * 16 + fr;
                        V1[(size_t)row * DM + c] = DN_ALPHA * Xin[(size_t)row * DM + c] + g2[c] * acc[m][n][j];
                    }
                }
        };
        gemm128(a0, a0 + (size_t)64 * DM, b0, b0 + (size_t)64 * DM, DM / 64, lds, epi);
    }
}

DI void phase_ln_mid(const Params& p0, int l) {
    const Params p = launder(p0); l = launder_s(l);
    float* Xout = (float*)(p.ws + WS_XB);
    const int lane = tid_() & 63, wid = tid_() >> 6;
    const float* V1 = (const float*)(p.ws + WS_V1);
    bf16_t* TOK = (bf16_t*)(p.ws + WS_TOK);
    const float* modv = (const float*)(p.ws + WS_MODV) + (size_t)l * 3 * 6144;
    const float* lg = p.ln_g + (size_t)(l * 2 + 0) * DM; const float* lb = p.ln_b + (size_t)(l * 2 + 0) * DM;
    for (int r = bid_() * 8 + wid; r < MROWS; r += gridDim.x * 8) {
        f32x4 v[4];
#pragma unroll
        for (int i = 0; i < 4; ++i) v[i] = *(const f32x4*)(V1 + (size_t)r * DM + lane * 4 + i * 256);
        float mu, rstd; ln_stats(v, mu, rstd);
#pragma unroll
        for (int i = 0; i < 4; ++i) {
            const int c = lane * 4 + i * 256;
            const f32x4 gg = *(const f32x4*)(lg + c), bb = *(const f32x4*)(lb + c);
#pragma unroll
            for (int j = 0; j < 4; ++j) v[i][j] = (v[i][j] - mu) * rstd * gg[j] + bb[j];
            *(f32x4*)(Xout + (size_t)r * DM + c) = v[i];
        }
        const float* mv = modv + (size_t)row_sel(r) * 6144;
        modulate_store(v, mv + 3 * 1024, mv + 4 * 1024, TOK + (size_t)r * DM, lane);
    }
}

DI void phase_router(const Params& p0, int l, LAS unsigned char* lds) {
    const Params p = launder(p0); l = launder_s(l);
    const bf16_t* A = (const bf16_t*)(p.ws + WS_TOK);
    const bf16_t* W = (const bf16_t*)(p.ws + WS_WR) + (size_t)l * 256 * DM;
    float* LG = (float*)(p.ws + WS_LOGIT);
    const int lrow = tid_() >> 3, lch = tid_() & 7;
    for (int u = bid_(); u < (MROWS / 128) * 2; u += gridDim.x) {
        const int tm = u >> 1, tn = u & 1;
        const bf16_t* a0 = A + (size_t)(tm * 128 + lrow) * DM + lch * 8;
        const bf16_t* b0 = W + (size_t)(tn * 128 + lrow) * DM + lch * 8;
        auto epi = [&](const f32x4 (&acc)[4][2], int wr, int wc, int fr, int fq) {
#pragma unroll
            for (int m = 0; m < 4; ++m)
#pragma unroll
                for (int j = 0; j < 4; ++j)
#pragma unroll
                    for (int n = 0; n < 2; ++n)
                        LG[(size_t)(tm * 128 + wr * 64 + m * 16 + fq * 4 + j) * 256 + tn * 128 + wc * 32 + n * 16 + fr] = acc[m][n][j];
        };
        gemm128(a0, a0 + (size_t)64 * DM, b0, b0 + (size_t)64 * DM, DM / 64, lds, epi);
    }
}

DI void phase_topk(const Params& p0, int l, LAS unsigned char* lds) {
    const Params p = launder(p0); l = launder_s(l);
    const int lane = tid_() & 63, wid = tid_() >> 6;
    const float* LG = (const float*)(p.ws + WS_LOGIT);
    const float* bias = p.router_bias + l * 256;
    int* EIDX = (int*)(p.ws + WS_EIDX); float* GATE = (float*)(p.ws + WS_GATE);
    int* RANK = (int*)(p.ws + WS_RANK); int* HIST = (int*)(p.ws + WS_HIST);
    LAS int* hist = (LAS int*)lds;
    if (tid_() < 256) hist[tid_()] = 0;
    __syncthreads();
    const int chunk = (MROWS + (int)gridDim.x - 1) / (int)gridDim.x, r_begin = bid_() * chunk, r_end = (r_begin + chunk) < MROWS ? (r_begin + chunk) : MROWS;
    const f32x4 bv = *(const f32x4*)(bias + lane * 4);
    for (int r = r_begin + wid; r < r_end; r += 8) {
        const f32x4 lg = *(const f32x4*)(LG + (size_t)r * 256 + lane * 4);
        float sc[4], gv[4];
#pragma unroll
        for (int i = 0; i < 4; ++i) { sc[i] = 1.0f / (1.0f + __expf(-lg[i])); gv[i] = sc[i] + bv[i]; }
        float a1 = fmaxf(gv[0], gv[1]), a2 = fminf(gv[0], gv[1]);
        { const float b1 = fmaxf(gv[2], gv[3]), b2 = fminf(gv[2], gv[3]); const float n1 = fmaxf(a1, b1), n2 = fmaxf(fminf(a1, b1), fmaxf(a2, b2)); a1 = n1; a2 = n2; }
#pragma unroll
        for (int o = 1; o < 8; o <<= 1) { const float b1 = __shfl_xor(a1, o), b2 = __shfl_xor(a2, o); const float n1 = fmaxf(a1, b1), n2 = fmaxf(fminf(a1, b1), fmaxf(a2, b2)); a1 = n1; a2 = n2; }
        const float gs = a1 + a2;
        const int myg = lane >> 3;
        int rank = 0;
#pragma unroll
        for (int g2 = 0; g2 < 8; ++g2) { const float o = __shfl(gs, g2 * 8); rank += (o > gs || (o == gs && g2 < myg)) ? 1 : 0; }
        const bool ok = rank < 4;
        float cv[4];
#pragma unroll
        for (int i = 0; i < 4; ++i) cv[i] = ok ? gv[i] : -INFINITY;
        float ssum = 0.f; float mysc = 0.f; int myidx = 0;
        for (int k = 0; k < TOPK; ++k) {
            float bvl = cv[0]; int bi = 0;
#pragma unroll
            for (int i = 1; i < 4; ++i) if (cv[i] > bvl) { bvl = cv[i]; bi = i; }
            int gi = lane * 4 + bi;
#pragma unroll
            for (int o = 1; o < 64; o <<= 1) {
                const float ov = __shfl_xor(bvl, o); const int oi = __shfl_xor(gi, o);
                if (ov > bvl || (ov == bvl && oi < gi)) { bvl = ov; gi = oi; }
            }
            const int owner = gi >> 2, oi = gi & 3;
            float s_own = 0.f;
#pragma unroll
            for (int i = 0; i < 4; ++i) if (i == oi) s_own = sc[i];
            const float ssel = __shfl(s_own, owner);
            if (lane == owner) {
#pragma unroll
                for (int i = 0; i < 4; ++i) if (i == oi) cv[i] = -INFINITY;
            }
            ssum += ssel;
            if (lane == k) { mysc = ssel; myidx = gi; }
        }
        if (lane < TOPK) {
            EIDX[(size_t)r * 8 + lane] = myidx;
            GATE[(size_t)r * 8 + lane] = mysc / ssum * 2.5f;
            RANK[(size_t)r * 8 + lane] = __hip_atomic_fetch_add(hist + myidx, 1, __ATOMIC_RELAXED, __HIP_MEMORY_SCOPE_WORKGROUP);
        }
    }
    __syncthreads();
    if (tid_() < 256) HIST[(size_t)bid_() * 256 + tid_()] = hist[tid_()];
    __syncthreads();
}

DI void phase_scatter(const Params& p0, int l, LAS unsigned char* lds) {
    const Params p = launder(p0); l = launder_s(l);
    LAS int* off = (LAS int*)lds;
    LAS int* toff = off + 260;
    LAS int* tot = toff + 260;
    LAS int* base = tot + 256;
    const int tid = tid_(), bid = bid_(), G = gridDim.x;
    const int* HIST = (const int*)(p.ws + WS_HIST);
    const int* RANK = (const int*)(p.ws + WS_RANK);
    int* ntl = (int*)(p.ws + CTL_NTILES) + l;
    int* TILES = (int*)(p.ws + WS_TILES);
    const int* EIDX = (const int*)(p.ws + WS_EIDX);
    int* SORT = (int*)(p.ws + WS_SORT);
    if (tid < 256) {
        int t = 0, bs = 0;
        for (int b2 = 0; b2 < G; ++b2) { const int v = HIST[(size_t)b2 * 256 + tid]; bs += (b2 < bid) ? v : 0; t += v; }
        tot[tid] = t; base[tid] = bs;
    }
    __syncthreads();
    if (tid == 0) {
        int a = 0, t = 0;
        for (int e = 0; e < 256; ++e) { off[e] = a; toff[e] = t; const int c = tot[e]; a += c; t += (c + 127) >> 7; }
        off[256] = a; toff[256] = t;
    }
    __syncthreads();
    if (bid == 0) {
        if (tid < 256) {
            const int e = tid, c = off[e + 1] - off[e], nt = toff[e + 1] - toff[e];
            for (int t = 0; t < nt; ++t) { int* T = TILES + (size_t)(toff[e] + t) * 4; T[0] = e; T[1] = off[e] + t * 128; T[2] = (c - t * 128) < 128 ? (c - t * 128) : 128; T[3] = 0; }
        }
        if (tid == 0) *ntl = toff[256];
    }
    const int chunk = (MROWS + G - 1) / G, r_begin = bid * chunk, r_end = (r_begin + chunk) < MROWS ? (r_begin + chunk) : MROWS;
    for (int a = r_begin * 8 + tid; a < r_end * 8; a += NTHREADS) {
        const int e = EIDX[a];
        SORT[off[e] + base[e] + RANK[a]] = a;
    }
    __syncthreads();
}

constexpr int MOE_STG = 40960;
constexpr int MOE_HT = 2 * MOE_STG;
constexpr int MOE_INFO = MOE_HT + 65536;
DI int swz64(int row, int chunk) { return row * 64 + ((chunk ^ ((0 - (row >> 2)) & 3)) << 4); }

DI void moe_unit(const Params& p, const float* Wgu, const float* Wdn, bf16_t* outbase, bool shared, int r0, int nr, LAS unsigned char* lds) {
    const int t = tid_(), lane = t & 63, wid = t >> 6, fr = lane & 15, fq = lane >> 4, wn = wid & 3, wt = wid >> 2;
    const bf16_t* TOK = (const bf16_t*)(p.ws + WS_TOK);
    const int* SORT = (const int*)(p.ws + WS_SORT);
    LAS int* rowtok = (LAS int*)(lds + MOE_INFO);
    LAS int* rowout = rowtok + 128;
    __syncthreads();
    if (t < 128) {
        int tk = -1, ro = -1;
        if (t < nr) { if (shared) { tk = r0 + t; ro = tk; } else { const int a = SORT[r0 + t]; tk = a >> 3; ro = a; } }
        rowtok[t] = tk; rowout[t] = ro;
    }
    __syncthreads();
    const int arow_l = t >> 2, ach = t & 3;
    const int atok = rowtok[arow_l];
    const bf16_t* aptr = TOK + (size_t)(atok < 0 ? 0 : atok) * DM + ach * 8;
    const int nq = t & 127, kg = t >> 7;
    const int a_off = swz64(arow_l, ach);
    const int b_off = 8192 + (4 * nq) * 64 + ((kg ^ ((0 - nq) & 3)) << 4);
    f32x4 acc[8][4];
    f32x4 wb[8]; u32x4 ta;
    const u32x4 z4 = {0u, 0u, 0u, 0u};
    {
        const int np = 4 * nq;
        const int srccol = ((np >> 4) & 1) * 256 + (np >> 5) * 16 + (np & 15);
        const float* wptr = Wgu + (size_t)(kg * 8) * 512 + srccol;
#pragma unroll
        for (int nf = 0; nf < 8; ++nf)
#pragma unroll
            for (int tf = 0; tf < 4; ++tf) acc[nf][tf] = (f32x4){0.f, 0.f, 0.f, 0.f};
        ta = atok < 0 ? z4 : *(const u32x4*)aptr;
#pragma unroll
        for (int kk = 0; kk < 8; ++kk) wb[kk] = *(const f32x4*)(wptr + (size_t)kk * 512);
        {
            LAS unsigned char* S = lds;
            *(LAS u32x4*)(S + a_off) = ta;
#pragma unroll
            for (int j = 0; j < 4; ++j) { const u32x4 w = {pk_bf16(wb[0][j], wb[1][j]), pk_bf16(wb[2][j], wb[3][j]), pk_bf16(wb[4][j], wb[5][j]), pk_bf16(wb[6][j], wb[7][j])}; *(LAS u32x4*)(S + b_off + j * 64) = w; }
        }
        __syncthreads();
        for (int kt = 0; kt < 32; ++kt) {
            const bool more = kt + 1 < 32;
            if (more) {
                ta = atok < 0 ? z4 : *(const u32x4*)(aptr + (kt + 1) * 32);
                const float* w2 = wptr + (size_t)(kt + 1) * 32 * 512;
#pragma unroll
                for (int kk = 0; kk < 8; ++kk) wb[kk] = *(const f32x4*)(w2 + (size_t)kk * 512);
            }
            LAS unsigned char* S = lds + (kt & 1) * MOE_STG;
            bf16x8 tfr[4];
#pragma unroll
            for (int tf = 0; tf < 4; ++tf) tfr[tf] = *(LAS bf16x8*)(S + swz64(wt * 64 + tf * 16 + fr, fq));
#pragma unroll
            for (int nf = 0; nf < 8; ++nf) {
                const bf16x8 wf = *(LAS bf16x8*)(S + 8192 + swz64(wn * 128 + nf * 16 + fr, fq));
#pragma unroll
                for (int tf = 0; tf < 4; ++tf) acc[nf][tf] = MFMA16(wf, tfr[tf], acc[nf][tf]);
            }
            if (more) {
                LAS unsigned char* S2 = lds + ((kt + 1) & 1) * MOE_STG;
                *(LAS u32x4*)(S2 + a_off) = ta;
#pragma unroll
                for (int j = 0; j < 4; ++j) { const u32x4 w = {pk_bf16(wb[0][j], wb[1][j]), pk_bf16(wb[2][j], wb[3][j]), pk_bf16(wb[4][j], wb[5][j]), pk_bf16(wb[6][j], wb[7][j])}; *(LAS u32x4*)(S2 + b_off + j * 64) = w; }
            }
            __syncthreads();
        }
#pragma unroll
        for (int i = 0; i < 4; ++i)
#pragma unroll
            for (int tf = 0; tf < 4; ++tf) {
                float hv[4];
#pragma unroll
                for (int j = 0; j < 4; ++j) hv[j] = silu_f(acc[2 * i][tf][j]) * acc[2 * i + 1][tf][j];
                const int tok = wt * 64 + tf * 16 + fr, hc = wn * 64 + i * 16 + 4 * fq;
                const u32x2 w = {pk_bf16(hv[0], hv[1]), pk_bf16(hv[2], hv[3])};
                *(LAS u32x2*)(lds + MOE_HT + tok * 512 + (((hc >> 3) ^ (tok & 15)) << 4) + (hc & 7) * 2) = w;
            }
    }
    __syncthreads();
    for (int nc = 0; nc < 2; ++nc) {
        const float* wptr = Wdn + (size_t)(kg * 8) * DM + nc * 512 + 4 * nq;
#pragma unroll
        for (int nf = 0; nf < 8; ++nf)
#pragma unroll
            for (int tf = 0; tf < 4; ++tf) acc[nf][tf] = (f32x4){0.f, 0.f, 0.f, 0.f};
#pragma unroll
        for (int kk = 0; kk < 8; ++kk) wb[kk] = *(const f32x4*)(wptr + (size_t)kk * DM);
        {
            LAS unsigned char* S = lds;
#pragma unroll
            for (int j = 0; j < 4; ++j) { const u32x4 w = {pk_bf16(wb[0][j], wb[1][j]), pk_bf16(wb[2][j], wb[3][j]), pk_bf16(wb[4][j], wb[5][j]), pk_bf16(wb[6][j], wb[7][j])}; *(LAS u32x4*)(S + b_off + j * 64) = w; }
        }
        __syncthreads();
        for (int kt = 0; kt < 8; ++kt) {
            const bool more = kt + 1 < 8;
            if (more) {
                const float* w2 = wptr + (size_t)(kt + 1) * 32 * DM;
#pragma unroll
                for (int kk = 0; kk < 8; ++kk) wb[kk] = *(const f32x4*)(w2 + (size_t)kk * DM);
            }
            LAS unsigned char* S = lds + (kt & 1) * MOE_STG;
            bf16x8 tfr[4];
#pragma unroll
            for (int tf = 0; tf < 4; ++tf) { const int tok = wt * 64 + tf * 16 + fr; tfr[tf] = *(LAS bf16x8*)(lds + MOE_HT + tok * 512 + (((kt * 4 + fq) ^ (tok & 15)) << 4)); }
#pragma unroll
            for (int nf = 0; nf < 8; ++nf) {
                const bf16x8 wf = *(LAS bf16x8*)(S + 8192 + swz64(wn * 128 + nf * 16 + fr, fq));
#pragma unroll
                for (int tf = 0; tf < 4; ++tf) acc[nf][tf] = MFMA16(wf, tfr[tf], acc[nf][tf]);
            }
            if (more) {
                LAS unsigned char* S2 = lds + ((kt + 1) & 1) * MOE_STG;
#pragma unroll
                for (int j = 0; j < 4; ++j) { const u32x4 w = {pk_bf16(wb[0][j], wb[1][j]), pk_bf16(wb[2][j], wb[3][j]), pk_bf16(wb[4][j], wb[5][j]), pk_bf16(wb[6][j], wb[7][j])}; *(LAS u32x4*)(S2 + b_off + j * 64) = w; }
            }
            __syncthreads();
        }
        LAS unsigned char* W = lds + wid * 9216;
#pragma unroll
        for (int half = 0; half < 2; ++half) {
#pragma unroll
            for (int nh = 0; nh < 4; ++nh)
#pragma unroll
                for (int tf = 0; tf < 4; ++tf) {
                    const f32x4 v = acc[half * 4 + nh][tf];
                    const u32x2 w = {pk_bf16(v[0], v[1]), pk_bf16(v[2], v[3])};
                    *(LAS u32x2*)(W + (tf * 16 + fr) * 144 + nh * 32 + fq * 8) = w;
                }
#pragma unroll
            for (int it = 0; it < 8; ++it) {
                const int row = it * 8 + (lane >> 3), ch = lane & 7;
                const u32x4 v = *(LAS u32x4*)(W + row * 144 + ch * 16);
                const int ro = rowout[wt * 64 + row];
                if (ro >= 0) *(u32x4*)(outbase + (size_t)ro * DM + nc * 512 + wn * 128 + half * 64 + ch * 8) = v;
            }
        }
        __syncthreads();
    }
}

DI void phase_moe(const Params& p0, int l, LAS unsigned char* lds) {
    const Params p = launder(p0); l = launder_s(l);
    const int* TILES = (const int*)(p.ws + WS_TILES);
    const int ntl = *((const int*)(p.ws + CTL_NTILES) + l);
    const int G = gridDim.x, bid = bid_();
    const int vcu = (G % 8 == 0) ? (bid % 8) * (G / 8) + bid / 8 : bid;
    const int total = ntl + MROWS / 128;
    for (int u = vcu; u < total; u += G) {
        if (u < ntl) {
            const int e = TILES[u * 4], r0 = TILES[u * 4 + 1], nr = TILES[u * 4 + 2];
            moe_unit(p, p.w_egu + ((size_t)l * NEXP + e) * DM * 512, p.w_edn + ((size_t)l * NEXP + e) * 256 * DM, (bf16_t*)(p.ws + WS_YSLOT), false, r0, nr, lds);
        } else {
            const int tm = u - ntl;
            if (l == 1 && (tm % (NT / 128)) < 2) continue;
            moe_unit(p, p.w_sgu + (size_t)l * DM * 512, p.w_sdn + (size_t)l * 256 * DM, (bf16_t*)(p.ws + WS_YSH), true, tm * 128, 128, lds);
        }
    }
}

DI void phase_combine(const Params& p0, int l) {
    const Params p = launder(p0); l = launder_s(l);
    const float* X1 = (const float*)(p.ws + WS_XB); float* Xnext = (float*)(p.ws + WS_XA);
    const int lane = tid_() & 63, wid = tid_() >> 6;
    const bf16_t* YSL = (const bf16_t*)(p.ws + WS_YSLOT); const bf16_t* YSH = (const bf16_t*)(p.ws + WS_YSH);
    const float* GATE = (const float*)(p.ws + WS_GATE);
    const float* modv = (const float*)(p.ws + WS_MODV);
    const float* lg = p.ln_g + (size_t)(l * 2 + 1) * DM; const float* lb = p.ln_b + (size_t)(l * 2 + 1) * DM;
    bf16_t* H = (bf16_t*)(p.ws + WS_H);
    for (int r = bid_() * 8 + wid; r < MROWS; r += gridDim.x * 8) {
        const int b = r >= NT, pp = r - b * NT;
        if (l == 1 && pp < NCTX) continue;
        const int sel = pp < NCTX ? 2 : b;
        float gt[8];
#pragma unroll
        for (int k = 0; k < 8; ++k) gt[k] = GATE[(size_t)r * 8 + k];
        const float* g5 = modv + ((size_t)l * 3 + sel) * 6144 + 5 * 1024;
        f32x4 v[4];
#pragma unroll
        for (int i = 0; i < 4; ++i) {
            const int c = lane * 4 + i * 256;
            const u32x2 sw = *(const u32x2*)(YSH + (size_t)r * DM + c);
            float f0 = bf_lo(sw[0]), f1 = bf_hi(sw[0]), f2 = bf_lo(sw[1]), f3 = bf_hi(sw[1]);
#pragma unroll
            for (int k = 0; k < 8; ++k) {
                const u32x2 w = *(const u32x2*)(YSL + ((size_t)r * 8 + k) * DM + c);
                f0 += gt[k] * bf_lo(w[0]); f1 += gt[k] * bf_hi(w[0]); f2 += gt[k] * bf_lo(w[1]); f3 += gt[k] * bf_hi(w[1]);
            }
            const f32x4 xv = *(const f32x4*)(X1 + (size_t)r * DM + c), gv = *(const f32x4*)(g5 + c);
            v[i] = (f32x4){DN_ALPHA * xv[0] + gv[0] * f0, DN_ALPHA * xv[1] + gv[1] * f1, DN_ALPHA * xv[2] + gv[2] * f2, DN_ALPHA * xv[3] + gv[3] * f3};
        }
        float mu, rstd; ln_stats(v, mu, rstd);
#pragma unroll
        for (int i = 0; i < 4; ++i) {
            const int c = lane * 4 + i * 256;
            const f32x4 gg = *(const f32x4*)(lg + c), bb = *(const f32x4*)(lb + c);
#pragma unroll
            for (int j = 0; j < 4; ++j) v[i][j] = (v[i][j] - mu) * rstd * gg[j] + bb[j];
            if (l == 1) *(f32x4*)(p.out + ((size_t)b * NLAT + (pp - NCTX)) * DM + c) = v[i];
            else *(f32x4*)(Xnext + (size_t)r * DM + c) = v[i];
        }
        if (l == 0) { const float* mv = modv + ((size_t)1 * 3 + sel) * 6144; modulate_store(v, mv, mv + 1024, H + (size_t)r * DM, lane); }
    }
}

constexpr int PH_PER_LAYER = 11, N_PHASES = 3 + 2 * PH_PER_LAYER;
__global__ void __launch_bounds__(NTHREADS, 2) mega(Params p) {
    extern __shared__ __attribute__((aligned(16))) unsigned char lds_raw[];
    LAS unsigned char* lds = (LAS unsigned char*)lds_raw;
    volatile LAS unsigned* bst = (volatile LAS unsigned*)(lds + LDS_BYTES - 16);
    if (threadIdx.x == 0) { bst[0] = 0u; bst[1] = 0u; bst[2] = 0u; bst[3] = 0u; }
    __syncthreads();
    const int lo = p.ph_lo, hi = p.ph_hi;
    XcdBarrier bar; bar.bar = (unsigned*)(p.ws + WS_CTL); bar.x = 0; bar.st = bst;
    if (hi - lo > 1) bar = xcd_barrier_post((unsigned*)(p.ws + WS_CTL), bst);
#ifndef ONLY_PHASE
#define ONLY_PHASE -1
#endif
#define IN(k) (lo <= (k) && (k) < hi)
#define ON(pid) (ONLY_PHASE < 0 || ONLY_PHASE == (pid))
#ifndef DUP_PHASE
#define DUP_PHASE -1
#endif
#define REP(pid) for (int rep_ = 0; rep_ < ((DUP_PHASE == (pid)) ? 2 : 1); ++rep_)
#define SEAM(k) do { if (IN(k) && IN((k) + 1)) xcd_barrier(bar); } while (0)
    if (ON(0) && IN(0)) REP(0) phase_convert(p, lds);
    SEAM(0);
    if (ON(1) && IN(1)) REP(1) phase_mod(p, lds);
    SEAM(1);
    if (ON(2) && IN(2)) REP(2) phase_ln0(p);
    SEAM(2);
    for (int l = 0; l < 2; ++l) {
        const int k0 = 3 + l * PH_PER_LAYER;
        if (ON(3) && IN(k0 + 0)) REP(3) phase_inproj(p, l, lds);
        SEAM(k0 + 0);
        if (ON(4) && IN(k0 + 1)) REP(4) phase_ret_sum_pool(p, l, lds);
        SEAM(k0 + 1);
        if (ON(5) && IN(k0 + 2)) REP(5) phase_ret_scan(p, l);
        SEAM(k0 + 2);
        if (ON(6) && IN(k0 + 3)) REP(6) { phase_attn(p, l, lds); phase_ret(p, l); }
        SEAM(k0 + 3);
        if (ON(7) && IN(k0 + 4)) REP(7) phase_outproj(p, l, lds);
        SEAM(k0 + 4);
        if (ON(8) && IN(k0 + 5)) REP(8) phase_ln_mid(p, l);
        SEAM(k0 + 5);
        if (ON(9) && IN(k0 + 6)) REP(9) phase_router(p, l, lds);
        SEAM(k0 + 6);
        if (ON(10) && IN(k0 + 7)) REP(10) phase_topk(p, l, lds);
        SEAM(k0 + 7);
        if (ON(11) && IN(k0 + 8)) REP(11) phase_scatter(p, l, lds);
        SEAM(k0 + 8);
        if (ON(12) && IN(k0 + 9)) REP(12) phase_moe(p, l, lds);
        SEAM(k0 + 9);
        if (ON(14) && IN(k0 + 10)) REP(14) phase_combine(p, l);
        if (l == 0) SEAM(k0 + 10);
    }
#undef IN
#undef SEAM
}

extern "C" void kernel_launch(void* const* d_in, const int* in_sizes, int n_in, void* d_out, int out_size, void* d_ws, size_t ws_size, hipStream_t stream) {
    static int grid = 0;
    if (grid == 0) {
        if (n_in != 20 || ws_size < WS_END || out_size != NB * NLAT * DM) { fprintf(stderr, "kernel_launch: unexpected shapes (n_in %d, ws %zu need %zu, out %d)\n", n_in, ws_size, (size_t)WS_END, out_size); grid = -1; return; }
        int dev = 0, cus = 0, per_cu = 0;
        hipGetDevice(&dev); hipDeviceGetAttribute(&cus, hipDeviceAttributeMultiprocessorCount, dev);
        if (hipFuncSetAttribute((const void*)mega, hipFuncAttributeMaxDynamicSharedMemorySize, LDS_BYTES) != hipSuccess) { fprintf(stderr, "kernel_launch: hipFuncSetAttribute failed\n"); grid = -1; return; }
        if (hipOccupancyMaxActiveBlocksPerMultiprocessor(&per_cu, (const void*)mega, NTHREADS, LDS_BYTES) != hipSuccess || per_cu < 1) { fprintf(stderr, "kernel_launch: occupancy query says %d\n", per_cu); }
        (void)hipGetLastError();
        grid = cus > 0 ? cus : 256;
    }
    if (grid < 0) return;
    hipMemsetAsync((char*)d_ws + WS_CTL, 0, CTL_BYTES, stream);
    Params p{};
    p.x = (const float*)d_in[0]; p.c = (const float*)d_in[1]; p.ctx = (const float*)d_in[2]; p.c_ctx = (const float*)d_in[3];
    p.w_mod = (const float*)d_in[4]; p.b_mod = (const float*)d_in[5]; p.w_in = (const float*)d_in[6]; p.w_out = (const float*)d_in[7];
    p.diff_lambda = (const float*)d_in[8]; p.pool_w = (const float*)d_in[9]; p.pool_scale = (const float*)d_in[10]; p.ret_log_decay = (const float*)d_in[11];
    p.ln_g = (const float*)d_in[12]; p.ln_b = (const float*)d_in[13]; p.w_router = (const float*)d_in[14]; p.router_bias = (const float*)d_in[15];
    p.w_egu = (const float*)d_in[16]; p.w_edn = (const float*)d_in[17]; p.w_sgu = (const float*)d_in[18]; p.w_sdn = (const float*)d_in[19];
    p.out = (float*)d_out; p.ws = (unsigned char*)d_ws;
#if N_LAUNCH_PER_PHASE
    for (int k = 0; k < N_PHASES; ++k) { p.ph_lo = k; p.ph_hi = k + 1; hipLaunchKernelGGL(mega, dim3(grid), dim3(NTHREADS), LDS_BYTES, stream, p); }
#else
    p.ph_lo = 0; p.ph_hi = N_PHASES;
    hipLaunchKernelGGL(mega, dim3(grid), dim3(NTHREADS), LDS_BYTES, stream, p);
#endif
}
```

```cpp
#include <hip/hip_runtime.h>
#include <stdint.h>
#include <stdio.h>

#ifndef N_LAUNCH_PER_PHASE
#define N_LAUNCH_PER_PHASE 0
#endif

#define LAS __attribute__((address_space(3)))
#define DI __device__ __forceinline__
typedef unsigned short bf16_t;
typedef short bf16x8 __attribute__((ext_vector_type(8)));
typedef float f32x2 __attribute__((ext_vector_type(2)));
typedef float f32x4 __attribute__((ext_vector_type(4)));
typedef float f32x16 __attribute__((ext_vector_type(16)));
typedef unsigned u32x2 __attribute__((ext_vector_type(2)));
typedef unsigned u32x4 __attribute__((ext_vector_type(4)));
typedef __bf16 bf16v2 __attribute__((ext_vector_type(2)));

constexpr int NB = 2, NLAT = 8192, NCTX = 256, NT = NLAT + NCTX  , MROWS = NB * NT  ;
constexpr int DM = 1024, INW = 2816, NEXP = 256, TOPK = 8, NASG = MROWS * TOPK  ;
constexpr int NCHUNK = NT / 128;
constexpr float DN_ALPHA = 1.41421356237f;
constexpr float LN_EPS = 1e-6f, RMS_EPS = 1e-5f;
constexpr float LOG2E = 1.44269504089f;
constexpr float QSCALE = 0.125f * LOG2E;
constexpr int NTHREADS = 512;
constexpr int LDS_BYTES = 155648;

constexpr int C_DQ = 0, C_DK = 512, C_DV = 1024, C_PU = 1536, C_RQ = 1792, C_RK = 2048, C_RV = 2304, C_RG = 2560;

constexpr size_t al256(size_t x) { return (x + 255) & ~(size_t)255; }
constexpr size_t WS_CTL = 0;
constexpr size_t CTL_BYTES = 65536;
constexpr size_t CTL_COUNTS = 16384;
constexpr size_t CTL_CURSOR = CTL_COUNTS + 2048;
constexpr size_t CTL_NTILES = CTL_CURSOR + 2048;
constexpr size_t CTL_XRANK = CTL_NTILES + 256;
constexpr size_t WS_MODV = WS_CTL + CTL_BYTES;
constexpr size_t WS_ROPE = al256(WS_MODV + 2 * 3 * 6144 * 4);
constexpr size_t WS_SCAL = al256(WS_ROPE + 128 * 16 * 8);
constexpr size_t WS_WIN = al256(WS_SCAL + 2 * 16 * 4);
constexpr size_t WS_WOUT = al256(WS_WIN + (size_t)2 * INW * DM * 2);
constexpr size_t WS_WR = al256(WS_WOUT + (size_t)2 * DM * DM * 2);
constexpr size_t WS_WIMG = al256(WS_WR + (size_t)2 * 256 * DM * 2);
constexpr size_t WS_XA = al256(WS_WIMG + (size_t)2 * 257 * 48 * 32768);
constexpr size_t WS_XB = al256(WS_XA + (size_t)MROWS * DM * 4);
constexpr size_t WS_V1 = al256(WS_XB + (size_t)MROWS * DM * 4);
constexpr size_t WS_H = al256(WS_V1 + (size_t)MROWS * DM * 4);
constexpr size_t WS_TOK = al256(WS_H + (size_t)MROWS * DM * 2);
constexpr size_t WS_P = al256(WS_TOK + (size_t)MROWS * DM * 2);
constexpr size_t WS_VT = al256(WS_P + (size_t)MROWS * INW * 2);
constexpr size_t WS_RKT = al256(WS_VT + (size_t)NB * 4 * 128 * NT * 2);
constexpr size_t WS_RVT = al256(WS_RKT + (size_t)NB * 4 * 64 * NT * 2);
constexpr size_t WS_MIX = al256(WS_RVT + (size_t)NB * 4 * 64 * NT * 2);
constexpr size_t ST_BYTES = (size_t)NB * 4 * NCHUNK * 4096 * 4;
constexpr size_t WS_UF = al256(WS_MIX + (size_t)MROWS * DM * 2);
constexpr size_t WS_UB = al256(WS_UF + ST_BYTES);
constexpr size_t WS_SF = al256(WS_UB + ST_BYTES);
constexpr size_t WS_SB = al256(WS_SF + ST_BYTES);
constexpr size_t WS_LOGIT = al256(WS_SB + ST_BYTES);
constexpr size_t WS_EIDX = al256(WS_LOGIT + (size_t)MROWS * 256 * 4);
constexpr size_t WS_GATE = al256(WS_EIDX + (size_t)NASG * 4);
constexpr size_t WS_SORT = al256(WS_GATE + (size_t)NASG * 4);
constexpr size_t WS_RANK = al256(WS_SORT + (size_t)NASG * 4);
constexpr size_t WS_HIST = al256(WS_RANK + (size_t)NASG * 4);
constexpr size_t WS_TILES = al256(WS_HIST + (size_t)1024 * 256 * 4);
constexpr size_t WS_YSLOT = al256(WS_TILES + 2048 * 16);
constexpr size_t WS_YSH = al256(WS_YSLOT + (size_t)NASG * DM * 2);
constexpr size_t WS_END = al256(WS_YSH + (size_t)MROWS * DM * 2);

struct Params {
    const float *x, *c, *ctx, *c_ctx, *w_mod, *b_mod, *w_in, *w_out, *diff_lambda, *pool_w, *pool_scale, *ret_log_decay, *ln_g, *ln_b,
        *w_router, *router_bias, *w_egu, *w_edn, *w_sgu, *w_sdn;
    float* out;
    unsigned char* ws;
    int ph_lo, ph_hi;
};


DI Params launder(const Params& a) {
    Params r = a;
    unsigned long long* d = (unsigned long long*)&r;
#pragma unroll
    for (int i = 0; i < 22; ++i) asm volatile("" : "+s"(d[i]));
    return r;
}
DI int launder_s(int v) { asm volatile("" : "+s"(v)); return v; }
DI int tid_() { int t = threadIdx.x; asm volatile("" : "+v"(t)); return t; }
DI int bid_() { int t = blockIdx.x; asm volatile("" : "+s"(t)); return t; }

#define XB_TMO      128
#define XB_XCNT(j)  (256  + 64 * (j))
#define XB_XSUB(j)  (1280 + 64 * (j))
#define XB_XGEN(j)  (2304 + 64 * (j))
#define XB_TOP      3328
#define XB_TOPGEN   3392
#define XCD_BAR_WORDS 3456
#define XB_SPIN_CAP (1u << 20)

__device__ __forceinline__ unsigned xb_ld(unsigned* p)              { return __hip_atomic_load(p, __ATOMIC_RELAXED, __HIP_MEMORY_SCOPE_AGENT); }
__device__ __forceinline__ unsigned xb_add(unsigned* p, unsigned v) { return __hip_atomic_fetch_add(p, v, __ATOMIC_RELAXED, __HIP_MEMORY_SCOPE_AGENT); }
__device__ __forceinline__ unsigned xb_xcc_id() { return (unsigned)__builtin_amdgcn_s_getreg((3 << 11) | 20) & 0xFu; }
#define XB_SPIN(cond, bar) do { unsigned _sp = 0; while (cond) { __builtin_amdgcn_s_sleep(1); \
    if ((++_sp & 255u) == 0u) { if (xb_ld(&(bar)[XB_TMO])) break; if (_sp > XB_SPIN_CAP) { atomicAdd(&(bar)[XB_TMO], 1u); break; } } } } while (0)

struct XcdBarrier { unsigned* bar; unsigned x; volatile LAS unsigned* st; };

__device__ __forceinline__ XcdBarrier xcd_barrier_post(unsigned* bar, volatile LAS unsigned* st) {
    XcdBarrier b; b.bar = bar; b.x = xb_xcc_id(); b.st = st;
    if (threadIdx.x == 0) (void)xb_add(&bar[XB_XCNT(b.x)], 1u);
    return b;
}
__device__ __forceinline__ void xcd_barrier_complete(unsigned* bar, unsigned x, unsigned& nloc, unsigned& nx) {
    const unsigned G = gridDim.x * gridDim.y * gridDim.z;
    unsigned sum, cnt, mine, sp = 0u;
    for (;;) {
        sum = 0u; cnt = 0u; mine = 0u;
#pragma unroll
        for (unsigned j = 0; j < 16; ++j) { const unsigned c = xb_ld(&bar[XB_XCNT(j)]); sum += c; cnt += (c > 0u) ? 1u : 0u; mine = (j == x) ? c : mine; }
        if (sum == G) break;
        __builtin_amdgcn_s_sleep(1);
        if ((++sp & 255u) == 0u) { if (xb_ld(&bar[XB_TMO])) break; if (sp > XB_SPIN_CAP) { atomicAdd(&bar[XB_TMO], 1u); break; } }
    }
    nloc = mine > 0u ? mine : 1u; nx = cnt > 0u ? cnt : 1u;
}
__device__ __forceinline__ void xcd_barrier(const XcdBarrier& b) {
    asm volatile("s_waitcnt vmcnt(0)" ::: "memory");
    __syncthreads();
    if (threadIdx.x == 0) {
        unsigned* bar = b.bar;
        __builtin_amdgcn_s_waitcnt(0);
        unsigned nloc = b.st[0], nx = b.st[1];
        if (nloc == 0u) { xcd_barrier_complete(bar, b.x, nloc, nx); b.st[0] = nloc; b.st[1] = nx; }
        const unsigned old = xb_add(&bar[XB_XSUB(b.x)], 1u);
        const unsigned gen = old / nloc;
        if (old + 1u == (gen + 1u) * nloc) {
            __builtin_amdgcn_fence(__ATOMIC_RELEASE, "agent");
            asm volatile("s_waitcnt vmcnt(0)" ::: "memory");
            const unsigned og = xb_add(&bar[XB_TOP], 1u);
            const unsigned tg = og / nx;
            if (og + 1u == (tg + 1u) * nx) xb_add(&bar[XB_TOPGEN], 1u);
            else XB_SPIN(xb_ld(&bar[XB_TOPGEN]) == tg, bar);
            __builtin_amdgcn_fence(__ATOMIC_ACQUIRE, "agent");
            xb_add(&bar[XB_XGEN(b.x)], 1u);
            asm volatile("s_waitcnt vmcnt(0)" ::: "memory");
        } else {
            XB_SPIN(xb_ld(&bar[XB_XGEN(b.x)]) == gen, bar);
            __builtin_amdgcn_fence(__ATOMIC_ACQUIRE, "agent");
            asm volatile("s_waitcnt vmcnt(0)" ::: "memory");
        }
    }
    __syncthreads();
}

DI unsigned pk_bf16(float a, float b) { f32x2 v = {a, b}; bf16v2 r = __builtin_convertvector(v, bf16v2); return __builtin_bit_cast(unsigned, r); }
DI bf16_t to_bf16(float a) { return (bf16_t)(pk_bf16(a, 0.f) & 0xffffu); }
DI float bf_lo(unsigned u) { return __uint_as_float(u << 16); }
DI float bf_hi(unsigned u) { return __uint_as_float(u & 0xffff0000u); }
DI float bf2f(bf16_t h) { return __uint_as_float(((unsigned)h) << 16); }
DI float wave_sum(float v) {
#pragma unroll
    for (int o = 32; o; o >>= 1) v += __shfl_xor(v, o);
    return v;
}
DI float fast_exp2(float x) { return __builtin_amdgcn_exp2f(x); }
DI float silu_f(float x) { return x / (1.f + __expf(-x)); }
DI bf16x8 as_bf16x8(u32x4 v) { return __builtin_bit_cast(bf16x8, v); }
#define WAIT_VM(n) asm volatile("s_waitcnt vmcnt(" #n ")" ::: "memory")
DI void dma16(const void* g, LAS unsigned char* l) { __builtin_amdgcn_global_load_lds(g, (LAS void*)l, 16, 0, 0); }
#define MFMA32(a, b, c) __builtin_amdgcn_mfma_f32_32x32x16_bf16((a), (b), (c), 0, 0, 0)
#define MFMA16(a, b, c) __builtin_amdgcn_mfma_f32_16x16x32_bf16((a), (b), (c), 0, 0, 0)

DI int row_sel(int r) { const int b = r >= NT; const int p = r - b * NT; return p < NCTX ? 2 : b; }

DI int swz_off(int row, int chunk) { return row * 128 + ((chunk ^ ((row >> 1) & 7)) << 4); }

template <class Epi>
DI void gemm128(const bf16_t* a0, const bf16_t* a1, const bf16_t* b0, const bf16_t* b1, int nk, LAS unsigned char* lds, const Epi& epi) {
    const int tid = tid_(), lane = tid & 63, wid = tid >> 6, wr = wid >> 2, wc = wid & 3, fr = lane & 15, fq = lane >> 4;
    const int lrow = tid >> 3, lch = tid & 7;
    f32x4 acc[4][2];
#pragma unroll
    for (int m = 0; m < 4; ++m)
#pragma unroll
        for (int n = 0; n < 2; ++n) acc[m][n] = (f32x4){0.f, 0.f, 0.f, 0.f};
    const u32x4 z4 = {0u, 0u, 0u, 0u};
    u32x4 ra0 = a0 ? *(const u32x4*)a0 : z4, ra1 = a1 ? *(const u32x4*)a1 : z4, rb0 = b0 ? *(const u32x4*)b0 : z4, rb1 = b1 ? *(const u32x4*)b1 : z4;
    const int wo0 = swz_off(lrow, lch), wo1 = swz_off(lrow + 64, lch);
    *(LAS u32x4*)(lds + wo0) = ra0; *(LAS u32x4*)(lds + wo1) = ra1;
    *(LAS u32x4*)(lds + 16384 + wo0) = rb0; *(LAS u32x4*)(lds + 16384 + wo1) = rb1;
    __syncthreads();
    for (int kt = 0; kt < nk; ++kt) {
        const bool more = kt + 1 < nk;
        if (more) {
            const int ko = (kt + 1) * 64;
            ra0 = a0 ? *(const u32x4*)(a0 + ko) : z4; ra1 = a1 ? *(const u32x4*)(a1 + ko) : z4;
            rb0 = b0 ? *(const u32x4*)(b0 + ko) : z4; rb1 = b1 ? *(const u32x4*)(b1 + ko) : z4;
        }
        LAS unsigned char* A = lds + (kt & 1) * 32768;
        LAS unsigned char* B = A + 16384;
#pragma unroll
        for (int kk = 0; kk < 2; ++kk) {
            bf16x8 af[4], bfr[2];
#pragma unroll
            for (int m = 0; m < 4; ++m) af[m] = *(LAS bf16x8*)(A + swz_off(wr * 64 + m * 16 + fr, kk * 4 + fq));
#pragma unroll
            for (int n = 0; n < 2; ++n) bfr[n] = *(LAS bf16x8*)(B + swz_off(wc * 32 + n * 16 + fr, kk * 4 + fq));
#pragma unroll
            for (int m = 0; m < 4; ++m)
#pragma unroll
                for (int n = 0; n < 2; ++n) acc[m][n] = MFMA16(af[m], bfr[n], acc[m][n]);
        }
        if (more) {
            LAS unsigned char* A2 = lds + ((kt + 1) & 1) * 32768;
            *(LAS u32x4*)(A2 + wo0) = ra0; *(LAS u32x4*)(A2 + wo1) = ra1;
            *(LAS u32x4*)(A2 + 16384 + wo0) = rb0; *(LAS u32x4*)(A2 + 16384 + wo1) = rb1;
        }
        __syncthreads();
    }
    epi(acc, wr, wc, fr, fq);
}

DI int perm_gu(int n) { const int f = n >> 8, jj = n & 255; return ((jj >> 4) << 5) + (f << 4) + (jj & 15); }
DI void conv_unit(const float* src, int N, int K, bf16_t* dst, int k0, int n0, bool perm, LAS unsigned char* lds) {
    LAS float* tl = (LAS float*)lds;
    const int tid = tid_();
#pragma unroll
    for (int i = 0; i < 8; ++i) {
        const int kk = (tid >> 6) + 8 * i, nn = (tid & 63) * 4;
        const f32x4 v = *(const f32x4*)(src + (size_t)(k0 + kk) * N + n0 + nn);
        tl[kk * 257 + nn] = v[0]; tl[kk * 257 + nn + 1] = v[1]; tl[kk * 257 + nn + 2] = v[2]; tl[kk * 257 + nn + 3] = v[3];
    }
    __syncthreads();
    const int n = tid >> 1, kh = (tid & 1) * 32;
    const int nd = perm ? perm_gu(n0 + n) : (n0 + n);
    bf16_t* d = dst + (size_t)nd * K + k0 + kh;
#pragma unroll
    for (int q = 0; q < 4; ++q) {
        u32x4 w;
#pragma unroll
        for (int j = 0; j < 4; ++j) w[j] = pk_bf16(tl[(kh + q * 8 + 2 * j) * 257 + n], tl[(kh + q * 8 + 2 * j + 1) * 257 + n]);
        *(u32x4*)(d + q * 8) = w;
    }
    __syncthreads();
}

DI void phase_convert(const Params& p0, LAS unsigned char* lds) {
    const Params p = launder(p0);
    constexpr int U_IN = 176, U_OUT = 64, U_R = 16;
    constexpr int U_L = U_IN + U_OUT + U_R;
    for (int u = bid_(); u < 2 * U_L; u += gridDim.x) {
        const int l = u / U_L; int v = u % U_L;
        if (v < U_IN) { conv_unit(p.w_in + (size_t)l * DM * INW, INW, DM, (bf16_t*)(p.ws + WS_WIN) + (size_t)l * INW * DM, (v / 11) * 64, (v % 11) * 256, false, lds); continue; }
        v -= U_IN;
        if (v < U_OUT) { conv_unit(p.w_out + (size_t)l * DM * DM, DM, DM, (bf16_t*)(p.ws + WS_WOUT) + (size_t)l * DM * DM, (v / 4) * 64, (v % 4) * 256, false, lds); continue; }
        v -= U_OUT;
        conv_unit(p.w_router + (size_t)l * DM * 256, 256, DM, (bf16_t*)(p.ws + WS_WR) + (size_t)l * 256 * DM, v * 64, 0, false, lds);
    }
}

DI void phase_mod(const Params& p0, LAS unsigned char* lds) {
    const Params p = launder(p0);
    LAS float* sc = (LAS float*)lds;
    LAS float* red = sc + 3 * 1024;
    const int tid = tid_();
    float* modv = (float*)(p.ws + WS_MODV);
    for (int u = bid_(); u < 193; u += gridDim.x) {
        if (u == 192) {
            float* rope = (float*)(p.ws + WS_ROPE);
            for (int i = tid; i < 128 * 16; i += NTHREADS) {
                const int pos = i >> 4, f = i & 15;
                const float freq = powf(10000.0f, -(float)f / 16.0f);
                const float ang = (float)pos * freq;
                rope[2 * i] = cosf(ang); rope[2 * i + 1] = sinf(ang);
            }
            float* scal = (float*)(p.ws + WS_SCAL);
            if (tid < 2) {
                const int l = tid;
                const float* dl = p.diff_lambda + l * 256;
                float s01 = 0.f, s23 = 0.f;
                for (int i = 0; i < 64; ++i) { s01 += dl[i] * dl[64 + i]; s23 += dl[128 + i] * dl[192 + i]; }
                const float lambda_init = 0.8f - 0.6f * expf(-0.3f * (float)l);
                scal[l * 16 + 0] = expf(s01) - expf(s23) + lambda_init;
                scal[l * 16 + 1] = 1.0f - lambda_init;
                for (int h = 0; h < 4; ++h) {
                    scal[l * 16 + 2 + h] = -expf(p.ret_log_decay[l * 8 + h]) * LOG2E;
                    scal[l * 16 + 6 + h] = -expf(p.ret_log_decay[l * 8 + 4 + h]) * LOG2E;
                }
            }
            continue;
        }
        const int l = u / 96, n0 = (u % 96) * 64;
        for (int i = tid; i < 3 * 1024; i += NTHREADS) {
            const int s = i >> 10, k = i & 1023;
            const float v = s < 2 ? p.c[s * 1024 + k] : p.c_ctx[k];
            sc[i] = silu_f(v);
        }
        __syncthreads();
        const int kq = tid >> 6, nl = tid & 63;
        const float* w = p.w_mod + (size_t)l * DM * 6144 + n0 + nl;
        float a0 = 0.f, a1 = 0.f, a2 = 0.f;
        for (int k = kq * 128; k < kq * 128 + 128; ++k) {
            const float wv = w[(size_t)k * 6144];
            a0 += sc[k] * wv; a1 += sc[1024 + k] * wv; a2 += sc[2048 + k] * wv;
        }
        red[(kq * 3 + 0) * 64 + nl] = a0; red[(kq * 3 + 1) * 64 + nl] = a1; red[(kq * 3 + 2) * 64 + nl] = a2;
        __syncthreads();
        if (tid < 192) {
            const int s = tid >> 6, n = tid & 63;
            float v = 0.f;
            for (int q = 0; q < 8; ++q) v += red[(q * 3 + s) * 64 + n];
            modv[((size_t)l * 3 + s) * 6144 + n0 + n] = v + p.b_mod[l * 6144 + n0 + n];
        }
        __syncthreads();
    }
}

DI void ln_stats(const f32x4 (&v)[4], float& mu, float& rstd) {
    float s = 0.f;
#pragma unroll
    for (int i = 0; i < 4; ++i) s += (v[i][0] + v[i][1]) + (v[i][2] + v[i][3]);
    mu = wave_sum(s) * (1.0f / 1024.0f);
    float q = 0.f;
#pragma unroll
    for (int i = 0; i < 4; ++i)
#pragma unroll
        for (int j = 0; j < 4; ++j) { const float d = v[i][j] - mu; q += d * d; }
    rstd = rsqrtf(wave_sum(q) * (1.0f / 1024.0f) + LN_EPS);
}
DI void modulate_store(const f32x4 (&v)[4], const float* shift, const float* scale, bf16_t* dst, int lane) {
    float mu, rstd; ln_stats(v, mu, rstd);
#pragma unroll
    for (int i = 0; i < 4; ++i) {
        const int c = lane * 4 + i * 256;
        const f32x4 sh = *(const f32x4*)(shift + c), scv = *(const f32x4*)(scale + c);
        float o[4];
#pragma unroll
        for (int j = 0; j < 4; ++j) o[j] = (v[i][j] - mu) * rstd * (1.0f + scv[j]) + sh[j];
        u32x2 w = {pk_bf16(o[0], o[1]), pk_bf16(o[2], o[3])};
        *(u32x2*)(dst + c) = w;
    }
}

DI void phase_ln0(const Params& p0) {
    const Params p = launder(p0);
    const int lane = tid_() & 63, wid = tid_() >> 6;
    float* XA = (float*)(p.ws + WS_XA);
    bf16_t* H = (bf16_t*)(p.ws + WS_H);
    const float* modv = (const float*)(p.ws + WS_MODV);
    for (int r = bid_() * 8 + wid; r < MROWS; r += gridDim.x * 8) {
        const int b = r >= NT, pp = r - b * NT;
        const float* src = pp < NCTX ? p.ctx + ((size_t)b * NCTX + pp) * DM : p.x + ((size_t)b * NLAT + (pp - NCTX)) * DM;
        f32x4 v[4];
#pragma unroll
        for (int i = 0; i < 4; ++i) { v[i] = *(const f32x4*)(src + lane * 4 + i * 256); *(f32x4*)(XA + (size_t)r * DM + lane * 4 + i * 256) = v[i]; }
        const float* mv = modv + (size_t)(0 * 3 + (pp < NCTX ? 2 : b)) * 6144;
        modulate_store(v, mv, mv + 1024, H + (size_t)r * DM, lane);
    }
}

DI void phase_inproj(const Params& p0, int l, LAS unsigned char* lds) {
    const Params p = launder(p0); l = launder_s(l);
    const bf16_t* H = (const bf16_t*)(p.ws + WS_H);
    const bf16_t* W = (const bf16_t*)(p.ws + WS_WIN) + (size_t)l * INW * DM;
    bf16_t* P = (bf16_t*)(p.ws + WS_P);
    bf16_t* VT = (bf16_t*)(p.ws + WS_VT);
    bf16_t* RKT = (bf16_t*)(p.ws + WS_RKT);
    bf16_t* RVT = (bf16_t*)(p.ws + WS_RVT);
    const f32x2* rope = (const f32x2*)(p.ws + WS_ROPE);
    const int lrow = tid_() >> 3, lch = tid_() & 7;
    constexpr int NTN = INW / 128;
    for (int u = bid_(); u < (MROWS / 128) * NTN; u += gridDim.x) {
        const int tm = u / NTN, tn = u % NTN;
        const bf16_t* a0 = H + (size_t)(tm * 128 + lrow) * DM + lch * 8;
        const bf16_t* b0 = W + (size_t)(tn * 128 + lrow) * DM + lch * 8;
        auto epi = [&](const f32x4 (&acc)[4][2], int wr, int wc, int fr, int fq) {
            const int c0 = tn * 128 + wc * 32;
            const int rbase = tm * 128 + wr * 64;
            if (c0 < C_DV) {
                const float qs = c0 < C_DK ? QSCALE : 1.0f;
                const int axis = (c0 >> 5) & 1;
#pragma unroll
                for (int m = 0; m < 4; ++m)
#pragma unroll
                    for (int j = 0; j < 4; ++j) {
                        const int row = rbase + m * 16 + fq * 4 + j;
                        const int b = row >= NT, pp = row - b * NT;
                        float x1 = acc[m][0][j], x2 = acc[m][1][j], o1 = x1, o2 = x2;
                        if (pp >= NCTX) {
                            const int t = pp - NCTX;
                            const int pos = axis ? (t & 63) : (t >> 6);
                            const f32x2 cs = rope[pos * 16 + fr];
                            o1 = x1 * cs[0] - x2 * cs[1]; o2 = x1 * cs[1] + x2 * cs[0];
                        }
                        P[(size_t)row * INW + c0 + fr] = to_bf16(o1 * qs);
                        P[(size_t)row * INW + c0 + 16 + fr] = to_bf16(o2 * qs);
                    }
            } else {
                const float sc = (c0 >= C_RK && c0 < C_RV) ? 0.125f : 1.0f;
#pragma unroll
                for (int m = 0; m < 4; ++m) {
                    const int row0 = rbase + m * 16 + fq * 4;
                    const int b = row0 >= NT, pp0 = row0 - b * NT;
#pragma unroll
                    for (int n = 0; n < 2; ++n) {
                        const int c = c0 + n * 16 + fr;
                        float o[4];
#pragma unroll
                        for (int j = 0; j < 4; ++j) { o[j] = acc[m][n][j] * sc; P[(size_t)(row0 + j) * INW + c] = to_bf16(o[j]); }
                        bf16_t* tp = nullptr;
                        if (c0 < C_PU) { const int cc = c - C_DV; const int fqp = (fq == 1) ? 2 : ((fq == 2) ? 1 : fq);
                            tp = VT + ((size_t)(b * 4 + (cc >> 7)) * 128 + (cc & 127)) * NT + (pp0 - fq * 4 + fqp * 4); }
                        else if (c0 >= C_RK && c0 < C_RV) { const int cc = c - C_RK; tp = RKT + ((size_t)(b * 4 + (cc >> 6)) * 64 + (cc & 63)) * NT + pp0; }
                        else if (c0 >= C_RV && c0 < C_RG) { const int cc = c - C_RV; tp = RVT + ((size_t)(b * 4 + (cc >> 6)) * 64 + (cc & 63)) * NT + pp0; }
                        if (tp) { u32x2 w = {pk_bf16(o[0], o[1]), pk_bf16(o[2], o[3])}; *(u32x2*)tp = w; }
                    }
                }
            }
        };
        gemm128(a0, a0 + (size_t)64 * DM, b0, b0 + (size_t)64 * DM, DM / 64, lds, epi);
    }
}

DI void phase_ret_sum_pool(const Params& p0, int l, LAS unsigned char* lds) {
    const Params p = launder(p0); l = launder_s(l);
    const int tid = tid_(), lane = tid & 63, wid = tid >> 6, fr = lane & 15, g = lane >> 4;
    const float* scal = (const float*)(p.ws + WS_SCAL) + l * 16;
    const bf16_t* RKT = (const bf16_t*)(p.ws + WS_RKT);
    const bf16_t* RVT = (const bf16_t*)(p.ws + WS_RVT);
    float* UF = (float*)(p.ws + WS_UF);
    float* UB = (float*)(p.ws + WS_UB);
    for (int u = bid_(); u < NB * 4 * NCHUNK; u += gridDim.x) {
        const int c = u % NCHUNK, bh = u / NCHUNK, h = bh & 3;
        const int dir = wid >> 2, eb = wid & 3;
        const float l2 = dir ? scal[6 + h] : scal[2 + h];
        const bf16_t* vrow = RVT + ((size_t)bh * 64 + eb * 16 + fr) * NT + c * 128;
        f32x4 acc[4];
#pragma unroll
        for (int db = 0; db < 4; ++db) acc[db] = (f32x4){0.f, 0.f, 0.f, 0.f};
#pragma unroll
        for (int ks = 0; ks < 4; ++ks) {
            const int j0 = ks * 32 + 8 * g;
            const bf16x8 af = *(const bf16x8*)(vrow + j0);
            float w[8];
#pragma unroll
            for (int jj = 0; jj < 8; ++jj) { const int j = j0 + jj; w[jj] = fast_exp2((dir ? (float)j : (float)(127 - j)) * l2); }
#pragma unroll
            for (int db = 0; db < 4; ++db) {
                const u32x4 kr = *(const u32x4*)(RKT + ((size_t)bh * 64 + db * 16 + fr) * NT + c * 128 + j0);
                u32x4 kw;
#pragma unroll
                for (int q = 0; q < 4; ++q) kw[q] = pk_bf16(bf_lo(kr[q]) * w[2 * q], bf_hi(kr[q]) * w[2 * q + 1]);
                acc[db] = MFMA16(af, as_bf16x8(kw), acc[db]);
            }
        }
        const int cidx = dir ? (c >= 2 ? c - 2 : 64 + c) : c;
        float* U = (dir ? UB : UF) + ((size_t)bh * NCHUNK + cidx) * 4096;
#pragma unroll
        for (int db = 0; db < 4; ++db)
#pragma unroll
            for (int j = 0; j < 4; ++j) U[(eb * 16 + 4 * g + j) * 64 + db * 16 + fr] = acc[db][j];
    }
    LAS float* ul = (LAS float*)lds;
    LAS float* dT = ul + 48 * 256;
    const bf16_t* P = (const bf16_t*)(p.ws + WS_P);
    bf16_t* MIX = (bf16_t*)(p.ws + WS_MIX);
    const float* pw = p.pool_w + (size_t)l * 4 * 64 * 64;
    const float* ps = p.pool_scale + l * 256;
    for (int u = bid_(); u < MROWS / 32; u += gridDim.x) {
        const int r0 = u * 32;
        const int b = r0 >= NT, pp0 = r0 - b * NT;
        const int s0 = pp0 < NCTX ? b * NT : b * NT + NCTX, s1 = pp0 < NCTX ? b * NT + NCTX : (b + 1) * NT;
        __syncthreads();
        for (int i = tid; i < 48 * 64; i += NTHREADS) {
            const int rr = i >> 6, c4 = (i & 63) * 4;
            const int row = r0 - 8 + rr;
            f32x4 v = {0.f, 0.f, 0.f, 0.f};
            if (row >= s0 && row < s1) { const u32x2 w = *(const u32x2*)(P + (size_t)row * INW + C_PU + c4); v = (f32x4){bf_lo(w[0]), bf_hi(w[0]), bf_lo(w[1]), bf_hi(w[1])}; }
            *(LAS f32x4*)(ul + rr * 256 + c4) = v;
        }
        __syncthreads();
        for (int i = tid; i < 32 * 256; i += NTHREADS) {
            const int rr = i >> 8, c = i & 255, gi = c >> 6;
            const int w = 2 << gi;
            const int row = r0 + rr;
            int lo = row - w / 2, hi = row + w - w / 2;
            lo = lo < s0 ? s0 : lo; hi = hi > s1 ? s1 : hi;
            float s = 0.f;
            for (int q = lo; q < hi; ++q) s += ul[(q - r0 + 8) * 256 + c];
            dT[c * 36 + rr] = s / (float)(hi - lo) - ul[(rr + 8) * 256 + c];
        }
        __syncthreads();
        {
            const int oc = tid & 255, rh = (tid >> 8) * 16, gi = oc >> 6, e = oc & 63;
            float acc[16];
#pragma unroll
            for (int i = 0; i < 16; ++i) acc[i] = 0.f;
            for (int c = 0; c < 64; ++c) {
                const float wv = pw[(gi * 64 + c) * 64 + e];
                const LAS float* dr = dT + (gi * 64 + c) * 36 + rh;
#pragma unroll
                for (int i = 0; i < 4; ++i) { const f32x4 d = *(const LAS f32x4*)(dr + 4 * i); acc[4 * i] += d[0] * wv; acc[4 * i + 1] += d[1] * wv; acc[4 * i + 2] += d[2] * wv; acc[4 * i + 3] += d[3] * wv; }
            }
            const float sc = ps[oc];
#pragma unroll
            for (int i = 0; i < 16; ++i) MIX[(size_t)(r0 + rh + i) * DM + 512 + oc] = to_bf16(acc[i] * sc);
        }
    }
    __syncthreads();
}

DI void phase_ret_scan(const Params& p0, int l) {
    const Params p = launder(p0); l = launder_s(l);
    const float* scal = (const float*)(p.ws + WS_SCAL) + l * 16;
    const float* UF = (const float*)(p.ws + WS_UF); const float* UB = (const float*)(p.ws + WS_UB);
    float* SF = (float*)(p.ws + WS_SF); float* SB = (float*)(p.ws + WS_SB);
    for (int i = bid_() * NTHREADS + tid_(); i < 2 * NB * 4 * 4096; i += gridDim.x * NTHREADS) {
        const int dir = i / (NB * 4 * 4096), rem = i % (NB * 4 * 4096), bh = rem >> 12, el = rem & 4095, h = bh & 3;
        const float G = fast_exp2(128.0f * (dir ? scal[6 + h] : scal[2 + h]));
        float S = 0.f;
        if (dir == 0) { for (int c = 0; c < NCHUNK; ++c) { const size_t o = ((size_t)bh * NCHUNK + c) * 4096 + el; SF[o] = S; S = S * G + UF[o]; } }
        else { for (int c = NCHUNK - 1; c >= 0; --c) { const size_t o = ((size_t)bh * NCHUNK + c) * 4096 + el; SB[o] = S; S = S * G + UB[o]; } }
    }
}

DI void attn_unit(const Params& p, int b, int h, int q_p0, int ntile, float lam, float oscale, LAS unsigned char* lds) {
    const int tid = tid_(), lane = tid & 63, wid = __builtin_amdgcn_readfirstlane(tid >> 6), map = wid >> 2, wq = wid & 3, r = lane & 31, hh = lane >> 5;
    const bf16_t* P = (const bf16_t*)(p.ws + WS_P);
    const bf16_t* VT = (const bf16_t*)(p.ws + WS_VT);
    bf16_t* MIX = (bf16_t*)(p.ws + WS_MIX);
    const size_t rowbase = (size_t)b * NT;
    const int qrow = q_p0 + wq * 32 + r;
    bf16x8 qf[4];
#pragma unroll
    for (int ks = 0; ks < 4; ++ks) qf[ks] = *(const bf16x8*)(P + (rowbase + qrow) * INW + C_DQ + h * 128 + map * 64 + ks * 16 + hh * 8);
    constexpr int ASTG = 32768;
    const bf16_t* ksrc0; const bf16_t* ksrc1; const bf16_t* vsrc0; const bf16_t* vsrc1;
    { const int key = tid >> 4, ph = tid & 15, c = ph ^ (key & 15);
      ksrc0 = P + (rowbase + key) * INW + C_DK + h * 128 + c * 8; ksrc1 = ksrc0 + (size_t)32 * INW;
      const int e = tid >> 3, pv = tid & 7, cv = pv ^ ((e >> 1) & 7);
      vsrc0 = VT + ((size_t)(b * 4 + h) * 128 + e) * NT + cv * 8; vsrc1 = vsrc0 + (size_t)64 * NT; }
    const int ddst = wid * 1024;
#define ATT_ISSUE(S, KT) do { LAS unsigned char* _s = lds + (S) * ASTG + ddst; const size_t _ko = (size_t)(KT) * 64 * INW; const int _vo = (KT) * 64; \
        dma16(ksrc0 + _ko, _s); dma16(ksrc1 + _ko, _s + 8192); dma16(vsrc0 + _vo, _s + 16384); dma16(vsrc1 + _vo, _s + 24576); } while (0)
    f32x16 o[4];
#pragma unroll
    for (int eb = 0; eb < 4; ++eb)
#pragma unroll
        for (int i = 0; i < 16; ++i) o[eb][i] = 0.f;
    f32x16 negm;
#pragma unroll
    for (int i = 0; i < 16; ++i) negm[i] = 0.f;
    float m_run = 0.f, l_run = 0.f;
    __syncthreads();
    ATT_ISSUE(0, 0);
    if (ntile > 1) ATT_ISSUE(1, 1);
    int st = 0;
    for (int kt = 0; kt < ntile; ++kt) {
        if (kt + 1 < ntile) WAIT_VM(4); else WAIT_VM(0);
        asm volatile("s_waitcnt lgkmcnt(0)" ::: "memory");
        __builtin_amdgcn_s_barrier();
        const int st2 = st == 0 ? 2 : st - 1;
        if (kt + 2 < ntile) ATT_ISSUE(st2, kt + 2);
        LAS unsigned char* L = lds + st * ASTG;
        st = st == 2 ? 0 : st + 1;
        f32x16 s0 = negm, s1 = negm;
#pragma unroll
        for (int ks = 0; ks < 4; ++ks) {
            const int ch = map * 8 + ks * 2 + hh;
            const int off = r * 256 + ((ch ^ (r & 15)) << 4);
            const bf16x8 a0 = *(LAS bf16x8*)(L + off);
            const bf16x8 a1 = *(LAS bf16x8*)(L + off + 32 * 256);
            s0 = MFMA32(a0, qf[ks], s0);
            s1 = MFMA32(a1, qf[ks], s1);
        }
        float mx = fmaxf(fmaxf(s0[0], s0[1]), s0[2]);
#pragma unroll
        for (int i = 3; i < 15; i += 2) mx = fmaxf(fmaxf(mx, s0[i]), s0[i + 1]);
        mx = fmaxf(mx, s0[15]);
#pragma unroll
        for (int i = 0; i < 16; i += 2) mx = fmaxf(fmaxf(mx, s1[i]), s1[i + 1]);
        mx = fmaxf(mx, __shfl_xor(mx, 32));
        if (__any(mx > 8.0f) || kt == 0) {
            const float d = (mx > 8.0f || kt == 0) ? mx : 0.f;
            const float alpha = fast_exp2(-d);
            m_run += d; l_run *= alpha;
#pragma unroll
            for (int i = 0; i < 16; ++i) { s0[i] -= d; s1[i] -= d; negm[i] = -m_run; }
#pragma unroll
            for (int eb = 0; eb < 4; ++eb)
#pragma unroll
                for (int i = 0; i < 16; ++i) o[eb][i] *= alpha;
        }
        f32x2 rs2 = {0.f, 0.f};
#pragma unroll
        for (int i = 0; i < 16; i += 2) { s0[i] = fast_exp2(s0[i]); s0[i + 1] = fast_exp2(s0[i + 1]); rs2 += (f32x2){s0[i], s0[i + 1]}; }
#pragma unroll
        for (int i = 0; i < 16; i += 2) { s1[i] = fast_exp2(s1[i]); s1[i + 1] = fast_exp2(s1[i + 1]); rs2 += (f32x2){s1[i], s1[i + 1]}; }
        l_run += rs2[0] + rs2[1];
#pragma unroll
        for (int s = 0; s < 4; ++s) {
            u32x4 pw;
#pragma unroll
            for (int q = 0; q < 4; ++q) pw[q] = (s >> 1) ? pk_bf16(s1[(s & 1) * 8 + 2 * q], s1[(s & 1) * 8 + 2 * q + 1]) : pk_bf16(s0[(s & 1) * 8 + 2 * q], s0[(s & 1) * 8 + 2 * q + 1]);
            const bf16x8 pb = as_bf16x8(pw);
            const int cv = s * 2 + hh;
#pragma unroll
            for (int eb = 0; eb < 4; ++eb) {
                const int e = eb * 32 + r;
                const bf16x8 va = *(LAS bf16x8*)(L + 16384 + e * 128 + ((cv ^ ((e >> 1) & 7)) << 4));
                o[eb] = MFMA32(va, pb, o[eb]);
            }
        }
    }
#undef ATT_ISSUE
    __syncthreads();
    const float lt = l_run + __shfl_xor(l_run, 32);
    const float inv = 1.0f / lt;
    LAS float* X = (LAS float*)lds;
    if (map == 1) {
#pragma unroll
        for (int eb = 0; eb < 4; ++eb)
#pragma unroll
            for (int i = 0; i < 16; ++i) X[(wq * 64 + eb * 16 + i) * 64 + lane] = o[eb][i] * inv;
    }
    __syncthreads();
    if (map == 0) {
        float ss = 0.f;
#pragma unroll
        for (int eb = 0; eb < 4; ++eb)
#pragma unroll
            for (int i = 0; i < 16; ++i) { const float v = o[eb][i] * inv - lam * X[(wq * 64 + eb * 16 + i) * 64 + lane]; o[eb][i] = v; ss += v * v; }
        ss += __shfl_xor(ss, 32);
        const float sc = rsqrtf(ss * (1.0f / 128.0f) + RMS_EPS) * oscale;
        LAS unsigned char* W = lds + 65536 + wq * 8704;
#pragma unroll
        for (int eb = 0; eb < 4; ++eb)
#pragma unroll
            for (int q = 0; q < 4; ++q) {
                const int e = eb * 32 + 8 * q + 4 * hh;
                const u32x2 w = {pk_bf16(o[eb][4 * q] * sc, o[eb][4 * q + 1] * sc), pk_bf16(o[eb][4 * q + 2] * sc, o[eb][4 * q + 3] * sc)};
                *(LAS u32x2*)(W + r * 272 + e * 2) = w;
            }
#pragma unroll
        for (int it = 0; it < 8; ++it) {
            const int row = it * 4 + (lane >> 4), ch = lane & 15;
            const u32x4 v = *(LAS u32x4*)(W + row * 272 + ch * 16);
            *(u32x4*)(MIX + (rowbase + q_p0 + wq * 32 + row) * DM + h * 128 + ch * 8) = v;
        }
    }
    __syncthreads();
}

DI void ret_unit(const Params& p, int l, int b, int h, int c) {
    const int tid = tid_(), lane = tid & 63, wid = tid >> 6, fr = lane & 15, g = lane >> 4;
    const float* scal = (const float*)(p.ws + WS_SCAL) + l * 16;
    const float lf2 = scal[2 + h], lb2 = scal[6 + h];
    const bf16_t* P = (const bf16_t*)(p.ws + WS_P);
    const bf16_t* RVT = (const bf16_t*)(p.ws + WS_RVT);
    const float* SF = (const float*)(p.ws + WS_SF); const float* SB = (const float*)(p.ws + WS_SB);
    bf16_t* MIX = (bf16_t*)(p.ws + WS_MIX);
    const int bh = b * 4 + h;
    const size_t row0 = (size_t)b * NT + c * 128;
    const int iloc = wid * 16 + fr;
    u32x4 qraw[2];
#pragma unroll
    for (int ks = 0; ks < 2; ++ks) qraw[ks] = *(const u32x4*)(P + (row0 + iloc) * INW + C_RQ + h * 64 + ks * 32 + 8 * g);
    f32x4 st[8];
#pragma unroll
    for (int jb = 0; jb < 8; ++jb) {
        st[jb] = (f32x4){0.f, 0.f, 0.f, 0.f};
#pragma unroll
        for (int ks = 0; ks < 2; ++ks) {
            const bf16x8 kf = *(const bf16x8*)(P + (row0 + jb * 16 + fr) * INW + C_RK + h * 64 + ks * 32 + 8 * g);
            st[jb] = MFMA16(kf, as_bf16x8(qraw[ks]), st[jb]);
        }
    }
#pragma unroll
    for (int jb = 0; jb < 8; ++jb)
#pragma unroll
        for (int q = 0; q < 4; ++q) {
            const int j = jb * 16 + 4 * g + q;
            const int d = iloc - j;
            const float w = d > 0 ? fast_exp2((float)d * lf2) : (d < 0 ? fast_exp2((float)(-d) * lb2) : 2.0f);
            st[jb][q] *= w;
        }
    f32x4 ot[4];
#pragma unroll
    for (int eb = 0; eb < 4; ++eb) ot[eb] = (f32x4){0.f, 0.f, 0.f, 0.f};
#pragma unroll
    for (int jj = 0; jj < 4; ++jj) {
        const u32x4 pw = {pk_bf16(st[2 * jj][0], st[2 * jj][1]), pk_bf16(st[2 * jj][2], st[2 * jj][3]), pk_bf16(st[2 * jj + 1][0], st[2 * jj + 1][1]), pk_bf16(st[2 * jj + 1][2], st[2 * jj + 1][3])};
#pragma unroll
        for (int eb = 0; eb < 4; ++eb) {
            const bf16_t* vp = RVT + ((size_t)bh * 64 + eb * 16 + fr) * NT + c * 128 + jj * 32 + 4 * g;
            const u32x2 v0 = *(const u32x2*)vp, v1 = *(const u32x2*)(vp + 16);
            const u32x4 va = {v0[0], v0[1], v1[0], v1[1]};
            ot[eb] = MFMA16(as_bf16x8(va), as_bf16x8(pw), ot[eb]);
        }
    }
    const float df = fast_exp2((float)(iloc + 1) * lf2), db = fast_exp2((float)(128 - iloc) * lb2);
    const int vc = c >= 2 ? c - 2 : 64 + c;
    const float* sf = SF + ((size_t)bh * NCHUNK + c) * 4096;
    const float* sb = SB + ((size_t)bh * NCHUNK + vc) * 4096;
#pragma unroll
    for (int ks = 0; ks < 2; ++ks) {
        u32x4 qf, qb;
#pragma unroll
        for (int q = 0; q < 4; ++q) { const float a = bf_lo(qraw[ks][q]), bb = bf_hi(qraw[ks][q]); qf[q] = pk_bf16(a * df, bb * df); qb[q] = pk_bf16(a * db, bb * db); }
#pragma unroll
        for (int eb = 0; eb < 4; ++eb) {
            const float* s1 = sf + (eb * 16 + fr) * 64 + ks * 32 + 8 * g;
            const float* s2 = sb + (eb * 16 + fr) * 64 + ks * 32 + 8 * g;
            const f32x4 a0 = *(const f32x4*)s1, a1 = *(const f32x4*)(s1 + 4), c0 = *(const f32x4*)s2, c1 = *(const f32x4*)(s2 + 4);
            const u32x4 sa = {pk_bf16(a0[0], a0[1]), pk_bf16(a0[2], a0[3]), pk_bf16(a1[0], a1[1]), pk_bf16(a1[2], a1[3])};
            const u32x4 sc = {pk_bf16(c0[0], c0[1]), pk_bf16(c0[2], c0[3]), pk_bf16(c1[0], c1[1]), pk_bf16(c1[2], c1[3])};
            ot[eb] = MFMA16(as_bf16x8(sa), as_bf16x8(qf), ot[eb]);
            ot[eb] = MFMA16(as_bf16x8(sc), as_bf16x8(qb), ot[eb]);
        }
    }
    float s = 0.f;
#pragma unroll
    for (int eb = 0; eb < 4; ++eb) s += (ot[eb][0] + ot[eb][1]) + (ot[eb][2] + ot[eb][3]);
    s += __shfl_xor(s, 16); s += __shfl_xor(s, 32);
    const float mu = s * (1.0f / 64.0f);
    float q2 = 0.f;
#pragma unroll
    for (int eb = 0; eb < 4; ++eb)
#pragma unroll
        for (int q = 0; q < 4; ++q) { const float d = ot[eb][q] - mu; q2 += d * d; }
    q2 += __shfl_xor(q2, 16); q2 += __shfl_xor(q2, 32);
    const float rstd = rsqrtf(q2 * (1.0f / 64.0f) + LN_EPS);
#pragma unroll
    for (int eb = 0; eb < 4; ++eb) {
        const int e = eb * 16 + 4 * g;
        const u32x2 gw = *(const u32x2*)(P + (row0 + iloc) * INW + C_RG + h * 64 + e);
        const float g0 = bf_lo(gw[0]), g1 = bf_hi(gw[0]), g2 = bf_lo(gw[1]), g3 = bf_hi(gw[1]);
        u32x2 w = {pk_bf16((ot[eb][0] - mu) * rstd * silu_f(g0), (ot[eb][1] - mu) * rstd * silu_f(g1)),
                   pk_bf16((ot[eb][2] - mu) * rstd * silu_f(g2), (ot[eb][3] - mu) * rstd * silu_f(g3))};
        *(u32x2*)(MIX + (row0 + iloc) * DM + 768 + h * 64 + e) = w;
    }
}

DI void phase_attn(const Params& p0, int l, LAS unsigned char* lds) {
    const Params p = launder(p0); l = launder_s(l);
    const float* scal = (const float*)(p.ws + WS_SCAL) + l * 16;
    const float lam = scal[0], oscale = scal[1];
    const int nunits = NB * 4 * 64 + (l == 0 ? NB * 4 * 2 : 0);
    for (int u = bid_(); u < nunits; u += gridDim.x) {
        int b, h, q0, ntile;
        if (u < NB * 4 * 64) { const int qt = u & 63; h = (u >> 6) & 3; b = u >> 8; q0 = NCTX + qt * 128; ntile = NT / 64; }
        else { const int v = u - NB * 4 * 64; const int qt = v & 1; h = (v >> 1) & 3; b = v >> 3; q0 = qt * 128; ntile = NCTX / 64; }
        attn_unit(p, b, h, q0, ntile, lam, oscale, lds);
    }
}
DI void phase_ret(const Params& p0, int l) {
    const Params p = launder(p0); l = launder_s(l);
    for (int u = bid_(); u < NB * 4 * NCHUNK; u += gridDim.x) {
        const int c = u % NCHUNK, bh = u / NCHUNK;
        if (l == 1 && c < 2) continue;
        ret_unit(p, l, bh >> 2, bh & 3, c);
    }
}

DI void phase_outproj(const Params& p0, int l, LAS unsigned char* lds) {
    const Params p = launder(p0); l = launder_s(l);
    const float* Xin = (const float*)(p.ws + WS_XA);
    const bf16_t* A = (const bf16_t*)(p.ws + WS_MIX);
    const bf16_t* W = (const bf16_t*)(p.ws + WS_WOUT) + (size_t)l * DM * DM;
    float* V1 = (float*)(p.ws + WS_V1);
    const float* modv = (const float*)(p.ws + WS_MODV) + (size_t)l * 3 * 6144;
    const int lrow = tid_() >> 3, lch = tid_() & 7;
    for (int u = bid_(); u < (MROWS / 128) * 8; u += gridDim.x) {
        const int tm = u >> 3, tn = u & 7;
        const bf16_t* a0 = A + (size_t)(tm * 128 + lrow) * DM + lch * 8;
        const bf16_t* b0 = W + (size_t)(tn * 128 + lrow) * DM + lch * 8;
        auto epi = [&](const f32x4 (&acc)[4][2], int wr, int wc, int fr, int fq) {
#pragma unroll
            for (int m = 0; m < 4; ++m)
#pragma unroll
                for (int j = 0; j < 4; ++j) {
                    const int row = tm * 128 + wr * 64 + m * 16 + fq * 4 + j;
                    const float* g2 = modv + (size_t)row_sel(row) * 6144 + 2 * 1024;
#pragma unroll
                    for (int n = 0; n < 2; ++n) {
                        const int c = tn * 128 + wc * 32 + n * 16 + fr;
                        V1[(size_t)row * DM + c] = DN_ALPHA * Xin[(size_t)row * DM + c] + g2[c] * acc[m][n][j];
                    }
                }
        };
        gemm128(a0, a0 + (size_t)64 * DM, b0, b0 + (size_t)64 * DM, DM / 64, lds, epi);
    }
}

DI void phase_ln_mid(const Params& p0, int l) {
    const Params p = launder(p0); l = launder_s(l);
    float* Xout = (float*)(p.ws + WS_XB);
    const int lane = tid_() & 63, wid = tid_() >> 6;
    const float* V1 = (const float*)(p.ws + WS_V1);
    bf16_t* TOK = (bf16_t*)(p.ws + WS_TOK);
    const float* modv = (const float*)(p.ws + WS_MODV) + (size_t)l * 3 * 6144;
    const float* lg = p.ln_g + (size_t)(l * 2 + 0) * DM; const float* lb = p.ln_b + (size_t)(l * 2 + 0) * DM;
    for (int r = bid_() * 8 + wid; r < MROWS; r += gridDim.x * 8) {
        f32x4 v[4];
#pragma unroll
        for (int i = 0; i < 4; ++i) v[i] = *(const f32x4*)(V1 + (size_t)r * DM + lane * 4 + i * 256);
        float mu, rstd; ln_stats(v, mu, rstd);
#pragma unroll
        for (int i = 0; i < 4; ++i) {
            const int c = lane * 4 + i * 256;
            const f32x4 gg = *(const f32x4*)(lg + c), bb = *(const f32x4*)(lb + c);
#pragma unroll
            for (int j = 0; j < 4; ++j) v[i][j] = (v[i][j] - mu) * rstd * gg[j] + bb[j];
            *(f32x4*)(Xout + (size_t)r * DM + c) = v[i];
        }
        const float* mv = modv + (size_t)row_sel(r) * 6144;
        modulate_store(v, mv + 3 * 1024, mv + 4 * 1024, TOK + (size_t)r * DM, lane);
    }
}

DI void phase_router(const Params& p0, int l, LAS unsigned char* lds) {
    const Params p = launder(p0); l = launder_s(l);
    const bf16_t* A = (const bf16_t*)(p.ws + WS_TOK);
    const bf16_t* W = (const bf16_t*)(p.ws + WS_WR) + (size_t)l * 256 * DM;
    float* LG = (float*)(p.ws + WS_LOGIT);
    const int lrow = tid_() >> 3, lch = tid_() & 7;
    for (int u = bid_(); u < (MROWS / 128) * 2; u += gridDim.x) {
        const int tm = u >> 1, tn = u & 1;
        const bf16_t* a0 = A + (size_t)(tm * 128 + lrow) * DM + lch * 8;
        const bf16_t* b0 = W + (size_t)(tn * 128 + lrow) * DM + lch * 8;
        auto epi = [&](const f32x4 (&acc)[4][2], int wr, int wc, int fr, int fq) {
#pragma unroll
            for (int m = 0; m < 4; ++m)
#pragma unroll
                for (int j = 0; j < 4; ++j)
#pragma unroll
                    for (int n = 0; n < 2; ++n)
                        LG[(size_t)(tm * 128 + wr * 64 + m * 16 + fq * 4 + j) * 256 + tn * 128 + wc * 32 + n * 16 + fr] = acc[m][n][j];
        };
        gemm128(a0, a0 + (size_t)64 * DM, b0, b0 + (size_t)64 * DM, DM / 64, lds, epi);
    }
}

DI void phase_topk(const Params& p0, int l, LAS unsigned char* lds) {
    const Params p = launder(p0); l = launder_s(l);
    const int lane = tid_() & 63, wid = tid_() >> 6;
    const float* LG = (const float*)(p.ws + WS_LOGIT);
    const float* bias = p.router_bias + l * 256;
    int* EIDX = (int*)(p.ws + WS_EIDX); float* GATE = (float*)(p.ws + WS_GATE);
    int* RANK = (int*)(p.ws + WS_RANK); int* HIST = (int*)(p.ws + WS_HIST);
    LAS int* hist = (LAS int*)lds;
    if (tid_() < 256) hist[tid_()] = 0;
    __syncthreads();
    const int chunk = (MROWS + (int)gridDim.x - 1) / (int)gridDim.x, r_begin = bid_() * chunk, r_end = (r_begin + chunk) < MROWS ? (r_begin + chunk) : MROWS;
    const f32x4 bv = *(const f32x4*)(bias + lane * 4);
    for (int r = r_begin + wid; r < r_end; r += 8) {
        const f32x4 lg = *(const f32x4*)(LG + (size_t)r * 256 + lane * 4);
        float sc[4], gv[4];
#pragma unroll
        for (int i = 0; i < 4; ++i) { sc[i] = 1.0f / (1.0f + __expf(-lg[i])); gv[i] = sc[i] + bv[i]; }
        float a1 = fmaxf(gv[0], gv[1]), a2 = fminf(gv[0], gv[1]);
        { const float b1 = fmaxf(gv[2], gv[3]), b2 = fminf(gv[2], gv[3]); const float n1 = fmaxf(a1, b1), n2 = fmaxf(fminf(a1, b1), fmaxf(a2, b2)); a1 = n1; a2 = n2; }
#pragma unroll
        for (int o = 1; o < 8; o <<= 1) { const float b1 = __shfl_xor(a1, o), b2 = __shfl_xor(a2, o); const float n1 = fmaxf(a1, b1), n2 = fmaxf(fminf(a1, b1), fmaxf(a2, b2)); a1 = n1; a2 = n2; }
        const float gs = a1 + a2;
        const int myg = lane >> 3;
        int rank = 0;
#pragma unroll
        for (int g2 = 0; g2 < 8; ++g2) { const float o = __shfl(gs, g2 * 8); rank += (o > gs || (o == gs && g2 < myg)) ? 1 : 0; }
        const bool ok = rank < 4;
        float cv[4];
#pragma unroll
        for (int i = 0; i < 4; ++i) cv[i] = ok ? gv[i] : -INFINITY;
        float ssum = 0.f; float mysc = 0.f; int myidx = 0;
        for (int k = 0; k < TOPK; ++k) {
            float bvl = cv[0]; int bi = 0;
#pragma unroll
            for (int i = 1; i < 4; ++i) if (cv[i] > bvl) { bvl = cv[i]; bi = i; }
            int gi = lane * 4 + bi;
#pragma unroll
            for (int o = 1; o < 64; o <<= 1) {
                const float ov = __shfl_xor(bvl, o); const int oi = __shfl_xor(gi, o);
                if (ov > bvl || (ov == bvl && oi < gi)) { bvl = ov; gi = oi; }
            }
            const int owner = gi >> 2, oi = gi & 3;
            float s_own = 0.f;
#pragma unroll
            for (int i = 0; i < 4; ++i) if (i == oi) s_own = sc[i];
            const float ssel = __shfl(s_own, owner);
            if (lane == owner) {
#pragma unroll
                for (int i = 0; i < 4; ++i) if (i == oi) cv[i] = -INFINITY;
            }
            ssum += ssel;
            if (lane == k) { mysc = ssel; myidx = gi; }
        }
        if (lane < TOPK) {
            EIDX[(size_t)r * 8 + lane] = myidx;
            GATE[(size_t)r * 8 + lane] = mysc / ssum * 2.5f;
            RANK[(size_t)r * 8 + lane] = __hip_atomic_fetch_add(hist + myidx, 1, __ATOMIC_RELAXED, __HIP_MEMORY_SCOPE_WORKGROUP);
        }
    }
    __syncthreads();
    if (tid_() < 256) HIST[(size_t)bid_() * 256 + tid_()] = hist[tid_()];
    __syncthreads();
}

DI void phase_scatter(const Params& p0, int l, LAS unsigned char* lds) {
    const Params p = launder(p0); l = launder_s(l);
    LAS int* off = (LAS int*)lds;
    LAS int* toff = off + 260;
    LAS int* tot = toff + 260;
    LAS int* base = tot + 256;
    const int tid = tid_(), bid = bid_(), G = gridDim.x;
    const int* HIST = (const int*)(p.ws + WS_HIST);
    const int* RANK = (const int*)(p.ws + WS_RANK);
    int* ntl = (int*)(p.ws + CTL_NTILES) + l;
    int* TILES = (int*)(p.ws + WS_TILES);
    const int* EIDX = (const int*)(p.ws + WS_EIDX);
    int* SORT = (int*)(p.ws + WS_SORT);
    if (tid < 256) {
        int t = 0, bs = 0;
        for (int b2 = 0; b2 < G; ++b2) { const int v = HIST[(size_t)b2 * 256 + tid]; bs += (b2 < bid) ? v : 0; t += v; }
        tot[tid] = t; base[tid] = bs;
    }
    __syncthreads();
    if (tid == 0) {
        int a = 0, t = 0;
        for (int e = 0; e < 256; ++e) { off[e] = a; toff[e] = t; const int c = tot[e]; a += c; t += (c + 127) >> 7; }
        off[256] = a; toff[256] = t;
    }
    __syncthreads();
    if (bid == 0) {
        if (tid < 256) {
            const int e = tid, c = off[e + 1] - off[e], nt = toff[e + 1] - toff[e];
            for (int t = 0; t < nt; ++t) { int* T = TILES + (size_t)(toff[e] + t) * 4; T[0] = e; T[1] = off[e] + t * 128; T[2] = (c - t * 128) < 128 ? (c - t * 128) : 128; T[3] = 0; }
        }
        if (tid == 0) *ntl = toff[256];
    }
    const int chunk = (MROWS + G - 1) / G, r_begin = bid * chunk, r_end = (r_begin + chunk) < MROWS ? (r_begin + chunk) : MROWS;
    for (int a = r_begin * 8 + tid; a < r_end * 8; a += NTHREADS) {
        const int e = EIDX[a];
        SORT[off[e] + base[e] + RANK[a]] = a;
    }
    __syncthreads();
}

constexpr int MOE_STG = 40960;
constexpr int MOE_HT = 86016;
constexpr int MOE_INFO = MOE_HT + 65536;
constexpr int IMG_BYTES = 32768, IMG_PER_E = 48;
DI int swz64(int row, int chunk) { return row * 64 + ((chunk ^ ((0 - (row >> 2)) & 3)) << 4); }

struct ImgJob { const float* wp; int ldw; unsigned char* d; int g; };
DI ImgJob img_job(const Params& p, int l, int u, unsigned char* IMG) {
    const int e = u / IMG_PER_E, im = u % IMG_PER_E;
    const int np = tid_();
    ImgJob j;
    if (im < 32) {
        const float* W = e < NEXP ? p.w_egu + ((size_t)l * NEXP + e) * DM * 512 : p.w_sgu + (size_t)l * DM * 512;
        j.ldw = 512; j.wp = W + (size_t)(im * 32) * 512 + (((np >> 4) & 1) * 256 + (np >> 5) * 16 + (np & 15));
    } else {
        const float* W = e < NEXP ? p.w_edn + ((size_t)l * NEXP + e) * 256 * DM : p.w_sdn + (size_t)l * 256 * DM;
        j.ldw = DM; j.wp = W + (size_t)(((im - 32) & 7) * 32) * DM + ((im - 32) >> 3) * 512 + np;
    }
    j.d = IMG + (size_t)u * IMG_BYTES + np * 64; j.g = (0 - (np >> 2)) & 3;
    return j;
}
DI void img_load(const ImgJob& j, float (&wb)[32]) {
#pragma unroll
    for (int kk = 0; kk < 32; ++kk) wb[kk] = __builtin_nontemporal_load(j.wp + (size_t)kk * j.ldw);
}
DI void img_store(const ImgJob& j, const float (&wb)[32]) {
#pragma unroll
    for (int c = 0; c < 4; ++c) { const u32x4 w = {pk_bf16(wb[8 * c], wb[8 * c + 1]), pk_bf16(wb[8 * c + 2], wb[8 * c + 3]), pk_bf16(wb[8 * c + 4], wb[8 * c + 5]), pk_bf16(wb[8 * c + 6], wb[8 * c + 7])}; *(u32x4*)(j.d + ((c ^ j.g) << 4)) = w; }
}
DI void phase_convert_experts(const Params& p0, int l) {
    const Params p = launder(p0); l = launder_s(l);
    unsigned char* IMG = p.ws + WS_WIMG + (size_t)l * (NEXP + 1) * IMG_PER_E * IMG_BYTES;
    const int total = (NEXP + 1) * IMG_PER_E, G = gridDim.x;
    float wa[32], wb[32];
    int u = bid_();
    if (u >= total) return;
    ImgJob ja = img_job(p, l, u, IMG), jb = ja;
    img_load(ja, wa);
    for (;;) {
        const bool hb = u + G < total;
        if (hb) { jb = img_job(p, l, u + G, IMG); img_load(jb, wb); }
        img_store(ja, wa);
        if (!hb) break;
        u += G;
        const bool ha = u + G < total;
        if (ha) { ja = img_job(p, l, u + G, IMG); img_load(ja, wa); }
        img_store(jb, wb);
        if (!ha) break;
        u += G;
    }
}

DI void moe_unit(const Params& p, const unsigned char* img, bf16_t* outbase, bool shared, int r0, int nr, LAS unsigned char* lds) {
    const int t = tid_(), lane = t & 63, wid = __builtin_amdgcn_readfirstlane(t >> 6), fr = lane & 15, fq = lane >> 4, wn = wid & 3, wt = wid >> 2;
    const bf16_t* TOK = (const bf16_t*)(p.ws + WS_TOK);
    const int* SORT = (const int*)(p.ws + WS_SORT);
    LAS int* rowout = (LAS int*)(lds + MOE_INFO);
    const int arow = t >> 2;
    int atok = 0, aout = -1;
    if (arow < nr) { if (shared) { atok = r0 + arow; aout = atok; } else { aout = SORT[r0 + arow]; atok = aout >> 3; } }
    const bf16_t* aptr = TOK + (size_t)atok * DM + (((t & 3) ^ ((0 - (arow >> 2)) & 3)) << 3);
    __syncthreads();
    if ((t & 3) == 0) rowout[arow] = aout;
    const unsigned char* wsrc = img + (size_t)t * 16;
    const int adst = wid * 1024, wdst = 8192 + wid * 1024;
#define MOE_ISSUE1(S, KT) do { LAS unsigned char* _s = lds + (S) * MOE_STG; dma16(aptr + (KT) * 32, _s + adst); \
        const unsigned char* _w = wsrc + (size_t)(KT) * IMG_BYTES; \
        dma16(_w, _s + wdst); dma16(_w + 8192, _s + wdst + 8192); dma16(_w + 16384, _s + wdst + 16384); dma16(_w + 24576, _s + wdst + 24576); } while (0)
#define MOE_ISSUE2(S, IM) do { LAS unsigned char* _s = lds + (S) * IMG_BYTES; const unsigned char* _w = wsrc + (size_t)(IM) * IMG_BYTES; \
        dma16(_w, _s + adst); dma16(_w + 8192, _s + adst + 8192); dma16(_w + 16384, _s + adst + 16384); dma16(_w + 24576, _s + adst + 24576); } while (0)
    f32x4 acc[8][4];
#pragma unroll
    for (int nf = 0; nf < 8; ++nf)
#pragma unroll
        for (int tf = 0; tf < 4; ++tf) acc[nf][tf] = (f32x4){0.f, 0.f, 0.f, 0.f};
    MOE_ISSUE1(0, 0);
    MOE_ISSUE1(1, 1);
    int st = 0;
    for (int kt = 0; kt < 32; ++kt) {
        if (kt < 31) WAIT_VM(5); else WAIT_VM(0);
        asm volatile("s_waitcnt lgkmcnt(0)" ::: "memory");
        __builtin_amdgcn_s_barrier();
        const int st2 = st == 0 ? 2 : st - 1;
        if (kt < 30) MOE_ISSUE1(st2, kt + 2);
        else if (kt == 31) MOE_ISSUE2(0, 32);
        LAS unsigned char* S = lds + st * MOE_STG;
        bf16x8 tfr[4];
#pragma unroll
        for (int tf = 0; tf < 4; ++tf) tfr[tf] = *(LAS bf16x8*)(S + swz64(wt * 64 + tf * 16 + fr, fq));
#pragma unroll
        for (int nf = 0; nf < 8; ++nf) {
            const bf16x8 wf = *(LAS bf16x8*)(S + 8192 + swz64(wn * 128 + nf * 16 + fr, fq));
#pragma unroll
            for (int tf = 0; tf < 4; ++tf) acc[nf][tf] = MFMA16(wf, tfr[tf], acc[nf][tf]);
        }
        st = st == 2 ? 0 : st + 1;
    }
#pragma unroll
    for (int i = 0; i < 4; ++i)
#pragma unroll
        for (int tf = 0; tf < 4; ++tf) {
            float hv[4];
#pragma unroll
            for (int j = 0; j < 4; ++j) hv[j] = silu_f(acc[2 * i][tf][j]) * acc[2 * i + 1][tf][j];
            const int tok = wt * 64 + tf * 16 + fr, hc = wn * 64 + i * 16 + 4 * fq;
            const u32x2 w = {pk_bf16(hv[0], hv[1]), pk_bf16(hv[2], hv[3])};
            *(LAS u32x2*)(lds + MOE_HT + tok * 512 + (((hc >> 3) ^ (tok & 15)) << 4) + (hc & 7) * 2) = w;
        }
#pragma unroll 1
    for (int nc = 0; nc < 2; ++nc) {
#pragma unroll
        for (int nf = 0; nf < 8; ++nf)
#pragma unroll
            for (int tf = 0; tf < 4; ++tf) acc[nf][tf] = (f32x4){0.f, 0.f, 0.f, 0.f};
        if (nc == 1) MOE_ISSUE2(0, 40);
        for (int kt = 0; kt < 8; ++kt) {
            WAIT_VM(0);
            asm volatile("s_waitcnt lgkmcnt(0)" ::: "memory");
            __builtin_amdgcn_s_barrier();
            if (kt < 7) MOE_ISSUE2((kt + 1) & 1, 32 + nc * 8 + kt + 1);
            LAS unsigned char* S = lds + (kt & 1) * IMG_BYTES;
            bf16x8 tfr[4];
#pragma unroll
            for (int tf = 0; tf < 4; ++tf) { const int tok = wt * 64 + tf * 16 + fr; tfr[tf] = *(LAS bf16x8*)(lds + MOE_HT + tok * 512 + (((kt * 4 + fq) ^ (tok & 15)) << 4)); }
#pragma unroll
            for (int nf = 0; nf < 8; ++nf) {
                const bf16x8 wf = *(LAS bf16x8*)(S + swz64(wn * 128 + nf * 16 + fr, fq));
#pragma unroll
                for (int tf = 0; tf < 4; ++tf) acc[nf][tf] = MFMA16(wf, tfr[tf], acc[nf][tf]);
            }
        }
        __syncthreads();
        LAS unsigned char* W = lds + wid * 9216;
#pragma unroll
        for (int half = 0; half < 2; ++half) {
#pragma unroll
            for (int nh = 0; nh < 4; ++nh)
#pragma unroll
                for (int tf = 0; tf < 4; ++tf) {
                    const f32x4 v = acc[half * 4 + nh][tf];
                    const u32x2 w = {pk_bf16(v[0], v[1]), pk_bf16(v[2], v[3])};
                    *(LAS u32x2*)(W + (tf * 16 + fr) * 144 + nh * 32 + fq * 8) = w;
                }
#pragma unroll
            for (int it = 0; it < 8; ++it) {
                const int row = it * 8 + (lane >> 3), ch = lane & 7;
                const u32x4 v = *(LAS u32x4*)(W + row * 144 + ch * 16);
                const int ro = rowout[wt * 64 + row];
                if (ro >= 0) *(u32x4*)(outbase + (size_t)ro * DM + nc * 512 + wn * 128 + half * 64 + ch * 8) = v;
            }
        }
        __syncthreads();
    }
#undef MOE_ISSUE1
#undef MOE_ISSUE2
}

DI void phase_moe(const Params& p0, int l, LAS unsigned char* lds) {
    const Params p = launder(p0); l = launder_s(l);
    const int* TILES = (const int*)(p.ws + WS_TILES);
    const int ntl = *((const int*)(p.ws + CTL_NTILES) + l);
    const int G = gridDim.x, bid = bid_();
    int vcu = bid;
    if (p.ph_hi - p.ph_lo > 1) {
        volatile LAS unsigned* bst = (volatile LAS unsigned*)(lds + LDS_BYTES - 16);
        const unsigned xc = bst[2]; unsigned pre = 0;
        for (unsigned j = 0; j < 16; ++j) { const unsigned c = xb_ld((unsigned*)(p.ws + WS_CTL) + XB_XCNT(j)); pre += (j < xc) ? c : 0u; }
        vcu = (int)(pre + bst[3]);
    }
    const int total = ntl + MROWS / 128;
    const unsigned char* IMG = p.ws + WS_WIMG + (size_t)l * (NEXP + 1) * IMG_PER_E * IMG_BYTES;
    for (int u = vcu; u < total; u += G) {
        if (u < ntl) {
            const int e = TILES[u * 4], r0 = TILES[u * 4 + 1], nr = TILES[u * 4 + 2];
            moe_unit(p, IMG + (size_t)e * IMG_PER_E * IMG_BYTES, (bf16_t*)(p.ws + WS_YSLOT), false, r0, nr, lds);
        } else {
            const int tm = u - ntl;
            if (l == 1 && (tm % (NT / 128)) < 2) continue;
            moe_unit(p, IMG + (size_t)NEXP * IMG_PER_E * IMG_BYTES, (bf16_t*)(p.ws + WS_YSH), true, tm * 128, 128, lds);
        }
    }
}

DI void phase_combine(const Params& p0, int l) {
    const Params p = launder(p0); l = launder_s(l);
    const float* X1 = (const float*)(p.ws + WS_XB); float* Xnext = (float*)(p.ws + WS_XA);
    const int lane = tid_() & 63, wid = tid_() >> 6;
    const bf16_t* YSL = (const bf16_t*)(p.ws + WS_YSLOT); const bf16_t* YSH = (const bf16_t*)(p.ws + WS_YSH);
    const float* GATE = (const float*)(p.ws + WS_GATE);
    const float* modv = (const float*)(p.ws + WS_MODV);
    const float* lg = p.ln_g + (size_t)(l * 2 + 1) * DM; const float* lb = p.ln_b + (size_t)(l * 2 + 1) * DM;
    bf16_t* H = (bf16_t*)(p.ws + WS_H);
    for (int r = bid_() * 8 + wid; r < MROWS; r += gridDim.x * 8) {
        const int b = r >= NT, pp = r - b * NT;
        if (l == 1 && pp < NCTX) continue;
        const int sel = pp < NCTX ? 2 : b;
        float gt[8];
#pragma unroll
        for (int k = 0; k < 8; ++k) gt[k] = GATE[(size_t)r * 8 + k];
        const float* g5 = modv + ((size_t)l * 3 + sel) * 6144 + 5 * 1024;
        f32x4 v[4];
#pragma unroll
        for (int i = 0; i < 4; ++i) {
            const int c = lane * 4 + i * 256;
            const u32x2 sw = *(const u32x2*)(YSH + (size_t)r * DM + c);
            float f0 = bf_lo(sw[0]), f1 = bf_hi(sw[0]), f2 = bf_lo(sw[1]), f3 = bf_hi(sw[1]);
#pragma unroll
            for (int k = 0; k < 8; ++k) {
                const u32x2 w = *(const u32x2*)(YSL + ((size_t)r * 8 + k) * DM + c);
                f0 += gt[k] * bf_lo(w[0]); f1 += gt[k] * bf_hi(w[0]); f2 += gt[k] * bf_lo(w[1]); f3 += gt[k] * bf_hi(w[1]);
            }
            const f32x4 xv = *(const f32x4*)(X1 + (size_t)r * DM + c), gv = *(const f32x4*)(g5 + c);
            v[i] = (f32x4){DN_ALPHA * xv[0] + gv[0] * f0, DN_ALPHA * xv[1] + gv[1] * f1, DN_ALPHA * xv[2] + gv[2] * f2, DN_ALPHA * xv[3] + gv[3] * f3};
        }
        float mu, rstd; ln_stats(v, mu, rstd);
#pragma unroll
        for (int i = 0; i < 4; ++i) {
            const int c = lane * 4 + i * 256;
            const f32x4 gg = *(const f32x4*)(lg + c), bb = *(const f32x4*)(lb + c);
#pragma unroll
            for (int j = 0; j < 4; ++j) v[i][j] = (v[i][j] - mu) * rstd * gg[j] + bb[j];
            if (l == 1) *(f32x4*)(p.out + ((size_t)b * NLAT + (pp - NCTX)) * DM + c) = v[i];
            else *(f32x4*)(Xnext + (size_t)r * DM + c) = v[i];
        }
        if (l == 0) { const float* mv = modv + ((size_t)1 * 3 + sel) * 6144; modulate_store(v, mv, mv + 1024, H + (size_t)r * DM, lane); }
    }
}

constexpr int PH_PER_LAYER = 11, N_PHASES = 3 + 2 * PH_PER_LAYER;
__global__ void __launch_bounds__(NTHREADS, 2) mega(Params p) {
    extern __shared__ __attribute__((aligned(16))) unsigned char lds_raw[];
    LAS unsigned char* lds = (LAS unsigned char*)lds_raw;
    volatile LAS unsigned* bst = (volatile LAS unsigned*)(lds + LDS_BYTES - 16);
    if (threadIdx.x == 0) { bst[0] = 0u; bst[1] = 0u; const unsigned xc = xb_xcc_id(); bst[2] = xc; bst[3] = xb_add((unsigned*)(p.ws + CTL_XRANK) + xc, 1u); }
    __syncthreads();
    const int lo = p.ph_lo, hi = p.ph_hi;
    XcdBarrier bar; bar.bar = (unsigned*)(p.ws + WS_CTL); bar.x = 0; bar.st = bst;
    if (hi - lo > 1) bar = xcd_barrier_post((unsigned*)(p.ws + WS_CTL), bst);
#ifndef ONLY_PHASE
#define ONLY_PHASE -1
#endif
#define IN(k) (lo <= (k) && (k) < hi)
#define ON(pid) (ONLY_PHASE < 0 || ONLY_PHASE == (pid))
#ifndef DUP_PHASE
#define DUP_PHASE -1
#endif
#define REP(pid) for (int rep_ = 0; rep_ < ((DUP_PHASE == (pid)) ? 2 : 1); ++rep_)
#define SEAM(k) do { if (IN(k) && IN((k) + 1)) xcd_barrier(bar); } while (0)
    if (ON(0) && IN(0)) REP(0) { phase_convert(p, lds); phase_convert_experts(p, 0); phase_convert_experts(p, 1); }
    SEAM(0);
    if (ON(1) && IN(1)) REP(1) phase_mod(p, lds);
    SEAM(1);
    if (ON(2) && IN(2)) REP(2) phase_ln0(p);
    SEAM(2);
    for (int l = 0; l < 2; ++l) {
        const int k0 = 3 + l * PH_PER_LAYER;
        if (ON(3) && IN(k0 + 0)) REP(3) phase_inproj(p, l, lds);
        SEAM(k0 + 0);
        if (ON(4) && IN(k0 + 1)) REP(4) phase_ret_sum_pool(p, l, lds);
        SEAM(k0 + 1);
        if (ON(5) && IN(k0 + 2)) REP(5) phase_ret_scan(p, l);
        SEAM(k0 + 2);
        if (ON(6) && IN(k0 + 3)) REP(6) { phase_attn(p, l, lds); phase_ret(p, l); }
        SEAM(k0 + 3);
        if (ON(7) && IN(k0 + 4)) REP(7) phase_outproj(p, l, lds);
        SEAM(k0 + 4);
        if (ON(8) && IN(k0 + 5)) REP(8) phase_ln_mid(p, l);
        SEAM(k0 + 5);
        if (ON(9) && IN(k0 + 6)) REP(9) phase_router(p, l, lds);
        SEAM(k0 + 6);
        if (ON(10) && IN(k0 + 7)) REP(10) phase_topk(p, l, lds);
        SEAM(k0 + 7);
        if (ON(11) && IN(k0 + 8)) REP(11) phase_scatter(p, l, lds);
        SEAM(k0 + 8);
        if (ON(12) && IN(k0 + 9)) REP(12) phase_moe(p, l, lds);
        SEAM(k0 + 9);
        if (ON(14) && IN(k0 + 10)) REP(14) phase_combine(p, l);
        if (l == 0) SEAM(k0 + 10);
    }
#undef IN
#undef SEAM
}

extern "C" void kernel_launch(void* const* d_in, const int* in_sizes, int n_in, void* d_out, int out_size, void* d_ws, size_t ws_size, hipStream_t stream) {
    static int grid = 0;
    if (grid == 0) {
        if (n_in != 20 || ws_size < WS_END || out_size != NB * NLAT * DM) { fprintf(stderr, "kernel_launch: unexpected shapes (n_in %d, ws %zu need %zu, out %d)\n", n_in, ws_size, (size_t)WS_END, out_size); grid = -1; return; }
        int dev = 0, cus = 0, per_cu = 0;
        hipGetDevice(&dev); hipDeviceGetAttribute(&cus, hipDeviceAttributeMultiprocessorCount, dev);
        if (hipFuncSetAttribute((const void*)mega, hipFuncAttributeMaxDynamicSharedMemorySize, LDS_BYTES) != hipSuccess) { fprintf(stderr, "kernel_launch: hipFuncSetAttribute failed\n"); grid = -1; return; }
        if (hipOccupancyMaxActiveBlocksPerMultiprocessor(&per_cu, (const void*)mega, NTHREADS, LDS_BYTES) != hipSuccess || per_cu < 1) { fprintf(stderr, "kernel_launch: occupancy query says %d\n", per_cu); }
        (void)hipGetLastError();
        grid = cus > 0 ? cus : 256;
    }
    if (grid < 0) return;
    hipMemsetAsync((char*)d_ws + WS_CTL, 0, CTL_BYTES, stream);
    Params p{};
    p.x = (const float*)d_in[0]; p.c = (const float*)d_in[1]; p.ctx = (const float*)d_in[2]; p.c_ctx = (const float*)d_in[3];
    p.w_mod = (const float*)d_in[4]; p.b_mod = (const float*)d_in[5]; p.w_in = (const float*)d_in[6]; p.w_out = (const float*)d_in[7];
    p.diff_lambda = (const float*)d_in[8]; p.pool_w = (const float*)d_in[9]; p.pool_scale = (const float*)d_in[10]; p.ret_log_decay = (const float*)d_in[11];
    p.ln_g = (const float*)d_in[12]; p.ln_b = (const float*)d_in[13]; p.w_router = (const float*)d_in[14]; p.router_bias = (const float*)d_in[15];
    p.w_egu = (const float*)d_in[16]; p.w_edn = (const float*)d_in[17]; p.w_sgu = (const float*)d_in[18]; p.w_sdn = (const float*)d_in[19];
    p.out = (float*)d_out; p.ws = (unsigned char*)d_ws;
#if N_LAUNCH_PER_PHASE
    for (int k = 0; k < N_PHASES; ++k) { p.ph_lo = k; p.ph_hi = k + 1; hipLaunchKernelGGL(mega, dim3(grid), dim3(NTHREADS), LDS_BYTES, stream, p); }
#else
    p.ph_lo = 0; p.ph_hi = N_PHASES;
    hipLaunchKernelGGL(mega, dim3(grid), dim3(NTHREADS), LDS_BYTES, stream, p);
#endif
}
```

```cpp
#include <hip/hip_runtime.h>
#include <stdint.h>
#include <stdio.h>

#ifndef N_LAUNCH_PER_PHASE
#define N_LAUNCH_PER_PHASE 0
#endif

#define LAS __attribute__((address_space(3)))
#define DI __device__ __forceinline__
typedef unsigned short bf16_t;
typedef short bf16x8 __attribute__((ext_vector_type(8)));
typedef float f32x2 __attribute__((ext_vector_type(2)));
typedef float f32x4 __attribute__((ext_vector_type(4)));
typedef float f32x16 __attribute__((ext_vector_type(16)));
typedef unsigned u32x2 __attribute__((ext_vector_type(2)));
typedef unsigned u32x4 __attribute__((ext_vector_type(4)));
typedef __bf16 bf16v2 __attribute__((ext_vector_type(2)));

constexpr int NB = 2, NLAT = 8192, NCTX = 256, NT = NLAT + NCTX  , MROWS = NB * NT  ;
constexpr int DM = 1024, INW = 2816, NEXP = 256, TOPK = 8, NASG = MROWS * TOPK  ;
constexpr int NCHUNK = NT / 128;
constexpr float DN_ALPHA = 1.41421356237f;
constexpr float LN_EPS = 1e-6f, RMS_EPS = 1e-5f;
constexpr float LOG2E = 1.44269504089f;
constexpr float QSCALE = 0.125f * LOG2E;
constexpr int NTHREADS = 512;
constexpr int LDS_BYTES = 155648;

constexpr int C_DQ = 0, C_DK = 512, C_DV = 1024, C_PU = 1536, C_RQ = 1792, C_RK = 2048, C_RV = 2304, C_RG = 2560;

constexpr size_t al256(size_t x) { return (x + 255) & ~(size_t)255; }
constexpr size_t WS_CTL = 0;
constexpr size_t CTL_BYTES = 65536;
constexpr size_t CTL_COUNTS = 16384;
constexpr size_t CTL_CURSOR = CTL_COUNTS + 2048;
constexpr size_t CTL_NTILES = CTL_CURSOR + 2048;
constexpr size_t CTL_XRANK = CTL_NTILES + 256;
constexpr size_t WS_MODV = WS_CTL + CTL_BYTES;
constexpr size_t WS_ROPE = al256(WS_MODV + 2 * 3 * 6144 * 4);
constexpr size_t WS_SCAL = al256(WS_ROPE + 128 * 16 * 8);
constexpr size_t WS_WIN = al256(WS_SCAL + 2 * 16 * 4);
constexpr size_t WS_WOUT = al256(WS_WIN + (size_t)2 * INW * DM * 2);
constexpr size_t WS_WR = al256(WS_WOUT + (size_t)2 * DM * DM * 2);
constexpr size_t WS_WIMG = al256(WS_WR + (size_t)2 * 256 * DM * 2);
constexpr size_t WS_XA = al256(WS_WIMG + (size_t)2 * 257 * 48 * 32768);
constexpr size_t WS_XB = al256(WS_XA + (size_t)MROWS * DM * 4);
constexpr size_t WS_V1 = al256(WS_XB + (size_t)MROWS * DM * 4);
constexpr size_t WS_H = al256(WS_V1 + (size_t)MROWS * DM * 4);
constexpr size_t WS_TOK = al256(WS_H + (size_t)MROWS * DM * 2);
constexpr size_t WS_P = al256(WS_TOK + (size_t)MROWS * DM * 2);
constexpr size_t WS_VT = al256(WS_P + (size_t)MROWS * INW * 2);
constexpr size_t WS_RKT = al256(WS_VT + (size_t)NB * 4 * 128 * NT * 2);
constexpr size_t WS_RVT = al256(WS_RKT + (size_t)NB * 4 * 64 * NT * 2);
constexpr size_t WS_MIX = al256(WS_RVT + (size_t)NB * 4 * 64 * NT * 2);
constexpr size_t ST_BYTES = (size_t)NB * 4 * NCHUNK * 4096 * 4;
constexpr size_t WS_UF = al256(WS_MIX + (size_t)MROWS * DM * 2);
constexpr size_t WS_UB = al256(WS_UF + ST_BYTES);
constexpr size_t WS_SF = al256(WS_UB + ST_BYTES);
constexpr size_t WS_SB = al256(WS_SF + ST_BYTES);
constexpr size_t WS_LOGIT = al256(WS_SB + ST_BYTES);
constexpr size_t WS_EIDX = al256(WS_LOGIT + (size_t)MROWS * 256 * 4);
constexpr size_t WS_GATE = al256(WS_EIDX + (size_t)NASG * 4);
constexpr size_t WS_SORT = al256(WS_GATE + (size_t)NASG * 4);
constexpr size_t WS_RANK = al256(WS_SORT + (size_t)NASG * 4);
constexpr size_t WS_HIST = al256(WS_RANK + (size_t)NASG * 4);
constexpr size_t WS_TILES = al256(WS_HIST + (size_t)1024 * 256 * 4);
constexpr size_t WS_YSLOT = al256(WS_TILES + 2048 * 16);
constexpr size_t WS_YSH = al256(WS_YSLOT + (size_t)NASG * DM * 2);
constexpr size_t WS_END = al256(WS_YSH + (size_t)MROWS * DM * 2);

struct Params {
    const float *x, *c, *ctx, *c_ctx, *w_mod, *b_mod, *w_in, *w_out, *diff_lambda, *pool_w, *pool_scale, *ret_log_decay, *ln_g, *ln_b,
        *w_router, *router_bias, *w_egu, *w_edn, *w_sgu, *w_sdn;
    float* out;
    unsigned char* ws;
    int ph_lo, ph_hi;
};


DI Params launder(const Params& a) {
    Params r = a;
    unsigned long long* d = (unsigned long long*)&r;
#pragma unroll
    for (int i = 0; i < 22; ++i) asm volatile("" : "+s"(d[i]));
    return r;
}
DI int launder_s(int v) { asm volatile("" : "+s"(v)); return v; }
DI int tid_() { int t = threadIdx.x; asm volatile("" : "+v"(t)); return t; }
DI int bid_() { int t = blockIdx.x; asm volatile("" : "+s"(t)); return t; }


#ifndef PROBE_ID
#define PROBE_ID 0
#endif
#ifndef PROBE_GAIN
#define PROBE_GAIN 8
#endif
#define PRB_WORDS(lds) ((volatile LAS unsigned long long*)((lds) + LDS_BYTES - 64))
#define PRB_MATCH(id) (PROBE_ID == (id) || (PROBE_ID == 999 && (id) >= 200) || (PROBE_ID == 998 && ((id) == 101 || (id) == 102 || (id) == 104 || (id) == 105 || (id) == 108 || (id) == 109 || (id) == 110 || (id) == 111)))
#define PRB_T0(id, lds) do { if (PRB_MATCH(id) && threadIdx.x == 0 && blockIdx.x == 0) { PRB_WORDS(lds)[0] = __builtin_readcyclecounter(); } } while (0)
#define PRB_T1(id, lds) do { if (PRB_MATCH(id) && threadIdx.x == 0 && blockIdx.x == 0) { PRB_WORDS(lds)[1] += __builtin_readcyclecounter() - PRB_WORDS(lds)[0]; } } while (0)

#define XB_TMO      128
#define XB_XCNT(j)  (256  + 64 * (j))
#define XB_XSUB(j)  (1280 + 64 * (j))
#define XB_XGEN(j)  (2304 + 64 * (j))
#define XB_TOP      3328
#define XB_TOPGEN   3392
#define XCD_BAR_WORDS 3456
#define XB_SPIN_CAP (1u << 20)

__device__ __forceinline__ unsigned xb_ld(unsigned* p)              { return __hip_atomic_load(p, __ATOMIC_RELAXED, __HIP_MEMORY_SCOPE_AGENT); }
__device__ __forceinline__ unsigned xb_add(unsigned* p, unsigned v) { return __hip_atomic_fetch_add(p, v, __ATOMIC_RELAXED, __HIP_MEMORY_SCOPE_AGENT); }
__device__ __forceinline__ unsigned xb_xcc_id() { return (unsigned)__builtin_amdgcn_s_getreg((3 << 11) | 20) & 0xFu; }
#define XB_SPIN(cond, bar) do { unsigned _sp = 0; while (cond) { __builtin_amdgcn_s_sleep(1); \
    if ((++_sp & 255u) == 0u) { if (xb_ld(&(bar)[XB_TMO])) break; if (_sp > XB_SPIN_CAP) { atomicAdd(&(bar)[XB_TMO], 1u); break; } } } } while (0)

struct XcdBarrier { unsigned* bar; unsigned x; volatile LAS unsigned* st; };

__device__ __forceinline__ XcdBarrier xcd_barrier_post(unsigned* bar, volatile LAS unsigned* st) {
    XcdBarrier b; b.bar = bar; b.x = xb_xcc_id(); b.st = st;
    if (threadIdx.x == 0) (void)xb_add(&bar[XB_XCNT(b.x)], 1u);
    return b;
}
__device__ __forceinline__ void xcd_barrier_complete(unsigned* bar, unsigned x, unsigned& nloc, unsigned& nx) {
    const unsigned G = gridDim.x * gridDim.y * gridDim.z;
    unsigned sum, cnt, mine, sp = 0u;
    for (;;) {
        sum = 0u; cnt = 0u; mine = 0u;
#pragma unroll
        for (unsigned j = 0; j < 16; ++j) { const unsigned c = xb_ld(&bar[XB_XCNT(j)]); sum += c; cnt += (c > 0u) ? 1u : 0u; mine = (j == x) ? c : mine; }
        if (sum == G) break;
        __builtin_amdgcn_s_sleep(1);
        if ((++sp & 255u) == 0u) { if (xb_ld(&bar[XB_TMO])) break; if (sp > XB_SPIN_CAP) { atomicAdd(&bar[XB_TMO], 1u); break; } }
    }
    nloc = mine > 0u ? mine : 1u; nx = cnt > 0u ? cnt : 1u;
}
__device__ __forceinline__ void xcd_barrier(const XcdBarrier& b) {
    asm volatile("s_waitcnt vmcnt(0)" ::: "memory");
    __syncthreads();
    if (threadIdx.x == 0) {
        unsigned* bar = b.bar;
        __builtin_amdgcn_s_waitcnt(0);
        unsigned nloc = b.st[0], nx = b.st[1];
        if (nloc == 0u) { xcd_barrier_complete(bar, b.x, nloc, nx); b.st[0] = nloc; b.st[1] = nx; }
        const unsigned old = xb_add(&bar[XB_XSUB(b.x)], 1u);
        const unsigned gen = old / nloc;
        if (old + 1u == (gen + 1u) * nloc) {
            __builtin_amdgcn_fence(__ATOMIC_RELEASE, "agent");
            asm volatile("s_waitcnt vmcnt(0)" ::: "memory");
            const unsigned og = xb_add(&bar[XB_TOP], 1u);
            const unsigned tg = og / nx;
            if (og + 1u == (tg + 1u) * nx) xb_add(&bar[XB_TOPGEN], 1u);
            else XB_SPIN(xb_ld(&bar[XB_TOPGEN]) == tg, bar);
            __builtin_amdgcn_fence(__ATOMIC_ACQUIRE, "agent");
            xb_add(&bar[XB_XGEN(b.x)], 1u);
            asm volatile("s_waitcnt vmcnt(0)" ::: "memory");
        } else {
            XB_SPIN(xb_ld(&bar[XB_XGEN(b.x)]) == gen, bar);
            __builtin_amdgcn_fence(__ATOMIC_ACQUIRE, "agent");
            asm volatile("s_waitcnt vmcnt(0)" ::: "memory");
        }
    }
    __syncthreads();
}

DI unsigned pk_bf16(float a, float b) { f32x2 v = {a, b}; bf16v2 r = __builtin_convertvector(v, bf16v2); return __builtin_bit_cast(unsigned, r); }
DI bf16_t to_bf16(float a) { return (bf16_t)(pk_bf16(a, 0.f) & 0xffffu); }
DI float bf_lo(unsigned u) { return __uint_as_float(u << 16); }
DI float bf_hi(unsigned u) { return __uint_as_float(u & 0xffff0000u); }
DI float bf2f(bf16_t h) { return __uint_as_float(((unsigned)h) << 16); }
DI float wave_sum(float v) {
#pragma unroll
    for (int o = 32; o; o >>= 1) v += __shfl_xor(v, o);
    return v;
}
DI float fast_exp2(float x) { return __builtin_amdgcn_exp2f(x); }
DI float silu_f(float x) { return x / (1.f + __expf(-x)); }
DI bf16x8 as_bf16x8(u32x4 v) { return __builtin_bit_cast(bf16x8, v); }
#define WAIT_VM(n) asm volatile("s_waitcnt vmcnt(" #n ")" ::: "memory")
DI void dma16(const void* g, LAS unsigned char* l) { __builtin_amdgcn_global_load_lds(g, (LAS void*)l, 16, 0, 0); }
#define MFMA32(a, b, c) __builtin_amdgcn_mfma_f32_32x32x16_bf16((a), (b), (c), 0, 0, 0)
#define MFMA16(a, b, c) __builtin_amdgcn_mfma_f32_16x16x32_bf16((a), (b), (c), 0, 0, 0)

DI int row_sel(int r) { const int b = r >= NT; const int p = r - b * NT; return p < NCTX ? 2 : b; }

DI int swz_off(int row, int chunk) { return row * 128 + ((chunk ^ ((row >> 1) & 7)) << 4); }

template <class Epi>
DI void gemm128(const bf16_t* a0, const bf16_t* a1, const bf16_t* b0, const bf16_t* b1, int nk, LAS unsigned char* lds, const Epi& epi) {
    const int tid = tid_(), lane = tid & 63, wid = tid >> 6, wr = wid >> 2, wc = wid & 3, fr = lane & 15, fq = lane >> 4;
    const int lrow = tid >> 3, lch = tid & 7;
    f32x4 acc[4][2];
#pragma unroll
    for (int m = 0; m < 4; ++m)
#pragma unroll
        for (int n = 0; n < 2; ++n) acc[m][n] = (f32x4){0.f, 0.f, 0.f, 0.f};
    const u32x4 z4 = {0u, 0u, 0u, 0u};
    u32x4 ra0 = a0 ? *(const u32x4*)a0 : z4, ra1 = a1 ? *(const u32x4*)a1 : z4, rb0 = b0 ? *(const u32x4*)b0 : z4, rb1 = b1 ? *(const u32x4*)b1 : z4;
    const int wo0 = swz_off(lrow, lch), wo1 = swz_off(lrow + 64, lch);
    *(LAS u32x4*)(lds + wo0) = ra0; *(LAS u32x4*)(lds + wo1) = ra1;
    *(LAS u32x4*)(lds + 16384 + wo0) = rb0; *(LAS u32x4*)(lds + 16384 + wo1) = rb1;
    __syncthreads();
    for (int kt = 0; kt < nk; ++kt) {
        const bool more = kt + 1 < nk;
        if (more) {
            const int ko = (kt + 1) * 64;
            ra0 = a0 ? *(const u32x4*)(a0 + ko) : z4; ra1 = a1 ? *(const u32x4*)(a1 + ko) : z4;
            rb0 = b0 ? *(const u32x4*)(b0 + ko) : z4; rb1 = b1 ? *(const u32x4*)(b1 + ko) : z4;
        }
        LAS unsigned char* A = lds + (kt & 1) * 32768;
        LAS unsigned char* B = A + 16384;
#pragma unroll
        for (int kk = 0; kk < 2; ++kk) {
            bf16x8 af[4], bfr[2];
#pragma unroll
            for (int m = 0; m < 4; ++m) af[m] = *(LAS bf16x8*)(A + swz_off(wr * 64 + m * 16 + fr, kk * 4 + fq));
#pragma unroll
            for (int n = 0; n < 2; ++n) bfr[n] = *(LAS bf16x8*)(B + swz_off(wc * 32 + n * 16 + fr, kk * 4 + fq));
#pragma unroll
            for (int m = 0; m < 4; ++m)
#pragma unroll
                for (int n = 0; n < 2; ++n) acc[m][n] = MFMA16(af[m], bfr[n], acc[m][n]);
        }
        if (more) {
            LAS unsigned char* A2 = lds + ((kt + 1) & 1) * 32768;
            *(LAS u32x4*)(A2 + wo0) = ra0; *(LAS u32x4*)(A2 + wo1) = ra1;
            *(LAS u32x4*)(A2 + 16384 + wo0) = rb0; *(LAS u32x4*)(A2 + 16384 + wo1) = rb1;
        }
        __syncthreads();
    }
    epi(acc, wr, wc, fr, fq);
}

DI int perm_gu(int n) { const int f = n >> 8, jj = n & 255; return ((jj >> 4) << 5) + (f << 4) + (jj & 15); }
DI void conv_unit(const float* src, int N, int K, bf16_t* dst, int k0, int n0, bool perm, LAS unsigned char* lds) {
    LAS float* tl = (LAS float*)lds;
    const int tid = tid_();
#pragma unroll
    for (int i = 0; i < 8; ++i) {
        const int kk = (tid >> 6) + 8 * i, nn = (tid & 63) * 4;
        const f32x4 v = *(const f32x4*)(src + (size_t)(k0 + kk) * N + n0 + nn);
        tl[kk * 257 + nn] = v[0]; tl[kk * 257 + nn + 1] = v[1]; tl[kk * 257 + nn + 2] = v[2]; tl[kk * 257 + nn + 3] = v[3];
    }
    __syncthreads();
    const int n = tid >> 1, kh = (tid & 1) * 32;
    const int nd = perm ? perm_gu(n0 + n) : (n0 + n);
    bf16_t* d = dst + (size_t)nd * K + k0 + kh;
#pragma unroll
    for (int q = 0; q < 4; ++q) {
        u32x4 w;
#pragma unroll
        for (int j = 0; j < 4; ++j) w[j] = pk_bf16(tl[(kh + q * 8 + 2 * j) * 257 + n], tl[(kh + q * 8 + 2 * j + 1) * 257 + n]);
        *(u32x4*)(d + q * 8) = w;
    }
    __syncthreads();
}

DI void phase_convert(const Params& p0, LAS unsigned char* lds) {
    const Params p = launder(p0);
    constexpr int U_IN = 176, U_OUT = 64, U_R = 16;
    constexpr int U_L = U_IN + U_OUT + U_R;
    for (int u = bid_(); u < 2 * U_L; u += gridDim.x) {
        const int l = u / U_L; int v = u % U_L;
        if (v < U_IN) { conv_unit(p.w_in + (size_t)l * DM * INW, INW, DM, (bf16_t*)(p.ws + WS_WIN) + (size_t)l * INW * DM, (v / 11) * 64, (v % 11) * 256, false, lds); continue; }
        v -= U_IN;
        if (v < U_OUT) { conv_unit(p.w_out + (size_t)l * DM * DM, DM, DM, (bf16_t*)(p.ws + WS_WOUT) + (size_t)l * DM * DM, (v / 4) * 64, (v % 4) * 256, false, lds); continue; }
        v -= U_OUT;
        conv_unit(p.w_router + (size_t)l * DM * 256, 256, DM, (bf16_t*)(p.ws + WS_WR) + (size_t)l * 256 * DM, v * 64, 0, false, lds);
    }
}

DI void phase_mod(const Params& p0, LAS unsigned char* lds) {
    const Params p = launder(p0);
    LAS float* sc = (LAS float*)lds;
    LAS float* red = sc + 3 * 1024;
    const int tid = tid_();
    float* modv = (float*)(p.ws + WS_MODV);
    for (int u = bid_(); u < 193; u += gridDim.x) {
        if (u == 192) {
            float* rope = (float*)(p.ws + WS_ROPE);
            for (int i = tid; i < 128 * 16; i += NTHREADS) {
                const int pos = i >> 4, f = i & 15;
                const float freq = powf(10000.0f, -(float)f / 16.0f);
                const float ang = (float)pos * freq;
                rope[2 * i] = cosf(ang); rope[2 * i + 1] = sinf(ang);
            }
            float* scal = (float*)(p.ws + WS_SCAL);
            if (tid < 2) {
                const int l = tid;
                const float* dl = p.diff_lambda + l * 256;
                float s01 = 0.f, s23 = 0.f;
                for (int i = 0; i < 64; ++i) { s01 += dl[i] * dl[64 + i]; s23 += dl[128 + i] * dl[192 + i]; }
                const float lambda_init = 0.8f - 0.6f * expf(-0.3f * (float)l);
                scal[l * 16 + 0] = expf(s01) - expf(s23) + lambda_init;
                scal[l * 16 + 1] = 1.0f - lambda_init;
                for (int h = 0; h < 4; ++h) {
                    scal[l * 16 + 2 + h] = -expf(p.ret_log_decay[l * 8 + h]) * LOG2E;
                    scal[l * 16 + 6 + h] = -expf(p.ret_log_decay[l * 8 + 4 + h]) * LOG2E;
                }
            }
            continue;
        }
        const int l = u / 96, n0 = (u % 96) * 64;
        for (int i = tid; i < 3 * 1024; i += NTHREADS) {
            const int s = i >> 10, k = i & 1023;
            const float v = s < 2 ? p.c[s * 1024 + k] : p.c_ctx[k];
            sc[i] = silu_f(v);
        }
        __syncthreads();
        const int kq = tid >> 6, nl = tid & 63;
        const float* w = p.w_mod + (size_t)l * DM * 6144 + n0 + nl;
        float a0 = 0.f, a1 = 0.f, a2 = 0.f;
        for (int k = kq * 128; k < kq * 128 + 128; ++k) {
            const float wv = w[(size_t)k * 6144];
            a0 += sc[k] * wv; a1 += sc[1024 + k] * wv; a2 += sc[2048 + k] * wv;
        }
        red[(kq * 3 + 0) * 64 + nl] = a0; red[(kq * 3 + 1) * 64 + nl] = a1; red[(kq * 3 + 2) * 64 + nl] = a2;
        __syncthreads();
        if (tid < 192) {
            const int s = tid >> 6, n = tid & 63;
            float v = 0.f;
            for (int q = 0; q < 8; ++q) v += red[(q * 3 + s) * 64 + n];
            modv[((size_t)l * 3 + s) * 6144 + n0 + n] = v + p.b_mod[l * 6144 + n0 + n];
        }
        __syncthreads();
    }
}

DI void ln_stats(const f32x4 (&v)[4], float& mu, float& rstd) {
    float s = 0.f;
#pragma unroll
    for (int i = 0; i < 4; ++i) s += (v[i][0] + v[i][1]) + (v[i][2] + v[i][3]);
    mu = wave_sum(s) * (1.0f / 1024.0f);
    float q = 0.f;
#pragma unroll
    for (int i = 0; i < 4; ++i)
#pragma unroll
        for (int j = 0; j < 4; ++j) { const float d = v[i][j] - mu; q += d * d; }
    rstd = rsqrtf(wave_sum(q) * (1.0f / 1024.0f) + LN_EPS);
}
DI void modulate_store(const f32x4 (&v)[4], const float* shift, const float* scale, bf16_t* dst, int lane) {
    float mu, rstd; ln_stats(v, mu, rstd);
#pragma unroll
    for (int i = 0; i < 4; ++i) {
        const int c = lane * 4 + i * 256;
        const f32x4 sh = *(const f32x4*)(shift + c), scv = *(const f32x4*)(scale + c);
        float o[4];
#pragma unroll
        for (int j = 0; j < 4; ++j) o[j] = (v[i][j] - mu) * rstd * (1.0f + scv[j]) + sh[j];
        u32x2 w = {pk_bf16(o[0], o[1]), pk_bf16(o[2], o[3])};
        *(u32x2*)(dst + c) = w;
    }
}

DI void phase_ln0(const Params& p0) {
    const Params p = launder(p0);
    const int lane = tid_() & 63, wid = tid_() >> 6;
    float* XA = (float*)(p.ws + WS_XA);
    bf16_t* H = (bf16_t*)(p.ws + WS_H);
    const float* modv = (const float*)(p.ws + WS_MODV);
    for (int r = bid_() * 8 + wid; r < MROWS; r += gridDim.x * 8) {
        const int b = r >= NT, pp = r - b * NT;
        const float* src = pp < NCTX ? p.ctx + ((size_t)b * NCTX + pp) * DM : p.x + ((size_t)b * NLAT + (pp - NCTX)) * DM;
        f32x4 v[4];
#pragma unroll
        for (int i = 0; i < 4; ++i) { v[i] = *(const f32x4*)(src + lane * 4 + i * 256); *(f32x4*)(XA + (size_t)r * DM + lane * 4 + i * 256) = v[i]; }
        const float* mv = modv + (size_t)(0 * 3 + (pp < NCTX ? 2 : b)) * 6144;
        modulate_store(v, mv, mv + 1024, H + (size_t)r * DM, lane);
    }
}

constexpr int G2_STG = 40960;
template <class Epi>
DI void gemm192(const bf16_t* A, int lda, const bf16_t* Bt, int ldb, int nk, int m0, int n0, LAS unsigned char* lds, const Epi& epi) {
    const int t = tid_(), lane = t & 63, wid = __builtin_amdgcn_readfirstlane(t >> 6), fr = lane & 15, fq = lane >> 4, wm = wid >> 1, wn = wid & 1;
    const bf16_t* asrc[3]; const bf16_t* bsrc[2];
#pragma unroll
    for (int i = 0; i < 3; ++i) { const int sl = t + 512 * i, row = sl >> 3, c = (sl & 7) ^ ((row >> 1) & 7); asrc[i] = A + (size_t)(m0 + row) * lda + c * 8; }
#pragma unroll
    for (int i = 0; i < 2; ++i) { const int sl = t + 512 * i, row = sl >> 3, c = (sl & 7) ^ ((row >> 1) & 7); bsrc[i] = Bt + (size_t)(n0 + row) * ldb + c * 8; }
    const int ddst = wid * 1024;
#define G2_ISSUE(S, KT) do { LAS unsigned char* _s = lds + (S) * G2_STG + ddst; const int _k = (KT) * 64; \
        dma16(asrc[0] + _k, _s); dma16(asrc[1] + _k, _s + 8192); dma16(asrc[2] + _k, _s + 16384); dma16(bsrc[0] + _k, _s + 24576); dma16(bsrc[1] + _k, _s + 32768); } while (0)
    f32x4 acc[4][3];
#pragma unroll
    for (int nf = 0; nf < 4; ++nf)
#pragma unroll
        for (int mf = 0; mf < 3; ++mf) acc[nf][mf] = (f32x4){0.f, 0.f, 0.f, 0.f};
    __syncthreads();
    G2_ISSUE(0, 0);
    if (nk > 1) G2_ISSUE(1, 1);
    int st = 0;
    for (int kt = 0; kt < nk; ++kt) {
        if (kt + 1 < nk) WAIT_VM(5); else WAIT_VM(0);
        asm volatile("s_waitcnt lgkmcnt(0)" ::: "memory");
        __builtin_amdgcn_s_barrier();
        const int st2 = st == 0 ? 2 : st - 1;
        if (kt + 2 < nk) G2_ISSUE(st2, kt + 2);
        LAS unsigned char* S = lds + st * G2_STG;
        st = st == 2 ? 0 : st + 1;
#pragma unroll
        for (int kk = 0; kk < 2; ++kk) {
            bf16x8 af[3], bfr[4];
#pragma unroll
            for (int mf = 0; mf < 3; ++mf) af[mf] = *(LAS bf16x8*)(S + swz_off(wm * 48 + mf * 16 + fr, kk * 4 + fq));
#pragma unroll
            for (int nf = 0; nf < 4; ++nf) bfr[nf] = *(LAS bf16x8*)(S + 24576 + swz_off(wn * 64 + nf * 16 + fr, kk * 4 + fq));
#pragma unroll
            for (int nf = 0; nf < 4; ++nf)
#pragma unroll
                for (int mf = 0; mf < 3; ++mf) acc[nf][mf] = MFMA16(bfr[nf], af[mf], acc[nf][mf]);
        }
    }
#undef G2_ISSUE
    __syncthreads();
    epi(acc, wm, wn, fr, fq, lane, wid);
}
DI LAS unsigned char* g2_stage(LAS unsigned char* lds, int wid) { return lds + wid * 13056; }

DI void phase_inproj(const Params& p0, int l, LAS unsigned char* lds) {
    const Params p = launder(p0); l = launder_s(l);
    const bf16_t* H = (const bf16_t*)(p.ws + WS_H);
    const bf16_t* W = (const bf16_t*)(p.ws + WS_WIN) + (size_t)l * INW * DM;
    bf16_t* P = (bf16_t*)(p.ws + WS_P);
    bf16_t* VT = (bf16_t*)(p.ws + WS_VT);
    bf16_t* RKT = (bf16_t*)(p.ws + WS_RKT);
    bf16_t* RVT = (bf16_t*)(p.ws + WS_RVT);
    const f32x2* rope = (const f32x2*)(p.ws + WS_ROPE);
    constexpr int NTN = INW / 128, NTM = MROWS / 192;
    for (int u = bid_(); u < NTM * NTN; u += gridDim.x) {
        const int tm = u / NTN, tn = u % NTN;
        auto epi = [&](f32x4 (&acc)[4][3], int wm, int wn, int fr, int fq, int lane, int wid) {
            const int c0 = tn * 128 + wn * 64;
            const int r0 = tm * 192 + wm * 48;
            LAS unsigned char* W_ = g2_stage(lds, wid);
            if (c0 < C_DV) {
                const float qs = c0 < C_DK ? QSCALE : 1.0f;
#pragma unroll
                for (int mf = 0; mf < 3; ++mf) {
                    const int row = r0 + mf * 16 + fr;
                    const int b = row >= NT, pp = row - b * NT;
                    const bool lat = pp >= NCTX;
                    const int tt = pp - NCTX;
#pragma unroll
                    for (int hb = 0; hb < 2; ++hb) {
                        const int axis = ((c0 >> 5) + hb) & 1;
                        const int pos = axis ? (tt & 63) : (tt >> 6);
#pragma unroll
                        for (int j = 0; j < 4; ++j) {
                            float x1 = acc[2 * hb][mf][j], x2 = acc[2 * hb + 1][mf][j];
                            if (lat) { const f32x2 cs = rope[pos * 16 + 4 * fq + j]; const float o1 = x1 * cs[0] - x2 * cs[1], o2 = x1 * cs[1] + x2 * cs[0]; x1 = o1; x2 = o2; }
                            acc[2 * hb][mf][j] = x1 * qs; acc[2 * hb + 1][mf][j] = x2 * qs;
                        }
                    }
                }
            } else if (c0 >= C_RK && c0 < C_RV) {
#pragma unroll
                for (int nf = 0; nf < 4; ++nf)
#pragma unroll
                    for (int mf = 0; mf < 3; ++mf) acc[nf][mf] *= 0.125f;
            }
#pragma unroll
            for (int nf = 0; nf < 4; ++nf)
#pragma unroll
                for (int mf = 0; mf < 3; ++mf) {
                    const f32x4 v = acc[nf][mf];
                    *(LAS u32x2*)(W_ + (mf * 16 + fr) * 144 + nf * 32 + fq * 8) = (u32x2){pk_bf16(v[0], v[1]), pk_bf16(v[2], v[3])};
                }
#pragma unroll
            for (int it = 0; it < 6; ++it) {
                const int row = it * 8 + (lane >> 3), ch = lane & 7;
                *(u32x4*)(P + (size_t)(r0 + row) * INW + c0 + ch * 8) = *(LAS u32x4*)(W_ + row * 144 + ch * 16);
            }
            const bool isv = c0 >= C_DV && c0 < C_PU, isk = c0 >= C_RK && c0 < C_RV, isr = c0 >= C_RV && c0 < C_RG;
            if (isv || isk || isr) {
                const int frp = isv ? ((fr & 3) | (((fr >> 2) == 1 ? 2 : ((fr >> 2) == 2 ? 1 : (fr >> 2))) << 2)) : fr;
                LAS bf16_t* T_ = (LAS bf16_t*)W_;
#pragma unroll
                for (int nf = 0; nf < 4; ++nf)
#pragma unroll
                    for (int mf = 0; mf < 3; ++mf)
#pragma unroll
                        for (int j = 0; j < 4; ++j) T_[(nf * 16 + 4 * fq + j) * 56 + mf * 16 + frp] = to_bf16(acc[nf][mf][j]);
                const int b = r0 >= NT, pp0 = r0 - b * NT;
                bf16_t* base; int nrows_per_head;
                if (isv) { const int cc = c0 - C_DV; base = VT + ((size_t)(b * 4 + (cc >> 7)) * 128 + (cc & 127)) * NT + pp0; }
                else if (isk) { const int cc = c0 - C_RK; base = RKT + ((size_t)(b * 4 + (cc >> 6)) * 64) * NT + pp0; }
                else { const int cc = c0 - C_RV; base = RVT + ((size_t)(b * 4 + (cc >> 6)) * 64) * NT + pp0; }
                (void)nrows_per_head;
#pragma unroll
                for (int it = 0; it < 6; ++it) {
                    const int sl = it * 64 + lane, n = sl / 6, pc = sl % 6;
                    *(u32x4*)(base + (size_t)n * NT + pc * 8) = *(LAS u32x4*)(W_ + n * 112 + pc * 16);
                }
            }
        };
        gemm192(H, DM, W, DM, DM / 64, tm * 192, tn * 128, lds, epi);
    }
}

DI void phase_ret_sum_pool(const Params& p0, int l, LAS unsigned char* lds) {
    const Params p = launder(p0); l = launder_s(l);
    const int tid = tid_(), lane = tid & 63, wid = tid >> 6, fr = lane & 15, g = lane >> 4;
    const float* scal = (const float*)(p.ws + WS_SCAL) + l * 16;
    const bf16_t* RKT = (const bf16_t*)(p.ws + WS_RKT);
    const bf16_t* RVT = (const bf16_t*)(p.ws + WS_RVT);
    float* UF = (float*)(p.ws + WS_UF);
    float* UB = (float*)(p.ws + WS_UB);
    for (int u = bid_(); u < NB * 4 * NCHUNK; u += gridDim.x) {
        const int c = u % NCHUNK, bh = u / NCHUNK, h = bh & 3;
        const int dir = wid >> 2, eb = wid & 3;
        const float l2 = dir ? scal[6 + h] : scal[2 + h];
        const bf16_t* vrow = RVT + ((size_t)bh * 64 + eb * 16 + fr) * NT + c * 128;
        f32x4 acc[4];
#pragma unroll
        for (int db = 0; db < 4; ++db) acc[db] = (f32x4){0.f, 0.f, 0.f, 0.f};
#pragma unroll
        for (int ks = 0; ks < 4; ++ks) {
            const int j0 = ks * 32 + 8 * g;
            const bf16x8 af = *(const bf16x8*)(vrow + j0);
            float w[8];
#pragma unroll
            for (int jj = 0; jj < 8; ++jj) { const int j = j0 + jj; w[jj] = fast_exp2((dir ? (float)j : (float)(127 - j)) * l2); }
#pragma unroll
            for (int db = 0; db < 4; ++db) {
                const u32x4 kr = *(const u32x4*)(RKT + ((size_t)bh * 64 + db * 16 + fr) * NT + c * 128 + j0);
                u32x4 kw;
#pragma unroll
                for (int q = 0; q < 4; ++q) kw[q] = pk_bf16(bf_lo(kr[q]) * w[2 * q], bf_hi(kr[q]) * w[2 * q + 1]);
                acc[db] = MFMA16(af, as_bf16x8(kw), acc[db]);
            }
        }
        const int cidx = dir ? (c >= 2 ? c - 2 : 64 + c) : c;
        float* U = (dir ? UB : UF) + ((size_t)bh * NCHUNK + cidx) * 4096;
#pragma unroll
        for (int db = 0; db < 4; ++db)
#pragma unroll
            for (int j = 0; j < 4; ++j) U[(eb * 16 + 4 * g + j) * 64 + db * 16 + fr] = acc[db][j];
    }
    LAS float* ul = (LAS float*)lds;
    LAS float* dT = ul + 48 * 256;
    const bf16_t* P = (const bf16_t*)(p.ws + WS_P);
    bf16_t* MIX = (bf16_t*)(p.ws + WS_MIX);
    const float* pw = p.pool_w + (size_t)l * 4 * 64 * 64;
    const float* ps = p.pool_scale + l * 256;
    for (int u = bid_(); u < MROWS / 32; u += gridDim.x) {
        const int r0 = u * 32;
        const int b = r0 >= NT, pp0 = r0 - b * NT;
        const int s0 = pp0 < NCTX ? b * NT : b * NT + NCTX, s1 = pp0 < NCTX ? b * NT + NCTX : (b + 1) * NT;
        __syncthreads();
        for (int i = tid; i < 48 * 64; i += NTHREADS) {
            const int rr = i >> 6, c4 = (i & 63) * 4;
            const int row = r0 - 8 + rr;
            f32x4 v = {0.f, 0.f, 0.f, 0.f};
            if (row >= s0 && row < s1) { const u32x2 w = *(const u32x2*)(P + (size_t)row * INW + C_PU + c4); v = (f32x4){bf_lo(w[0]), bf_hi(w[0]), bf_lo(w[1]), bf_hi(w[1])}; }
            *(LAS f32x4*)(ul + rr * 256 + c4) = v;
        }
        __syncthreads();
        for (int i = tid; i < 32 * 256; i += NTHREADS) {
            const int rr = i >> 8, c = i & 255, gi = c >> 6;
            const int w = 2 << gi;
            const int row = r0 + rr;
            int lo = row - w / 2, hi = row + w - w / 2;
            lo = lo < s0 ? s0 : lo; hi = hi > s1 ? s1 : hi;
            float s = 0.f;
            for (int q = lo; q < hi; ++q) s += ul[(q - r0 + 8) * 256 + c];
            dT[c * 36 + rr] = s / (float)(hi - lo) - ul[(rr + 8) * 256 + c];
        }
        __syncthreads();
        {
            const int oc = tid & 255, rh = (tid >> 8) * 16, gi = oc >> 6, e = oc & 63;
            float acc[16];
#pragma unroll
            for (int i = 0; i < 16; ++i) acc[i] = 0.f;
            for (int c = 0; c < 64; ++c) {
                const float wv = pw[(gi * 64 + c) * 64 + e];
                const LAS float* dr = dT + (gi * 64 + c) * 36 + rh;
#pragma unroll
                for (int i = 0; i < 4; ++i) { const f32x4 d = *(const LAS f32x4*)(dr + 4 * i); acc[4 * i] += d[0] * wv; acc[4 * i + 1] += d[1] * wv; acc[4 * i + 2] += d[2] * wv; acc[4 * i + 3] += d[3] * wv; }
            }
            const float sc = ps[oc];
#pragma unroll
            for (int i = 0; i < 16; ++i) MIX[(size_t)(r0 + rh + i) * DM + 512 + oc] = to_bf16(acc[i] * sc);
        }
    }
    __syncthreads();
}

DI void phase_ret_scan(const Params& p0, int l) {
    const Params p = launder(p0); l = launder_s(l);
    const float* scal = (const float*)(p.ws + WS_SCAL) + l * 16;
    const float* UF = (const float*)(p.ws + WS_UF); const float* UB = (const float*)(p.ws + WS_UB);
    float* SF = (float*)(p.ws + WS_SF); float* SB = (float*)(p.ws + WS_SB);
    for (int i = bid_() * NTHREADS + tid_(); i < 2 * NB * 4 * 4096; i += gridDim.x * NTHREADS) {
        const int dir = i / (NB * 4 * 4096), rem = i % (NB * 4 * 4096), bh = rem >> 12, el = rem & 4095, h = bh & 3;
        const float G = fast_exp2(128.0f * (dir ? scal[6 + h] : scal[2 + h]));
        float S = 0.f;
        if (dir == 0) { for (int c = 0; c < NCHUNK; ++c) { const size_t o = ((size_t)bh * NCHUNK + c) * 4096 + el; SF[o] = S; S = S * G + UF[o]; } }
        else { for (int c = NCHUNK - 1; c >= 0; --c) { const size_t o = ((size_t)bh * NCHUNK + c) * 4096 + el; SB[o] = S; S = S * G + UB[o]; } }
    }
}

DI void attn_unit(const Params& p, int b, int h, int q_p0, int ntile, float lam, float oscale, LAS unsigned char* lds) {
    const int tid = tid_(), lane = tid & 63, wid = __builtin_amdgcn_readfirstlane(tid >> 6), map = wid >> 2, wq = wid & 3, r = lane & 31, hh = lane >> 5;
    const bf16_t* P = (const bf16_t*)(p.ws + WS_P);
    const bf16_t* VT = (const bf16_t*)(p.ws + WS_VT);
    bf16_t* MIX = (bf16_t*)(p.ws + WS_MIX);
    const size_t rowbase = (size_t)b * NT;
    const int qrow = q_p0 + wq * 32 + r;
    bf16x8 qf[4];
#pragma unroll
    for (int ks = 0; ks < 4; ++ks) qf[ks] = *(const bf16x8*)(P + (rowbase + qrow) * INW + C_DQ + h * 128 + map * 64 + ks * 16 + hh * 8);
    constexpr int ASTG = 32768;
    const bf16_t* ksrc0; const bf16_t* ksrc1; const bf16_t* vsrc0; const bf16_t* vsrc1;
    { const int key = tid >> 4, ph = tid & 15, c = ph ^ (key & 15);
      ksrc0 = P + (rowbase + key) * INW + C_DK + h * 128 + c * 8; ksrc1 = ksrc0 + (size_t)32 * INW;
      const int e = tid >> 3, pv = tid & 7, cv = pv ^ ((e >> 1) & 7);
      vsrc0 = VT + ((size_t)(b * 4 + h) * 128 + e) * NT + cv * 8; vsrc1 = vsrc0 + (size_t)64 * NT; }
    const int ddst = wid * 1024;
#define ATT_ISSUE(S, KT) do { LAS unsigned char* _s = lds + (S) * ASTG + ddst; const size_t _ko = (size_t)(KT) * 64 * INW; const int _vo = (KT) * 64; \
        dma16(ksrc0 + _ko, _s); dma16(ksrc1 + _ko, _s + 8192); dma16(vsrc0 + _vo, _s + 16384); dma16(vsrc1 + _vo, _s + 24576); } while (0)
    f32x16 o[4];
#pragma unroll
    for (int eb = 0; eb < 4; ++eb)
#pragma unroll
        for (int i = 0; i < 16; ++i) o[eb][i] = 0.f;
    f32x16 negm;
#pragma unroll
    for (int i = 0; i < 16; ++i) negm[i] = 0.f;
    float m_run = 0.f, l_run = 0.f;
    __syncthreads();
    ATT_ISSUE(0, 0);
    if (ntile > 1) ATT_ISSUE(1, 1);
    int st = 0;
    for (int kt = 0; kt < ntile; ++kt) {
        PRB_T0(1, lds);
        if (kt + 1 < ntile) WAIT_VM(4); else WAIT_VM(0);
        asm volatile("s_waitcnt lgkmcnt(0)" ::: "memory");
        __builtin_amdgcn_s_barrier();
        PRB_T1(1, lds); PRB_T0(2, lds);
        const int st2 = st == 0 ? 2 : st - 1;
        if (map == 0 && kt + 2 < ntile) ATT_ISSUE(st2, kt + 2);
        LAS unsigned char* L = lds + st * ASTG;
        st = st == 2 ? 0 : st + 1;
        bf16x8 kf[8], va[4], vb[4];
#pragma unroll
        for (int ks = 0; ks < 4; ++ks) {
            const int ch = map * 8 + ks * 2 + hh;
            const int off = r * 256 + ((ch ^ (r & 15)) << 4);
            kf[2 * ks] = *(LAS bf16x8*)(L + off);
            kf[2 * ks + 1] = *(LAS bf16x8*)(L + off + 32 * 256);
        }
#define ATT_VREAD(dst, S_) do { _Pragma("unroll") for (int eb = 0; eb < 4; ++eb) { const int e = eb * 32 + r; \
            dst[eb] = *(LAS bf16x8*)(L + 16384 + e * 128 + ((((S_) * 2 + hh) ^ ((e >> 1) & 7)) << 4)); } } while (0)
#define ATT_PACK(dst, SRC, B_) do { u32x4 _pw; _Pragma("unroll") for (int q = 0; q < 4; ++q) _pw[q] = pk_bf16(SRC[(B_) + 2 * q], SRC[(B_) + 2 * q + 1]); dst = as_bf16x8(_pw); } while (0)
#define ATT_EXP8(SRC, B_) do { _Pragma("unroll") for (int i = 0; i < 8; ++i) { SRC[(B_) + i] = fast_exp2(SRC[(B_) + i]); rsum += SRC[(B_) + i]; pmx = fmaxf(pmx, SRC[(B_) + i]); } } while (0)
        ATT_VREAD(va, 0);
        asm volatile("" ::: "memory");
        f32x16 s0 = negm, s1 = negm;
#pragma unroll
        for (int ks = 0; ks < 4; ++ks) { s0 = MFMA32(kf[2 * ks], qf[ks], s0); s1 = MFMA32(kf[2 * ks + 1], qf[ks], s1); }
        if (map == 1 && kt + 2 < ntile) ATT_ISSUE(st2, kt + 2);
        PRB_T1(2, lds); PRB_T0(3, lds);
        if (kt == 0) {
            float mx = fmaxf(fmaxf(s0[0], s0[1]), s0[2]);
#pragma unroll
            for (int i = 3; i < 15; i += 2) mx = fmaxf(fmaxf(mx, s0[i]), s0[i + 1]);
            mx = fmaxf(mx, s0[15]);
#pragma unroll
            for (int i = 0; i < 16; i += 2) mx = fmaxf(fmaxf(mx, s1[i]), s1[i + 1]);
            mx = fmaxf(mx, __shfl_xor(mx, 32));
            m_run = mx;
#pragma unroll
            for (int i = 0; i < 16; ++i) { s0[i] -= mx; s1[i] -= mx; negm[i] = -mx; }
        }
        float rsum = 0.f, pmx = 0.f;
        bf16x8 pb;
        ATT_EXP8(s0, 0); ATT_PACK(pb, s0, 0);
        ATT_VREAD(vb, 1); asm volatile("" ::: "memory");
#pragma unroll
        for (int eb = 0; eb < 4; ++eb) o[eb] = MFMA32(va[eb], pb, o[eb]);
        ATT_EXP8(s0, 8); ATT_PACK(pb, s0, 8);
        ATT_VREAD(va, 2); asm volatile("" ::: "memory");
#pragma unroll
        for (int eb = 0; eb < 4; ++eb) o[eb] = MFMA32(vb[eb], pb, o[eb]);
        ATT_EXP8(s1, 0); ATT_PACK(pb, s1, 0);
        ATT_VREAD(vb, 3); asm volatile("" ::: "memory");
#pragma unroll
        for (int eb = 0; eb < 4; ++eb) o[eb] = MFMA32(va[eb], pb, o[eb]);
        ATT_EXP8(s1, 8); ATT_PACK(pb, s1, 8);
#pragma unroll
        for (int eb = 0; eb < 4; ++eb) o[eb] = MFMA32(vb[eb], pb, o[eb]);
        l_run += rsum;
        PRB_T1(3, lds);
#undef ATT_VREAD
#undef ATT_PACK
#undef ATT_EXP8
        pmx = fmaxf(pmx, __shfl_xor(pmx, 32));
        if (__any(pmx > 256.0f)) {
            const float d = pmx > 256.0f ? __builtin_amdgcn_logf(pmx) : 0.f;
            const float alpha = fast_exp2(-d);
            m_run += d; l_run *= alpha;
#pragma unroll
            for (int i = 0; i < 16; ++i) negm[i] = -m_run;
#pragma unroll
            for (int eb = 0; eb < 4; ++eb)
#pragma unroll
                for (int i = 0; i < 16; ++i) o[eb][i] *= alpha;
        }
    }
#undef ATT_ISSUE
    __syncthreads();
    const float lt = l_run + __shfl_xor(l_run, 32);
    const float inv = 1.0f / lt;
    LAS float* X = (LAS float*)lds;
    if (map == 1) {
#pragma unroll
        for (int eb = 0; eb < 4; ++eb)
#pragma unroll
            for (int i = 0; i < 16; ++i) X[(wq * 64 + eb * 16 + i) * 64 + lane] = o[eb][i] * inv;
    }
    __syncthreads();
    if (map == 0) {
        float ss = 0.f;
#pragma unroll
        for (int eb = 0; eb < 4; ++eb)
#pragma unroll
            for (int i = 0; i < 16; ++i) { const float v = o[eb][i] * inv - lam * X[(wq * 64 + eb * 16 + i) * 64 + lane]; o[eb][i] = v; ss += v * v; }
        ss += __shfl_xor(ss, 32);
        const float sc = rsqrtf(ss * (1.0f / 128.0f) + RMS_EPS) * oscale;
        LAS unsigned char* W = lds + 65536 + wq * 8704;
#pragma unroll
        for (int eb = 0; eb < 4; ++eb)
#pragma unroll
            for (int q = 0; q < 4; ++q) {
                const int e = eb * 32 + 8 * q + 4 * hh;
                const u32x2 w = {pk_bf16(o[eb][4 * q] * sc, o[eb][4 * q + 1] * sc), pk_bf16(o[eb][4 * q + 2] * sc, o[eb][4 * q + 3] * sc)};
                *(LAS u32x2*)(W + r * 272 + e * 2) = w;
            }
#pragma unroll
        for (int it = 0; it < 8; ++it) {
            const int row = it * 4 + (lane >> 4), ch = lane & 15;
            const u32x4 v = *(LAS u32x4*)(W + row * 272 + ch * 16);
            *(u32x4*)(MIX + (rowbase + q_p0 + wq * 32 + row) * DM + h * 128 + ch * 8) = v;
        }
    }
    __syncthreads();
}

DI void ret_unit(const Params& p, int l, int b, int h, int c) {
    const int tid = tid_(), lane = tid & 63, wid = tid >> 6, fr = lane & 15, g = lane >> 4;
    const float* scal = (const float*)(p.ws + WS_SCAL) + l * 16;
    const float lf2 = scal[2 + h], lb2 = scal[6 + h];
    const bf16_t* P = (const bf16_t*)(p.ws + WS_P);
    const bf16_t* RVT = (const bf16_t*)(p.ws + WS_RVT);
    const float* SF = (const float*)(p.ws + WS_SF); const float* SB = (const float*)(p.ws + WS_SB);
    bf16_t* MIX = (bf16_t*)(p.ws + WS_MIX);
    const int bh = b * 4 + h;
    const size_t row0 = (size_t)b * NT + c * 128;
    const int iloc = wid * 16 + fr;
    u32x4 qraw[2];
#pragma unroll
    for (int ks = 0; ks < 2; ++ks) qraw[ks] = *(const u32x4*)(P + (row0 + iloc) * INW + C_RQ + h * 64 + ks * 32 + 8 * g);
    f32x4 st[8];
#pragma unroll
    for (int jb = 0; jb < 8; ++jb) {
        st[jb] = (f32x4){0.f, 0.f, 0.f, 0.f};
#pragma unroll
        for (int ks = 0; ks < 2; ++ks) {
            const bf16x8 kf = *(const bf16x8*)(P + (row0 + jb * 16 + fr) * INW + C_RK + h * 64 + ks * 32 + 8 * g);
            st[jb] = MFMA16(kf, as_bf16x8(qraw[ks]), st[jb]);
        }
    }
#pragma unroll
    for (int jb = 0; jb < 8; ++jb)
#pragma unroll
        for (int q = 0; q < 4; ++q) {
            const int j = jb * 16 + 4 * g + q;
            const int d = iloc - j;
            const float w = d > 0 ? fast_exp2((float)d * lf2) : (d < 0 ? fast_exp2((float)(-d) * lb2) : 2.0f);
            st[jb][q] *= w;
        }
    f32x4 ot[4];
#pragma unroll
    for (int eb = 0; eb < 4; ++eb) ot[eb] = (f32x4){0.f, 0.f, 0.f, 0.f};
#pragma unroll
    for (int jj = 0; jj < 4; ++jj) {
        const u32x4 pw = {pk_bf16(st[2 * jj][0], st[2 * jj][1]), pk_bf16(st[2 * jj][2], st[2 * jj][3]), pk_bf16(st[2 * jj + 1][0], st[2 * jj + 1][1]), pk_bf16(st[2 * jj + 1][2], st[2 * jj + 1][3])};
#pragma unroll
        for (int eb = 0; eb < 4; ++eb) {
            const bf16_t* vp = RVT + ((size_t)bh * 64 + eb * 16 + fr) * NT + c * 128 + jj * 32 + 4 * g;
            const u32x2 v0 = *(const u32x2*)vp, v1 = *(const u32x2*)(vp + 16);
            const u32x4 va = {v0[0], v0[1], v1[0], v1[1]};
            ot[eb] = MFMA16(as_bf16x8(va), as_bf16x8(pw), ot[eb]);
        }
    }
    const float df = fast_exp2((float)(iloc + 1) * lf2), db = fast_exp2((float)(128 - iloc) * lb2);
    const int vc = c >= 2 ? c - 2 : 64 + c;
    const float* sf = SF + ((size_t)bh * NCHUNK + c) * 4096;
    const float* sb = SB + ((size_t)bh * NCHUNK + vc) * 4096;
#pragma unroll
    for (int ks = 0; ks < 2; ++ks) {
        u32x4 qf, qb;
#pragma unroll
        for (int q = 0; q < 4; ++q) { const float a = bf_lo(qraw[ks][q]), bb = bf_hi(qraw[ks][q]); qf[q] = pk_bf16(a * df, bb * df); qb[q] = pk_bf16(a * db, bb * db); }
#pragma unroll
        for (int eb = 0; eb < 4; ++eb) {
            const float* s1 = sf + (eb * 16 + fr) * 64 + ks * 32 + 8 * g;
            const float* s2 = sb + (eb * 16 + fr) * 64 + ks * 32 + 8 * g;
            const f32x4 a0 = *(const f32x4*)s1, a1 = *(const f32x4*)(s1 + 4), c0 = *(const f32x4*)s2, c1 = *(const f32x4*)(s2 + 4);
            const u32x4 sa = {pk_bf16(a0[0], a0[1]), pk_bf16(a0[2], a0[3]), pk_bf16(a1[0], a1[1]), pk_bf16(a1[2], a1[3])};
            const u32x4 sc = {pk_bf16(c0[0], c0[1]), pk_bf16(c0[2], c0[3]), pk_bf16(c1[0], c1[1]), pk_bf16(c1[2], c1[3])};
            ot[eb] = MFMA16(as_bf16x8(sa), as_bf16x8(qf), ot[eb]);
            ot[eb] = MFMA16(as_bf16x8(sc), as_bf16x8(qb), ot[eb]);
        }
    }
    float s = 0.f;
#pragma unroll
    for (int eb = 0; eb < 4; ++eb) s += (ot[eb][0] + ot[eb][1]) + (ot[eb][2] + ot[eb][3]);
    s += __shfl_xor(s, 16); s += __shfl_xor(s, 32);
    const float mu = s * (1.0f / 64.0f);
    float q2 = 0.f;
#pragma unroll
    for (int eb = 0; eb < 4; ++eb)
#pragma unroll
        for (int q = 0; q < 4; ++q) { const float d = ot[eb][q] - mu; q2 += d * d; }
    q2 += __shfl_xor(q2, 16); q2 += __shfl_xor(q2, 32);
    const float rstd = rsqrtf(q2 * (1.0f / 64.0f) + LN_EPS);
#pragma unroll
    for (int eb = 0; eb < 4; ++eb) {
        const int e = eb * 16 + 4 * g;
        const u32x2 gw = *(const u32x2*)(P + (row0 + iloc) * INW + C_RG + h * 64 + e);
        const float g0 = bf_lo(gw[0]), g1 = bf_hi(gw[0]), g2 = bf_lo(gw[1]), g3 = bf_hi(gw[1]);
        u32x2 w = {pk_bf16((ot[eb][0] - mu) * rstd * silu_f(g0), (ot[eb][1] - mu) * rstd * silu_f(g1)),
                   pk_bf16((ot[eb][2] - mu) * rstd * silu_f(g2), (ot[eb][3] - mu) * rstd * silu_f(g3))};
        *(u32x2*)(MIX + (row0 + iloc) * DM + 768 + h * 64 + e) = w;
    }
}

DI void phase_attn(const Params& p0, int l, LAS unsigned char* lds) {
    const Params p = launder(p0); l = launder_s(l);
    const float* scal = (const float*)(p.ws + WS_SCAL) + l * 16;
    const float lam = scal[0], oscale = scal[1];
    const int nunits = NB * 4 * 64 + (l == 0 ? NB * 4 * 2 : 0);
    for (int u = bid_(); u < nunits; u += gridDim.x) {
        int b, h, q0, ntile;
        if (u < NB * 4 * 64) { const int qt = u & 63; h = (u >> 6) & 3; b = u >> 8; q0 = NCTX + qt * 128; ntile = NT / 64; }
        else { const int v = u - NB * 4 * 64; const int qt = v & 1; h = (v >> 1) & 3; b = v >> 3; q0 = qt * 128; ntile = NCTX / 64; }
        attn_unit(p, b, h, q0, ntile, lam, oscale, lds);
    }
}
DI void phase_ret(const Params& p0, int l) {
    const Params p = launder(p0); l = launder_s(l);
    for (int u = bid_(); u < NB * 4 * NCHUNK; u += gridDim.x) {
        const int c = u % NCHUNK, bh = u / NCHUNK;
        if (l == 1 && c < 2) continue;
        ret_unit(p, l, bh >> 2, bh & 3, c);
    }
}

DI void phase_outproj(const Params& p0, int l, LAS unsigned char* lds) {
    const Params p = launder(p0); l = launder_s(l);
    const float* Xin = (const float*)(p.ws + WS_XA);
    const bf16_t* A = (const bf16_t*)(p.ws + WS_MIX);
    const bf16_t* W = (const bf16_t*)(p.ws + WS_WOUT) + (size_t)l * DM * DM;
    float* V1 = (float*)(p.ws + WS_V1);
    const float* modv = (const float*)(p.ws + WS_MODV) + (size_t)l * 3 * 6144;
    for (int u = bid_(); u < (MROWS / 192) * 8; u += gridDim.x) {
        const int tm = u >> 3, tn = u & 7;
        auto epi = [&](f32x4 (&acc)[4][3], int wm, int wn, int fr, int fq, int lane, int wid) {
            const int c0 = tn * 128 + wn * 64, r0 = tm * 192 + wm * 48;
            LAS unsigned char* W_ = g2_stage(lds, wid);
#pragma unroll
            for (int nf = 0; nf < 4; ++nf)
#pragma unroll
                for (int mf = 0; mf < 3; ++mf) *(LAS f32x4*)(W_ + (mf * 16 + fr) * 272 + nf * 64 + fq * 16) = acc[nf][mf];
#pragma unroll
            for (int it = 0; it < 12; ++it) {
                const int row = it * 4 + (lane >> 4), ch = lane & 15;
                const int grow = r0 + row;
                const f32x4 y = *(LAS f32x4*)(W_ + row * 272 + ch * 16);
                const f32x4 xv = *(const f32x4*)(Xin + (size_t)grow * DM + c0 + ch * 4);
                const f32x4 g2 = *(const f32x4*)(modv + (size_t)row_sel(grow) * 6144 + 2 * 1024 + c0 + ch * 4);
                *(f32x4*)(V1 + (size_t)grow * DM + c0 + ch * 4) = (f32x4){DN_ALPHA * xv[0] + g2[0] * y[0], DN_ALPHA * xv[1] + g2[1] * y[1], DN_ALPHA * xv[2] + g2[2] * y[2], DN_ALPHA * xv[3] + g2[3] * y[3]};
            }
        };
        gemm192(A, DM, W, DM, DM / 64, tm * 192, tn * 128, lds, epi);
    }
}

DI void phase_ln_mid(const Params& p0, int l) {
    const Params p = launder(p0); l = launder_s(l);
    float* Xout = (float*)(p.ws + WS_XB);
    const int lane = tid_() & 63, wid = tid_() >> 6;
    const float* V1 = (const float*)(p.ws + WS_V1);
    bf16_t* TOK = (bf16_t*)(p.ws + WS_TOK);
    const float* modv = (const float*)(p.ws + WS_MODV) + (size_t)l * 3 * 6144;
    const float* lg = p.ln_g + (size_t)(l * 2 + 0) * DM; const float* lb = p.ln_b + (size_t)(l * 2 + 0) * DM;
    for (int r = bid_() * 8 + wid; r < MROWS; r += gridDim.x * 8) {
        f32x4 v[4];
#pragma unroll
        for (int i = 0; i < 4; ++i) v[i] = *(const f32x4*)(V1 + (size_t)r * DM + lane * 4 + i * 256);
        float mu, rstd; ln_stats(v, mu, rstd);
#pragma unroll
        for (int i = 0; i < 4; ++i) {
            const int c = lane * 4 + i * 256;
            const f32x4 gg = *(const f32x4*)(lg + c), bb = *(const f32x4*)(lb + c);
#pragma unroll
            for (int j = 0; j < 4; ++j) v[i][j] = (v[i][j] - mu) * rstd * gg[j] + bb[j];
            *(f32x4*)(Xout + (size_t)r * DM + c) = v[i];
        }
        const float* mv = modv + (size_t)row_sel(r) * 6144;
        modulate_store(v, mv + 3 * 1024, mv + 4 * 1024, TOK + (size_t)r * DM, lane);
    }
}

DI void phase_router(const Params& p0, int l, LAS unsigned char* lds) {
    const Params p = launder(p0); l = launder_s(l);
    const bf16_t* A = (const bf16_t*)(p.ws + WS_TOK);
    const bf16_t* W = (const bf16_t*)(p.ws + WS_WR) + (size_t)l * 256 * DM;
    float* LG = (float*)(p.ws + WS_LOGIT);
    for (int u = bid_(); u < (MROWS / 192) * 2; u += gridDim.x) {
        const int tm = u >> 1, tn = u & 1;
        auto epi = [&](f32x4 (&acc)[4][3], int wm, int wn, int fr, int fq, int lane, int wid) {
            const int c0 = tn * 128 + wn * 64, r0 = tm * 192 + wm * 48;
            LAS unsigned char* W_ = g2_stage(lds, wid);
#pragma unroll
            for (int nf = 0; nf < 4; ++nf)
#pragma unroll
                for (int mf = 0; mf < 3; ++mf) *(LAS f32x4*)(W_ + (mf * 16 + fr) * 272 + nf * 64 + fq * 16) = acc[nf][mf];
#pragma unroll
            for (int it = 0; it < 12; ++it) {
                const int row = it * 4 + (lane >> 4), ch = lane & 15;
                *(f32x4*)(LG + (size_t)(r0 + row) * 256 + c0 + ch * 4) = *(LAS f32x4*)(W_ + row * 272 + ch * 16);
            }
        };
        gemm192(A, DM, W, DM, DM / 64, tm * 192, tn * 128, lds, epi);
    }
}

DI void phase_topk(const Params& p0, int l, LAS unsigned char* lds) {
    const Params p = launder(p0); l = launder_s(l);
    const int lane = tid_() & 63, wid = tid_() >> 6, rs = lane >> 3, g = lane & 7;
    const float* LG = (const float*)(p.ws + WS_LOGIT);
    const float* bias = p.router_bias + l * 256 + g * 32;
    int* EIDX = (int*)(p.ws + WS_EIDX); float* GATE = (float*)(p.ws + WS_GATE);
    int* RANK = (int*)(p.ws + WS_RANK); int* HIST = (int*)(p.ws + WS_HIST);
    LAS int* hist = (LAS int*)lds;
    if (tid_() < 256) hist[tid_()] = 0;
    __syncthreads();
    const int chunk = (MROWS + (int)gridDim.x - 1) / (int)gridDim.x, r_begin = bid_() * chunk, r_end = (r_begin + chunk) < MROWS ? (r_begin + chunk) : MROWS;
    for (int base = r_begin + wid * 8; base < r_end; base += 64) {
        const int row = base + rs; const bool valid = row < r_end;
        const float* lp = LG + (size_t)(valid ? row : r_begin) * 256 + g * 32;
        float sc[32], gv[32];
#pragma unroll
        for (int q = 0; q < 8; ++q) {
            const f32x4 lg = *(const f32x4*)(lp + 4 * q), bv = *(const f32x4*)(bias + 4 * q);
#pragma unroll
            for (int j = 0; j < 4; ++j) { sc[4 * q + j] = 1.0f / (1.0f + __expf(-lg[j])); gv[4 * q + j] = sc[4 * q + j] + bv[j]; }
        }
        float m1 = fmaxf(gv[0], gv[1]), m2 = fminf(gv[0], gv[1]);
#pragma unroll
        for (int i = 2; i < 32; ++i) { const float v = gv[i]; m2 = fmaxf(m2, fminf(m1, v)); m1 = fmaxf(m1, v); }
        const float gs = m1 + m2;
        int rank = 0;
#pragma unroll
        for (int g2 = 0; g2 < 8; ++g2) { const float o = __shfl(gs, (lane & 56) + g2); rank += (o > gs || (o == gs && g2 < g)) ? 1 : 0; }
        if (rank >= 4) {
#pragma unroll
            for (int i = 0; i < 32; ++i) gv[i] = -INFINITY;
        }
        float ssum = 0.f, mysc = 0.f; int myidx = 0;
#pragma unroll 1
        for (int k = 0; k < TOPK; ++k) {
            float bv = gv[0], bs = sc[0]; int bi = 0;
#pragma unroll
            for (int i = 1; i < 32; ++i) { const bool gt = gv[i] > bv; bv = gt ? gv[i] : bv; bs = gt ? sc[i] : bs; bi = gt ? i : bi; }
            int gi = g * 32 + bi;
#pragma unroll
            for (int o = 1; o < 8; o <<= 1) {
                const float ov = __shfl_xor(bv, o), os = __shfl_xor(bs, o); const int oi = __shfl_xor(gi, o);
                const bool tk = ov > bv || (ov == bv && oi < gi);
                bv = tk ? ov : bv; bs = tk ? os : bs; gi = tk ? oi : gi;
            }
            if ((gi >> 5) == g) {
                const int oi = gi & 31;
#pragma unroll
                for (int i = 0; i < 32; ++i) gv[i] = (i == oi) ? -INFINITY : gv[i];
            }
            ssum += bs;
            if (g == k) { mysc = bs; myidx = gi; }
        }
        if (valid) {
            EIDX[(size_t)row * 8 + g] = myidx;
            GATE[(size_t)row * 8 + g] = mysc / ssum * 2.5f;
            RANK[(size_t)row * 8 + g] = __hip_atomic_fetch_add(hist + myidx, 1, __ATOMIC_RELAXED, __HIP_MEMORY_SCOPE_WORKGROUP);
        }
    }
    __syncthreads();
    if (tid_() < 256) HIST[(size_t)bid_() * 256 + tid_()] = hist[tid_()];
    __syncthreads();
}

DI void phase_scatter(const Params& p0, int l, LAS unsigned char* lds) {
    const Params p = launder(p0); l = launder_s(l);
    LAS int* off = (LAS int*)lds;
    LAS int* toff = off + 260;
    LAS int* tot = toff + 260;
    LAS int* base = tot + 256;
    const int tid = tid_(), bid = bid_(), G = gridDim.x;
    const int* HIST = (const int*)(p.ws + WS_HIST);
    const int* RANK = (const int*)(p.ws + WS_RANK);
    int* ntl = (int*)(p.ws + CTL_NTILES) + l;
    int* TILES = (int*)(p.ws + WS_TILES);
    const int* EIDX = (const int*)(p.ws + WS_EIDX);
    int* SORT = (int*)(p.ws + WS_SORT);
    if (tid < 256) {
        int t = 0, bs = 0;
#pragma unroll 16
        for (int b2 = 0; b2 < G; ++b2) { const int v = HIST[(size_t)b2 * 256 + tid]; bs += (b2 < bid) ? v : 0; t += v; }
        tot[tid] = t; base[tid] = bs;
    }
    __syncthreads();
    if (tid == 0) {
        int a = 0, t = 0;
        for (int e = 0; e < 256; ++e) { off[e] = a; toff[e] = t; const int c = tot[e]; a += c; t += (c + 127) >> 7; }
        off[256] = a; toff[256] = t;
    }
    __syncthreads();
    if (bid == 0) {
        if (tid < 256) {
            const int e = tid, c = off[e + 1] - off[e], nt = toff[e + 1] - toff[e];
            for (int t = 0; t < nt; ++t) { int* T = TILES + (size_t)(toff[e] + t) * 4; T[0] = e; T[1] = off[e] + t * 128; T[2] = (c - t * 128) < 128 ? (c - t * 128) : 128; T[3] = 0; }
        }
        if (tid == 0) *ntl = toff[256];
    }
    const int chunk = (MROWS + G - 1) / G, r_begin = bid * chunk, r_end = (r_begin + chunk) < MROWS ? (r_begin + chunk) : MROWS;
    for (int a = r_begin * 8 + tid; a < r_end * 8; a += NTHREADS) {
        const int e = EIDX[a];
        SORT[off[e] + base[e] + RANK[a]] = a;
    }
    __syncthreads();
}

constexpr int MOE_STG = 40960;
constexpr int MOE_HT = 86016;
constexpr int MOE_INFO = MOE_HT + 65536;
constexpr int IMG_BYTES = 32768, IMG_PER_E = 48;
DI int swz64(int row, int chunk) { return row * 64 + ((chunk ^ ((0 - (row >> 2)) & 3)) << 4); }

struct ImgJob { const float* wp; int ldw; unsigned char* d; int g; };
DI ImgJob img_job(const Params& p, int l, int u, unsigned char* IMG) {
    const int e = u / IMG_PER_E, im = u % IMG_PER_E;
    const int np = tid_();
    ImgJob j;
    if (im < 32) {
        const float* W = e < NEXP ? p.w_egu + ((size_t)l * NEXP + e) * DM * 512 : p.w_sgu + (size_t)l * DM * 512;
        j.ldw = 512; j.wp = W + (size_t)(im * 32) * 512 + (((np >> 4) & 1) * 256 + (np >> 5) * 16 + (np & 15));
    } else {
        const float* W = e < NEXP ? p.w_edn + ((size_t)l * NEXP + e) * 256 * DM : p.w_sdn + (size_t)l * 256 * DM;
        j.ldw = DM; j.wp = W + (size_t)(((im - 32) & 7) * 32) * DM + ((im - 32) >> 3) * 512 + np;
    }
    j.d = IMG + (size_t)u * IMG_BYTES + np * 64; j.g = (0 - (np >> 2)) & 3;
    return j;
}
DI void img_load(const ImgJob& j, float (&wb)[32]) {
#pragma unroll
    for (int kk = 0; kk < 32; ++kk) wb[kk] = __builtin_nontemporal_load(j.wp + (size_t)kk * j.ldw);
}
DI void img_store(const ImgJob& j, const float (&wb)[32]) {
#pragma unroll
    for (int c = 0; c < 4; ++c) { const u32x4 w = {pk_bf16(wb[8 * c], wb[8 * c + 1]), pk_bf16(wb[8 * c + 2], wb[8 * c + 3]), pk_bf16(wb[8 * c + 4], wb[8 * c + 5]), pk_bf16(wb[8 * c + 6], wb[8 * c + 7])}; *(u32x4*)(j.d + ((c ^ j.g) << 4)) = w; }
}
DI void phase_convert_experts(const Params& p0, int l) {
    const Params p = launder(p0); l = launder_s(l);
    unsigned char* IMG = p.ws + WS_WIMG + (size_t)l * (NEXP + 1) * IMG_PER_E * IMG_BYTES;
    const int total = (NEXP + 1) * IMG_PER_E, G = gridDim.x;
    float wa[32], wb[32];
    int u = bid_();
    if (u >= total) return;
    ImgJob ja = img_job(p, l, u, IMG), jb = ja;
    img_load(ja, wa);
    for (;;) {
        const bool hb = u + G < total;
        if (hb) { jb = img_job(p, l, u + G, IMG); img_load(jb, wb); }
        img_store(ja, wa);
        if (!hb) break;
        u += G;
        const bool ha = u + G < total;
        if (ha) { ja = img_job(p, l, u + G, IMG); img_load(ja, wa); }
        img_store(jb, wb);
        if (!ha) break;
        u += G;
    }
}

DI void moe_unit(const Params& p, const unsigned char* img, bf16_t* outbase, bool shared, int r0, int nr, LAS unsigned char* lds) {
    const int t = tid_(), lane = t & 63, wid = __builtin_amdgcn_readfirstlane(t >> 6), fr = lane & 15, fq = lane >> 4, wn = wid & 3, wt = wid >> 2;
    const bf16_t* TOK = (const bf16_t*)(p.ws + WS_TOK);
    const int* SORT = (const int*)(p.ws + WS_SORT);
    LAS int* rowout = (LAS int*)(lds + MOE_INFO);
    const int arow = t >> 2;
    int atok = 0, aout = -1;
    if (arow < nr) { if (shared) { atok = r0 + arow; aout = atok; } else { aout = SORT[r0 + arow]; atok = aout >> 3; } }
    const bf16_t* aptr = TOK + (size_t)atok * DM + (((t & 3) ^ ((0 - (arow >> 2)) & 3)) << 3);
    __syncthreads();
    if ((t & 3) == 0) rowout[arow] = aout;
    const unsigned char* wsrc = img + (size_t)t * 16;
    const int adst = wid * 1024, wdst = 8192 + wid * 1024;
#define MOE_ISSUE1(S, KT) do { LAS unsigned char* _s = lds + (S) * MOE_STG; dma16(aptr + (KT) * 32, _s + adst); \
        const unsigned char* _w = wsrc + (size_t)(KT) * IMG_BYTES; \
        dma16(_w, _s + wdst); dma16(_w + 8192, _s + wdst + 8192); dma16(_w + 16384, _s + wdst + 16384); dma16(_w + 24576, _s + wdst + 24576); } while (0)
#define MOE_ISSUE2(S, IM) do { LAS unsigned char* _s = lds + (S) * IMG_BYTES; const unsigned char* _w = wsrc + (size_t)(IM) * IMG_BYTES; \
        dma16(_w, _s + adst); dma16(_w + 8192, _s + adst + 8192); dma16(_w + 16384, _s + adst + 16384); dma16(_w + 24576, _s + adst + 24576); } while (0)
    f32x4 acc[8][4];
#pragma unroll
    for (int nf = 0; nf < 8; ++nf)
#pragma unroll
        for (int tf = 0; tf < 4; ++tf) acc[nf][tf] = (f32x4){0.f, 0.f, 0.f, 0.f};
    MOE_ISSUE1(0, 0);
    MOE_ISSUE1(1, 1);
    int st = 0;
    for (int kt = 0; kt < 32; ++kt) {
        if (kt < 31) WAIT_VM(5); else WAIT_VM(0);
        asm volatile("s_waitcnt lgkmcnt(0)" ::: "memory");
        __builtin_amdgcn_s_barrier();
        const int st2 = st == 0 ? 2 : st - 1;
        if (wt == 0) { if (kt < 30) MOE_ISSUE1(st2, kt + 2); else if (kt == 31) MOE_ISSUE2(0, 32); }
        LAS unsigned char* S = lds + st * MOE_STG;
        bf16x8 tfr[4];
#pragma unroll
        for (int tf = 0; tf < 4; ++tf) tfr[tf] = *(LAS bf16x8*)(S + swz64(wt * 64 + tf * 16 + fr, fq));
#pragma unroll
        for (int nf = 0; nf < 8; ++nf) {
            const bf16x8 wf = *(LAS bf16x8*)(S + 8192 + swz64(wn * 128 + nf * 16 + fr, fq));
#pragma unroll
            for (int tf = 0; tf < 4; ++tf) acc[nf][tf] = MFMA16(wf, tfr[tf], acc[nf][tf]);
            if (nf == 3 && wt == 1) { if (kt < 30) MOE_ISSUE1(st2, kt + 2); else if (kt == 31) MOE_ISSUE2(0, 32); }
        }
        st = st == 2 ? 0 : st + 1;
    }
#pragma unroll
    for (int i = 0; i < 4; ++i)
#pragma unroll
        for (int tf = 0; tf < 4; ++tf) {
            float hv[4];
#pragma unroll
            for (int j = 0; j < 4; ++j) hv[j] = silu_f(acc[2 * i][tf][j]) * acc[2 * i + 1][tf][j];
            const int tok = wt * 64 + tf * 16 + fr, hc = wn * 64 + i * 16 + 4 * fq;
            const u32x2 w = {pk_bf16(hv[0], hv[1]), pk_bf16(hv[2], hv[3])};
            *(LAS u32x2*)(lds + MOE_HT + tok * 512 + (((hc >> 3) ^ (tok & 15)) << 4) + (hc & 7) * 2) = w;
        }
#pragma unroll 1
    for (int nc = 0; nc < 2; ++nc) {
#pragma unroll
        for (int nf = 0; nf < 8; ++nf)
#pragma unroll
            for (int tf = 0; tf < 4; ++tf) acc[nf][tf] = (f32x4){0.f, 0.f, 0.f, 0.f};
        if (nc == 1) MOE_ISSUE2(0, 40);
        for (int kt = 0; kt < 8; ++kt) {
            WAIT_VM(0);
            asm volatile("s_waitcnt lgkmcnt(0)" ::: "memory");
            __builtin_amdgcn_s_barrier();
            if (wt == 0 && kt < 7) MOE_ISSUE2((kt + 1) & 1, 32 + nc * 8 + kt + 1);
            LAS unsigned char* S = lds + (kt & 1) * IMG_BYTES;
            bf16x8 tfr[4];
#pragma unroll
            for (int tf = 0; tf < 4; ++tf) { const int tok = wt * 64 + tf * 16 + fr; tfr[tf] = *(LAS bf16x8*)(lds + MOE_HT + tok * 512 + (((kt * 4 + fq) ^ (tok & 15)) << 4)); }
#pragma unroll
            for (int nf = 0; nf < 8; ++nf) {
                const bf16x8 wf = *(LAS bf16x8*)(S + swz64(wn * 128 + nf * 16 + fr, fq));
#pragma unroll
                for (int tf = 0; tf < 4; ++tf) acc[nf][tf] = MFMA16(wf, tfr[tf], acc[nf][tf]);
                if (nf == 3 && wt == 1 && kt < 7) MOE_ISSUE2((kt + 1) & 1, 32 + nc * 8 + kt + 1);
            }
        }
        __syncthreads();
        LAS unsigned char* W = lds + wid * 9216;
#pragma unroll
        for (int half = 0; half < 2; ++half) {
#pragma unroll
            for (int nh = 0; nh < 4; ++nh)
#pragma unroll
                for (int tf = 0; tf < 4; ++tf) {
                    const f32x4 v = acc[half * 4 + nh][tf];
                    const u32x2 w = {pk_bf16(v[0], v[1]), pk_bf16(v[2], v[3])};
                    *(LAS u32x2*)(W + (tf * 16 + fr) * 144 + nh * 32 + fq * 8) = w;
                }
#pragma unroll
            for (int it = 0; it < 8; ++it) {
                const int row = it * 8 + (lane >> 3), ch = lane & 7;
                const u32x4 v = *(LAS u32x4*)(W + row * 144 + ch * 16);
                const int ro = rowout[wt * 64 + row];
                if (ro >= 0) *(u32x4*)(outbase + (size_t)ro * DM + nc * 512 + wn * 128 + half * 64 + ch * 8) = v;
            }
        }
        __syncthreads();
    }
#undef MOE_ISSUE1
#undef MOE_ISSUE2
}

DI void phase_moe(const Params& p0, int l, LAS unsigned char* lds) {
    const Params p = launder(p0); l = launder_s(l);
    const int* TILES = (const int*)(p.ws + WS_TILES);
    const int ntl = *((const int*)(p.ws + CTL_NTILES) + l);
    const int G = gridDim.x, bid = bid_();
    int vcu = bid;
    if (p.ph_hi - p.ph_lo > 1) {
        volatile LAS unsigned* bst = (volatile LAS unsigned*)(lds + LDS_BYTES - 16);
        const unsigned xc = bst[2]; unsigned pre = 0;
        for (unsigned j = 0; j < 16; ++j) { const unsigned c = xb_ld((unsigned*)(p.ws + WS_CTL) + XB_XCNT(j)); pre += (j < xc) ? c : 0u; }
        vcu = (int)(pre + bst[3]);
    }
    const int total = ntl + MROWS / 128;
    const unsigned char* IMG = p.ws + WS_WIMG + (size_t)l * (NEXP + 1) * IMG_PER_E * IMG_BYTES;
    for (int u = vcu; u < total; u += G) {
        if (u < ntl) {
            const int e = TILES[u * 4], r0 = TILES[u * 4 + 1], nr = TILES[u * 4 + 2];
            moe_unit(p, IMG + (size_t)e * IMG_PER_E * IMG_BYTES, (bf16_t*)(p.ws + WS_YSLOT), false, r0, nr, lds);
        } else {
            const int tm = u - ntl;
            if (l == 1 && (tm % (NT / 128)) < 2) continue;
            moe_unit(p, IMG + (size_t)NEXP * IMG_PER_E * IMG_BYTES, (bf16_t*)(p.ws + WS_YSH), true, tm * 128, 128, lds);
        }
    }
}

DI void phase_combine(const Params& p0, int l) {
    const Params p = launder(p0); l = launder_s(l);
    const float* X1 = (const float*)(p.ws + WS_XB); float* Xnext = (float*)(p.ws + WS_XA);
    const int lane = tid_() & 63, wid = tid_() >> 6;
    const bf16_t* YSL = (const bf16_t*)(p.ws + WS_YSLOT); const bf16_t* YSH = (const bf16_t*)(p.ws + WS_YSH);
    const float* GATE = (const float*)(p.ws + WS_GATE);
    const float* modv = (const float*)(p.ws + WS_MODV);
    const float* lg = p.ln_g + (size_t)(l * 2 + 1) * DM; const float* lb = p.ln_b + (size_t)(l * 2 + 1) * DM;
    bf16_t* H = (bf16_t*)(p.ws + WS_H);
    for (int r = bid_() * 8 + wid; r < MROWS; r += gridDim.x * 8) {
        const int b = r >= NT, pp = r - b * NT;
        if (l == 1 && pp < NCTX) continue;
        const int sel = pp < NCTX ? 2 : b;
        float gt[8];
#pragma unroll
        for (int k = 0; k < 8; ++k) gt[k] = GATE[(size_t)r * 8 + k];
        const float* g5 = modv + ((size_t)l * 3 + sel) * 6144 + 5 * 1024;
        f32x4 v[4];
#pragma unroll
        for (int i = 0; i < 4; ++i) {
            const int c = lane * 4 + i * 256;
            const u32x2 sw = *(const u32x2*)(YSH + (size_t)r * DM + c);
            float f0 = bf_lo(sw[0]), f1 = bf_hi(sw[0]), f2 = bf_lo(sw[1]), f3 = bf_hi(sw[1]);
#pragma unroll
            for (int k = 0; k < 8; ++k) {
                const u32x2 w = *(const u32x2*)(YSL + ((size_t)r * 8 + k) * DM + c);
                f0 += gt[k] * bf_lo(w[0]); f1 += gt[k] * bf_hi(w[0]); f2 += gt[k] * bf_lo(w[1]); f3 += gt[k] * bf_hi(w[1]);
            }
            const f32x4 xv = *(const f32x4*)(X1 + (size_t)r * DM + c), gv = *(const f32x4*)(g5 + c);
            v[i] = (f32x4){DN_ALPHA * xv[0] + gv[0] * f0, DN_ALPHA * xv[1] + gv[1] * f1, DN_ALPHA * xv[2] + gv[2] * f2, DN_ALPHA * xv[3] + gv[3] * f3};
        }
        float mu, rstd; ln_stats(v, mu, rstd);
#pragma unroll
        for (int i = 0; i < 4; ++i) {
            const int c = lane * 4 + i * 256;
            const f32x4 gg = *(const f32x4*)(lg + c), bb = *(const f32x4*)(lb + c);
#pragma unroll
            for (int j = 0; j < 4; ++j) v[i][j] = (v[i][j] - mu) * rstd * gg[j] + bb[j];
            if (l == 1) *(f32x4*)(p.out + ((size_t)b * NLAT + (pp - NCTX)) * DM + c) = v[i];
            else *(f32x4*)(Xnext + (size_t)r * DM + c) = v[i];
        }
        if (l == 0) { const float* mv = modv + ((size_t)1 * 3 + sel) * 6144; modulate_store(v, mv, mv + 1024, H + (size_t)r * DM, lane); }
    }
}

constexpr int PH_PER_LAYER = 11, N_PHASES = 3 + 2 * PH_PER_LAYER;
__global__ void __launch_bounds__(NTHREADS, 2) mega(Params p) {
    extern __shared__ __attribute__((aligned(16))) unsigned char lds_raw[];
    LAS unsigned char* lds = (LAS unsigned char*)lds_raw;
    volatile LAS unsigned* bst = (volatile LAS unsigned*)(lds + LDS_BYTES - 16);
    if (PROBE_ID != 0 && threadIdx.x == 0) { PRB_WORDS(lds)[0] = 0ull; PRB_WORDS(lds)[1] = 0ull; }
    if (threadIdx.x == 0) { bst[0] = 0u; bst[1] = 0u; const unsigned xc = xb_xcc_id(); bst[2] = xc; bst[3] = xb_add((unsigned*)(p.ws + CTL_XRANK) + xc, 1u); }
    __syncthreads();
    const int lo = p.ph_lo, hi = p.ph_hi;
    XcdBarrier bar; bar.bar = (unsigned*)(p.ws + WS_CTL); bar.x = 0; bar.st = bst;
    if (hi - lo > 1) bar = xcd_barrier_post((unsigned*)(p.ws + WS_CTL), bst);
#ifndef ONLY_PHASE
#define ONLY_PHASE -1
#endif
#define IN(k) (lo <= (k) && (k) < hi)
#define ON(pid) (ONLY_PHASE < 0 || ONLY_PHASE == (pid))
#ifndef DUP_PHASE
#define DUP_PHASE -1
#endif
#define REP(pid) for (int rep_ = 0; rep_ < ((DUP_PHASE == (pid)) ? 2 : 1); ++rep_)
#define SEAM(k) do { if (IN(k) && IN((k) + 1)) xcd_barrier(bar); } while (0)
    PRB_T0(100, lds); if (ON(0) && IN(0)) REP(0) { phase_convert(p, lds); phase_convert_experts(p, 0); phase_convert_experts(p, 1); } PRB_T1(100, lds);
    PRB_T0(200, lds); SEAM(0); PRB_T1(200, lds);
    PRB_T0(101, lds); if (ON(1) && IN(1)) REP(1) phase_mod(p, lds); PRB_T1(101, lds);
    PRB_T0(201, lds); SEAM(1); PRB_T1(201, lds);
    PRB_T0(102, lds); if (ON(2) && IN(2)) REP(2) phase_ln0(p); PRB_T1(102, lds);
    PRB_T0(202, lds); SEAM(2); PRB_T1(202, lds);
    for (int l = 0; l < 2; ++l) {
        const int k0 = 3 + l * PH_PER_LAYER;
        PRB_T0(103, lds); if (ON(3) && IN(k0 + 0)) REP(3) phase_inproj(p, l, lds); PRB_T1(103, lds);
        PRB_T0(203, lds); SEAM(k0 + 0); PRB_T1(203, lds);
        PRB_T0(104, lds); if (ON(4) && IN(k0 + 1)) REP(4) phase_ret_sum_pool(p, l, lds); PRB_T1(104, lds);
        PRB_T0(204, lds); SEAM(k0 + 1); PRB_T1(204, lds);
        PRB_T0(105, lds); if (ON(5) && IN(k0 + 2)) REP(5) phase_ret_scan(p, l); PRB_T1(105, lds);
        PRB_T0(205, lds); SEAM(k0 + 2); PRB_T1(205, lds);
        PRB_T0(106, lds); if (ON(6) && IN(k0 + 3)) REP(6) { phase_attn(p, l, lds); phase_ret(p, l); } PRB_T1(106, lds);
        PRB_T0(206, lds); SEAM(k0 + 3); PRB_T1(206, lds);
        PRB_T0(107, lds); if (ON(7) && IN(k0 + 4)) REP(7) phase_outproj(p, l, lds); PRB_T1(107, lds);
        PRB_T0(207, lds); SEAM(k0 + 4); PRB_T1(207, lds);
        PRB_T0(108, lds); if (ON(8) && IN(k0 + 5)) REP(8) phase_ln_mid(p, l); PRB_T1(108, lds);
        PRB_T0(208, lds); SEAM(k0 + 5); PRB_T1(208, lds);
        PRB_T0(109, lds); if (ON(9) && IN(k0 + 6)) REP(9) phase_router(p, l, lds); PRB_T1(109, lds);
        PRB_T0(209, lds); SEAM(k0 + 6); PRB_T1(209, lds);
        PRB_T0(110, lds); if (ON(10) && IN(k0 + 7)) REP(10) phase_topk(p, l, lds); PRB_T1(110, lds);
        PRB_T0(210, lds); SEAM(k0 + 7); PRB_T1(210, lds);
        PRB_T0(111, lds); if (ON(11) && IN(k0 + 8)) REP(11) phase_scatter(p, l, lds); PRB_T1(111, lds);
        PRB_T0(211, lds); SEAM(k0 + 8); PRB_T1(211, lds);
        PRB_T0(112, lds); if (ON(12) && IN(k0 + 9)) REP(12) phase_moe(p, l, lds); PRB_T1(112, lds);
        PRB_T0(212, lds); SEAM(k0 + 9); PRB_T1(212, lds);
        PRB_T0(114, lds); if (ON(14) && IN(k0 + 10)) REP(14) phase_combine(p, l); PRB_T1(114, lds);
        if (l == 0) SEAM(k0 + 10);
    }
#undef IN
#undef SEAM
    if (PROBE_ID != 0 && threadIdx.x == 0 && blockIdx.x == 0) {
        const unsigned long long t0 = __builtin_readcyclecounter(), span = PRB_WORDS(lds)[1] * PROBE_GAIN;
        while (__builtin_readcyclecounter() - t0 < span) __builtin_amdgcn_s_sleep(8);
    }
}

extern "C" void kernel_launch(void* const* d_in, const int* in_sizes, int n_in, void* d_out, int out_size, void* d_ws, size_t ws_size, hipStream_t stream) {
    static int grid = 0;
    if (grid == 0) {
        if (n_in != 20 || ws_size < WS_END || out_size != NB * NLAT * DM) { fprintf(stderr, "kernel_launch: unexpected shapes (n_in %d, ws %zu need %zu, out %d)\n", n_in, ws_size, (size_t)WS_END, out_size); grid = -1; return; }
        int dev = 0, cus = 0, per_cu = 0;
        hipGetDevice(&dev); hipDeviceGetAttribute(&cus, hipDeviceAttributeMultiprocessorCount, dev);
        if (hipFuncSetAttribute((const void*)mega, hipFuncAttributeMaxDynamicSharedMemorySize, LDS_BYTES) != hipSuccess) { fprintf(stderr, "kernel_launch: hipFuncSetAttribute failed\n"); grid = -1; return; }
        if (hipOccupancyMaxActiveBlocksPerMultiprocessor(&per_cu, (const void*)mega, NTHREADS, LDS_BYTES) != hipSuccess || per_cu < 1) { fprintf(stderr, "kernel_launch: occupancy query says %d\n", per_cu); }
        (void)hipGetLastError();
        grid = cus > 0 ? cus : 256;
    }
    if (grid < 0) return;
    hipMemsetAsync((char*)d_ws + WS_CTL, 0, CTL_BYTES, stream);
    Params p{};
    p.x = (const float*)d_in[0]; p.c = (const float*)d_in[1]; p.ctx = (const float*)d_in[2]; p.c_ctx = (const float*)d_in[3];
    p.w_mod = (const float*)d_in[4]; p.b_mod = (const float*)d_in[5]; p.w_in = (const float*)d_in[6]; p.w_out = (const float*)d_in[7];
    p.diff_lambda = (const float*)d_in[8]; p.pool_w = (const float*)d_in[9]; p.pool_scale = (const float*)d_in[10]; p.ret_log_decay = (const float*)d_in[11];
    p.ln_g = (const float*)d_in[12]; p.ln_b = (const float*)d_in[13]; p.w_router = (const float*)d_in[14]; p.router_bias = (const float*)d_in[15];
    p.w_egu = (const float*)d_in[16]; p.w_edn = (const float*)d_in[17]; p.w_sgu = (const float*)d_in[18]; p.w_sdn = (const float*)d_in[19];
    p.out = (float*)d_out; p.ws = (unsigned char*)d_ws;
#if N_LAUNCH_PER_PHASE
    for (int k = 0; k < N_PHASES; ++k) { p.ph_lo = k; p.ph_hi = k + 1; hipLaunchKernelGGL(mega, dim3(grid), dim3(NTHREADS), LDS_BYTES, stream, p); }
#else
    p.ph_lo = 0; p.ph_hi = N_PHASES;
    hipLaunchKernelGGL(mega, dim3(grid), dim3(NTHREADS), LDS_BYTES, stream, p);
#endif
}
```

```cpp
#include <hip/hip_runtime.h>
#include <stdint.h>
#include <stdio.h>

#ifndef N_LAUNCH_PER_PHASE
#define N_LAUNCH_PER_PHASE 0
#endif

#define LAS __attribute__((address_space(3)))
#define DI __device__ __forceinline__
typedef unsigned short bf16_t;
typedef short bf16x8 __attribute__((ext_vector_type(8)));
typedef float f32x2 __attribute__((ext_vector_type(2)));
typedef float f32x4 __attribute__((ext_vector_type(4)));
typedef float f32x16 __attribute__((ext_vector_type(16)));
typedef unsigned u32x2 __attribute__((ext_vector_type(2)));
typedef unsigned u32x4 __attribute__((ext_vector_type(4)));
typedef __bf16 bf16v2 __attribute__((ext_vector_type(2)));

constexpr int NB = 2, NLAT = 8192, NCTX = 256, NT = NLAT + NCTX  , MROWS = NB * NT  ;
constexpr int DM = 1024, INW = 2816, NEXP = 256, TOPK = 8, NASG = MROWS * TOPK  ;
constexpr int NCHUNK = NT / 128;
constexpr float DN_ALPHA = 1.41421356237f;
constexpr float LN_EPS = 1e-6f, RMS_EPS = 1e-5f;
constexpr float LOG2E = 1.44269504089f;
constexpr float QSCALE = 0.125f * LOG2E;
constexpr int NTHREADS = 512;
constexpr int LDS_BYTES = 155648;

constexpr int C_DQ = 0, C_DK = 512, C_DV = 1024, C_PU = 1536, C_RQ = 1792, C_RK = 2048, C_RV = 2304, C_RG = 2560;

constexpr size_t al256(size_t x) { return (x + 255) & ~(size_t)255; }
constexpr size_t WS_CTL = 0;
constexpr size_t CTL_BYTES = 65536;
constexpr size_t CTL_COUNTS = 16384;
constexpr size_t CTL_CURSOR = CTL_COUNTS + 2048;
constexpr size_t CTL_NTILES = CTL_CURSOR + 2048;
constexpr size_t CTL_XRANK = CTL_NTILES + 256;
constexpr size_t WS_MODV = WS_CTL + CTL_BYTES;
constexpr size_t WS_ROPE = al256(WS_MODV + 2 * 3 * 6144 * 4);
constexpr size_t WS_SCAL = al256(WS_ROPE + 128 * 16 * 8);
constexpr size_t WS_WIN = al256(WS_SCAL + 2 * 16 * 4);
constexpr size_t WS_WOUT = al256(WS_WIN + (size_t)2 * INW * DM * 2);
constexpr size_t WS_WR = al256(WS_WOUT + (size_t)2 * DM * DM * 2);
constexpr size_t WS_WIMG = al256(WS_WR + (size_t)2 * 256 * DM * 2);
constexpr size_t WS_XA = al256(WS_WIMG + (size_t)2 * 257 * 48 * 32768);
constexpr size_t WS_XB = al256(WS_XA + (size_t)MROWS * DM * 4);
constexpr size_t WS_V1 = al256(WS_XB + (size_t)MROWS * DM * 4);
constexpr size_t WS_H = al256(WS_V1 + (size_t)MROWS * DM * 4);
constexpr size_t WS_TOK = al256(WS_H + (size_t)MROWS * DM * 2);
constexpr size_t WS_P = al256(WS_TOK + (size_t)MROWS * DM * 2);
constexpr size_t WS_VT = al256(WS_P + (size_t)MROWS * INW * 2);
constexpr size_t WS_RKT = al256(WS_VT + (size_t)NB * 4 * 128 * NT * 2);
constexpr size_t WS_RVT = al256(WS_RKT + (size_t)NB * 4 * 64 * NT * 2);
constexpr size_t WS_MIX = al256(WS_RVT + (size_t)NB * 4 * 64 * NT * 2);
constexpr size_t ST_BYTES = (size_t)NB * 4 * NCHUNK * 4096 * 4;
constexpr size_t WS_UF = al256(WS_MIX + (size_t)MROWS * DM * 2);
constexpr size_t WS_UB = al256(WS_UF + ST_BYTES);
constexpr size_t WS_SF = al256(WS_UB + ST_BYTES);
constexpr size_t WS_SB = al256(WS_SF + ST_BYTES);
constexpr size_t WS_LOGIT = al256(WS_SB + ST_BYTES);
constexpr size_t WS_EIDX = al256(WS_LOGIT + (size_t)MROWS * 256 * 4);
constexpr size_t WS_GATE = al256(WS_EIDX + (size_t)NASG * 4);
constexpr size_t WS_SORT = al256(WS_GATE + (size_t)NASG * 4);
constexpr size_t WS_RANK = al256(WS_SORT + (size_t)NASG * 4);
constexpr size_t WS_HIST = al256(WS_RANK + (size_t)NASG * 4);
constexpr size_t WS_TILES = al256(WS_HIST + (size_t)1024 * 256 * 4);
constexpr size_t WS_YSLOT = al256(WS_TILES + 2048 * 16);
constexpr size_t WS_YSH = al256(WS_YSLOT + (size_t)NASG * DM * 2);
constexpr size_t WS_END = al256(WS_YSH + (size_t)MROWS * DM * 2);

struct Params {
    const float *x, *c, *ctx, *c_ctx, *w_mod, *b_mod, *w_in, *w_out, *diff_lambda, *pool_w, *pool_scale, *ret_log_decay, *ln_g, *ln_b,
        *w_router, *router_bias, *w_egu, *w_edn, *w_sgu, *w_sdn;
    float* out;
    unsigned char* ws;
    int ph_lo, ph_hi;
};


DI Params launder(const Params& a) {
    size_t z = 0; asm volatile("" : "+s"(z));
    Params r = a;
#define LND(f) r.f = (decltype(r.f))((const unsigned char*)a.f + z)
    LND(x); LND(c); LND(ctx); LND(c_ctx); LND(w_mod); LND(b_mod); LND(w_in); LND(w_out); LND(diff_lambda); LND(pool_w); LND(pool_scale); LND(ret_log_decay); LND(ln_g); LND(ln_b);
    LND(w_router); LND(router_bias); LND(w_egu); LND(w_edn); LND(w_sgu); LND(w_sdn);
#undef LND
    r.out = (float*)((unsigned char*)a.out + z); r.ws = a.ws + z;
    return r;
}
DI int launder_s(int v) { asm volatile("" : "+s"(v)); return v; }
DI int tid_() { int t = threadIdx.x; asm volatile("" : "+v"(t)); return t; }
DI int bid_() { int t = blockIdx.x; asm volatile("" : "+s"(t)); return t; }


#ifndef PROBE_ID
#define PROBE_ID 0
#endif
#ifndef PROBE_GAIN
#define PROBE_GAIN 8
#endif
#define PRB_WORDS(lds) ((volatile LAS unsigned long long*)((lds) + LDS_BYTES - 64))
#define PRB_MATCH(id) (PROBE_ID == (id) || (PROBE_ID == 999 && (id) >= 200) || (PROBE_ID == 998 && ((id) == 101 || (id) == 102 || (id) == 104 || (id) == 105 || (id) == 108 || (id) == 109 || (id) == 110 || (id) == 111)))
#define PRB_T0(id, lds) do { if (PRB_MATCH(id) && threadIdx.x == 0 && blockIdx.x == 0) { PRB_WORDS(lds)[0] = __builtin_readcyclecounter(); } } while (0)
#define PRB_T1(id, lds) do { if (PRB_MATCH(id) && threadIdx.x == 0 && blockIdx.x == 0) { PRB_WORDS(lds)[1] += __builtin_readcyclecounter() - PRB_WORDS(lds)[0]; } } while (0)

#define XB_TMO      128
#define XB_XCNT(j)  (256  + 64 * (j))
#define XB_XSUB(j)  (1280 + 64 * (j))
#define XB_XGEN(j)  (2304 + 64 * (j))
#define XB_TOP      3328
#define XB_TOPGEN   3392
#define XCD_BAR_WORDS 3456
#define XB_SPIN_CAP (1u << 20)

__device__ __forceinline__ unsigned xb_ld(unsigned* p)              { return __hip_atomic_load(p, __ATOMIC_RELAXED, __HIP_MEMORY_SCOPE_AGENT); }
__device__ __forceinline__ unsigned xb_add(unsigned* p, unsigned v) { return __hip_atomic_fetch_add(p, v, __ATOMIC_RELAXED, __HIP_MEMORY_SCOPE_AGENT); }
__device__ __forceinline__ unsigned xb_xcc_id() { return (unsigned)__builtin_amdgcn_s_getreg((3 << 11) | 20) & 0xFu; }
#define XB_SPIN(cond, bar) do { unsigned _sp = 0; while (cond) { __builtin_amdgcn_s_sleep(1); \
    if ((++_sp & 255u) == 0u) { if (xb_ld(&(bar)[XB_TMO])) break; if (_sp > XB_SPIN_CAP) { atomicAdd(&(bar)[XB_TMO], 1u); break; } } } } while (0)

struct XcdBarrier { unsigned* bar; unsigned x; volatile LAS unsigned* st; };

__device__ __forceinline__ XcdBarrier xcd_barrier_post(unsigned* bar, volatile LAS unsigned* st) {
    XcdBarrier b; b.bar = bar; b.x = xb_xcc_id(); b.st = st;
    if (threadIdx.x == 0) (void)xb_add(&bar[XB_XCNT(b.x)], 1u);
    return b;
}
__device__ __forceinline__ void xcd_barrier_complete(unsigned* bar, unsigned x, unsigned& nloc, unsigned& nx) {
    const unsigned G = gridDim.x * gridDim.y * gridDim.z;
    unsigned sum, cnt, mine, sp = 0u;
    for (;;) {
        sum = 0u; cnt = 0u; mine = 0u;
#pragma unroll
        for (unsigned j = 0; j < 16; ++j) { const unsigned c = xb_ld(&bar[XB_XCNT(j)]); sum += c; cnt += (c > 0u) ? 1u : 0u; mine = (j == x) ? c : mine; }
        if (sum == G) break;
        __builtin_amdgcn_s_sleep(1);
        if ((++sp & 255u) == 0u) { if (xb_ld(&bar[XB_TMO])) break; if (sp > XB_SPIN_CAP) { atomicAdd(&bar[XB_TMO], 1u); break; } }
    }
    nloc = mine > 0u ? mine : 1u; nx = cnt > 0u ? cnt : 1u;
}
__device__ __forceinline__ void xcd_barrier(const XcdBarrier& b) {
    asm volatile("s_waitcnt vmcnt(0)" ::: "memory");
    __syncthreads();
    if (threadIdx.x == 0) {
        unsigned* bar = b.bar;
        __builtin_amdgcn_s_waitcnt(0);
        unsigned nloc = b.st[0], nx = b.st[1];
        if (nloc == 0u) { xcd_barrier_complete(bar, b.x, nloc, nx); b.st[0] = nloc; b.st[1] = nx; }
        const unsigned old = xb_add(&bar[XB_XSUB(b.x)], 1u);
        const unsigned gen = old / nloc;
        if (old + 1u == (gen + 1u) * nloc) {
            __builtin_amdgcn_fence(__ATOMIC_RELEASE, "agent");
            asm volatile("s_waitcnt vmcnt(0)" ::: "memory");
            const unsigned og = xb_add(&bar[XB_TOP], 1u);
            const unsigned tg = og / nx;
            if (og + 1u == (tg + 1u) * nx) xb_add(&bar[XB_TOPGEN], 1u);
            else XB_SPIN(xb_ld(&bar[XB_TOPGEN]) == tg, bar);
            __builtin_amdgcn_fence(__ATOMIC_ACQUIRE, "agent");
            xb_add(&bar[XB_XGEN(b.x)], 1u);
            asm volatile("s_waitcnt vmcnt(0)" ::: "memory");
        } else {
            XB_SPIN(xb_ld(&bar[XB_XGEN(b.x)]) == gen, bar);
            __builtin_amdgcn_fence(__ATOMIC_ACQUIRE, "agent");
            asm volatile("s_waitcnt vmcnt(0)" ::: "memory");
        }
    }
    __syncthreads();
}

DI unsigned pk_bf16(float a, float b) { f32x2 v = {a, b}; bf16v2 r = __builtin_convertvector(v, bf16v2); return __builtin_bit_cast(unsigned, r); }
DI bf16_t to_bf16(float a) { return (bf16_t)(pk_bf16(a, 0.f) & 0xffffu); }
DI float bf_lo(unsigned u) { return __uint_as_float(u << 16); }
DI float bf_hi(unsigned u) { return __uint_as_float(u & 0xffff0000u); }
DI float bf2f(bf16_t h) { return __uint_as_float(((unsigned)h) << 16); }
DI float wave_sum(float v) {
#pragma unroll
    for (int o = 32; o; o >>= 1) v += __shfl_xor(v, o);
    return v;
}
DI float fast_exp2(float x) { return __builtin_amdgcn_exp2f(x); }
DI float silu_f(float x) { return x / (1.f + __expf(-x)); }
DI bf16x8 as_bf16x8(u32x4 v) { return __builtin_bit_cast(bf16x8, v); }
#define WAIT_VM(n) asm volatile("s_waitcnt vmcnt(" #n ")" ::: "memory")
DI void dma16(const void* g, LAS unsigned char* l) { __builtin_amdgcn_global_load_lds(g, (LAS void*)l, 16, 0, 0); }
#define MFMA32(a, b, c) __builtin_amdgcn_mfma_f32_32x32x16_bf16((a), (b), (c), 0, 0, 0)
#define MFMA16(a, b, c) __builtin_amdgcn_mfma_f32_16x16x32_bf16((a), (b), (c), 0, 0, 0)

DI int row_sel(int r) { const int b = r >= NT; const int p = r - b * NT; return p < NCTX ? 2 : b; }

DI int swz_off(int row, int chunk) { return row * 128 + ((chunk ^ ((row >> 1) & 7)) << 4); }

template <class Epi>
DI void gemm128(const bf16_t* a0, const bf16_t* a1, const bf16_t* b0, const bf16_t* b1, int nk, LAS unsigned char* lds, const Epi& epi) {
    const int tid = tid_(), lane = tid & 63, wid = tid >> 6, wr = wid >> 2, wc = wid & 3, fr = lane & 15, fq = lane >> 4;
    const int lrow = tid >> 3, lch = tid & 7;
    f32x4 acc[4][2];
#pragma unroll
    for (int m = 0; m < 4; ++m)
#pragma unroll
        for (int n = 0; n < 2; ++n) acc[m][n] = (f32x4){0.f, 0.f, 0.f, 0.f};
    const u32x4 z4 = {0u, 0u, 0u, 0u};
    u32x4 ra0 = a0 ? *(const u32x4*)a0 : z4, ra1 = a1 ? *(const u32x4*)a1 : z4, rb0 = b0 ? *(const u32x4*)b0 : z4, rb1 = b1 ? *(const u32x4*)b1 : z4;
    const int wo0 = swz_off(lrow, lch), wo1 = swz_off(lrow + 64, lch);
    *(LAS u32x4*)(lds + wo0) = ra0; *(LAS u32x4*)(lds + wo1) = ra1;
    *(LAS u32x4*)(lds + 16384 + wo0) = rb0; *(LAS u32x4*)(lds + 16384 + wo1) = rb1;
    __syncthreads();
    for (int kt = 0; kt < nk; ++kt) {
        const bool more = kt + 1 < nk;
        if (more) {
            const int ko = (kt + 1) * 64;
            ra0 = a0 ? *(const u32x4*)(a0 + ko) : z4; ra1 = a1 ? *(const u32x4*)(a1 + ko) : z4;
            rb0 = b0 ? *(const u32x4*)(b0 + ko) : z4; rb1 = b1 ? *(const u32x4*)(b1 + ko) : z4;
        }
        LAS unsigned char* A = lds + (kt & 1) * 32768;
        LAS unsigned char* B = A + 16384;
#pragma unroll
        for (int kk = 0; kk < 2; ++kk) {
            bf16x8 af[4], bfr[2];
#pragma unroll
            for (int m = 0; m < 4; ++m) af[m] = *(LAS bf16x8*)(A + swz_off(wr * 64 + m * 16 + fr, kk * 4 + fq));
#pragma unroll
            for (int n = 0; n < 2; ++n) bfr[n] = *(LAS bf16x8*)(B + swz_off(wc * 32 + n * 16 + fr, kk * 4 + fq));
#pragma unroll
            for (int m = 0; m < 4; ++m)
#pragma unroll
                for (int n = 0; n < 2; ++n) acc[m][n] = MFMA16(af[m], bfr[n], acc[m][n]);
        }
        if (more) {
            LAS unsigned char* A2 = lds + ((kt + 1) & 1) * 32768;
            *(LAS u32x4*)(A2 + wo0) = ra0; *(LAS u32x4*)(A2 + wo1) = ra1;
            *(LAS u32x4*)(A2 + 16384 + wo0) = rb0; *(LAS u32x4*)(A2 + 16384 + wo1) = rb1;
        }
        __syncthreads();
    }
    epi(acc, wr, wc, fr, fq);
}

DI int perm_gu(int n) { const int f = n >> 8, jj = n & 255; return ((jj >> 4) << 5) + (f << 4) + (jj & 15); }
DI void conv_unit(const float* src, int N, int K, bf16_t* dst, int k0, int n0, bool perm, LAS unsigned char* lds) {
    LAS float* tl = (LAS float*)lds;
    const int tid = tid_();
#pragma unroll
    for (int i = 0; i < 8; ++i) {
        const int kk = (tid >> 6) + 8 * i, nn = (tid & 63) * 4;
        const f32x4 v = *(const f32x4*)(src + (size_t)(k0 + kk) * N + n0 + nn);
        tl[kk * 257 + nn] = v[0]; tl[kk * 257 + nn + 1] = v[1]; tl[kk * 257 + nn + 2] = v[2]; tl[kk * 257 + nn + 3] = v[3];
    }
    __syncthreads();
    const int n = tid >> 1, kh = (tid & 1) * 32;
    const int nd = perm ? perm_gu(n0 + n) : (n0 + n);
    bf16_t* d = dst + (size_t)nd * K + k0 + kh;
#pragma unroll
    for (int q = 0; q < 4; ++q) {
        u32x4 w;
#pragma unroll
        for (int j = 0; j < 4; ++j) w[j] = pk_bf16(tl[(kh + q * 8 + 2 * j) * 257 + n], tl[(kh + q * 8 + 2 * j + 1) * 257 + n]);
        *(u32x4*)(d + q * 8) = w;
    }
    __syncthreads();
}

DI void phase_convert(const Params& p0, LAS unsigned char* lds) {
    const Params p = launder(p0);
    constexpr int U_IN = 176, U_OUT = 64, U_R = 16;
    constexpr int U_L = U_IN + U_OUT + U_R;
    for (int u = bid_(); u < 2 * U_L; u += gridDim.x) {
        const int l = u / U_L; int v = u % U_L;
        if (v < U_IN) { conv_unit(p.w_in + (size_t)l * DM * INW, INW, DM, (bf16_t*)(p.ws + WS_WIN) + (size_t)l * INW * DM, (v / 11) * 64, (v % 11) * 256, false, lds); continue; }
        v -= U_IN;
        if (v < U_OUT) { conv_unit(p.w_out + (size_t)l * DM * DM, DM, DM, (bf16_t*)(p.ws + WS_WOUT) + (size_t)l * DM * DM, (v / 4) * 64, (v % 4) * 256, false, lds); continue; }
        v -= U_OUT;
        conv_unit(p.w_router + (size_t)l * DM * 256, 256, DM, (bf16_t*)(p.ws + WS_WR) + (size_t)l * 256 * DM, v * 64, 0, false, lds);
    }
}

DI void phase_mod(const Params& p0, LAS unsigned char* lds) {
    const Params p = launder(p0);
    LAS float* sc = (LAS float*)lds;
    LAS float* red = sc + 3 * 1024;
    const int tid = tid_();
    float* modv = (float*)(p.ws + WS_MODV);
    for (int u = bid_(); u < 193; u += gridDim.x) {
        if (u == 192) {
            float* rope = (float*)(p.ws + WS_ROPE);
            for (int i = tid; i < 128 * 16; i += NTHREADS) {
                const int pos = i >> 4, f = i & 15;
                const float freq = powf(10000.0f, -(float)f / 16.0f);
                const float ang = (float)pos * freq;
                rope[2 * i] = cosf(ang); rope[2 * i + 1] = sinf(ang);
            }
            float* scal = (float*)(p.ws + WS_SCAL);
            if (tid < 2) {
                const int l = tid;
                const float* dl = p.diff_lambda + l * 256;
                float s01 = 0.f, s23 = 0.f;
                for (int i = 0; i < 64; ++i) { s01 += dl[i] * dl[64 + i]; s23 += dl[128 + i] * dl[192 + i]; }
                const float lambda_init = 0.8f - 0.6f * expf(-0.3f * (float)l);
                scal[l * 16 + 0] = expf(s01) - expf(s23) + lambda_init;
                scal[l * 16 + 1] = 1.0f - lambda_init;
                for (int h = 0; h < 4; ++h) {
                    scal[l * 16 + 2 + h] = -expf(p.ret_log_decay[l * 8 + h]) * LOG2E;
                    scal[l * 16 + 6 + h] = -expf(p.ret_log_decay[l * 8 + 4 + h]) * LOG2E;
                }
            }
            continue;
        }
        const int l = u / 96, n0 = (u % 96) * 64;
        for (int i = tid; i < 3 * 1024; i += NTHREADS) {
            const int s = i >> 10, k = i & 1023;
            const float v = s < 2 ? p.c[s * 1024 + k] : p.c_ctx[k];
            sc[i] = silu_f(v);
        }
        __syncthreads();
        const int kq = tid >> 6, nl = tid & 63;
        const float* w = p.w_mod + (size_t)l * DM * 6144 + n0 + nl;
        float a0 = 0.f, a1 = 0.f, a2 = 0.f;
        for (int k = kq * 128; k < kq * 128 + 128; ++k) {
            const float wv = w[(size_t)k * 6144];
            a0 += sc[k] * wv; a1 += sc[1024 + k] * wv; a2 += sc[2048 + k] * wv;
        }
        red[(kq * 3 + 0) * 64 + nl] = a0; red[(kq * 3 + 1) * 64 + nl] = a1; red[(kq * 3 + 2) * 64 + nl] = a2;
        __syncthreads();
        if (tid < 192) {
            const int s = tid >> 6, n = tid & 63;
            float v = 0.f;
            for (int q = 0; q < 8; ++q) v += red[(q * 3 + s) * 64 + n];
            modv[((size_t)l * 3 + s) * 6144 + n0 + n] = v + p.b_mod[l * 6144 + n0 + n];
        }
        __syncthreads();
    }
}

DI void ln_stats(const f32x4 (&v)[4], float& mu, float& rstd) {
    float s = 0.f;
#pragma unroll
    for (int i = 0; i < 4; ++i) s += (v[i][0] + v[i][1]) + (v[i][2] + v[i][3]);
    mu = wave_sum(s) * (1.0f / 1024.0f);
    float q = 0.f;
#pragma unroll
    for (int i = 0; i < 4; ++i)
#pragma unroll
        for (int j = 0; j < 4; ++j) { const float d = v[i][j] - mu; q += d * d; }
    rstd = rsqrtf(wave_sum(q) * (1.0f / 1024.0f) + LN_EPS);
}
DI void modulate_store(const f32x4 (&v)[4], const float* shift, const float* scale, bf16_t* dst, int lane) {
    float mu, rstd; ln_stats(v, mu, rstd);
#pragma unroll
    for (int i = 0; i < 4; ++i) {
        const int c = lane * 4 + i * 256;
        const f32x4 sh = *(const f32x4*)(shift + c), scv = *(const f32x4*)(scale + c);
        float o[4];
#pragma unroll
        for (int j = 0; j < 4; ++j) o[j] = (v[i][j] - mu) * rstd * (1.0f + scv[j]) + sh[j];
        u32x2 w = {pk_bf16(o[0], o[1]), pk_bf16(o[2], o[3])};
        *(u32x2*)(dst + c) = w;
    }
}

DI void phase_ln0(const Params& p0) {
    const Params p = launder(p0);
    const int lane = tid_() & 63, wid = tid_() >> 6;
    float* XA = (float*)(p.ws + WS_XA);
    bf16_t* H = (bf16_t*)(p.ws + WS_H);
    const float* modv = (const float*)(p.ws + WS_MODV);
    for (int r = bid_() * 8 + wid; r < MROWS; r += gridDim.x * 8) {
        const int b = r >= NT, pp = r - b * NT;
        const float* src = pp < NCTX ? p.ctx + ((size_t)b * NCTX + pp) * DM : p.x + ((size_t)b * NLAT + (pp - NCTX)) * DM;
        f32x4 v[4];
#pragma unroll
        for (int i = 0; i < 4; ++i) { v[i] = *(const f32x4*)(src + lane * 4 + i * 256); *(f32x4*)(XA + (size_t)r * DM + lane * 4 + i * 256) = v[i]; }
        const float* mv = modv + (size_t)(0 * 3 + (pp < NCTX ? 2 : b)) * 6144;
        modulate_store(v, mv, mv + 1024, H + (size_t)r * DM, lane);
    }
}

constexpr int G2_STG = 40960;
template <class Epi>
DI void gemm192(const bf16_t* A, int lda, const bf16_t* Bt, int ldb, int nk, int m0, int n0, LAS unsigned char* lds, const Epi& epi) {
    const int t = tid_(), lane = t & 63, wid = __builtin_amdgcn_readfirstlane(t >> 6), fr = lane & 15, fq = lane >> 4, wm = wid >> 1, wn = wid & 1;
    const bf16_t* asrc[3]; const bf16_t* bsrc[2];
#pragma unroll
    for (int i = 0; i < 3; ++i) { const int sl = t + 512 * i, row = sl >> 3, c = (sl & 7) ^ ((row >> 1) & 7); asrc[i] = A + (size_t)(m0 + row) * lda + c * 8; }
#pragma unroll
    for (int i = 0; i < 2; ++i) { const int sl = t + 512 * i, row = sl >> 3, c = (sl & 7) ^ ((row >> 1) & 7); bsrc[i] = Bt + (size_t)(n0 + row) * ldb + c * 8; }
    const int ddst = wid * 1024;
#define G2_ISSUE(S, KT) do { LAS unsigned char* _s = lds + (S) * G2_STG + ddst; const int _k = (KT) * 64; \
        dma16(asrc[0] + _k, _s); dma16(asrc[1] + _k, _s + 8192); dma16(asrc[2] + _k, _s + 16384); dma16(bsrc[0] + _k, _s + 24576); dma16(bsrc[1] + _k, _s + 32768); } while (0)
    f32x4 acc[4][3];
#pragma unroll
    for (int nf = 0; nf < 4; ++nf)
#pragma unroll
        for (int mf = 0; mf < 3; ++mf) acc[nf][mf] = (f32x4){0.f, 0.f, 0.f, 0.f};
    __syncthreads();
    G2_ISSUE(0, 0);
    if (nk > 1) G2_ISSUE(1, 1);
    int st = 0;
    for (int kt = 0; kt < nk; ++kt) {
        if (kt + 1 < nk) WAIT_VM(5); else WAIT_VM(0);
        asm volatile("s_waitcnt lgkmcnt(0)" ::: "memory");
        __builtin_amdgcn_s_barrier();
        const int st2 = st == 0 ? 2 : st - 1;
        if (kt + 2 < nk) G2_ISSUE(st2, kt + 2);
        LAS unsigned char* S = lds + st * G2_STG;
        st = st == 2 ? 0 : st + 1;
#pragma unroll
        for (int kk = 0; kk < 2; ++kk) {
            bf16x8 af[3], bfr[4];
#pragma unroll
            for (int mf = 0; mf < 3; ++mf) af[mf] = *(LAS bf16x8*)(S + swz_off(wm * 48 + mf * 16 + fr, kk * 4 + fq));
#pragma unroll
            for (int nf = 0; nf < 4; ++nf) bfr[nf] = *(LAS bf16x8*)(S + 24576 + swz_off(wn * 64 + nf * 16 + fr, kk * 4 + fq));
#pragma unroll
            for (int nf = 0; nf < 4; ++nf)
#pragma unroll
                for (int mf = 0; mf < 3; ++mf) acc[nf][mf] = MFMA16(bfr[nf], af[mf], acc[nf][mf]);
        }
    }
#undef G2_ISSUE
    __syncthreads();
    epi(acc, wm, wn, fr, fq, lane, wid);
}
DI LAS unsigned char* g2_stage(LAS unsigned char* lds, int wid) { return lds + wid * 13056; }

DI void phase_inproj(const Params& p0, int l, LAS unsigned char* lds) {
    const Params p = launder(p0); l = launder_s(l);
    const bf16_t* H = (const bf16_t*)(p.ws + WS_H);
    const bf16_t* W = (const bf16_t*)(p.ws + WS_WIN) + (size_t)l * INW * DM;
    bf16_t* P = (bf16_t*)(p.ws + WS_P);
    bf16_t* VT = (bf16_t*)(p.ws + WS_VT);
    bf16_t* RKT = (bf16_t*)(p.ws + WS_RKT);
    bf16_t* RVT = (bf16_t*)(p.ws + WS_RVT);
    const f32x2* rope = (const f32x2*)(p.ws + WS_ROPE);
    constexpr int NTN = INW / 128, NTM = MROWS / 192;
    for (int u = bid_(); u < NTM * NTN; u += gridDim.x) {
        const int tm = u / NTN, tn = u % NTN;
        auto epi = [&](f32x4 (&acc)[4][3], int wm, int wn, int fr, int fq, int lane, int wid) {
            const int c0 = tn * 128 + wn * 64;
            const int r0 = tm * 192 + wm * 48;
            LAS unsigned char* W_ = g2_stage(lds, wid);
            if (c0 < C_DV) {
                const float qs = c0 < C_DK ? QSCALE : 1.0f;
#pragma unroll
                for (int mf = 0; mf < 3; ++mf) {
                    const int row = r0 + mf * 16 + fr;
                    const int b = row >= NT, pp = row - b * NT;
                    const bool lat = pp >= NCTX;
                    const int tt = pp - NCTX;
#pragma unroll
                    for (int hb = 0; hb < 2; ++hb) {
                        const int axis = ((c0 >> 5) + hb) & 1;
                        const int pos = axis ? (tt & 63) : (tt >> 6);
#pragma unroll
                        for (int j = 0; j < 4; ++j) {
                            float x1 = acc[2 * hb][mf][j], x2 = acc[2 * hb + 1][mf][j];
                            if (lat) { const f32x2 cs = rope[pos * 16 + 4 * fq + j]; const float o1 = x1 * cs[0] - x2 * cs[1], o2 = x1 * cs[1] + x2 * cs[0]; x1 = o1; x2 = o2; }
                            acc[2 * hb][mf][j] = x1 * qs; acc[2 * hb + 1][mf][j] = x2 * qs;
                        }
                    }
                }
            } else if (c0 >= C_RK && c0 < C_RV) {
#pragma unroll
                for (int nf = 0; nf < 4; ++nf)
#pragma unroll
                    for (int mf = 0; mf < 3; ++mf) acc[nf][mf] *= 0.125f;
            }
#pragma unroll
            for (int nf = 0; nf < 4; ++nf)
#pragma unroll
                for (int mf = 0; mf < 3; ++mf) {
                    const f32x4 v = acc[nf][mf];
                    *(LAS u32x2*)(W_ + (mf * 16 + fr) * 144 + nf * 32 + fq * 8) = (u32x2){pk_bf16(v[0], v[1]), pk_bf16(v[2], v[3])};
                }
#pragma unroll
            for (int it = 0; it < 6; ++it) {
                const int row = it * 8 + (lane >> 3), ch = lane & 7;
                *(u32x4*)(P + (size_t)(r0 + row) * INW + c0 + ch * 8) = *(LAS u32x4*)(W_ + row * 144 + ch * 16);
            }
            const bool isv = c0 >= C_DV && c0 < C_PU, isk = c0 >= C_RK && c0 < C_RV, isr = c0 >= C_RV && c0 < C_RG;
            if (isv || isk || isr) {
                const int frp = isv ? ((fr & 3) | (((fr >> 2) == 1 ? 2 : ((fr >> 2) == 2 ? 1 : (fr >> 2))) << 2)) : fr;
                LAS bf16_t* T_ = (LAS bf16_t*)W_;
#pragma unroll
                for (int nf = 0; nf < 4; ++nf)
#pragma unroll
                    for (int mf = 0; mf < 3; ++mf)
#pragma unroll
                        for (int j = 0; j < 4; ++j) T_[(nf * 16 + 4 * fq + j) * 56 + mf * 16 + frp] = to_bf16(acc[nf][mf][j]);
                const int b = r0 >= NT, pp0 = r0 - b * NT;
                bf16_t* base; int nrows_per_head;
                if (isv) { const int cc = c0 - C_DV; base = VT + ((size_t)(b * 4 + (cc >> 7)) * 128 + (cc & 127)) * NT + pp0; }
                else if (isk) { const int cc = c0 - C_RK; base = RKT + ((size_t)(b * 4 + (cc >> 6)) * 64) * NT + pp0; }
                else { const int cc = c0 - C_RV; base = RVT + ((size_t)(b * 4 + (cc >> 6)) * 64) * NT + pp0; }
                (void)nrows_per_head;
#pragma unroll
                for (int it = 0; it < 6; ++it) {
                    const int sl = it * 64 + lane, n = sl / 6, pc = sl % 6;
                    *(u32x4*)(base + (size_t)n * NT + pc * 8) = *(LAS u32x4*)(W_ + n * 112 + pc * 16);
                }
            }
        };
        gemm192(H, DM, W, DM, DM / 64, tm * 192, tn * 128, lds, epi);
    }
}

DI void phase_ret_sum_pool(const Params& p0, int l, LAS unsigned char* lds) {
    const Params p = launder(p0); l = launder_s(l);
    const int tid = tid_(), lane = tid & 63, wid = tid >> 6, fr = lane & 15, g = lane >> 4;
    const float* scal = (const float*)(p.ws + WS_SCAL) + l * 16;
    const bf16_t* RKT = (const bf16_t*)(p.ws + WS_RKT);
    const bf16_t* RVT = (const bf16_t*)(p.ws + WS_RVT);
    float* UF = (float*)(p.ws + WS_UF);
    float* UB = (float*)(p.ws + WS_UB);
    for (int u = bid_(); u < NB * 4 * NCHUNK; u += gridDim.x) {
        const int c = u % NCHUNK, bh = u / NCHUNK, h = bh & 3;
        const int dir = wid >> 2, eb = wid & 3;
        const float l2 = dir ? scal[6 + h] : scal[2 + h];
        const bf16_t* vrow = RVT + ((size_t)bh * 64 + eb * 16 + fr) * NT + c * 128;
        f32x4 acc[4];
#pragma unroll
        for (int db = 0; db < 4; ++db) acc[db] = (f32x4){0.f, 0.f, 0.f, 0.f};
#pragma unroll
        for (int ks = 0; ks < 4; ++ks) {
            const int j0 = ks * 32 + 8 * g;
            const bf16x8 af = *(const bf16x8*)(vrow + j0);
            float w[8];
#pragma unroll
            for (int jj = 0; jj < 8; ++jj) { const int j = j0 + jj; w[jj] = fast_exp2((dir ? (float)j : (float)(127 - j)) * l2); }
#pragma unroll
            for (int db = 0; db < 4; ++db) {
                const u32x4 kr = *(const u32x4*)(RKT + ((size_t)bh * 64 + db * 16 + fr) * NT + c * 128 + j0);
                u32x4 kw;
#pragma unroll
                for (int q = 0; q < 4; ++q) kw[q] = pk_bf16(bf_lo(kr[q]) * w[2 * q], bf_hi(kr[q]) * w[2 * q + 1]);
                acc[db] = MFMA16(af, as_bf16x8(kw), acc[db]);
            }
        }
        const int cidx = dir ? (c >= 2 ? c - 2 : 64 + c) : c;
        float* U = (dir ? UB : UF) + ((size_t)bh * NCHUNK + cidx) * 4096;
#pragma unroll
        for (int db = 0; db < 4; ++db)
#pragma unroll
            for (int j = 0; j < 4; ++j) U[(eb * 16 + 4 * g + j) * 64 + db * 16 + fr] = acc[db][j];
    }
    LAS float* ul = (LAS float*)lds;
    LAS float* dT = ul + 48 * 256;
    const bf16_t* P = (const bf16_t*)(p.ws + WS_P);
    bf16_t* MIX = (bf16_t*)(p.ws + WS_MIX);
    const float* pw = p.pool_w + (size_t)l * 4 * 64 * 64;
    const float* ps = p.pool_scale + l * 256;
    for (int u = bid_(); u < MROWS / 32; u += gridDim.x) {
        const int r0 = u * 32;
        const int b = r0 >= NT, pp0 = r0 - b * NT;
        const int s0 = pp0 < NCTX ? b * NT : b * NT + NCTX, s1 = pp0 < NCTX ? b * NT + NCTX : (b + 1) * NT;
        __syncthreads();
        for (int i = tid; i < 48 * 64; i += NTHREADS) {
            const int rr = i >> 6, c4 = (i & 63) * 4;
            const int row = r0 - 8 + rr;
            f32x4 v = {0.f, 0.f, 0.f, 0.f};
            if (row >= s0 && row < s1) { const u32x2 w = *(const u32x2*)(P + (size_t)row * INW + C_PU + c4); v = (f32x4){bf_lo(w[0]), bf_hi(w[0]), bf_lo(w[1]), bf_hi(w[1])}; }
            *(LAS f32x4*)(ul + rr * 256 + c4) = v;
        }
        __syncthreads();
        for (int i = tid; i < 32 * 256; i += NTHREADS) {
            const int rr = i >> 8, c = i & 255, gi = c >> 6;
            const int w = 2 << gi;
            const int row = r0 + rr;
            int lo = row - w / 2, hi = row + w - w / 2;
            lo = lo < s0 ? s0 : lo; hi = hi > s1 ? s1 : hi;
            float s = 0.f;
            for (int q = lo; q < hi; ++q) s += ul[(q - r0 + 8) * 256 + c];
            dT[c * 36 + rr] = s / (float)(hi - lo) - ul[(rr + 8) * 256 + c];
        }
        __syncthreads();
        {
            const int oc = tid & 255, rh = (tid >> 8) * 16, gi = oc >> 6, e = oc & 63;
            float acc[16];
#pragma unroll
            for (int i = 0; i < 16; ++i) acc[i] = 0.f;
            float wreg[64];
#pragma unroll
            for (int c = 0; c < 64; ++c) wreg[c] = pw[(gi * 64 + c) * 64 + e];
#pragma unroll
            for (int c = 0; c < 64; ++c) {
                const float wv = wreg[c];
                const LAS float* dr = dT + (gi * 64 + c) * 36 + rh;
#pragma unroll
                for (int i = 0; i < 4; ++i) { const f32x4 d = *(const LAS f32x4*)(dr + 4 * i); acc[4 * i] += d[0] * wv; acc[4 * i + 1] += d[1] * wv; acc[4 * i + 2] += d[2] * wv; acc[4 * i + 3] += d[3] * wv; }
            }
            const float sc = ps[oc];
#pragma unroll
            for (int i = 0; i < 16; ++i) MIX[(size_t)(r0 + rh + i) * DM + 512 + oc] = to_bf16(acc[i] * sc);
        }
    }
    __syncthreads();
}

DI void phase_ret_scan(const Params& p0, int l) {
    const Params p = launder(p0); l = launder_s(l);
    const float* scal = (const float*)(p.ws + WS_SCAL) + l * 16;
    const float* UF = (const float*)(p.ws + WS_UF); const float* UB = (const float*)(p.ws + WS_UB);
    float* SF = (float*)(p.ws + WS_SF); float* SB = (float*)(p.ws + WS_SB);
    for (int i = bid_() * NTHREADS + tid_(); i < 2 * NB * 4 * 4096; i += gridDim.x * NTHREADS) {
        const int dir = i / (NB * 4 * 4096), rem = i % (NB * 4 * 4096), bh = rem >> 12, el = rem & 4095, h = bh & 3;
        const float G = fast_exp2(128.0f * (dir ? scal[6 + h] : scal[2 + h]));
        float S = 0.f;
        if (dir == 0) { for (int c = 0; c < NCHUNK; ++c) { const size_t o = ((size_t)bh * NCHUNK + c) * 4096 + el; SF[o] = S; S = S * G + UF[o]; } }
        else { for (int c = NCHUNK - 1; c >= 0; --c) { const size_t o = ((size_t)bh * NCHUNK + c) * 4096 + el; SB[o] = S; S = S * G + UB[o]; } }
    }
}

DI void attn_unit(const Params& p, int b, int h, int q_p0, int ntile, float lam, float oscale, LAS unsigned char* lds) {
    const int tid = tid_(), lane = tid & 63, wid = __builtin_amdgcn_readfirstlane(tid >> 6), map = wid >> 2, wq = wid & 3, r = lane & 31, hh = lane >> 5;
    const bf16_t* P = (const bf16_t*)(p.ws + WS_P);
    const bf16_t* VT = (const bf16_t*)(p.ws + WS_VT);
    bf16_t* MIX = (bf16_t*)(p.ws + WS_MIX);
    const size_t rowbase = (size_t)b * NT;
    const int qrow = q_p0 + wq * 32 + r;
    bf16x8 qf[4];
#pragma unroll
    for (int ks = 0; ks < 4; ++ks) qf[ks] = *(const bf16x8*)(P + (rowbase + qrow) * INW + C_DQ + h * 128 + map * 64 + ks * 16 + hh * 8);
    constexpr int ASTG = 32768;
    const bf16_t* ksrc0; const bf16_t* ksrc1; const bf16_t* vsrc0; const bf16_t* vsrc1;
    { const int key = tid >> 4, ph = tid & 15, c = ph ^ (key & 15);
      ksrc0 = P + (rowbase + key) * INW + C_DK + h * 128 + c * 8; ksrc1 = ksrc0 + (size_t)32 * INW;
      const int e = tid >> 3, pv = tid & 7, cv = pv ^ ((e >> 1) & 7);
      vsrc0 = VT + ((size_t)(b * 4 + h) * 128 + e) * NT + cv * 8; vsrc1 = vsrc0 + (size_t)64 * NT; }
    const int ddst = wid * 1024;
#define ATT_ISSUE(S, KT) do { LAS unsigned char* _s = lds + (S) * ASTG + ddst; const size_t _ko = (size_t)(KT) * 64 * INW; const int _vo = (KT) * 64; \
        dma16(ksrc0 + _ko, _s); dma16(ksrc1 + _ko, _s + 8192); dma16(vsrc0 + _vo, _s + 16384); dma16(vsrc1 + _vo, _s + 24576); } while (0)
    f32x16 o[4];
#pragma unroll
    for (int eb = 0; eb < 4; ++eb)
#pragma unroll
        for (int i = 0; i < 16; ++i) o[eb][i] = 0.f;
    f32x16 negm;
#pragma unroll
    for (int i = 0; i < 16; ++i) negm[i] = 0.f;
    float m_run = 0.f, l_run = 0.f;
    __syncthreads();
    ATT_ISSUE(0, 0);
    if (ntile > 1) ATT_ISSUE(1, 1);
    if (ntile > 2) ATT_ISSUE(2, 2);
    for (int kt = 0; kt < ntile; ++kt) {
        PRB_T0(1, lds);
        if (kt + 2 < ntile) WAIT_VM(8); else if (kt + 1 < ntile) WAIT_VM(4); else WAIT_VM(0);
        asm volatile("s_waitcnt lgkmcnt(0)" ::: "memory");
        __builtin_amdgcn_s_barrier();
        PRB_T1(1, lds); PRB_T0(2, lds);
        const int st = kt & 3, st2 = (kt + 3) & 3;
        if (map == 0 && kt + 3 < ntile) ATT_ISSUE(st2, kt + 3);
        LAS unsigned char* L = lds + st * ASTG;
        bf16x8 kf[8], va[4], vb[4];
#pragma unroll
        for (int ks = 0; ks < 4; ++ks) {
            const int ch = map * 8 + ks * 2 + hh;
            const int off = r * 256 + ((ch ^ (r & 15)) << 4);
            kf[2 * ks] = *(LAS bf16x8*)(L + off);
            kf[2 * ks + 1] = *(LAS bf16x8*)(L + off + 32 * 256);
        }
#define ATT_VREAD(dst, S_) do { _Pragma("unroll") for (int eb = 0; eb < 4; ++eb) { const int e = eb * 32 + r; \
            dst[eb] = *(LAS bf16x8*)(L + 16384 + e * 128 + ((((S_) * 2 + hh) ^ ((e >> 1) & 7)) << 4)); } } while (0)
#define ATT_PACK(dst, SRC, B_) do { u32x4 _pw; _Pragma("unroll") for (int q = 0; q < 4; ++q) _pw[q] = pk_bf16(SRC[(B_) + 2 * q], SRC[(B_) + 2 * q + 1]); dst = as_bf16x8(_pw); } while (0)
#define ATT_EXP8(SRC, B_) do { _Pragma("unroll") for (int i = 0; i < 8; ++i) { SRC[(B_) + i] = fast_exp2(SRC[(B_) + i]); rsum += SRC[(B_) + i]; pmx = fmaxf(pmx, SRC[(B_) + i]); } } while (0)
        ATT_VREAD(va, 0);
        asm volatile("" ::: "memory");
        f32x16 s0 = negm, s1 = negm;
#pragma unroll
        for (int ks = 0; ks < 4; ++ks) { s0 = MFMA32(kf[2 * ks], qf[ks], s0); s1 = MFMA32(kf[2 * ks + 1], qf[ks], s1); }
        if (map == 1 && kt + 3 < ntile) ATT_ISSUE(st2, kt + 3);
        PRB_T1(2, lds); PRB_T0(3, lds);
        if (kt == 0) {
            float mx = fmaxf(fmaxf(s0[0], s0[1]), s0[2]);
#pragma unroll
            for (int i = 3; i < 15; i += 2) mx = fmaxf(fmaxf(mx, s0[i]), s0[i + 1]);
            mx = fmaxf(mx, s0[15]);
#pragma unroll
            for (int i = 0; i < 16; i += 2) mx = fmaxf(fmaxf(mx, s1[i]), s1[i + 1]);
            mx = fmaxf(mx, __shfl_xor(mx, 32));
            m_run = mx;
#pragma unroll
            for (int i = 0; i < 16; ++i) { s0[i] -= mx; s1[i] -= mx; negm[i] = -mx; }
        }
        float rsum = 0.f, pmx = 0.f;
        bf16x8 pb;
        ATT_EXP8(s0, 0); ATT_PACK(pb, s0, 0);
        ATT_VREAD(vb, 1); asm volatile("" ::: "memory");
#pragma unroll
        for (int eb = 0; eb < 4; ++eb) o[eb] = MFMA32(va[eb], pb, o[eb]);
        ATT_EXP8(s0, 8); ATT_PACK(pb, s0, 8);
        ATT_VREAD(va, 2); asm volatile("" ::: "memory");
#pragma unroll
        for (int eb = 0; eb < 4; ++eb) o[eb] = MFMA32(vb[eb], pb, o[eb]);
        ATT_EXP8(s1, 0); ATT_PACK(pb, s1, 0);
        ATT_VREAD(vb, 3); asm volatile("" ::: "memory");
#pragma unroll
        for (int eb = 0; eb < 4; ++eb) o[eb] = MFMA32(va[eb], pb, o[eb]);
        ATT_EXP8(s1, 8); ATT_PACK(pb, s1, 8);
#pragma unroll
        for (int eb = 0; eb < 4; ++eb) o[eb] = MFMA32(vb[eb], pb, o[eb]);
        l_run += rsum;
        PRB_T1(3, lds);
#undef ATT_VREAD
#undef ATT_PACK
#undef ATT_EXP8
        pmx = fmaxf(pmx, __shfl_xor(pmx, 32));
        if (__any(pmx > 256.0f)) {
            const float d = pmx > 256.0f ? __builtin_amdgcn_logf(pmx) : 0.f;
            const float alpha = fast_exp2(-d);
            m_run += d; l_run *= alpha;
#pragma unroll
            for (int i = 0; i < 16; ++i) negm[i] = -m_run;
#pragma unroll
            for (int eb = 0; eb < 4; ++eb)
#pragma unroll
                for (int i = 0; i < 16; ++i) o[eb][i] *= alpha;
        }
    }
#undef ATT_ISSUE
    __syncthreads();
    const float lt = l_run + __shfl_xor(l_run, 32);
    const float inv = 1.0f / lt;
    LAS float* X = (LAS float*)lds;
    if (map == 1) {
#pragma unroll
        for (int eb = 0; eb < 4; ++eb)
#pragma unroll
            for (int i = 0; i < 16; ++i) X[(wq * 64 + eb * 16 + i) * 64 + lane] = o[eb][i] * inv;
    }
    __syncthreads();
    if (map == 0) {
        float ss = 0.f;
#pragma unroll
        for (int eb = 0; eb < 4; ++eb)
#pragma unroll
            for (int i = 0; i < 16; ++i) { const float v = o[eb][i] * inv - lam * X[(wq * 64 + eb * 16 + i) * 64 + lane]; o[eb][i] = v; ss += v * v; }
        ss += __shfl_xor(ss, 32);
        const float sc = rsqrtf(ss * (1.0f / 128.0f) + RMS_EPS) * oscale;
        LAS unsigned char* W = lds + 65536 + wq * 8704;
#pragma unroll
        for (int eb = 0; eb < 4; ++eb)
#pragma unroll
            for (int q = 0; q < 4; ++q) {
                const int e = eb * 32 + 8 * q + 4 * hh;
                const u32x2 w = {pk_bf16(o[eb][4 * q] * sc, o[eb][4 * q + 1] * sc), pk_bf16(o[eb][4 * q + 2] * sc, o[eb][4 * q + 3] * sc)};
                *(LAS u32x2*)(W + r * 272 + e * 2) = w;
            }
#pragma unroll
        for (int it = 0; it < 8; ++it) {
            const int row = it * 4 + (lane >> 4), ch = lane & 15;
            const u32x4 v = *(LAS u32x4*)(W + row * 272 + ch * 16);
            *(u32x4*)(MIX + (rowbase + q_p0 + wq * 32 + row) * DM + h * 128 + ch * 8) = v;
        }
    }
    __syncthreads();
}

DI void ret_unit(const Params& p, int l, int b, int h, int c) {
    const int tid = tid_(), lane = tid & 63, wid = tid >> 6, fr = lane & 15, g = lane >> 4;
    const float* scal = (const float*)(p.ws + WS_SCAL) + l * 16;
    const float lf2 = scal[2 + h], lb2 = scal[6 + h];
    const bf16_t* P = (const bf16_t*)(p.ws + WS_P);
    const bf16_t* RVT = (const bf16_t*)(p.ws + WS_RVT);
    const float* SF = (const float*)(p.ws + WS_SF); const float* SB = (const float*)(p.ws + WS_SB);
    bf16_t* MIX = (bf16_t*)(p.ws + WS_MIX);
    const int bh = b * 4 + h;
    const size_t row0 = (size_t)b * NT + c * 128;
    const int iloc = wid * 16 + fr;
    u32x4 qraw[2];
#pragma unroll
    for (int ks = 0; ks < 2; ++ks) qraw[ks] = *(const u32x4*)(P + (row0 + iloc) * INW + C_RQ + h * 64 + ks * 32 + 8 * g);
    f32x4 st[8];
#pragma unroll
    for (int jb = 0; jb < 8; ++jb) {
        st[jb] = (f32x4){0.f, 0.f, 0.f, 0.f};
#pragma unroll
        for (int ks = 0; ks < 2; ++ks) {
            const bf16x8 kf = *(const bf16x8*)(P + (row0 + jb * 16 + fr) * INW + C_RK + h * 64 + ks * 32 + 8 * g);
            st[jb] = MFMA16(kf, as_bf16x8(qraw[ks]), st[jb]);
        }
    }
#pragma unroll
    for (int jb = 0; jb < 8; ++jb)
#pragma unroll
        for (int q = 0; q < 4; ++q) {
            const int j = jb * 16 + 4 * g + q;
            const int d = iloc - j;
            const float w = d > 0 ? fast_exp2((float)d * lf2) : (d < 0 ? fast_exp2((float)(-d) * lb2) : 2.0f);
            st[jb][q] *= w;
        }
    f32x4 ot[4];
#pragma unroll
    for (int eb = 0; eb < 4; ++eb) ot[eb] = (f32x4){0.f, 0.f, 0.f, 0.f};
#pragma unroll
    for (int jj = 0; jj < 4; ++jj) {
        const u32x4 pw = {pk_bf16(st[2 * jj][0], st[2 * jj][1]), pk_bf16(st[2 * jj][2], st[2 * jj][3]), pk_bf16(st[2 * jj + 1][0], st[2 * jj + 1][1]), pk_bf16(st[2 * jj + 1][2], st[2 * jj + 1][3])};
#pragma unroll
        for (int eb = 0; eb < 4; ++eb) {
            const bf16_t* vp = RVT + ((size_t)bh * 64 + eb * 16 + fr) * NT + c * 128 + jj * 32 + 4 * g;
            const u32x2 v0 = *(const u32x2*)vp, v1 = *(const u32x2*)(vp + 16);
            const u32x4 va = {v0[0], v0[1], v1[0], v1[1]};
            ot[eb] = MFMA16(as_bf16x8(va), as_bf16x8(pw), ot[eb]);
        }
    }
    const float df = fast_exp2((float)(iloc + 1) * lf2), db = fast_exp2((float)(128 - iloc) * lb2);
    const int vc = c >= 2 ? c - 2 : 64 + c;
    const float* sf = SF + ((size_t)bh * NCHUNK + c) * 4096;
    const float* sb = SB + ((size_t)bh * NCHUNK + vc) * 4096;
#pragma unroll
    for (int ks = 0; ks < 2; ++ks) {
        u32x4 qf, qb;
#pragma unroll
        for (int q = 0; q < 4; ++q) { const float a = bf_lo(qraw[ks][q]), bb = bf_hi(qraw[ks][q]); qf[q] = pk_bf16(a * df, bb * df); qb[q] = pk_bf16(a * db, bb * db); }
#pragma unroll
        for (int eb = 0; eb < 4; ++eb) {
            const float* s1 = sf + (eb * 16 + fr) * 64 + ks * 32 + 8 * g;
            const float* s2 = sb + (eb * 16 + fr) * 64 + ks * 32 + 8 * g;
            const f32x4 a0 = *(const f32x4*)s1, a1 = *(const f32x4*)(s1 + 4), c0 = *(const f32x4*)s2, c1 = *(const f32x4*)(s2 + 4);
            const u32x4 sa = {pk_bf16(a0[0], a0[1]), pk_bf16(a0[2], a0[3]), pk_bf16(a1[0], a1[1]), pk_bf16(a1[2], a1[3])};
            const u32x4 sc = {pk_bf16(c0[0], c0[1]), pk_bf16(c0[2], c0[3]), pk_bf16(c1[0], c1[1]), pk_bf16(c1[2], c1[3])};
            ot[eb] = MFMA16(as_bf16x8(sa), as_bf16x8(qf), ot[eb]);
            ot[eb] = MFMA16(as_bf16x8(sc), as_bf16x8(qb), ot[eb]);
        }
    }
    float s = 0.f;
#pragma unroll
    for (int eb = 0; eb < 4; ++eb) s += (ot[eb][0] + ot[eb][1]) + (ot[eb][2] + ot[eb][3]);
    s += __shfl_xor(s, 16); s += __shfl_xor(s, 32);
    const float mu = s * (1.0f / 64.0f);
    float q2 = 0.f;
#pragma unroll
    for (int eb = 0; eb < 4; ++eb)
#pragma unroll
        for (int q = 0; q < 4; ++q) { const float d = ot[eb][q] - mu; q2 += d * d; }
    q2 += __shfl_xor(q2, 16); q2 += __shfl_xor(q2, 32);
    const float rstd = rsqrtf(q2 * (1.0f / 64.0f) + LN_EPS);
#pragma unroll
    for (int eb = 0; eb < 4; ++eb) {
        const int e = eb * 16 + 4 * g;
        const u32x2 gw = *(const u32x2*)(P + (row0 + iloc) * INW + C_RG + h * 64 + e);
        const float g0 = bf_lo(gw[0]), g1 = bf_hi(gw[0]), g2 = bf_lo(gw[1]), g3 = bf_hi(gw[1]);
        u32x2 w = {pk_bf16((ot[eb][0] - mu) * rstd * silu_f(g0), (ot[eb][1] - mu) * rstd * silu_f(g1)),
                   pk_bf16((ot[eb][2] - mu) * rstd * silu_f(g2), (ot[eb][3] - mu) * rstd * silu_f(g3))};
        *(u32x2*)(MIX + (row0 + iloc) * DM + 768 + h * 64 + e) = w;
    }
}

DI void phase_attn(const Params& p0, int l, LAS unsigned char* lds) {
    const Params p = launder(p0); l = launder_s(l);
    const float* scal = (const float*)(p.ws + WS_SCAL) + l * 16;
    const float lam = scal[0], oscale = scal[1];
    const int nunits = NB * 4 * 64 + (l == 0 ? NB * 4 * 2 : 0);
    for (int u = bid_(); u < nunits; u += gridDim.x) {
        int b, h, q0, ntile;
        if (u < NB * 4 * 64) { const int qt = u & 63; h = (u >> 6) & 3; b = u >> 8; q0 = NCTX + qt * 128; ntile = NT / 64; }
        else { const int v = u - NB * 4 * 64; const int qt = v & 1; h = (v >> 1) & 3; b = v >> 3; q0 = qt * 128; ntile = NCTX / 64; }
        attn_unit(p, b, h, q0, ntile, lam, oscale, lds);
    }
}
DI void phase_ret(const Params& p0, int l) {
    const Params p = launder(p0); l = launder_s(l);
    for (int u = bid_(); u < NB * 4 * NCHUNK; u += gridDim.x) {
        const int c = u % NCHUNK, bh = u / NCHUNK;
        if (l == 1 && c < 2) continue;
        ret_unit(p, l, bh >> 2, bh & 3, c);
    }
}

DI void phase_outproj(const Params& p0, int l, LAS unsigned char* lds) {
    const Params p = launder(p0); l = launder_s(l);
    const float* Xin = (const float*)(p.ws + WS_XA);
    const bf16_t* A = (const bf16_t*)(p.ws + WS_MIX);
    const bf16_t* W = (const bf16_t*)(p.ws + WS_WOUT) + (size_t)l * DM * DM;
    float* V1 = (float*)(p.ws + WS_V1);
    const float* modv = (const float*)(p.ws + WS_MODV) + (size_t)l * 3 * 6144;
    for (int u = bid_(); u < (MROWS / 192) * 8; u += gridDim.x) {
        const int tm = u >> 3, tn = u & 7;
        auto epi = [&](f32x4 (&acc)[4][3], int wm, int wn, int fr, int fq, int lane, int wid) {
            const int c0 = tn * 128 + wn * 64, r0 = tm * 192 + wm * 48;
            LAS unsigned char* W_ = g2_stage(lds, wid);
#pragma unroll
            for (int nf = 0; nf < 4; ++nf)
#pragma unroll
                for (int mf = 0; mf < 3; ++mf) *(LAS f32x4*)(W_ + (mf * 16 + fr) * 272 + nf * 64 + fq * 16) = acc[nf][mf];
#pragma unroll
            for (int it = 0; it < 12; ++it) {
                const int row = it * 4 + (lane >> 4), ch = lane & 15;
                const int grow = r0 + row;
                const f32x4 y = *(LAS f32x4*)(W_ + row * 272 + ch * 16);
                const f32x4 xv = *(const f32x4*)(Xin + (size_t)grow * DM + c0 + ch * 4);
                const f32x4 g2 = *(const f32x4*)(modv + (size_t)row_sel(grow) * 6144 + 2 * 1024 + c0 + ch * 4);
                *(f32x4*)(V1 + (size_t)grow * DM + c0 + ch * 4) = (f32x4){DN_ALPHA * xv[0] + g2[0] * y[0], DN_ALPHA * xv[1] + g2[1] * y[1], DN_ALPHA * xv[2] + g2[2] * y[2], DN_ALPHA * xv[3] + g2[3] * y[3]};
            }
        };
        gemm192(A, DM, W, DM, DM / 64, tm * 192, tn * 128, lds, epi);
    }
}

DI void phase_ln_mid(const Params& p0, int l) {
    const Params p = launder(p0); l = launder_s(l);
    float* Xout = (float*)(p.ws + WS_XB);
    const int lane = tid_() & 63, wid = tid_() >> 6;
    const float* V1 = (const float*)(p.ws + WS_V1);
    bf16_t* TOK = (bf16_t*)(p.ws + WS_TOK);
    const float* modv = (const float*)(p.ws + WS_MODV) + (size_t)l * 3 * 6144;
    const float* lg = p.ln_g + (size_t)(l * 2 + 0) * DM; const float* lb = p.ln_b + (size_t)(l * 2 + 0) * DM;
    for (int r = bid_() * 8 + wid; r < MROWS; r += gridDim.x * 8) {
        f32x4 v[4];
#pragma unroll
        for (int i = 0; i < 4; ++i) v[i] = *(const f32x4*)(V1 + (size_t)r * DM + lane * 4 + i * 256);
        float mu, rstd; ln_stats(v, mu, rstd);
#pragma unroll
        for (int i = 0; i < 4; ++i) {
            const int c = lane * 4 + i * 256;
            const f32x4 gg = *(const f32x4*)(lg + c), bb = *(const f32x4*)(lb + c);
#pragma unroll
            for (int j = 0; j < 4; ++j) v[i][j] = (v[i][j] - mu) * rstd * gg[j] + bb[j];
            *(f32x4*)(Xout + (size_t)r * DM + c) = v[i];
        }
        const float* mv = modv + (size_t)row_sel(r) * 6144;
        modulate_store(v, mv + 3 * 1024, mv + 4 * 1024, TOK + (size_t)r * DM, lane);
    }
}

DI void phase_router(const Params& p0, int l, LAS unsigned char* lds) {
    const Params p = launder(p0); l = launder_s(l);
    const bf16_t* A = (const bf16_t*)(p.ws + WS_TOK);
    const bf16_t* W = (const bf16_t*)(p.ws + WS_WR) + (size_t)l * 256 * DM;
    float* LG = (float*)(p.ws + WS_LOGIT);
    for (int u = bid_(); u < (MROWS / 192) * 2; u += gridDim.x) {
        const int tm = u >> 1, tn = u & 1;
        auto epi = [&](f32x4 (&acc)[4][3], int wm, int wn, int fr, int fq, int lane, int wid) {
            const int c0 = tn * 128 + wn * 64, r0 = tm * 192 + wm * 48;
            LAS unsigned char* W_ = g2_stage(lds, wid);
#pragma unroll
            for (int nf = 0; nf < 4; ++nf)
#pragma unroll
                for (int mf = 0; mf < 3; ++mf) *(LAS f32x4*)(W_ + (mf * 16 + fr) * 272 + nf * 64 + fq * 16) = acc[nf][mf];
#pragma unroll
            for (int it = 0; it < 12; ++it) {
                const int row = it * 4 + (lane >> 4), ch = lane & 15;
                *(f32x4*)(LG + (size_t)(r0 + row) * 256 + c0 + ch * 4) = *(LAS f32x4*)(W_ + row * 272 + ch * 16);
            }
        };
        gemm192(A, DM, W, DM, DM / 64, tm * 192, tn * 128, lds, epi);
    }
}

DI void phase_topk(const Params& p0, int l, LAS unsigned char* lds) {
    const Params p = launder(p0); l = launder_s(l);
    const int lane = tid_() & 63, wid = tid_() >> 6, rs = lane >> 3, g = lane & 7;
    const float* LG = (const float*)(p.ws + WS_LOGIT);
    const float* bias = p.router_bias + l * 256 + g * 32;
    int* EIDX = (int*)(p.ws + WS_EIDX); float* GATE = (float*)(p.ws + WS_GATE);
    int* RANK = (int*)(p.ws + WS_RANK); int* HIST = (int*)(p.ws + WS_HIST);
    LAS int* hist = (LAS int*)lds;
    if (tid_() < 256) hist[tid_()] = 0;
    __syncthreads();
    const int chunk = (MROWS + (int)gridDim.x - 1) / (int)gridDim.x, r_begin = bid_() * chunk, r_end = (r_begin + chunk) < MROWS ? (r_begin + chunk) : MROWS;
    for (int base = r_begin + wid * 8; base < r_end; base += 64) {
        const int row = base + rs; const bool valid = row < r_end;
        const float* lp = LG + (size_t)(valid ? row : r_begin) * 256 + g * 32;
        float sc[32], gv[32];
#pragma unroll
        for (int q = 0; q < 8; ++q) {
            const f32x4 lg = *(const f32x4*)(lp + 4 * q), bv = *(const f32x4*)(bias + 4 * q);
#pragma unroll
            for (int j = 0; j < 4; ++j) { sc[4 * q + j] = 1.0f / (1.0f + __expf(-lg[j])); gv[4 * q + j] = sc[4 * q + j] + bv[j]; }
        }
        float m1 = fmaxf(gv[0], gv[1]), m2 = fminf(gv[0], gv[1]);
#pragma unroll
        for (int i = 2; i < 32; ++i) { const float v = gv[i]; m2 = fmaxf(m2, fminf(m1, v)); m1 = fmaxf(m1, v); }
        const float gs = m1 + m2;
        int rank = 0;
#pragma unroll
        for (int g2 = 0; g2 < 8; ++g2) { const float o = __shfl(gs, (lane & 56) + g2); rank += (o > gs || (o == gs && g2 < g)) ? 1 : 0; }
        if (rank >= 4) {
#pragma unroll
            for (int i = 0; i < 32; ++i) gv[i] = -INFINITY;
        }
        float ssum = 0.f, mysc = 0.f; int myidx = 0;
#pragma unroll 1
        for (int k = 0; k < TOPK; ++k) {
            float bv = gv[0], bs = sc[0]; int bi = 0;
#pragma unroll
            for (int i = 1; i < 32; ++i) { const bool gt = gv[i] > bv; bv = gt ? gv[i] : bv; bs = gt ? sc[i] : bs; bi = gt ? i : bi; }
            int gi = g * 32 + bi;
#pragma unroll
            for (int o = 1; o < 8; o <<= 1) {
                const float ov = __shfl_xor(bv, o), os = __shfl_xor(bs, o); const int oi = __shfl_xor(gi, o);
                const bool tk = ov > bv || (ov == bv && oi < gi);
                bv = tk ? ov : bv; bs = tk ? os : bs; gi = tk ? oi : gi;
            }
            if ((gi >> 5) == g) {
                const int oi = gi & 31;
#pragma unroll
                for (int i = 0; i < 32; ++i) gv[i] = (i == oi) ? -INFINITY : gv[i];
            }
            ssum += bs;
            if (g == k) { mysc = bs; myidx = gi; }
        }
        if (valid) {
            EIDX[(size_t)row * 8 + g] = myidx;
            GATE[(size_t)row * 8 + g] = mysc / ssum * 2.5f;
            RANK[(size_t)row * 8 + g] = __hip_atomic_fetch_add(hist + myidx, 1, __ATOMIC_RELAXED, __HIP_MEMORY_SCOPE_WORKGROUP);
        }
    }
    __syncthreads();
    if (tid_() < 256) HIST[(size_t)bid_() * 256 + tid_()] = hist[tid_()];
    __syncthreads();
}

DI void phase_scatter(const Params& p0, int l, LAS unsigned char* lds) {
    const Params p = launder(p0); l = launder_s(l);
    LAS int* off = (LAS int*)lds;
    LAS int* toff = off + 260;
    LAS int* tot = toff + 260;
    LAS int* base = tot + 256;
    const int tid = tid_(), bid = bid_(), G = gridDim.x;
    const int* HIST = (const int*)(p.ws + WS_HIST);
    const int* RANK = (const int*)(p.ws + WS_RANK);
    int* ntl = (int*)(p.ws + CTL_NTILES) + l;
    int* TILES = (int*)(p.ws + WS_TILES);
    const int* EIDX = (const int*)(p.ws + WS_EIDX);
    int* SORT = (int*)(p.ws + WS_SORT);
    if (tid < 256) {
        int t = 0, bs = 0;
#pragma unroll 16
        for (int b2 = 0; b2 < G; ++b2) { const int v = HIST[(size_t)b2 * 256 + tid]; bs += (b2 < bid) ? v : 0; t += v; }
        tot[tid] = t; base[tid] = bs;
    }
    __syncthreads();
    if (tid == 0) {
        int a = 0, t = 0;
        for (int e = 0; e < 256; ++e) { off[e] = a; toff[e] = t; const int c = tot[e]; a += c; t += (c + 127) >> 7; }
        off[256] = a; toff[256] = t;
    }
    __syncthreads();
    if (bid == 0) {
        if (tid < 256) {
            const int e = tid, c = off[e + 1] - off[e], nt = toff[e + 1] - toff[e];
            for (int t = 0; t < nt; ++t) { int* T = TILES + (size_t)(toff[e] + t) * 4; T[0] = e; T[1] = off[e] + t * 128; T[2] = (c - t * 128) < 128 ? (c - t * 128) : 128; T[3] = 0; }
        }
        if (tid == 0) *ntl = toff[256];
    }
    const int chunk = (MROWS + G - 1) / G, r_begin = bid * chunk, r_end = (r_begin + chunk) < MROWS ? (r_begin + chunk) : MROWS;
    for (int a = r_begin * 8 + tid; a < r_end * 8; a += NTHREADS) {
        const int e = EIDX[a];
        SORT[off[e] + base[e] + RANK[a]] = a;
    }
    __syncthreads();
}

constexpr int MOE_STG = 40960;
constexpr int MOE_HT = 86016;
constexpr int MOE_INFO = MOE_HT + 65536;
constexpr int IMG_BYTES = 32768, IMG_PER_E = 48;
DI int swz64(int row, int chunk) { return row * 64 + ((chunk ^ ((0 - (row >> 2)) & 3)) << 4); }

struct ImgJob { const float* wp; int ldw; unsigned char* d; int g; };
DI ImgJob img_job(const Params& p, int l, int uu, unsigned char* IMG) {
    const int u = (NEXP + 1) * IMG_PER_E - 1 - uu;
    const int e = u / IMG_PER_E, im = u % IMG_PER_E;
    const int np = tid_();
    ImgJob j;
    if (im < 32) {
        const float* W = e < NEXP ? p.w_egu + ((size_t)l * NEXP + e) * DM * 512 : p.w_sgu + (size_t)l * DM * 512;
        j.ldw = 512; j.wp = W + (size_t)(im * 32) * 512 + (((np >> 4) & 1) * 256 + (np >> 5) * 16 + (np & 15));
    } else {
        const float* W = e < NEXP ? p.w_edn + ((size_t)l * NEXP + e) * 256 * DM : p.w_sdn + (size_t)l * 256 * DM;
        j.ldw = DM; j.wp = W + (size_t)(((im - 32) & 7) * 32) * DM + ((im - 32) >> 3) * 512 + np;
    }
    j.d = IMG + (size_t)u * IMG_BYTES + np * 64; j.g = (0 - (np >> 2)) & 3;
    return j;
}
DI void img_load(const ImgJob& j, float (&wb)[32]) {
#pragma unroll
    for (int kk = 0; kk < 32; ++kk) wb[kk] = __builtin_nontemporal_load(j.wp + (size_t)kk * j.ldw);
}
DI void img_store(const ImgJob& j, const float (&wb)[32]) {
#pragma unroll
    for (int c = 0; c < 4; ++c) { const u32x4 w = {pk_bf16(wb[8 * c], wb[8 * c + 1]), pk_bf16(wb[8 * c + 2], wb[8 * c + 3]), pk_bf16(wb[8 * c + 4], wb[8 * c + 5]), pk_bf16(wb[8 * c + 6], wb[8 * c + 7])}; *(u32x4*)(j.d + ((c ^ j.g) << 4)) = w; }
}
DI void phase_convert_experts(const Params& p0, int l) {
    const Params p = launder(p0); l = launder_s(l);
    unsigned char* IMG = p.ws + WS_WIMG + (size_t)l * (NEXP + 1) * IMG_PER_E * IMG_BYTES;
    const int total = (NEXP + 1) * IMG_PER_E, G = gridDim.x;
    float wa[32], wb[32];
    int u = bid_();
    if (u >= total) return;
    ImgJob ja = img_job(p, l, u, IMG), jb = ja;
    img_load(ja, wa);
    for (;;) {
        const bool hb = u + G < total;
        if (hb) { jb = img_job(p, l, u + G, IMG); img_load(jb, wb); }
        img_store(ja, wa);
        if (!hb) break;
        u += G;
        const bool ha = u + G < total;
        if (ha) { ja = img_job(p, l, u + G, IMG); img_load(ja, wa); }
        img_store(jb, wb);
        if (!ha) break;
        u += G;
    }
}

DI void moe_unit(const Params& p, const unsigned char* img, bf16_t* outbase, bool shared, int r0, int nr, LAS unsigned char* lds) {
    const int t = tid_(), lane = t & 63, wid = __builtin_amdgcn_readfirstlane(t >> 6), fr = lane & 15, fq = lane >> 4, wn = wid & 3, wt = wid >> 2;
    const bf16_t* TOK = (const bf16_t*)(p.ws + WS_TOK);
    const int* SORT = (const int*)(p.ws + WS_SORT);
    LAS int* rowout = (LAS int*)(lds + MOE_INFO);
    const int arow = t >> 2;
    int atok = 0, aout = -1;
    if (arow < nr) { if (shared) { atok = r0 + arow; aout = atok; } else { aout = SORT[r0 + arow]; atok = aout >> 3; } }
    const bf16_t* aptr = TOK + (size_t)atok * DM + (((t & 3) ^ ((0 - (arow >> 2)) & 3)) << 3);
    __syncthreads();
    if ((t & 3) == 0) rowout[arow] = aout;
    const unsigned char* wsrc = img + (size_t)t * 16;
    const int adst = wid * 1024, wdst = 8192 + wid * 1024;
#define MOE_ISSUE1(S, KT) do { LAS unsigned char* _s = lds + (S) * MOE_STG; dma16(aptr + (KT) * 32, _s + adst); \
        const unsigned char* _w = wsrc + (size_t)(KT) * IMG_BYTES; \
        dma16(_w, _s + wdst); dma16(_w + 8192, _s + wdst + 8192); dma16(_w + 16384, _s + wdst + 16384); dma16(_w + 24576, _s + wdst + 24576); } while (0)
#define MOE_ISSUE2(S, IM) do { LAS unsigned char* _s = lds + (S) * IMG_BYTES; const unsigned char* _w = wsrc + (size_t)(IM) * IMG_BYTES; \
        dma16(_w, _s + adst); dma16(_w + 8192, _s + adst + 8192); dma16(_w + 16384, _s + adst + 16384); dma16(_w + 24576, _s + adst + 24576); } while (0)
    f32x4 acc[8][4];
#pragma unroll
    for (int nf = 0; nf < 8; ++nf)
#pragma unroll
        for (int tf = 0; tf < 4; ++tf) acc[nf][tf] = (f32x4){0.f, 0.f, 0.f, 0.f};
    MOE_ISSUE1(0, 0);
    MOE_ISSUE1(1, 1);
    int st = 0;
    for (int kt = 0; kt < 32; ++kt) {
        if (kt < 31) WAIT_VM(5); else WAIT_VM(0);
        asm volatile("s_waitcnt lgkmcnt(0)" ::: "memory");
        __builtin_amdgcn_s_barrier();
        const int st2 = st == 0 ? 2 : st - 1;
        if (wt == 0) { if (kt < 30) MOE_ISSUE1(st2, kt + 2); else if (kt == 31) MOE_ISSUE2(0, 32); }
        LAS unsigned char* S = lds + st * MOE_STG;
        bf16x8 tfr[4];
#pragma unroll
        for (int tf = 0; tf < 4; ++tf) tfr[tf] = *(LAS bf16x8*)(S + swz64(wt * 64 + tf * 16 + fr, fq));
#pragma unroll
        for (int nf = 0; nf < 8; ++nf) {
            const bf16x8 wf = *(LAS bf16x8*)(S + 8192 + swz64(wn * 128 + nf * 16 + fr, fq));
#pragma unroll
            for (int tf = 0; tf < 4; ++tf) acc[nf][tf] = MFMA16(wf, tfr[tf], acc[nf][tf]);
            if (nf == 3 && wt == 1) { if (kt < 30) MOE_ISSUE1(st2, kt + 2); else if (kt == 31) MOE_ISSUE2(0, 32); }
        }
        st = st == 2 ? 0 : st + 1;
    }
#pragma unroll
    for (int i = 0; i < 4; ++i)
#pragma unroll
        for (int tf = 0; tf < 4; ++tf) {
            float hv[4];
#pragma unroll
            for (int j = 0; j < 4; ++j) hv[j] = silu_f(acc[2 * i][tf][j]) * acc[2 * i + 1][tf][j];
            const int tok = wt * 64 + tf * 16 + fr, hc = wn * 64 + i * 16 + 4 * fq;
            const u32x2 w = {pk_bf16(hv[0], hv[1]), pk_bf16(hv[2], hv[3])};
            *(LAS u32x2*)(lds + MOE_HT + tok * 512 + (((hc >> 3) ^ (tok & 15)) << 4) + (hc & 7) * 2) = w;
        }
#pragma unroll 1
    for (int nc = 0; nc < 2; ++nc) {
#pragma unroll
        for (int nf = 0; nf < 8; ++nf)
#pragma unroll
            for (int tf = 0; tf < 4; ++tf) acc[nf][tf] = (f32x4){0.f, 0.f, 0.f, 0.f};
        if (nc == 1) MOE_ISSUE2(0, 40);
        for (int kt = 0; kt < 8; ++kt) {
            WAIT_VM(0);
            asm volatile("s_waitcnt lgkmcnt(0)" ::: "memory");
            __builtin_amdgcn_s_barrier();
            if (wt == 0 && kt < 7) MOE_ISSUE2((kt + 1) & 1, 32 + nc * 8 + kt + 1);
            LAS unsigned char* S = lds + (kt & 1) * IMG_BYTES;
            bf16x8 tfr[4];
#pragma unroll
            for (int tf = 0; tf < 4; ++tf) { const int tok = wt * 64 + tf * 16 + fr; tfr[tf] = *(LAS bf16x8*)(lds + MOE_HT + tok * 512 + (((kt * 4 + fq) ^ (tok & 15)) << 4)); }
#pragma unroll
            for (int nf = 0; nf < 8; ++nf) {
                const bf16x8 wf = *(LAS bf16x8*)(S + swz64(wn * 128 + nf * 16 + fr, fq));
#pragma unroll
                for (int tf = 0; tf < 4; ++tf) acc[nf][tf] = MFMA16(wf, tfr[tf], acc[nf][tf]);
                if (nf == 3 && wt == 1 && kt < 7) MOE_ISSUE2((kt + 1) & 1, 32 + nc * 8 + kt + 1);
            }
        }
        __syncthreads();
        LAS unsigned char* W = lds + wid * 9216;
#pragma unroll
        for (int half = 0; half < 2; ++half) {
#pragma unroll
            for (int nh = 0; nh < 4; ++nh)
#pragma unroll
                for (int tf = 0; tf < 4; ++tf) {
                    const f32x4 v = acc[half * 4 + nh][tf];
                    const u32x2 w = {pk_bf16(v[0], v[1]), pk_bf16(v[2], v[3])};
                    *(LAS u32x2*)(W + (tf * 16 + fr) * 144 + nh * 32 + fq * 8) = w;
                }
#pragma unroll
            for (int it = 0; it < 8; ++it) {
                const int row = it * 8 + (lane >> 3), ch = lane & 7;
                const u32x4 v = *(LAS u32x4*)(W + row * 144 + ch * 16);
                const int ro = rowout[wt * 64 + row];
                if (ro >= 0) *(u32x4*)(outbase + (size_t)ro * DM + nc * 512 + wn * 128 + half * 64 + ch * 8) = v;
            }
        }
        __syncthreads();
    }
#undef MOE_ISSUE1
#undef MOE_ISSUE2
}

DI void phase_moe(const Params& p0, int l, LAS unsigned char* lds) {
    const Params p = launder(p0); l = launder_s(l);
    const int* TILES = (const int*)(p.ws + WS_TILES);
    const int ntl = *((const int*)(p.ws + CTL_NTILES) + l);
    const int G = gridDim.x, bid = bid_();
    int vcu = bid;
    if (p.ph_hi - p.ph_lo > 1) {
        volatile LAS unsigned* bst = (volatile LAS unsigned*)(lds + LDS_BYTES - 16);
        const unsigned xc = bst[2]; unsigned pre = 0;
        for (unsigned j = 0; j < 16; ++j) { const unsigned c = xb_ld((unsigned*)(p.ws + WS_CTL) + XB_XCNT(j)); pre += (j < xc) ? c : 0u; }
        vcu = (int)(pre + bst[3]);
    }
    const int total = ntl + MROWS / 128;
    const unsigned char* IMG = p.ws + WS_WIMG + (size_t)l * (NEXP + 1) * IMG_PER_E * IMG_BYTES;
    for (int u = vcu; u < total; u += G) {
        if (u < ntl) {
            const int e = TILES[u * 4], r0 = TILES[u * 4 + 1], nr = TILES[u * 4 + 2];
            moe_unit(p, IMG + (size_t)e * IMG_PER_E * IMG_BYTES, (bf16_t*)(p.ws + WS_YSLOT), false, r0, nr, lds);
        } else {
            const int tm = u - ntl;
            if (l == 1 && (tm % (NT / 128)) < 2) continue;
            moe_unit(p, IMG + (size_t)NEXP * IMG_PER_E * IMG_BYTES, (bf16_t*)(p.ws + WS_YSH), true, tm * 128, 128, lds);
        }
    }
}

DI void phase_combine(const Params& p0, int l) {
    const Params p = launder(p0); l = launder_s(l);
    const float* X1 = (const float*)(p.ws + WS_XB); float* Xnext = (float*)(p.ws + WS_XA);
    const int lane = tid_() & 63, wid = tid_() >> 6;
    const bf16_t* YSL = (const bf16_t*)(p.ws + WS_YSLOT); const bf16_t* YSH = (const bf16_t*)(p.ws + WS_YSH);
    const float* GATE = (const float*)(p.ws + WS_GATE);
    const float* modv = (const float*)(p.ws + WS_MODV);
    const float* lg = p.ln_g + (size_t)(l * 2 + 1) * DM; const float* lb = p.ln_b + (size_t)(l * 2 + 1) * DM;
    bf16_t* H = (bf16_t*)(p.ws + WS_H);
    for (int r = bid_() * 8 + wid; r < MROWS; r += gridDim.x * 8) {
        const int b = r >= NT, pp = r - b * NT;
        if (l == 1 && pp < NCTX) continue;
        const int sel = pp < NCTX ? 2 : b;
        float gt[8];
#pragma unroll
        for (int k = 0; k < 8; ++k) gt[k] = GATE[(size_t)r * 8 + k];
        const float* g5 = modv + ((size_t)l * 3 + sel) * 6144 + 5 * 1024;
        f32x4 v[4];
        u32x2 sl[4][9]; f32x4 xv4[4];
#pragma unroll
        for (int i = 0; i < 4; ++i) {
            const int c = lane * 4 + i * 256;
            sl[i][8] = *(const u32x2*)(YSH + (size_t)r * DM + c);
#pragma unroll
            for (int k = 0; k < 8; ++k) sl[i][k] = *(const u32x2*)(YSL + ((size_t)r * 8 + k) * DM + c);
            xv4[i] = *(const f32x4*)(X1 + (size_t)r * DM + c);
        }
#pragma unroll
        for (int i = 0; i < 4; ++i) {
            const int c = lane * 4 + i * 256;
            float f0 = bf_lo(sl[i][8][0]), f1 = bf_hi(sl[i][8][0]), f2 = bf_lo(sl[i][8][1]), f3 = bf_hi(sl[i][8][1]);
#pragma unroll
            for (int k = 0; k < 8; ++k) { const u32x2 w = sl[i][k]; f0 += gt[k] * bf_lo(w[0]); f1 += gt[k] * bf_hi(w[0]); f2 += gt[k] * bf_lo(w[1]); f3 += gt[k] * bf_hi(w[1]); }
            const f32x4 xv = xv4[i], gv = *(const f32x4*)(g5 + c);
            v[i] = (f32x4){DN_ALPHA * xv[0] + gv[0] * f0, DN_ALPHA * xv[1] + gv[1] * f1, DN_ALPHA * xv[2] + gv[2] * f2, DN_ALPHA * xv[3] + gv[3] * f3};
        }
        float mu, rstd; ln_stats(v, mu, rstd);
#pragma unroll
        for (int i = 0; i < 4; ++i) {
            const int c = lane * 4 + i * 256;
            const f32x4 gg = *(const f32x4*)(lg + c), bb = *(const f32x4*)(lb + c);
#pragma unroll
            for (int j = 0; j < 4; ++j) v[i][j] = (v[i][j] - mu) * rstd * gg[j] + bb[j];
            if (l == 1) *(f32x4*)(p.out + ((size_t)b * NLAT + (pp - NCTX)) * DM + c) = v[i];
            else *(f32x4*)(Xnext + (size_t)r * DM + c) = v[i];
        }
        if (l == 0) { const float* mv = modv + ((size_t)1 * 3 + sel) * 6144; modulate_store(v, mv, mv + 1024, H + (size_t)r * DM, lane); }
    }
}

constexpr int PH_PER_LAYER = 11, N_PHASES = 3 + 2 * PH_PER_LAYER;
__global__ void __launch_bounds__(NTHREADS, 2) mega(Params p) {
    extern __shared__ __attribute__((aligned(16))) unsigned char lds_raw[];
    LAS unsigned char* lds = (LAS unsigned char*)lds_raw;
    volatile LAS unsigned* bst = (volatile LAS unsigned*)(lds + LDS_BYTES - 16);
    if (PROBE_ID != 0 && threadIdx.x == 0) { PRB_WORDS(lds)[0] = 0ull; PRB_WORDS(lds)[1] = 0ull; }
    if (threadIdx.x == 0) { bst[0] = 0u; bst[1] = 0u; const unsigned xc = xb_xcc_id(); bst[2] = xc; bst[3] = xb_add((unsigned*)(p.ws + CTL_XRANK) + xc, 1u); }
    __syncthreads();
    const int lo = p.ph_lo, hi = p.ph_hi;
    XcdBarrier bar; bar.bar = (unsigned*)(p.ws + WS_CTL); bar.x = 0; bar.st = bst;
    if (hi - lo > 1) bar = xcd_barrier_post((unsigned*)(p.ws + WS_CTL), bst);
#ifndef ONLY_PHASE
#define ONLY_PHASE -1
#endif
#define IN(k) (lo <= (k) && (k) < hi)
#define ON(pid) (ONLY_PHASE < 0 || ONLY_PHASE == (pid))
#ifndef DUP_PHASE
#define DUP_PHASE -1
#endif
#define REP(pid) for (int rep_ = 0; rep_ < ((DUP_PHASE == (pid)) ? 2 : 1); ++rep_)
#define SEAM(k) do { if (IN(k) && IN((k) + 1)) xcd_barrier(bar); } while (0)
    PRB_T0(100, lds); if (ON(0) && IN(0)) REP(0) { phase_convert(p, lds); } PRB_T1(100, lds);
    PRB_T0(200, lds); SEAM(0); PRB_T1(200, lds);
    PRB_T0(101, lds); if (ON(1) && IN(1)) REP(1) phase_mod(p, lds); PRB_T1(101, lds);
    PRB_T0(201, lds); SEAM(1); PRB_T1(201, lds);
    PRB_T0(102, lds); if (ON(2) && IN(2)) REP(2) phase_ln0(p); PRB_T1(102, lds);
    PRB_T0(202, lds); SEAM(2); PRB_T1(202, lds);
    for (int l = 0; l < 2; ++l) {
        const int k0 = 3 + l * PH_PER_LAYER;
        PRB_T0(103, lds); if (ON(3) && IN(k0 + 0)) REP(3) phase_inproj(p, l, lds); PRB_T1(103, lds);
        PRB_T0(203, lds); SEAM(k0 + 0); PRB_T1(203, lds);
        PRB_T0(104, lds); if (ON(4) && IN(k0 + 1)) REP(4) phase_ret_sum_pool(p, l, lds); PRB_T1(104, lds);
        PRB_T0(204, lds); SEAM(k0 + 1); PRB_T1(204, lds);
        PRB_T0(105, lds); if (ON(5) && IN(k0 + 2)) REP(5) phase_ret_scan(p, l); PRB_T1(105, lds);
        PRB_T0(205, lds); SEAM(k0 + 2); PRB_T1(205, lds);
        PRB_T0(106, lds); if (ON(6) && IN(k0 + 3)) REP(6) { phase_attn(p, l, lds); phase_ret(p, l); } PRB_T1(106, lds);
        PRB_T0(206, lds); SEAM(k0 + 3); PRB_T1(206, lds);
        PRB_T0(107, lds); if (ON(7) && IN(k0 + 4)) REP(7) phase_outproj(p, l, lds); PRB_T1(107, lds);
        PRB_T0(207, lds); SEAM(k0 + 4); PRB_T1(207, lds);
        PRB_T0(108, lds); if (ON(8) && IN(k0 + 5)) REP(8) phase_ln_mid(p, l); PRB_T1(108, lds);
        PRB_T0(208, lds); SEAM(k0 + 5); PRB_T1(208, lds);
        PRB_T0(109, lds); if (ON(9) && IN(k0 + 6)) REP(9) phase_router(p, l, lds); PRB_T1(109, lds);
        PRB_T0(209, lds); SEAM(k0 + 6); PRB_T1(209, lds);
        PRB_T0(110, lds); if (ON(10) && IN(k0 + 7)) REP(10) phase_topk(p, l, lds); PRB_T1(110, lds);
        PRB_T0(210, lds); SEAM(k0 + 7); PRB_T1(210, lds);
        PRB_T0(111, lds); if (ON(11) && IN(k0 + 8)) REP(11) { phase_scatter(p, l, lds); phase_convert_experts(p, l); } PRB_T1(111, lds);
        PRB_T0(211, lds); SEAM(k0 + 8); PRB_T1(211, lds);
        PRB_T0(112, lds); if (ON(12) && IN(k0 + 9)) REP(12) phase_moe(p, l, lds); PRB_T1(112, lds);
        PRB_T0(212, lds); SEAM(k0 + 9); PRB_T1(212, lds);
        PRB_T0(114, lds); if (ON(14) && IN(k0 + 10)) REP(14) phase_combine(p, l); PRB_T1(114, lds);
        if (l == 0) SEAM(k0 + 10);
    }
#undef IN
#undef SEAM
    if (PROBE_ID != 0 && threadIdx.x == 0 && blockIdx.x == 0) {
        const unsigned long long t0 = __builtin_readcyclecounter(), span = PRB_WORDS(lds)[1] * PROBE_GAIN;
        while (__builtin_readcyclecounter() - t0 < span) __builtin_amdgcn_s_sleep(8);
    }
}

extern "C" void kernel_launch(void* const* d_in, const int* in_sizes, int n_in, void* d_out, int out_size, void* d_ws, size_t ws_size, hipStream_t stream) {
    static int grid = 0;
    if (grid == 0) {
        if (n_in != 20 || ws_size < WS_END || out_size != NB * NLAT * DM) { fprintf(stderr, "kernel_launch: unexpected shapes (n_in %d, ws %zu need %zu, out %d)\n", n_in, ws_size, (size_t)WS_END, out_size); grid = -1; return; }
        int dev = 0, cus = 0, per_cu = 0;
        hipGetDevice(&dev); hipDeviceGetAttribute(&cus, hipDeviceAttributeMultiprocessorCount, dev);
        if (hipFuncSetAttribute((const void*)mega, hipFuncAttributeMaxDynamicSharedMemorySize, LDS_BYTES) != hipSuccess) { fprintf(stderr, "kernel_launch: hipFuncSetAttribute failed\n"); grid = -1; return; }
        if (hipOccupancyMaxActiveBlocksPerMultiprocessor(&per_cu, (const void*)mega, NTHREADS, LDS_BYTES) != hipSuccess || per_cu < 1) { fprintf(stderr, "kernel_launch: occupancy query says %d\n", per_cu); }
        (void)hipGetLastError();
        grid = cus > 0 ? cus : 256;
    }
    if (grid < 0) return;
    hipMemsetAsync((char*)d_ws + WS_CTL, 0, CTL_BYTES, stream);
    Params p{};
    p.x = (const float*)d_in[0]; p.c = (const float*)d_in[1]; p.ctx = (const float*)d_in[2]; p.c_ctx = (const float*)d_in[3];
    p.w_mod = (const float*)d_in[4]; p.b_mod = (const float*)d_in[5]; p.w_in = (const float*)d_in[6]; p.w_out = (const float*)d_in[7];
    p.diff_lambda = (const float*)d_in[8]; p.pool_w = (const float*)d_in[9]; p.pool_scale = (const float*)d_in[10]; p.ret_log_decay = (const float*)d_in[11];
    p.ln_g = (const float*)d_in[12]; p.ln_b = (const float*)d_in[13]; p.w_router = (const float*)d_in[14]; p.router_bias = (const float*)d_in[15];
    p.w_egu = (const float*)d_in[16]; p.w_edn = (const float*)d_in[17]; p.w_sgu = (const float*)d_in[18]; p.w_sdn = (const float*)d_in[19];
    p.out = (float*)d_out; p.ws = (unsigned char*)d_ws;
#if N_LAUNCH_PER_PHASE
    for (int k = 0; k < N_PHASES; ++k) { p.ph_lo = k; p.ph_hi = k + 1; hipLaunchKernelGGL(mega, dim3(grid), dim3(NTHREADS), LDS_BYTES, stream, p); }
#else
    p.ph_lo = 0; p.ph_hi = N_PHASES;
    hipLaunchKernelGGL(mega, dim3(grid), dim3(NTHREADS), LDS_BYTES, stream, p);
#endif
}
```

```cpp
#include <hip/hip_runtime.h>
#include <stdint.h>
#include <stdio.h>

#ifndef N_LAUNCH_PER_PHASE
#define N_LAUNCH_PER_PHASE 0
#endif

#define LAS __attribute__((address_space(3)))
#define DI __device__ __forceinline__
typedef unsigned short bf16_t;
typedef short bf16x8 __attribute__((ext_vector_type(8)));
typedef float f32x2 __attribute__((ext_vector_type(2)));
typedef float f32x4 __attribute__((ext_vector_type(4)));
typedef float f32x16 __attribute__((ext_vector_type(16)));
typedef unsigned u32x2 __attribute__((ext_vector_type(2)));
typedef unsigned u32x4 __attribute__((ext_vector_type(4)));
typedef __bf16 bf16v2 __attribute__((ext_vector_type(2)));

constexpr int NB = 2, NLAT = 8192, NCTX = 256, NT = NLAT + NCTX  , MROWS = NB * NT  ;
constexpr int DM = 1024, INW = 2816, NEXP = 256, TOPK = 8, NASG = MROWS * TOPK  ;
constexpr int NCHUNK = NT / 128;
constexpr float DN_ALPHA = 1.41421356237f;
constexpr float LN_EPS = 1e-6f, RMS_EPS = 1e-5f;
constexpr float LOG2E = 1.44269504089f;
constexpr float QSCALE = 0.125f * LOG2E;
constexpr int NTHREADS = 512;
constexpr int LDS_BYTES = 155648;

constexpr int C_DQ = 0, C_DK = 512, C_DV = 1024, C_PU = 1536, C_RQ = 1792, C_RK = 2048, C_RV = 2304, C_RG = 2560;

constexpr size_t al256(size_t x) { return (x + 255) & ~(size_t)255; }
constexpr size_t WS_CTL = 0;
constexpr size_t CTL_BYTES = 65536;
constexpr size_t CTL_COUNTS = 16384;
constexpr size_t CTL_CURSOR = CTL_COUNTS + 2048;
constexpr size_t CTL_NTILES = CTL_CURSOR + 2048;
constexpr size_t CTL_XRANK = CTL_NTILES + 256;
constexpr size_t WS_MODV = WS_CTL + CTL_BYTES;
constexpr size_t WS_ROPE = al256(WS_MODV + 2 * 3 * 6144 * 4);
constexpr size_t WS_SCAL = al256(WS_ROPE + 128 * 16 * 8);
constexpr size_t WS_WIN = al256(WS_SCAL + 2 * 16 * 4);
constexpr size_t WS_WOUT = al256(WS_WIN + (size_t)2 * INW * DM * 2);
constexpr size_t WS_WR = al256(WS_WOUT + (size_t)2 * DM * DM * 2);
constexpr size_t WS_WIMG = al256(WS_WR + (size_t)2 * 256 * DM * 2);
constexpr size_t WS_XA = al256(WS_WIMG + (size_t)2 * 257 * 48 * 32768);
constexpr size_t WS_XB = al256(WS_XA + (size_t)MROWS * DM * 4);
constexpr size_t WS_V1 = al256(WS_XB + (size_t)MROWS * DM * 4);
constexpr size_t WS_H = al256(WS_V1 + (size_t)MROWS * DM * 4);
constexpr size_t WS_TOK = al256(WS_H + (size_t)MROWS * DM * 2);
constexpr size_t WS_P = al256(WS_TOK + (size_t)MROWS * DM * 2);
constexpr size_t WS_VT = al256(WS_P + (size_t)MROWS * INW * 2);
constexpr size_t WS_RKT = al256(WS_VT + (size_t)NB * 4 * 128 * NT * 2);
constexpr size_t WS_RVT = al256(WS_RKT + (size_t)NB * 4 * 64 * NT * 2);
constexpr size_t WS_MIX = al256(WS_RVT + (size_t)NB * 4 * 64 * NT * 2);
constexpr size_t ST_BYTES = (size_t)NB * 4 * NCHUNK * 4096 * 4;
constexpr size_t WS_UF = al256(WS_MIX + (size_t)MROWS * DM * 2);
constexpr size_t WS_UB = al256(WS_UF + ST_BYTES);
constexpr size_t WS_SF = al256(WS_UB + ST_BYTES);
constexpr size_t WS_SB = al256(WS_SF + ST_BYTES);
constexpr size_t WS_LOGIT = al256(WS_SB + ST_BYTES);
constexpr size_t WS_EIDX = al256(WS_LOGIT + (size_t)MROWS * 256 * 4);
constexpr size_t WS_GATE = al256(WS_EIDX + (size_t)NASG * 4);
constexpr size_t WS_SORT = al256(WS_GATE + (size_t)NASG * 4);
constexpr size_t WS_RANK = al256(WS_SORT + (size_t)NASG * 4);
constexpr size_t WS_HIST = al256(WS_RANK + (size_t)NASG * 4);
constexpr size_t WS_TILES = al256(WS_HIST + (size_t)1024 * 256 * 4);
constexpr size_t WS_YSLOT = al256(WS_TILES + 2048 * 16);
constexpr size_t WS_YSH = al256(WS_YSLOT + (size_t)NASG * DM * 2);
constexpr size_t WS_END = al256(WS_YSH + (size_t)MROWS * DM * 2);

struct Params {
    const float *x, *c, *ctx, *c_ctx, *w_mod, *b_mod, *w_in, *w_out, *diff_lambda, *pool_w, *pool_scale, *ret_log_decay, *ln_g, *ln_b,
        *w_router, *router_bias, *w_egu, *w_edn, *w_sgu, *w_sdn;
    float* out;
    unsigned char* ws;
    int ph_lo, ph_hi;
};


DI Params launder(const Params& a) {
    size_t z = 0; asm volatile("" : "+s"(z));
    Params r = a;
#define LND(f) r.f = (decltype(r.f))((const unsigned char*)a.f + z)
    LND(x); LND(c); LND(ctx); LND(c_ctx); LND(w_mod); LND(b_mod); LND(w_in); LND(w_out); LND(diff_lambda); LND(pool_w); LND(pool_scale); LND(ret_log_decay); LND(ln_g); LND(ln_b);
    LND(w_router); LND(router_bias); LND(w_egu); LND(w_edn); LND(w_sgu); LND(w_sdn);
#undef LND
    r.out = (float*)((unsigned char*)a.out + z); r.ws = a.ws + z;
    return r;
}
DI int launder_s(int v) { asm volatile("" : "+s"(v)); return v; }
DI int tid_() { int t = threadIdx.x; asm volatile("" : "+v"(t)); return t; }
DI int bid_() { int t = blockIdx.x; asm volatile("" : "+s"(t)); return t; }


#ifndef PROBE_ID
#define PROBE_ID 0
#endif
#ifndef PROBE_GAIN
#define PROBE_GAIN 8
#endif
#define PRB_WORDS(lds) ((volatile LAS unsigned long long*)((lds) + LDS_BYTES - 64))
#define PRB_MATCH(id) (PROBE_ID == (id) || (PROBE_ID == 999 && (id) >= 200) || (PROBE_ID == 998 && ((id) == 101 || (id) == 102 || (id) == 104 || (id) == 105 || (id) == 108 || (id) == 109 || (id) == 110 || (id) == 111)))
#define PRB_T0(id, lds) do { if (PRB_MATCH(id) && threadIdx.x == 0 && blockIdx.x == 0) { PRB_WORDS(lds)[0] = __builtin_readcyclecounter(); } } while (0)
#define PRB_T1(id, lds) do { if (PRB_MATCH(id) && threadIdx.x == 0 && blockIdx.x == 0) { PRB_WORDS(lds)[1] += __builtin_readcyclecounter() - PRB_WORDS(lds)[0]; } } while (0)

#define XB_TMO      128
#define XB_XCNT(j)  (256  + 64 * (j))
#define XB_XSUB(j)  (1280 + 64 * (j))
#define XB_XGEN(j)  (2304 + 64 * (j))
#define XB_TOP      3328
#define XB_TOPGEN   3392
#define XCD_BAR_WORDS 3456
#define XB_SPIN_CAP (1u << 20)

__device__ __forceinline__ unsigned xb_ld(unsigned* p)              { return __hip_atomic_load(p, __ATOMIC_RELAXED, __HIP_MEMORY_SCOPE_AGENT); }
__device__ __forceinline__ unsigned xb_add(unsigned* p, unsigned v) { return __hip_atomic_fetch_add(p, v, __ATOMIC_RELAXED, __HIP_MEMORY_SCOPE_AGENT); }
__device__ __forceinline__ unsigned xb_xcc_id() { return (unsigned)__builtin_amdgcn_s_getreg((3 << 11) | 20) & 0xFu; }
#define XB_SPIN(cond, bar) do { unsigned _sp = 0; while (cond) { __builtin_amdgcn_s_sleep(1); \
    if ((++_sp & 255u) == 0u) { if (xb_ld(&(bar)[XB_TMO])) break; if (_sp > XB_SPIN_CAP) { atomicAdd(&(bar)[XB_TMO], 1u); break; } } } } while (0)

struct XcdBarrier { unsigned* bar; unsigned x; volatile LAS unsigned* st; };

__device__ __forceinline__ XcdBarrier xcd_barrier_post(unsigned* bar, volatile LAS unsigned* st) {
    XcdBarrier b; b.bar = bar; b.x = xb_xcc_id(); b.st = st;
    if (threadIdx.x == 0) (void)xb_add(&bar[XB_XCNT(b.x)], 1u);
    return b;
}
__device__ __forceinline__ void xcd_barrier_complete(unsigned* bar, unsigned x, unsigned& nloc, unsigned& nx) {
    const unsigned G = gridDim.x * gridDim.y * gridDim.z;
    unsigned sum, cnt, mine, sp = 0u;
    for (;;) {
        sum = 0u; cnt = 0u; mine = 0u;
#pragma unroll
        for (unsigned j = 0; j < 16; ++j) { const unsigned c = xb_ld(&bar[XB_XCNT(j)]); sum += c; cnt += (c > 0u) ? 1u : 0u; mine = (j == x) ? c : mine; }
        if (sum == G) break;
        __builtin_amdgcn_s_sleep(1);
        if ((++sp & 255u) == 0u) { if (xb_ld(&bar[XB_TMO])) break; if (sp > XB_SPIN_CAP) { atomicAdd(&bar[XB_TMO], 1u); break; } }
    }
    nloc = mine > 0u ? mine : 1u; nx = cnt > 0u ? cnt : 1u;
}
__device__ __forceinline__ void xcd_barrier(const XcdBarrier& b) {
    asm volatile("s_waitcnt vmcnt(0)" ::: "memory");
    __syncthreads();
    if (threadIdx.x == 0) {
        unsigned* bar = b.bar;
        __builtin_amdgcn_s_waitcnt(0);
        unsigned nloc = b.st[0], nx = b.st[1];
        if (nloc == 0u) { xcd_barrier_complete(bar, b.x, nloc, nx); b.st[0] = nloc; b.st[1] = nx; }
        const unsigned old = xb_add(&bar[XB_XSUB(b.x)], 1u);
        const unsigned gen = old / nloc;
        if (old + 1u == (gen + 1u) * nloc) {
            __builtin_amdgcn_fence(__ATOMIC_RELEASE, "agent");
            asm volatile("s_waitcnt vmcnt(0)" ::: "memory");
            const unsigned og = xb_add(&bar[XB_TOP], 1u);
            const unsigned tg = og / nx;
            if (og + 1u == (tg + 1u) * nx) xb_add(&bar[XB_TOPGEN], 1u);
            else XB_SPIN(xb_ld(&bar[XB_TOPGEN]) == tg, bar);
            __builtin_amdgcn_fence(__ATOMIC_ACQUIRE, "agent");
            xb_add(&bar[XB_XGEN(b.x)], 1u);
            asm volatile("s_waitcnt vmcnt(0)" ::: "memory");
        } else {
            XB_SPIN(xb_ld(&bar[XB_XGEN(b.x)]) == gen, bar);
            __builtin_amdgcn_fence(__ATOMIC_ACQUIRE, "agent");
            asm volatile("s_waitcnt vmcnt(0)" ::: "memory");
        }
    }
    __syncthreads();
}

DI unsigned pk_bf16(float a, float b) { f32x2 v = {a, b}; bf16v2 r = __builtin_convertvector(v, bf16v2); return __builtin_bit_cast(unsigned, r); }
DI bf16_t to_bf16(float a) { return (bf16_t)(pk_bf16(a, 0.f) & 0xffffu); }
DI float bf_lo(unsigned u) { return __uint_as_float(u << 16); }
DI float bf_hi(unsigned u) { return __uint_as_float(u & 0xffff0000u); }
DI float bf2f(bf16_t h) { return __uint_as_float(((unsigned)h) << 16); }
DI float wave_sum(float v) {
#pragma unroll
    for (int o = 32; o; o >>= 1) v += __shfl_xor(v, o);
    return v;
}
DI float fast_exp2(float x) { return __builtin_amdgcn_exp2f(x); }
DI float silu_f(float x) { return x / (1.f + __expf(-x)); }
DI bf16x8 as_bf16x8(u32x4 v) { return __builtin_bit_cast(bf16x8, v); }
#define WAIT_VM(n) asm volatile("s_waitcnt vmcnt(" #n ")" ::: "memory")
DI void dma16(const void* g, LAS unsigned char* l) { __builtin_amdgcn_global_load_lds(g, (LAS void*)l, 16, 0, 0); }
#define MFMA32(a, b, c) __builtin_amdgcn_mfma_f32_32x32x16_bf16((a), (b), (c), 0, 0, 0)
#define MFMA16(a, b, c) __builtin_amdgcn_mfma_f32_16x16x32_bf16((a), (b), (c), 0, 0, 0)

DI int row_sel(int r) { const int b = r >= NT; const int p = r - b * NT; return p < NCTX ? 2 : b; }

DI int swz_off(int row, int chunk) { return row * 128 + ((chunk ^ ((row >> 1) & 7)) << 4); }

template <class Epi>
DI void gemm128(const bf16_t* a0, const bf16_t* a1, const bf16_t* b0, const bf16_t* b1, int nk, LAS unsigned char* lds, const Epi& epi) {
    const int tid = tid_(), lane = tid & 63, wid = tid >> 6, wr = wid >> 2, wc = wid & 3, fr = lane & 15, fq = lane >> 4;
    const int lrow = tid >> 3, lch = tid & 7;
    f32x4 acc[4][2];
#pragma unroll
    for (int m = 0; m < 4; ++m)
#pragma unroll
        for (int n = 0; n < 2; ++n) acc[m][n] = (f32x4){0.f, 0.f, 0.f, 0.f};
    const u32x4 z4 = {0u, 0u, 0u, 0u};
    u32x4 ra0 = a0 ? *(const u32x4*)a0 : z4, ra1 = a1 ? *(const u32x4*)a1 : z4, rb0 = b0 ? *(const u32x4*)b0 : z4, rb1 = b1 ? *(const u32x4*)b1 : z4;
    const int wo0 = swz_off(lrow, lch), wo1 = swz_off(lrow + 64, lch);
    *(LAS u32x4*)(lds + wo0) = ra0; *(LAS u32x4*)(lds + wo1) = ra1;
    *(LAS u32x4*)(lds + 16384 + wo0) = rb0; *(LAS u32x4*)(lds + 16384 + wo1) = rb1;
    __syncthreads();
    for (int kt = 0; kt < nk; ++kt) {
        const bool more = kt + 1 < nk;
        if (more) {
            const int ko = (kt + 1) * 64;
            ra0 = a0 ? *(const u32x4*)(a0 + ko) : z4; ra1 = a1 ? *(const u32x4*)(a1 + ko) : z4;
            rb0 = b0 ? *(const u32x4*)(b0 + ko) : z4; rb1 = b1 ? *(const u32x4*)(b1 + ko) : z4;
        }
        LAS unsigned char* A = lds + (kt & 1) * 32768;
        LAS unsigned char* B = A + 16384;
#pragma unroll
        for (int kk = 0; kk < 2; ++kk) {
            bf16x8 af[4], bfr[2];
#pragma unroll
            for (int m = 0; m < 4; ++m) af[m] = *(LAS bf16x8*)(A + swz_off(wr * 64 + m * 16 + fr, kk * 4 + fq));
#pragma unroll
            for (int n = 0; n < 2; ++n) bfr[n] = *(LAS bf16x8*)(B + swz_off(wc * 32 + n * 16 + fr, kk * 4 + fq));
#pragma unroll
            for (int m = 0; m < 4; ++m)
#pragma unroll
                for (int n = 0; n < 2; ++n) acc[m][n] = MFMA16(af[m], bfr[n], acc[m][n]);
        }
        if (more) {
            LAS unsigned char* A2 = lds + ((kt + 1) & 1) * 32768;
            *(LAS u32x4*)(A2 + wo0) = ra0; *(LAS u32x4*)(A2 + wo1) = ra1;
            *(LAS u32x4*)(A2 + 16384 + wo0) = rb0; *(LAS u32x4*)(A2 + 16384 + wo1) = rb1;
        }
        __syncthreads();
    }
    epi(acc, wr, wc, fr, fq);
}

DI int perm_gu(int n) { const int f = n >> 8, jj = n & 255; return ((jj >> 4) << 5) + (f << 4) + (jj & 15); }
DI void conv_unit(const float* src, int N, int K, bf16_t* dst, int k0, int n0, bool perm, LAS unsigned char* lds) {
    LAS float* tl = (LAS float*)lds;
    const int tid = tid_();
#pragma unroll
    for (int i = 0; i < 8; ++i) {
        const int kk = (tid >> 6) + 8 * i, nn = (tid & 63) * 4;
        const f32x4 v = *(const f32x4*)(src + (size_t)(k0 + kk) * N + n0 + nn);
        tl[kk * 257 + nn] = v[0]; tl[kk * 257 + nn + 1] = v[1]; tl[kk * 257 + nn + 2] = v[2]; tl[kk * 257 + nn + 3] = v[3];
    }
    __syncthreads();
    const int n = tid >> 1, kh = (tid & 1) * 32;
    const int nd = perm ? perm_gu(n0 + n) : (n0 + n);
    bf16_t* d = dst + (size_t)nd * K + k0 + kh;
#pragma unroll
    for (int q = 0; q < 4; ++q) {
        u32x4 w;
#pragma unroll
        for (int j = 0; j < 4; ++j) w[j] = pk_bf16(tl[(kh + q * 8 + 2 * j) * 257 + n], tl[(kh + q * 8 + 2 * j + 1) * 257 + n]);
        *(u32x4*)(d + q * 8) = w;
    }
    __syncthreads();
}

DI void phase_convert(const Params& p0, LAS unsigned char* lds) {
    const Params p = launder(p0);
    constexpr int U_IN = 176, U_OUT = 64, U_R = 16;
    constexpr int U_L = U_IN + U_OUT + U_R;
    for (int u = bid_(); u < 2 * U_L; u += gridDim.x) {
        const int l = u / U_L; int v = u % U_L;
        if (v < U_IN) { conv_unit(p.w_in + (size_t)l * DM * INW, INW, DM, (bf16_t*)(p.ws + WS_WIN) + (size_t)l * INW * DM, (v / 11) * 64, (v % 11) * 256, false, lds); continue; }
        v -= U_IN;
        if (v < U_OUT) { conv_unit(p.w_out + (size_t)l * DM * DM, DM, DM, (bf16_t*)(p.ws + WS_WOUT) + (size_t)l * DM * DM, (v / 4) * 64, (v % 4) * 256, false, lds); continue; }
        v -= U_OUT;
        conv_unit(p.w_router + (size_t)l * DM * 256, 256, DM, (bf16_t*)(p.ws + WS_WR) + (size_t)l * 256 * DM, v * 64, 0, false, lds);
    }
}

DI void phase_mod(const Params& p0, LAS unsigned char* lds) {
    const Params p = launder(p0);
    LAS float* sc = (LAS float*)lds;
    LAS float* red = sc + 3 * 1024;
    const int tid = tid_();
    float* modv = (float*)(p.ws + WS_MODV);
    for (int u = bid_(); u < 193; u += gridDim.x) {
        if (u == 192) {
            float* rope = (float*)(p.ws + WS_ROPE);
            for (int i = tid; i < 128 * 16; i += NTHREADS) {
                const int pos = i >> 4, f = i & 15;
                const float freq = powf(10000.0f, -(float)f / 16.0f);
                const float ang = (float)pos * freq;
                rope[2 * i] = cosf(ang); rope[2 * i + 1] = sinf(ang);
            }
            float* scal = (float*)(p.ws + WS_SCAL);
            if (tid < 2) {
                const int l = tid;
                const float* dl = p.diff_lambda + l * 256;
                float s01 = 0.f, s23 = 0.f;
                for (int i = 0; i < 64; ++i) { s01 += dl[i] * dl[64 + i]; s23 += dl[128 + i] * dl[192 + i]; }
                const float lambda_init = 0.8f - 0.6f * expf(-0.3f * (float)l);
                scal[l * 16 + 0] = expf(s01) - expf(s23) + lambda_init;
                scal[l * 16 + 1] = 1.0f - lambda_init;
                for (int h = 0; h < 4; ++h) {
                    scal[l * 16 + 2 + h] = -expf(p.ret_log_decay[l * 8 + h]) * LOG2E;
                    scal[l * 16 + 6 + h] = -expf(p.ret_log_decay[l * 8 + 4 + h]) * LOG2E;
                }
            }
            continue;
        }
        const int l = u / 96, n0 = (u % 96) * 64;
        for (int i = tid; i < 3 * 1024; i += NTHREADS) {
            const int s = i >> 10, k = i & 1023;
            const float v = s < 2 ? p.c[s * 1024 + k] : p.c_ctx[k];
            sc[i] = silu_f(v);
        }
        __syncthreads();
        const int kq = tid >> 6, nl = tid & 63;
        const float* w = p.w_mod + (size_t)l * DM * 6144 + n0 + nl;
        float a0 = 0.f, a1 = 0.f, a2 = 0.f;
        for (int k = kq * 128; k < kq * 128 + 128; ++k) {
            const float wv = w[(size_t)k * 6144];
            a0 += sc[k] * wv; a1 += sc[1024 + k] * wv; a2 += sc[2048 + k] * wv;
        }
        red[(kq * 3 + 0) * 64 + nl] = a0; red[(kq * 3 + 1) * 64 + nl] = a1; red[(kq * 3 + 2) * 64 + nl] = a2;
        __syncthreads();
        if (tid < 192) {
            const int s = tid >> 6, n = tid & 63;
            float v = 0.f;
            for (int q = 0; q < 8; ++q) v += red[(q * 3 + s) * 64 + n];
            modv[((size_t)l * 3 + s) * 6144 + n0 + n] = v + p.b_mod[l * 6144 + n0 + n];
        }
        __syncthreads();
    }
}

DI void ln_stats(const f32x4 (&v)[4], float& mu, float& rstd) {
    float s = 0.f;
#pragma unroll
    for (int i = 0; i < 4; ++i) s += (v[i][0] + v[i][1]) + (v[i][2] + v[i][3]);
    mu = wave_sum(s) * (1.0f / 1024.0f);
    float q = 0.f;
#pragma unroll
    for (int i = 0; i < 4; ++i)
#pragma unroll
        for (int j = 0; j < 4; ++j) { const float d = v[i][j] - mu; q += d * d; }
    rstd = rsqrtf(wave_sum(q) * (1.0f / 1024.0f) + LN_EPS);
}
DI void modulate_store(const f32x4 (&v)[4], const float* shift, const float* scale, bf16_t* dst, int lane) {
    float mu, rstd; ln_stats(v, mu, rstd);
#pragma unroll
    for (int i = 0; i < 4; ++i) {
        const int c = lane * 4 + i * 256;
        const f32x4 sh = *(const f32x4*)(shift + c), scv = *(const f32x4*)(scale + c);
        float o[4];
#pragma unroll
        for (int j = 0; j < 4; ++j) o[j] = (v[i][j] - mu) * rstd * (1.0f + scv[j]) + sh[j];
        u32x2 w = {pk_bf16(o[0], o[1]), pk_bf16(o[2], o[3])};
        *(u32x2*)(dst + c) = w;
    }
}

DI void phase_ln0(const Params& p0) {
    const Params p = launder(p0);
    const int lane = tid_() & 63, wid = tid_() >> 6;
    float* XA = (float*)(p.ws + WS_XA);
    bf16_t* H = (bf16_t*)(p.ws + WS_H);
    const float* modv = (const float*)(p.ws + WS_MODV);
    for (int r = bid_() * 8 + wid; r < MROWS; r += gridDim.x * 8) {
        const int b = r >= NT, pp = r - b * NT;
        const float* src = pp < NCTX ? p.ctx + ((size_t)b * NCTX + pp) * DM : p.x + ((size_t)b * NLAT + (pp - NCTX)) * DM;
        f32x4 v[4];
#pragma unroll
        for (int i = 0; i < 4; ++i) { v[i] = *(const f32x4*)(src + lane * 4 + i * 256); *(f32x4*)(XA + (size_t)r * DM + lane * 4 + i * 256) = v[i]; }
        const float* mv = modv + (size_t)(0 * 3 + (pp < NCTX ? 2 : b)) * 6144;
        modulate_store(v, mv, mv + 1024, H + (size_t)r * DM, lane);
    }
}

constexpr int G2_STG = 40960;
template <class Epi>
DI void gemm192(const bf16_t* A, int lda, const bf16_t* Bt, int ldb, int nk, int m0, int n0, LAS unsigned char* lds, const Epi& epi) {
    const int t = tid_(), lane = t & 63, wid = __builtin_amdgcn_readfirstlane(t >> 6), fr = lane & 15, fq = lane >> 4, wm = wid >> 1, wn = wid & 1;
    const bf16_t* asrc[3]; const bf16_t* bsrc[2];
#pragma unroll
    for (int i = 0; i < 3; ++i) { const int sl = t + 512 * i, row = sl >> 3, c = (sl & 7) ^ ((row >> 1) & 7); asrc[i] = A + (size_t)(m0 + row) * lda + c * 8; }
#pragma unroll
    for (int i = 0; i < 2; ++i) { const int sl = t + 512 * i, row = sl >> 3, c = (sl & 7) ^ ((row >> 1) & 7); bsrc[i] = Bt + (size_t)(n0 + row) * ldb + c * 8; }
    const int ddst = wid * 1024;
#define G2_ISSUE(S, KT) do { LAS unsigned char* _s = lds + (S) * G2_STG + ddst; const int _k = (KT) * 64; \
        dma16(asrc[0] + _k, _s); dma16(asrc[1] + _k, _s + 8192); dma16(asrc[2] + _k, _s + 16384); dma16(bsrc[0] + _k, _s + 24576); dma16(bsrc[1] + _k, _s + 32768); } while (0)
    f32x4 acc[4][3];
#pragma unroll
    for (int nf = 0; nf < 4; ++nf)
#pragma unroll
        for (int mf = 0; mf < 3; ++mf) acc[nf][mf] = (f32x4){0.f, 0.f, 0.f, 0.f};
    __syncthreads();
    G2_ISSUE(0, 0);
    if (nk > 1) G2_ISSUE(1, 1);
    int st = 0;
    for (int kt = 0; kt < nk; ++kt) {
        if (kt + 1 < nk) WAIT_VM(5); else WAIT_VM(0);
        asm volatile("s_waitcnt lgkmcnt(0)" ::: "memory");
        __builtin_amdgcn_s_barrier();
        const int st2 = st == 0 ? 2 : st - 1;
        if (kt + 2 < nk) G2_ISSUE(st2, kt + 2);
        LAS unsigned char* S = lds + st * G2_STG;
        st = st == 2 ? 0 : st + 1;
#pragma unroll
        for (int kk = 0; kk < 2; ++kk) {
            bf16x8 af[3], bfr[4];
#pragma unroll
            for (int mf = 0; mf < 3; ++mf) af[mf] = *(LAS bf16x8*)(S + swz_off(wm * 48 + mf * 16 + fr, kk * 4 + fq));
#pragma unroll
            for (int nf = 0; nf < 4; ++nf) bfr[nf] = *(LAS bf16x8*)(S + 24576 + swz_off(wn * 64 + nf * 16 + fr, kk * 4 + fq));
#pragma unroll
            for (int nf = 0; nf < 4; ++nf)
#pragma unroll
                for (int mf = 0; mf < 3; ++mf) acc[nf][mf] = MFMA16(bfr[nf], af[mf], acc[nf][mf]);
        }
    }
#undef G2_ISSUE
    __syncthreads();
    epi(acc, wm, wn, fr, fq, lane, wid);
}
DI LAS unsigned char* g2_stage(LAS unsigned char* lds, int wid) { return lds + wid * 13056; }

DI void phase_inproj(const Params& p0, int l, LAS unsigned char* lds) {
    const Params p = launder(p0); l = launder_s(l);
    const bf16_t* H = (const bf16_t*)(p.ws + WS_H);
    const bf16_t* W = (const bf16_t*)(p.ws + WS_WIN) + (size_t)l * INW * DM;
    bf16_t* P = (bf16_t*)(p.ws + WS_P);
    bf16_t* VT = (bf16_t*)(p.ws + WS_VT);
    bf16_t* RKT = (bf16_t*)(p.ws + WS_RKT);
    bf16_t* RVT = (bf16_t*)(p.ws + WS_RVT);
    const f32x2* rope = (const f32x2*)(p.ws + WS_ROPE);
    constexpr int NTN = INW / 128, NTM = MROWS / 192;
    for (int u = bid_(); u < NTM * NTN; u += gridDim.x) {
        const int tm = u / NTN, tn = u % NTN;
        auto epi = [&](f32x4 (&acc)[4][3], int wm, int wn, int fr, int fq, int lane, int wid) {
            const int c0 = tn * 128 + wn * 64;
            const int r0 = tm * 192 + wm * 48;
            LAS unsigned char* W_ = g2_stage(lds, wid);
            if (c0 < C_DV) {
                const float qs = c0 < C_DK ? QSCALE : 1.0f;
#pragma unroll
                for (int mf = 0; mf < 3; ++mf) {
                    const int row = r0 + mf * 16 + fr;
                    const int b = row >= NT, pp = row - b * NT;
                    const bool lat = pp >= NCTX;
                    const int tt = pp - NCTX;
#pragma unroll
                    for (int hb = 0; hb < 2; ++hb) {
                        const int axis = ((c0 >> 5) + hb) & 1;
                        const int pos = axis ? (tt & 63) : (tt >> 6);
#pragma unroll
                        for (int j = 0; j < 4; ++j) {
                            float x1 = acc[2 * hb][mf][j], x2 = acc[2 * hb + 1][mf][j];
                            if (lat) { const f32x2 cs = rope[pos * 16 + 4 * fq + j]; const float o1 = x1 * cs[0] - x2 * cs[1], o2 = x1 * cs[1] + x2 * cs[0]; x1 = o1; x2 = o2; }
                            acc[2 * hb][mf][j] = x1 * qs; acc[2 * hb + 1][mf][j] = x2 * qs;
                        }
                    }
                }
            } else if (c0 >= C_RK && c0 < C_RV) {
#pragma unroll
                for (int nf = 0; nf < 4; ++nf)
#pragma unroll
                    for (int mf = 0; mf < 3; ++mf) acc[nf][mf] *= 0.125f;
            }
#pragma unroll
            for (int nf = 0; nf < 4; ++nf)
#pragma unroll
                for (int mf = 0; mf < 3; ++mf) {
                    const f32x4 v = acc[nf][mf];
                    *(LAS u32x2*)(W_ + (mf * 16 + fr) * 144 + nf * 32 + fq * 8) = (u32x2){pk_bf16(v[0], v[1]), pk_bf16(v[2], v[3])};
                }
#pragma unroll
            for (int it = 0; it < 6; ++it) {
                const int row = it * 8 + (lane >> 3), ch = lane & 7;
                *(u32x4*)(P + (size_t)(r0 + row) * INW + c0 + ch * 8) = *(LAS u32x4*)(W_ + row * 144 + ch * 16);
            }
            const bool isv = c0 >= C_DV && c0 < C_PU, isk = c0 >= C_RK && c0 < C_RV, isr = c0 >= C_RV && c0 < C_RG;
            if (isv || isk || isr) {
                const int frp = isv ? ((fr & 3) | (((fr >> 2) == 1 ? 2 : ((fr >> 2) == 2 ? 1 : (fr >> 2))) << 2)) : fr;
                LAS bf16_t* T_ = (LAS bf16_t*)W_;
#pragma unroll
                for (int nf = 0; nf < 4; ++nf)
#pragma unroll
                    for (int mf = 0; mf < 3; ++mf)
#pragma unroll
                        for (int j = 0; j < 4; ++j) T_[(nf * 16 + 4 * fq + j) * 56 + mf * 16 + frp] = to_bf16(acc[nf][mf][j]);
                const int b = r0 >= NT, pp0 = r0 - b * NT;
                bf16_t* base; int nrows_per_head;
                if (isv) { const int cc = c0 - C_DV; base = VT + ((size_t)(b * 4 + (cc >> 7)) * 128 + (cc & 127)) * NT + pp0; }
                else if (isk) { const int cc = c0 - C_RK; base = RKT + ((size_t)(b * 4 + (cc >> 6)) * 64) * NT + pp0; }
                else { const int cc = c0 - C_RV; base = RVT + ((size_t)(b * 4 + (cc >> 6)) * 64) * NT + pp0; }
                (void)nrows_per_head;
#pragma unroll
                for (int it = 0; it < 6; ++it) {
                    const int sl = it * 64 + lane, n = sl / 6, pc = sl % 6;
                    *(u32x4*)(base + (size_t)n * NT + pc * 8) = *(LAS u32x4*)(W_ + n * 112 + pc * 16);
                }
            }
        };
        gemm192(H, DM, W, DM, DM / 64, tm * 192, tn * 128, lds, epi);
    }
}

DI void phase_ret_sum_pool(const Params& p0, int l, LAS unsigned char* lds) {
    const Params p = launder(p0); l = launder_s(l);
    const int tid = tid_(), lane = tid & 63, wid = tid >> 6, fr = lane & 15, g = lane >> 4;
    const float* scal = (const float*)(p.ws + WS_SCAL) + l * 16;
    const bf16_t* RKT = (const bf16_t*)(p.ws + WS_RKT);
    const bf16_t* RVT = (const bf16_t*)(p.ws + WS_RVT);
    float* UF = (float*)(p.ws + WS_UF);
    float* UB = (float*)(p.ws + WS_UB);
    for (int u = bid_(); u < NB * 4 * NCHUNK; u += gridDim.x) {
        const int c = u % NCHUNK, bh = u / NCHUNK, h = bh & 3;
        const int dir = wid >> 2, eb = wid & 3;
        const float l2 = dir ? scal[6 + h] : scal[2 + h];
        const bf16_t* vrow = RVT + ((size_t)bh * 64 + eb * 16 + fr) * NT + c * 128;
        f32x4 acc[4];
#pragma unroll
        for (int db = 0; db < 4; ++db) acc[db] = (f32x4){0.f, 0.f, 0.f, 0.f};
#pragma unroll
        for (int ks = 0; ks < 4; ++ks) {
            const int j0 = ks * 32 + 8 * g;
            const bf16x8 af = *(const bf16x8*)(vrow + j0);
            float w[8];
#pragma unroll
            for (int jj = 0; jj < 8; ++jj) { const int j = j0 + jj; w[jj] = fast_exp2((dir ? (float)j : (float)(127 - j)) * l2); }
#pragma unroll
            for (int db = 0; db < 4; ++db) {
                const u32x4 kr = *(const u32x4*)(RKT + ((size_t)bh * 64 + db * 16 + fr) * NT + c * 128 + j0);
                u32x4 kw;
#pragma unroll
                for (int q = 0; q < 4; ++q) kw[q] = pk_bf16(bf_lo(kr[q]) * w[2 * q], bf_hi(kr[q]) * w[2 * q + 1]);
                acc[db] = MFMA16(af, as_bf16x8(kw), acc[db]);
            }
        }
        const int cidx = dir ? (c >= 2 ? c - 2 : 64 + c) : c;
        float* U = (dir ? UB : UF) + ((size_t)bh * NCHUNK + cidx) * 4096;
#pragma unroll
        for (int db = 0; db < 4; ++db)
#pragma unroll
            for (int j = 0; j < 4; ++j) U[(eb * 16 + 4 * g + j) * 64 + db * 16 + fr] = acc[db][j];
    }
    LAS float* ul = (LAS float*)lds;
    LAS float* dT = ul + 48 * 256;
    LAS float* pwl = dT + 256 * 36;
    const bf16_t* P = (const bf16_t*)(p.ws + WS_P);
    bf16_t* MIX = (bf16_t*)(p.ws + WS_MIX);
    const float* pw = p.pool_w + (size_t)l * 4 * 64 * 64;
    const float* ps = p.pool_scale + l * 256;
    __syncthreads();
    if (bid_() < MROWS / 32) {
#pragma unroll
        for (int i = 0; i < 8; ++i) *(LAS f32x4*)(pwl + (tid + 512 * i) * 4) = *(const f32x4*)(pw + (tid + 512 * i) * 4);
    }
    for (int u = bid_(); u < MROWS / 32; u += gridDim.x) {
        const int r0 = u * 32;
        const int b = r0 >= NT, pp0 = r0 - b * NT;
        const int s0 = pp0 < NCTX ? b * NT : b * NT + NCTX, s1 = pp0 < NCTX ? b * NT + NCTX : (b + 1) * NT;
        __syncthreads();
        {
            u32x2 wv[6]; bool ok[6];
#pragma unroll
            for (int it = 0; it < 6; ++it) {
                const int i = tid + 512 * it, rr = i >> 6, c4 = (i & 63) * 4, row = r0 - 8 + rr;
                ok[it] = row >= s0 && row < s1;
                wv[it] = ok[it] ? *(const u32x2*)(P + (size_t)row * INW + C_PU + c4) : (u32x2){0u, 0u};
            }
#pragma unroll
            for (int it = 0; it < 6; ++it) {
                const int i = tid + 512 * it, rr = i >> 6, c4 = (i & 63) * 4;
                *(LAS f32x4*)(ul + rr * 256 + c4) = (f32x4){bf_lo(wv[it][0]), bf_hi(wv[it][0]), bf_lo(wv[it][1]), bf_hi(wv[it][1])};
            }
        }
        __syncthreads();
        {
            const int c = tid & 255, gi = c >> 6, rb = tid >> 8;
#define POOL_WIN(HW) do { _Pragma("unroll") for (int it = 0; it < 16; ++it) { const int rr = it * 2 + rb, row = r0 + rr; float sm = 0.f; \
                _Pragma("unroll") for (int q = -(HW); q < (HW); ++q) sm += ul[(rr + 8 + q) * 256 + c]; \
                const int lo = (row - (HW)) < s0 ? s0 : (row - (HW)), hi = (row + (HW)) > s1 ? s1 : (row + (HW)); \
                dT[c * 36 + rr] = sm / (float)(hi - lo) - ul[(rr + 8) * 256 + c]; } } while (0)
            if (gi == 0) POOL_WIN(1); else if (gi == 1) POOL_WIN(2); else if (gi == 2) POOL_WIN(4); else POOL_WIN(8);
#undef POOL_WIN
        }
        __syncthreads();
        {
            const int oc = tid & 255, rh = (tid >> 8) * 16, gi = oc >> 6, e = oc & 63;
            float acc[16];
#pragma unroll
            for (int i = 0; i < 16; ++i) acc[i] = 0.f;
#pragma unroll 8
            for (int c = 0; c < 64; ++c) {
                const float wv = pwl[(gi * 64 + c) * 64 + e];
                const LAS float* dr = dT + (gi * 64 + c) * 36 + rh;
#pragma unroll
                for (int i = 0; i < 4; ++i) { const f32x4 d = *(const LAS f32x4*)(dr + 4 * i); acc[4 * i] += d[0] * wv; acc[4 * i + 1] += d[1] * wv; acc[4 * i + 2] += d[2] * wv; acc[4 * i + 3] += d[3] * wv; }
            }
            const float sc = ps[oc];
#pragma unroll
            for (int i = 0; i < 16; ++i) MIX[(size_t)(r0 + rh + i) * DM + 512 + oc] = to_bf16(acc[i] * sc);
        }
    }
    __syncthreads();
}

DI void phase_ret_scan(const Params& p0, int l) {
    const Params p = launder(p0); l = launder_s(l);
    const float* scal = (const float*)(p.ws + WS_SCAL) + l * 16;
    const float* UF = (const float*)(p.ws + WS_UF); const float* UB = (const float*)(p.ws + WS_UB);
    bf16_t* SF = (bf16_t*)(p.ws + WS_SF); bf16_t* SB = (bf16_t*)(p.ws + WS_SB);
    for (int i = bid_() * NTHREADS + tid_(); i < 2 * NB * 4 * 4096; i += gridDim.x * NTHREADS) {
        const int dir = i / (NB * 4 * 4096), rem = i % (NB * 4 * 4096), bh = rem >> 12, el = rem & 4095, h = bh & 3;
        const float G = fast_exp2(128.0f * (dir ? scal[6 + h] : scal[2 + h]));
        float S = 0.f;
        if (dir == 0) {
#pragma unroll 11
            for (int c = 0; c < NCHUNK; ++c) { const size_t o = ((size_t)bh * NCHUNK + c) * 4096 + el; SF[o] = to_bf16(S); S = S * G + UF[o]; } }
        else {
#pragma unroll 11
            for (int c = NCHUNK - 1; c >= 0; --c) { const size_t o = ((size_t)bh * NCHUNK + c) * 4096 + el; SB[o] = to_bf16(S); S = S * G + UB[o]; } }
    }
}

DI void attn_unit(const Params& p, int b, int h, int q_p0, int ntile, float lam, float oscale, LAS unsigned char* lds) {
    const int tid = tid_(), lane = tid & 63, wid = __builtin_amdgcn_readfirstlane(tid >> 6), map = wid >> 2, wq = wid & 3, r = lane & 31, hh = lane >> 5;
    const bf16_t* P = (const bf16_t*)(p.ws + WS_P);
    const bf16_t* VT = (const bf16_t*)(p.ws + WS_VT);
    bf16_t* MIX = (bf16_t*)(p.ws + WS_MIX);
    const size_t rowbase = (size_t)b * NT;
    const int qrow = q_p0 + wq * 32 + r;
    bf16x8 qf[4];
#pragma unroll
    for (int ks = 0; ks < 4; ++ks) qf[ks] = *(const bf16x8*)(P + (rowbase + qrow) * INW + C_DQ + h * 128 + map * 64 + ks * 16 + hh * 8);
    constexpr int ASTG = 32768;
    const bf16_t* ksrc0; const bf16_t* ksrc1; const bf16_t* vsrc0; const bf16_t* vsrc1;
    { const int key = tid >> 4, ph = tid & 15, c = ph ^ (key & 15);
      ksrc0 = P + (rowbase + key) * INW + C_DK + h * 128 + c * 8; ksrc1 = ksrc0 + (size_t)32 * INW;
      const int e = tid >> 3, pv = tid & 7, cv = pv ^ ((e >> 1) & 7);
      vsrc0 = VT + ((size_t)(b * 4 + h) * 128 + e) * NT + cv * 8; vsrc1 = vsrc0 + (size_t)64 * NT; }
    const int ddst = wid * 1024;
#define ATT_ISSUE(S, KT) do { LAS unsigned char* _s = lds + (S) * ASTG + ddst; const size_t _ko = (size_t)(KT) * 64 * INW; const int _vo = (KT) * 64; \
        dma16(ksrc0 + _ko, _s); dma16(ksrc1 + _ko, _s + 8192); dma16(vsrc0 + _vo, _s + 16384); dma16(vsrc1 + _vo, _s + 24576); } while (0)
    f32x16 o[4];
#pragma unroll
    for (int eb = 0; eb < 4; ++eb)
#pragma unroll
        for (int i = 0; i < 16; ++i) o[eb][i] = 0.f;
    f32x16 negm;
#pragma unroll
    for (int i = 0; i < 16; ++i) negm[i] = 0.f;
    float m_run = 0.f, l_run = 0.f;
    __syncthreads();
    ATT_ISSUE(0, 0);
    if (ntile > 1) ATT_ISSUE(1, 1);
    if (ntile > 2) ATT_ISSUE(2, 2);
    for (int kt = 0; kt < ntile; ++kt) {
        PRB_T0(1, lds);
        if (kt + 2 < ntile) WAIT_VM(8); else if (kt + 1 < ntile) WAIT_VM(4); else WAIT_VM(0);
        asm volatile("s_waitcnt lgkmcnt(0)" ::: "memory");
        __builtin_amdgcn_s_barrier();
        PRB_T1(1, lds); PRB_T0(2, lds);
        const int st = kt & 3, st2 = (kt + 3) & 3;
        if (map == 0 && kt + 3 < ntile) ATT_ISSUE(st2, kt + 3);
        LAS unsigned char* L = lds + st * ASTG;
        bf16x8 kf[8], va[4], vb[4];
#pragma unroll
        for (int ks = 0; ks < 4; ++ks) {
            const int ch = map * 8 + ks * 2 + hh;
            const int off = r * 256 + ((ch ^ (r & 15)) << 4);
            kf[2 * ks] = *(LAS bf16x8*)(L + off);
            kf[2 * ks + 1] = *(LAS bf16x8*)(L + off + 32 * 256);
        }
#define ATT_VREAD(dst, S_) do { _Pragma("unroll") for (int eb = 0; eb < 4; ++eb) { const int e = eb * 32 + r; \
            dst[eb] = *(LAS bf16x8*)(L + 16384 + e * 128 + ((((S_) * 2 + hh) ^ ((e >> 1) & 7)) << 4)); } } while (0)
#define ATT_PACK(dst, SRC, B_) do { u32x4 _pw; _Pragma("unroll") for (int q = 0; q < 4; ++q) _pw[q] = pk_bf16(SRC[(B_) + 2 * q], SRC[(B_) + 2 * q + 1]); dst = as_bf16x8(_pw); } while (0)
#define ATT_EXP8(SRC, B_) do { _Pragma("unroll") for (int i = 0; i < 8; ++i) { SRC[(B_) + i] = fast_exp2(SRC[(B_) + i]); rsum += SRC[(B_) + i]; pmx = fmaxf(pmx, SRC[(B_) + i]); } } while (0)
        ATT_VREAD(va, 0);
        asm volatile("" ::: "memory");
        f32x16 s0 = negm, s1 = negm;
#pragma unroll
        for (int ks = 0; ks < 4; ++ks) { s0 = MFMA32(kf[2 * ks], qf[ks], s0); s1 = MFMA32(kf[2 * ks + 1], qf[ks], s1); }
        if (map == 1 && kt + 3 < ntile) ATT_ISSUE(st2, kt + 3);
        PRB_T1(2, lds); PRB_T0(3, lds);
        if (kt == 0) {
            float mx = fmaxf(fmaxf(s0[0], s0[1]), s0[2]);
#pragma unroll
            for (int i = 3; i < 15; i += 2) mx = fmaxf(fmaxf(mx, s0[i]), s0[i + 1]);
            mx = fmaxf(mx, s0[15]);
#pragma unroll
            for (int i = 0; i < 16; i += 2) mx = fmaxf(fmaxf(mx, s1[i]), s1[i + 1]);
            mx = fmaxf(mx, __shfl_xor(mx, 32));
            m_run = mx;
#pragma unroll
            for (int i = 0; i < 16; ++i) { s0[i] -= mx; s1[i] -= mx; negm[i] = -mx; }
        }
        float rsum = 0.f, pmx = 0.f;
        bf16x8 pb;
        ATT_EXP8(s0, 0); ATT_PACK(pb, s0, 0);
        ATT_VREAD(vb, 1); asm volatile("" ::: "memory");
#pragma unroll
        for (int eb = 0; eb < 4; ++eb) o[eb] = MFMA32(va[eb], pb, o[eb]);
        ATT_EXP8(s0, 8); ATT_PACK(pb, s0, 8);
        ATT_VREAD(va, 2); asm volatile("" ::: "memory");
#pragma unroll
        for (int eb = 0; eb < 4; ++eb) o[eb] = MFMA32(vb[eb], pb, o[eb]);
        ATT_EXP8(s1, 0); ATT_PACK(pb, s1, 0);
        ATT_VREAD(vb, 3); asm volatile("" ::: "memory");
#pragma unroll
        for (int eb = 0; eb < 4; ++eb) o[eb] = MFMA32(va[eb], pb, o[eb]);
        ATT_EXP8(s1, 8); ATT_PACK(pb, s1, 8);
#pragma unroll
        for (int eb = 0; eb < 4; ++eb) o[eb] = MFMA32(vb[eb], pb, o[eb]);
        l_run += rsum;
        PRB_T1(3, lds);
#undef ATT_VREAD
#undef ATT_PACK
#undef ATT_EXP8
        pmx = fmaxf(pmx, __shfl_xor(pmx, 32));
        if (__any(pmx > 256.0f)) {
            const float d = pmx > 256.0f ? __builtin_amdgcn_logf(pmx) : 0.f;
            const float alpha = fast_exp2(-d);
            m_run += d; l_run *= alpha;
#pragma unroll
            for (int i = 0; i < 16; ++i) negm[i] = -m_run;
#pragma unroll
            for (int eb = 0; eb < 4; ++eb)
#pragma unroll
                for (int i = 0; i < 16; ++i) o[eb][i] *= alpha;
        }
    }
#undef ATT_ISSUE
    __syncthreads();
    const float lt = l_run + __shfl_xor(l_run, 32);
    const float inv = 1.0f / lt;
    LAS float* X = (LAS float*)lds;
    if (map == 1) {
#pragma unroll
        for (int eb = 0; eb < 4; ++eb)
#pragma unroll
            for (int i = 0; i < 16; ++i) X[(wq * 64 + eb * 16 + i) * 64 + lane] = o[eb][i] * inv;
    }
    __syncthreads();
    if (map == 0) {
        float ss = 0.f;
#pragma unroll
        for (int eb = 0; eb < 4; ++eb)
#pragma unroll
            for (int i = 0; i < 16; ++i) { const float v = o[eb][i] * inv - lam * X[(wq * 64 + eb * 16 + i) * 64 + lane]; o[eb][i] = v; ss += v * v; }
        ss += __shfl_xor(ss, 32);
        const float sc = rsqrtf(ss * (1.0f / 128.0f) + RMS_EPS) * oscale;
        LAS unsigned char* W = lds + 65536 + wq * 8704;
#pragma unroll
        for (int eb = 0; eb < 4; ++eb)
#pragma unroll
            for (int q = 0; q < 4; ++q) {
                const int e = eb * 32 + 8 * q + 4 * hh;
                const u32x2 w = {pk_bf16(o[eb][4 * q] * sc, o[eb][4 * q + 1] * sc), pk_bf16(o[eb][4 * q + 2] * sc, o[eb][4 * q + 3] * sc)};
                *(LAS u32x2*)(W + r * 272 + e * 2) = w;
            }
#pragma unroll
        for (int it = 0; it < 8; ++it) {
            const int row = it * 4 + (lane >> 4), ch = lane & 15;
            const u32x4 v = *(LAS u32x4*)(W + row * 272 + ch * 16);
            *(u32x4*)(MIX + (rowbase + q_p0 + wq * 32 + row) * DM + h * 128 + ch * 8) = v;
        }
    }
    __syncthreads();
}

DI void ret_unit(const Params& p, int l, int b, int h, int c) {
    const int tid = tid_(), lane = tid & 63, wid = tid >> 6, fr = lane & 15, g = lane >> 4;
    const float* scal = (const float*)(p.ws + WS_SCAL) + l * 16;
    const float lf2 = scal[2 + h], lb2 = scal[6 + h];
    const bf16_t* P = (const bf16_t*)(p.ws + WS_P);
    const bf16_t* RVT = (const bf16_t*)(p.ws + WS_RVT);
    const bf16_t* SF = (const bf16_t*)(p.ws + WS_SF); const bf16_t* SB = (const bf16_t*)(p.ws + WS_SB);
    bf16_t* MIX = (bf16_t*)(p.ws + WS_MIX);
    const int bh = b * 4 + h;
    const size_t row0 = (size_t)b * NT + c * 128;
    const int iloc = wid * 16 + fr;
    u32x4 qraw[2];
#pragma unroll
    for (int ks = 0; ks < 2; ++ks) qraw[ks] = *(const u32x4*)(P + (row0 + iloc) * INW + C_RQ + h * 64 + ks * 32 + 8 * g);
    bf16x8 kf[8][2];
#pragma unroll
    for (int jb = 0; jb < 8; ++jb)
#pragma unroll
        for (int ks = 0; ks < 2; ++ks) kf[jb][ks] = *(const bf16x8*)(P + (row0 + jb * 16 + fr) * INW + C_RK + h * 64 + ks * 32 + 8 * g);
    u32x4 vf[4][4];
#pragma unroll
    for (int jj = 0; jj < 4; ++jj)
#pragma unroll
        for (int eb = 0; eb < 4; ++eb) {
            const bf16_t* vp = RVT + ((size_t)bh * 64 + eb * 16 + fr) * NT + c * 128 + jj * 32 + 4 * g;
            const u32x2 v0 = *(const u32x2*)vp, v1 = *(const u32x2*)(vp + 16);
            vf[jj][eb] = (u32x4){v0[0], v0[1], v1[0], v1[1]};
        }
    f32x4 st[8];
#pragma unroll
    for (int jb = 0; jb < 8; ++jb) {
        st[jb] = (f32x4){0.f, 0.f, 0.f, 0.f};
#pragma unroll
        for (int ks = 0; ks < 2; ++ks) st[jb] = MFMA16(kf[jb][ks], as_bf16x8(qraw[ks]), st[jb]);
    }
    const int vc = c >= 2 ? c - 2 : 64 + c;
    const bf16_t* sf = SF + ((size_t)bh * NCHUNK + c) * 4096 + fr * 64 + 8 * g;
    const bf16_t* sb = SB + ((size_t)bh * NCHUNK + vc) * 4096 + fr * 64 + 8 * g;
    bf16x8 sfa[2][4], sba[2][4];
#pragma unroll
    for (int ks = 0; ks < 2; ++ks)
#pragma unroll
        for (int eb = 0; eb < 4; ++eb) { sfa[ks][eb] = *(const bf16x8*)(sf + eb * 1024 + ks * 32); sba[ks][eb] = *(const bf16x8*)(sb + eb * 1024 + ks * 32); }
    u32x2 gw[4];
#pragma unroll
    for (int eb = 0; eb < 4; ++eb) gw[eb] = *(const u32x2*)(P + (row0 + iloc) * INW + C_RG + h * 64 + eb * 16 + 4 * g);
#pragma unroll
    for (int jb = 0; jb < 8; ++jb)
#pragma unroll
        for (int q = 0; q < 4; ++q) {
            const int j = jb * 16 + 4 * g + q;
            const int d = iloc - j;
            const float w = d > 0 ? fast_exp2((float)d * lf2) : (d < 0 ? fast_exp2((float)(-d) * lb2) : 2.0f);
            st[jb][q] *= w;
        }
    f32x4 ot[4];
#pragma unroll
    for (int eb = 0; eb < 4; ++eb) ot[eb] = (f32x4){0.f, 0.f, 0.f, 0.f};
#pragma unroll
    for (int jj = 0; jj < 4; ++jj) {
        const u32x4 pw = {pk_bf16(st[2 * jj][0], st[2 * jj][1]), pk_bf16(st[2 * jj][2], st[2 * jj][3]), pk_bf16(st[2 * jj + 1][0], st[2 * jj + 1][1]), pk_bf16(st[2 * jj + 1][2], st[2 * jj + 1][3])};
#pragma unroll
        for (int eb = 0; eb < 4; ++eb) ot[eb] = MFMA16(as_bf16x8(vf[jj][eb]), as_bf16x8(pw), ot[eb]);
    }
    const float df = fast_exp2((float)(iloc + 1) * lf2), db = fast_exp2((float)(128 - iloc) * lb2);
#pragma unroll
    for (int ks = 0; ks < 2; ++ks) {
        u32x4 qf, qb;
#pragma unroll
        for (int q = 0; q < 4; ++q) { const float a = bf_lo(qraw[ks][q]), bb = bf_hi(qraw[ks][q]); qf[q] = pk_bf16(a * df, bb * df); qb[q] = pk_bf16(a * db, bb * db); }
#pragma unroll
        for (int eb = 0; eb < 4; ++eb) {
            ot[eb] = MFMA16(sfa[ks][eb], as_bf16x8(qf), ot[eb]);
            ot[eb] = MFMA16(sba[ks][eb], as_bf16x8(qb), ot[eb]);
        }
    }
    float s = 0.f;
#pragma unroll
    for (int eb = 0; eb < 4; ++eb) s += (ot[eb][0] + ot[eb][1]) + (ot[eb][2] + ot[eb][3]);
    s += __shfl_xor(s, 16); s += __shfl_xor(s, 32);
    const float mu = s * (1.0f / 64.0f);
    float q2 = 0.f;
#pragma unroll
    for (int eb = 0; eb < 4; ++eb)
#pragma unroll
        for (int q = 0; q < 4; ++q) { const float d = ot[eb][q] - mu; q2 += d * d; }
    q2 += __shfl_xor(q2, 16); q2 += __shfl_xor(q2, 32);
    const float rstd = rsqrtf(q2 * (1.0f / 64.0f) + LN_EPS);
#pragma unroll
    for (int eb = 0; eb < 4; ++eb) {
        const int e = eb * 16 + 4 * g;
        const float g0 = bf_lo(gw[eb][0]), g1 = bf_hi(gw[eb][0]), g2 = bf_lo(gw[eb][1]), g3 = bf_hi(gw[eb][1]);
        u32x2 w = {pk_bf16((ot[eb][0] - mu) * rstd * silu_f(g0), (ot[eb][1] - mu) * rstd * silu_f(g1)),
                   pk_bf16((ot[eb][2] - mu) * rstd * silu_f(g2), (ot[eb][3] - mu) * rstd * silu_f(g3))};
        *(u32x2*)(MIX + (row0 + iloc) * DM + 768 + h * 64 + e) = w;
    }
}

DI void phase_attn(const Params& p0, int l, LAS unsigned char* lds) {
    const Params p = launder(p0); l = launder_s(l);
    const float* scal = (const float*)(p.ws + WS_SCAL) + l * 16;
    const float lam = scal[0], oscale = scal[1];
    const int nunits = NB * 4 * 64 + (l == 0 ? NB * 4 * 2 : 0);
    for (int u = bid_(); u < nunits; u += gridDim.x) {
        int b, h, q0, ntile;
        if (u < NB * 4 * 64) { const int qt = u & 63; h = (u >> 6) & 3; b = u >> 8; q0 = NCTX + qt * 128; ntile = NT / 64; }
        else { const int v = u - NB * 4 * 64; const int qt = v & 1; h = (v >> 1) & 3; b = v >> 3; q0 = qt * 128; ntile = NCTX / 64; }
        attn_unit(p, b, h, q0, ntile, lam, oscale, lds);
    }
}
DI void phase_ret(const Params& p0, int l) {
    const Params p = launder(p0); l = launder_s(l);
    for (int u = bid_(); u < NB * 4 * NCHUNK; u += gridDim.x) {
        const int c = u % NCHUNK, bh = u / NCHUNK;
        if (l == 1 && c < 2) continue;
        ret_unit(p, l, bh >> 2, bh & 3, c);
    }
}

DI void phase_outproj(const Params& p0, int l, LAS unsigned char* lds) {
    const Params p = launder(p0); l = launder_s(l);
    const float* Xin = (const float*)(p.ws + WS_XA);
    const bf16_t* A = (const bf16_t*)(p.ws + WS_MIX);
    const bf16_t* W = (const bf16_t*)(p.ws + WS_WOUT) + (size_t)l * DM * DM;
    float* V1 = (float*)(p.ws + WS_V1);
    const float* modv = (const float*)(p.ws + WS_MODV) + (size_t)l * 3 * 6144;
    for (int u = bid_(); u < (MROWS / 192) * 8; u += gridDim.x) {
        const int tm = u >> 3, tn = u & 7;
        auto epi = [&](f32x4 (&acc)[4][3], int wm, int wn, int fr, int fq, int lane, int wid) {
            const int c0 = tn * 128 + wn * 64, r0 = tm * 192 + wm * 48;
            LAS unsigned char* W_ = g2_stage(lds, wid);
#pragma unroll
            for (int nf = 0; nf < 4; ++nf)
#pragma unroll
                for (int mf = 0; mf < 3; ++mf) *(LAS f32x4*)(W_ + (mf * 16 + fr) * 272 + nf * 64 + fq * 16) = acc[nf][mf];
#pragma unroll
            for (int it = 0; it < 12; ++it) {
                const int row = it * 4 + (lane >> 4), ch = lane & 15;
                const int grow = r0 + row;
                const f32x4 y = *(LAS f32x4*)(W_ + row * 272 + ch * 16);
                const f32x4 xv = *(const f32x4*)(Xin + (size_t)grow * DM + c0 + ch * 4);
                const f32x4 g2 = *(const f32x4*)(modv + (size_t)row_sel(grow) * 6144 + 2 * 1024 + c0 + ch * 4);
                *(f32x4*)(V1 + (size_t)grow * DM + c0 + ch * 4) = (f32x4){DN_ALPHA * xv[0] + g2[0] * y[0], DN_ALPHA * xv[1] + g2[1] * y[1], DN_ALPHA * xv[2] + g2[2] * y[2], DN_ALPHA * xv[3] + g2[3] * y[3]};
            }
        };
        gemm192(A, DM, W, DM, DM / 64, tm * 192, tn * 128, lds, epi);
    }
}

DI void phase_ln_mid(const Params& p0, int l) {
    const Params p = launder(p0); l = launder_s(l);
    float* Xout = (float*)(p.ws + WS_XB);
    const int lane = tid_() & 63, wid = tid_() >> 6;
    const float* V1 = (const float*)(p.ws + WS_V1);
    bf16_t* TOK = (bf16_t*)(p.ws + WS_TOK);
    const float* modv = (const float*)(p.ws + WS_MODV) + (size_t)l * 3 * 6144;
    const float* lg = p.ln_g + (size_t)(l * 2 + 0) * DM; const float* lb = p.ln_b + (size_t)(l * 2 + 0) * DM;
    for (int r = bid_() * 8 + wid; r < MROWS; r += gridDim.x * 8) {
        f32x4 v[4];
#pragma unroll
        for (int i = 0; i < 4; ++i) v[i] = *(const f32x4*)(V1 + (size_t)r * DM + lane * 4 + i * 256);
        float mu, rstd; ln_stats(v, mu, rstd);
#pragma unroll
        for (int i = 0; i < 4; ++i) {
            const int c = lane * 4 + i * 256;
            const f32x4 gg = *(const f32x4*)(lg + c), bb = *(const f32x4*)(lb + c);
#pragma unroll
            for (int j = 0; j < 4; ++j) v[i][j] = (v[i][j] - mu) * rstd * gg[j] + bb[j];
            *(f32x4*)(Xout + (size_t)r * DM + c) = v[i];
        }
        const float* mv = modv + (size_t)row_sel(r) * 6144;
        modulate_store(v, mv + 3 * 1024, mv + 4 * 1024, TOK + (size_t)r * DM, lane);
    }
}

DI void phase_router(const Params& p0, int l, LAS unsigned char* lds) {
    const Params p = launder(p0); l = launder_s(l);
    const bf16_t* A = (const bf16_t*)(p.ws + WS_TOK);
    const bf16_t* W = (const bf16_t*)(p.ws + WS_WR) + (size_t)l * 256 * DM;
    float* LG = (float*)(p.ws + WS_LOGIT);
    for (int u = bid_(); u < (MROWS / 192) * 2; u += gridDim.x) {
        const int tm = u >> 1, tn = u & 1;
        auto epi = [&](f32x4 (&acc)[4][3], int wm, int wn, int fr, int fq, int lane, int wid) {
            const int c0 = tn * 128 + wn * 64, r0 = tm * 192 + wm * 48;
            LAS unsigned char* W_ = g2_stage(lds, wid);
#pragma unroll
            for (int nf = 0; nf < 4; ++nf)
#pragma unroll
                for (int mf = 0; mf < 3; ++mf) *(LAS f32x4*)(W_ + (mf * 16 + fr) * 272 + nf * 64 + fq * 16) = acc[nf][mf];
#pragma unroll
            for (int it = 0; it < 12; ++it) {
                const int row = it * 4 + (lane >> 4), ch = lane & 15;
                *(f32x4*)(LG + (size_t)(r0 + row) * 256 + c0 + ch * 4) = *(LAS f32x4*)(W_ + row * 272 + ch * 16);
            }
        };
        gemm192(A, DM, W, DM, DM / 64, tm * 192, tn * 128, lds, epi);
    }
}

DI void phase_topk(const Params& p0, int l, LAS unsigned char* lds) {
    const Params p = launder(p0); l = launder_s(l);
    const int lane = tid_() & 63, wid = tid_() >> 6, rs = lane >> 3, g = lane & 7;
    const float* LG = (const float*)(p.ws + WS_LOGIT);
    const float* bias = p.router_bias + l * 256 + g * 32;
    int* EIDX = (int*)(p.ws + WS_EIDX); float* GATE = (float*)(p.ws + WS_GATE);
    int* RANK = (int*)(p.ws + WS_RANK); int* HIST = (int*)(p.ws + WS_HIST);
    LAS int* hist = (LAS int*)lds;
    if (tid_() < 256) hist[tid_()] = 0;
    __syncthreads();
    const int chunk = (MROWS + (int)gridDim.x - 1) / (int)gridDim.x, r_begin = bid_() * chunk, r_end = (r_begin + chunk) < MROWS ? (r_begin + chunk) : MROWS;
    for (int base = r_begin + wid * 8; base < r_end; base += 64) {
        const int row = base + rs; const bool valid = row < r_end;
        const float* lp = LG + (size_t)(valid ? row : r_begin) * 256 + g * 32;
        float sc[32], gv[32];
#pragma unroll
        for (int q = 0; q < 8; ++q) {
            const f32x4 lg = *(const f32x4*)(lp + 4 * q), bv = *(const f32x4*)(bias + 4 * q);
#pragma unroll
            for (int j = 0; j < 4; ++j) { sc[4 * q + j] = 1.0f / (1.0f + __expf(-lg[j])); gv[4 * q + j] = sc[4 * q + j] + bv[j]; }
        }
        float m1 = fmaxf(gv[0], gv[1]), m2 = fminf(gv[0], gv[1]);
#pragma unroll
        for (int i = 2; i < 32; ++i) { const float v = gv[i]; m2 = fmaxf(m2, fminf(m1, v)); m1 = fmaxf(m1, v); }
        const float gs = m1 + m2;
        int rank = 0;
#pragma unroll
        for (int g2 = 0; g2 < 8; ++g2) { const float o = __shfl(gs, (lane & 56) + g2); rank += (o > gs || (o == gs && g2 < g)) ? 1 : 0; }
        if (rank >= 4) {
#pragma unroll
            for (int i = 0; i < 32; ++i) gv[i] = -INFINITY;
        }
        float ssum = 0.f, mysc = 0.f; int myidx = 0;
#pragma unroll 1
        for (int k = 0; k < TOPK; ++k) {
            float bv = gv[0], bs = sc[0]; int bi = 0;
#pragma unroll
            for (int i = 1; i < 32; ++i) { const bool gt = gv[i] > bv; bv = gt ? gv[i] : bv; bs = gt ? sc[i] : bs; bi = gt ? i : bi; }
            int gi = g * 32 + bi;
#pragma unroll
            for (int o = 1; o < 8; o <<= 1) {
                const float ov = __shfl_xor(bv, o), os = __shfl_xor(bs, o); const int oi = __shfl_xor(gi, o);
                const bool tk = ov > bv || (ov == bv && oi < gi);
                bv = tk ? ov : bv; bs = tk ? os : bs; gi = tk ? oi : gi;
            }
            if ((gi >> 5) == g) {
                const int oi = gi & 31;
#pragma unroll
                for (int i = 0; i < 32; ++i) gv[i] = (i == oi) ? -INFINITY : gv[i];
            }
            ssum += bs;
            if (g == k) { mysc = bs; myidx = gi; }
        }
        if (valid) {
            EIDX[(size_t)row * 8 + g] = myidx;
            GATE[(size_t)row * 8 + g] = mysc / ssum * 2.5f;
            RANK[(size_t)row * 8 + g] = __hip_atomic_fetch_add(hist + myidx, 1, __ATOMIC_RELAXED, __HIP_MEMORY_SCOPE_WORKGROUP);
        }
    }
    __syncthreads();
    if (tid_() < 256) HIST[(size_t)bid_() * 256 + tid_()] = hist[tid_()];
    __syncthreads();
}

DI void phase_scatter(const Params& p0, int l, LAS unsigned char* lds) {
    const Params p = launder(p0); l = launder_s(l);
    LAS int* off = (LAS int*)lds;
    LAS int* toff = off + 260;
    LAS int* tot = toff + 260;
    LAS int* base = tot + 256;
    const int tid = tid_(), bid = bid_(), G = gridDim.x;
    const int* HIST = (const int*)(p.ws + WS_HIST);
    const int* RANK = (const int*)(p.ws + WS_RANK);
    int* ntl = (int*)(p.ws + CTL_NTILES) + l;
    int* TILES = (int*)(p.ws + WS_TILES);
    const int* EIDX = (const int*)(p.ws + WS_EIDX);
    int* SORT = (int*)(p.ws + WS_SORT);
    if (tid < 256) {
        int t = 0, bs = 0;
#pragma unroll 16
        for (int b2 = 0; b2 < G; ++b2) { const int v = HIST[(size_t)b2 * 256 + tid]; bs += (b2 < bid) ? v : 0; t += v; }
        tot[tid] = t; base[tid] = bs;
    }
    __syncthreads();
    if (tid == 0) {
        int a = 0, t = 0;
        for (int e = 0; e < 256; ++e) { off[e] = a; toff[e] = t; const int c = tot[e]; a += c; t += (c + 127) >> 7; }
        off[256] = a; toff[256] = t;
    }
    __syncthreads();
    if (bid == 0) {
        if (tid < 256) {
            const int e = tid, c = off[e + 1] - off[e], nt = toff[e + 1] - toff[e];
            for (int t = 0; t < nt; ++t) { int* T = TILES + (size_t)(toff[e] + t) * 4; T[0] = e; T[1] = off[e] + t * 128; T[2] = (c - t * 128) < 128 ? (c - t * 128) : 128; T[3] = 0; }
        }
        if (tid == 0) *ntl = toff[256];
    }
    const int chunk = (MROWS + G - 1) / G, r_begin = bid * chunk, r_end = (r_begin + chunk) < MROWS ? (r_begin + chunk) : MROWS;
    for (int a = r_begin * 8 + tid; a < r_end * 8; a += NTHREADS) {
        const int e = EIDX[a];
        SORT[off[e] + base[e] + RANK[a]] = a;
    }
    __syncthreads();
}

constexpr int MOE_STG = 40960;
constexpr int MOE_HT = 86016;
constexpr int MOE_INFO = MOE_HT + 65536;
constexpr int IMG_BYTES = 32768, IMG_PER_E = 48;
DI int swz64(int row, int chunk) { return row * 64 + ((chunk ^ ((0 - (row >> 2)) & 3)) << 4); }

struct ImgJob { const float* wp; int ldw; unsigned char* d; int g; };
DI ImgJob img_job(const Params& p, int l, int uu, unsigned char* IMG) {
    const int u = (NEXP + 1) * IMG_PER_E - 1 - uu;
    const int e = u / IMG_PER_E, im = u % IMG_PER_E;
    const int np = tid_();
    ImgJob j;
    if (im < 32) {
        const float* W = e < NEXP ? p.w_egu + ((size_t)l * NEXP + e) * DM * 512 : p.w_sgu + (size_t)l * DM * 512;
        j.ldw = 512; j.wp = W + (size_t)(im * 32) * 512 + (((np >> 4) & 1) * 256 + (np >> 5) * 16 + (np & 15));
    } else {
        const float* W = e < NEXP ? p.w_edn + ((size_t)l * NEXP + e) * 256 * DM : p.w_sdn + (size_t)l * 256 * DM;
        j.ldw = DM; j.wp = W + (size_t)(((im - 32) & 7) * 32) * DM + ((im - 32) >> 3) * 512 + np;
    }
    j.d = IMG + (size_t)u * IMG_BYTES + np * 64; j.g = (0 - (np >> 2)) & 3;
    return j;
}
DI void img_load(const ImgJob& j, float (&wb)[32]) {
#pragma unroll
    for (int kk = 0; kk < 32; ++kk) wb[kk] = __builtin_nontemporal_load(j.wp + (size_t)kk * j.ldw);
}
DI void img_store(const ImgJob& j, const float (&wb)[32]) {
#pragma unroll
    for (int c = 0; c < 4; ++c) { const u32x4 w = {pk_bf16(wb[8 * c], wb[8 * c + 1]), pk_bf16(wb[8 * c + 2], wb[8 * c + 3]), pk_bf16(wb[8 * c + 4], wb[8 * c + 5]), pk_bf16(wb[8 * c + 6], wb[8 * c + 7])}; *(u32x4*)(j.d + ((c ^ j.g) << 4)) = w; }
}
DI void phase_convert_experts(const Params& p0, int l) {
    const Params p = launder(p0); l = launder_s(l);
    unsigned char* IMG = p.ws + WS_WIMG + (size_t)l * (NEXP + 1) * IMG_PER_E * IMG_BYTES;
    const int total = (NEXP + 1) * IMG_PER_E, G = gridDim.x;
    float wa[32], wb[32];
    int u = bid_();
    if (u >= total) return;
    ImgJob ja = img_job(p, l, u, IMG), jb = ja;
    img_load(ja, wa);
    for (;;) {
        const bool hb = u + G < total;
        if (hb) { jb = img_job(p, l, u + G, IMG); img_load(jb, wb); }
        img_store(ja, wa);
        if (!hb) break;
        u += G;
        const bool ha = u + G < total;
        if (ha) { ja = img_job(p, l, u + G, IMG); img_load(ja, wa); }
        img_store(jb, wb);
        if (!ha) break;
        u += G;
    }
}

DI void moe_unit(const Params& p, const unsigned char* img, bf16_t* outbase, bool shared, int r0, int nr, LAS unsigned char* lds) {
    const int t = tid_(), lane = t & 63, wid = __builtin_amdgcn_readfirstlane(t >> 6), fr = lane & 15, fq = lane >> 4, wn = wid & 3, wt = wid >> 2;
    const bf16_t* TOK = (const bf16_t*)(p.ws + WS_TOK);
    const int* SORT = (const int*)(p.ws + WS_SORT);
    LAS int* rowout = (LAS int*)(lds + MOE_INFO);
    const int arow = t >> 2;
    int atok = 0, aout = -1;
    if (arow < nr) { if (shared) { atok = r0 + arow; aout = atok; } else { aout = SORT[r0 + arow]; atok = aout >> 3; } }
    const bf16_t* aptr = TOK + (size_t)atok * DM + (((t & 3) ^ ((0 - (arow >> 2)) & 3)) << 3);
    __syncthreads();
    if ((t & 3) == 0) rowout[arow] = aout;
    const unsigned char* wsrc = img + (size_t)t * 16;
    const int adst = wid * 1024, wdst = 8192 + wid * 1024;
#define MOE_ISSUE1(S, KT) do { LAS unsigned char* _s = lds + (S) * MOE_STG; dma16(aptr + (KT) * 32, _s + adst); \
        const unsigned char* _w = wsrc + (size_t)(KT) * IMG_BYTES; \
        dma16(_w, _s + wdst); dma16(_w + 8192, _s + wdst + 8192); dma16(_w + 16384, _s + wdst + 16384); dma16(_w + 24576, _s + wdst + 24576); } while (0)
#define MOE_ISSUE2(S, IM) do { LAS unsigned char* _s = lds + (S) * IMG_BYTES; const unsigned char* _w = wsrc + (size_t)(IM) * IMG_BYTES; \
        dma16(_w, _s + adst); dma16(_w + 8192, _s + adst + 8192); dma16(_w + 16384, _s + adst + 16384); dma16(_w + 24576, _s + adst + 24576); } while (0)
    f32x4 acc[8][4];
#pragma unroll
    for (int nf = 0; nf < 8; ++nf)
#pragma unroll
        for (int tf = 0; tf < 4; ++tf) acc[nf][tf] = (f32x4){0.f, 0.f, 0.f, 0.f};
    MOE_ISSUE1(0, 0);
    MOE_ISSUE1(1, 1);
    int st = 0;
    for (int kt = 0; kt < 32; ++kt) {
        if (kt < 31) WAIT_VM(5); else WAIT_VM(0);
        asm volatile("s_waitcnt lgkmcnt(0)" ::: "memory");
        __builtin_amdgcn_s_barrier();
        const int st2 = st == 0 ? 2 : st - 1;
        if (wt == 0) { if (kt < 30) MOE_ISSUE1(st2, kt + 2); else if (kt == 31) MOE_ISSUE2(0, 32); }
        LAS unsigned char* S = lds + st * MOE_STG;
        bf16x8 tfr[4];
#pragma unroll
        for (int tf = 0; tf < 4; ++tf) tfr[tf] = *(LAS bf16x8*)(S + swz64(wt * 64 + tf * 16 + fr, fq));
#pragma unroll
        for (int nf = 0; nf < 8; ++nf) {
            const bf16x8 wf = *(LAS bf16x8*)(S + 8192 + swz64(wn * 128 + nf * 16 + fr, fq));
#pragma unroll
            for (int tf = 0; tf < 4; ++tf) acc[nf][tf] = MFMA16(wf, tfr[tf], acc[nf][tf]);
            if (nf == 3 && wt == 1) { if (kt < 30) MOE_ISSUE1(st2, kt + 2); else if (kt == 31) MOE_ISSUE2(0, 32); }
        }
        st = st == 2 ? 0 : st + 1;
    }
#pragma unroll
    for (int i = 0; i < 4; ++i)
#pragma unroll
        for (int tf = 0; tf < 4; ++tf) {
            float hv[4];
#pragma unroll
            for (int j = 0; j < 4; ++j) hv[j] = silu_f(acc[2 * i][tf][j]) * acc[2 * i + 1][tf][j];
            const int tok = wt * 64 + tf * 16 + fr, hc = wn * 64 + i * 16 + 4 * fq;
            const u32x2 w = {pk_bf16(hv[0], hv[1]), pk_bf16(hv[2], hv[3])};
            *(LAS u32x2*)(lds + MOE_HT + tok * 512 + (((hc >> 3) ^ (tok & 15)) << 4) + (hc & 7) * 2) = w;
        }
#pragma unroll 1
    for (int nc = 0; nc < 2; ++nc) {
#pragma unroll
        for (int nf = 0; nf < 8; ++nf)
#pragma unroll
            for (int tf = 0; tf < 4; ++tf) acc[nf][tf] = (f32x4){0.f, 0.f, 0.f, 0.f};
        if (nc == 1) MOE_ISSUE2(0, 40);
        for (int kt = 0; kt < 8; ++kt) {
            WAIT_VM(0);
            asm volatile("s_waitcnt lgkmcnt(0)" ::: "memory");
            __builtin_amdgcn_s_barrier();
            if (wt == 0 && kt < 7) MOE_ISSUE2((kt + 1) & 1, 32 + nc * 8 + kt + 1);
            LAS unsigned char* S = lds + (kt & 1) * IMG_BYTES;
            bf16x8 tfr[4];
#pragma unroll
            for (int tf = 0; tf < 4; ++tf) { const int tok = wt * 64 + tf * 16 + fr; tfr[tf] = *(LAS bf16x8*)(lds + MOE_HT + tok * 512 + (((kt * 4 + fq) ^ (tok & 15)) << 4)); }
#pragma unroll
            for (int nf = 0; nf < 8; ++nf) {
                const bf16x8 wf = *(LAS bf16x8*)(S + swz64(wn * 128 + nf * 16 + fr, fq));
#pragma unroll
                for (int tf = 0; tf < 4; ++tf) acc[nf][tf] = MFMA16(wf, tfr[tf], acc[nf][tf]);
                if (nf == 3 && wt == 1 && kt < 7) MOE_ISSUE2((kt + 1) & 1, 32 + nc * 8 + kt + 1);
            }
        }
        __syncthreads();
        LAS unsigned char* W = lds + wid * 9216;
#pragma unroll
        for (int half = 0; half < 2; ++half) {
#pragma unroll
            for (int nh = 0; nh < 4; ++nh)
#pragma unroll
                for (int tf = 0; tf < 4; ++tf) {
                    const f32x4 v = acc[half * 4 + nh][tf];
                    const u32x2 w = {pk_bf16(v[0], v[1]), pk_bf16(v[2], v[3])};
                    *(LAS u32x2*)(W + (tf * 16 + fr) * 144 + nh * 32 + fq * 8) = w;
                }
#pragma unroll
            for (int it = 0; it < 8; ++it) {
                const int row = it * 8 + (lane >> 3), ch = lane & 7;
                const u32x4 v = *(LAS u32x4*)(W + row * 144 + ch * 16);
                const int ro = rowout[wt * 64 + row];
                if (ro >= 0) *(u32x4*)(outbase + (size_t)ro * DM + nc * 512 + wn * 128 + half * 64 + ch * 8) = v;
            }
        }
        __syncthreads();
    }
#undef MOE_ISSUE1
#undef MOE_ISSUE2
}

DI void phase_moe(const Params& p0, int l, LAS unsigned char* lds) {
    const Params p = launder(p0); l = launder_s(l);
    const int* TILES = (const int*)(p.ws + WS_TILES);
    const int ntl = *((const int*)(p.ws + CTL_NTILES) + l);
    const int G = gridDim.x, bid = bid_();
    int vcu = bid;
    if (p.ph_hi - p.ph_lo > 1) {
        volatile LAS unsigned* bst = (volatile LAS unsigned*)(lds + LDS_BYTES - 16);
        const unsigned xc = bst[2]; unsigned pre = 0;
        for (unsigned j = 0; j < 16; ++j) { const unsigned c = xb_ld((unsigned*)(p.ws + WS_CTL) + XB_XCNT(j)); pre += (j < xc) ? c : 0u; }
        vcu = (int)(pre + bst[3]);
    }
    const int total = ntl + MROWS / 128;
    const unsigned char* IMG = p.ws + WS_WIMG + (size_t)l * (NEXP + 1) * IMG_PER_E * IMG_BYTES;
    for (int u = vcu; u < total; u += G) {
        if (u < ntl) {
            const int e = TILES[u * 4], r0 = TILES[u * 4 + 1], nr = TILES[u * 4 + 2];
            moe_unit(p, IMG + (size_t)e * IMG_PER_E * IMG_BYTES, (bf16_t*)(p.ws + WS_YSLOT), false, r0, nr, lds);
        } else {
            const int tm = u - ntl;
            if (l == 1 && (tm % (NT / 128)) < 2) continue;
            moe_unit(p, IMG + (size_t)NEXP * IMG_PER_E * IMG_BYTES, (bf16_t*)(p.ws + WS_YSH), true, tm * 128, 128, lds);
        }
    }
}

DI void phase_combine(const Params& p0, int l) {
    const Params p = launder(p0); l = launder_s(l);
    const float* X1 = (const float*)(p.ws + WS_XB); float* Xnext = (float*)(p.ws + WS_XA);
    const int lane = tid_() & 63, wid = tid_() >> 6;
    const bf16_t* YSL = (const bf16_t*)(p.ws + WS_YSLOT); const bf16_t* YSH = (const bf16_t*)(p.ws + WS_YSH);
    const float* GATE = (const float*)(p.ws + WS_GATE);
    const float* modv = (const float*)(p.ws + WS_MODV);
    const float* lg = p.ln_g + (size_t)(l * 2 + 1) * DM; const float* lb = p.ln_b + (size_t)(l * 2 + 1) * DM;
    bf16_t* H = (bf16_t*)(p.ws + WS_H);
    for (int r = bid_() * 8 + wid; r < MROWS; r += gridDim.x * 8) {
        const int b = r >= NT, pp = r - b * NT;
        if (l == 1 && pp < NCTX) continue;
        const int sel = pp < NCTX ? 2 : b;
        float gt[8];
#pragma unroll
        for (int k = 0; k < 8; ++k) gt[k] = GATE[(size_t)r * 8 + k];
        const float* g5 = modv + ((size_t)l * 3 + sel) * 6144 + 5 * 1024;
        f32x4 v[4];
        u32x2 sl[4][9]; f32x4 xv4[4];
#pragma unroll
        for (int i = 0; i < 4; ++i) {
            const int c = lane * 4 + i * 256;
            sl[i][8] = *(const u32x2*)(YSH + (size_t)r * DM + c);
#pragma unroll
            for (int k = 0; k < 8; ++k) sl[i][k] = *(const u32x2*)(YSL + ((size_t)r * 8 + k) * DM + c);
            xv4[i] = *(const f32x4*)(X1 + (size_t)r * DM + c);
        }
#pragma unroll
        for (int i = 0; i < 4; ++i) {
            const int c = lane * 4 + i * 256;
            float f0 = bf_lo(sl[i][8][0]), f1 = bf_hi(sl[i][8][0]), f2 = bf_lo(sl[i][8][1]), f3 = bf_hi(sl[i][8][1]);
#pragma unroll
            for (int k = 0; k < 8; ++k) { const u32x2 w = sl[i][k]; f0 += gt[k] * bf_lo(w[0]); f1 += gt[k] * bf_hi(w[0]); f2 += gt[k] * bf_lo(w[1]); f3 += gt[k] * bf_hi(w[1]); }
            const f32x4 xv = xv4[i], gv = *(const f32x4*)(g5 + c);
            v[i] = (f32x4){DN_ALPHA * xv[0] + gv[0] * f0, DN_ALPHA * xv[1] + gv[1] * f1, DN_ALPHA * xv[2] + gv[2] * f2, DN_ALPHA * xv[3] + gv[3] * f3};
        }
        float mu, rstd; ln_stats(v, mu, rstd);
#pragma unroll
        for (int i = 0; i < 4; ++i) {
            const int c = lane * 4 + i * 256;
            const f32x4 gg = *(const f32x4*)(lg + c), bb = *(const f32x4*)(lb + c);
#pragma unroll
            for (int j = 0; j < 4; ++j) v[i][j] = (v[i][j] - mu) * rstd * gg[j] + bb[j];
            if (l == 1) *(f32x4*)(p.out + ((size_t)b * NLAT + (pp - NCTX)) * DM + c) = v[i];
            else *(f32x4*)(Xnext + (size_t)r * DM + c) = v[i];
        }
        if (l == 0) { const float* mv = modv + ((size_t)1 * 3 + sel) * 6144; modulate_store(v, mv, mv + 1024, H + (size_t)r * DM, lane); }
    }
}

constexpr int PH_PER_LAYER = 11, N_PHASES = 3 + 2 * PH_PER_LAYER;
__global__ void __launch_bounds__(NTHREADS, 2) mega(Params p) {
    extern __shared__ __attribute__((aligned(16))) unsigned char lds_raw[];
    LAS unsigned char* lds = (LAS unsigned char*)lds_raw;
    volatile LAS unsigned* bst = (volatile LAS unsigned*)(lds + LDS_BYTES - 16);
    if (PROBE_ID != 0 && threadIdx.x == 0) { PRB_WORDS(lds)[0] = 0ull; PRB_WORDS(lds)[1] = 0ull; }
    if (threadIdx.x == 0) { bst[0] = 0u; bst[1] = 0u; const unsigned xc = xb_xcc_id(); bst[2] = xc; bst[3] = xb_add((unsigned*)(p.ws + CTL_XRANK) + xc, 1u); }
    __syncthreads();
    const int lo = p.ph_lo, hi = p.ph_hi;
    XcdBarrier bar; bar.bar = (unsigned*)(p.ws + WS_CTL); bar.x = 0; bar.st = bst;
    if (hi - lo > 1) bar = xcd_barrier_post((unsigned*)(p.ws + WS_CTL), bst);
#ifndef ONLY_PHASE
#define ONLY_PHASE -1
#endif
#define IN(k) (lo <= (k) && (k) < hi)
#define ON(pid) (ONLY_PHASE < 0 || ONLY_PHASE == (pid))
#ifndef DUP_PHASE
#define DUP_PHASE -1
#endif
#define REP(pid) for (int rep_ = 0; rep_ < ((DUP_PHASE == (pid)) ? 2 : 1); ++rep_)
#define SEAM(k) do { if (IN(k) && IN((k) + 1)) xcd_barrier(bar); } while (0)
    PRB_T0(100, lds); if (ON(0) && IN(0)) REP(0) { phase_convert(p, lds); } PRB_T1(100, lds);
    PRB_T0(200, lds); SEAM(0); PRB_T1(200, lds);
    PRB_T0(101, lds); if (ON(1) && IN(1)) REP(1) phase_mod(p, lds); PRB_T1(101, lds);
    PRB_T0(201, lds); SEAM(1); PRB_T1(201, lds);
    PRB_T0(102, lds); if (ON(2) && IN(2)) REP(2) phase_ln0(p); PRB_T1(102, lds);
    PRB_T0(202, lds); SEAM(2); PRB_T1(202, lds);
    for (int l = 0; l < 2; ++l) {
        const int k0 = 3 + l * PH_PER_LAYER;
        PRB_T0(103, lds); if (ON(3) && IN(k0 + 0)) REP(3) phase_inproj(p, l, lds); PRB_T1(103, lds);
        PRB_T0(203, lds); SEAM(k0 + 0); PRB_T1(203, lds);
        PRB_T0(104, lds); if (ON(4) && IN(k0 + 1)) REP(4) phase_ret_sum_pool(p, l, lds); PRB_T1(104, lds);
        PRB_T0(204, lds); SEAM(k0 + 1); PRB_T1(204, lds);
        PRB_T0(105, lds); if (ON(5) && IN(k0 + 2)) REP(5) phase_ret_scan(p, l); PRB_T1(105, lds);
        PRB_T0(205, lds); SEAM(k0 + 2); PRB_T1(205, lds);
        PRB_T0(106, lds); if (ON(6) && IN(k0 + 3)) REP(6) { phase_attn(p, l, lds); phase_ret(p, l); } PRB_T1(106, lds);
        PRB_T0(206, lds); SEAM(k0 + 3); PRB_T1(206, lds);
        PRB_T0(107, lds); if (ON(7) && IN(k0 + 4)) REP(7) phase_outproj(p, l, lds); PRB_T1(107, lds);
        PRB_T0(207, lds); SEAM(k0 + 4); PRB_T1(207, lds);
        PRB_T0(108, lds); if (ON(8) && IN(k0 + 5)) REP(8) phase_ln_mid(p, l); PRB_T1(108, lds);
        PRB_T0(208, lds); SEAM(k0 + 5); PRB_T1(208, lds);
        PRB_T0(109, lds); if (ON(9) && IN(k0 + 6)) REP(9) phase_router(p, l, lds); PRB_T1(109, lds);
        PRB_T0(209, lds); SEAM(k0 + 6); PRB_T1(209, lds);
        PRB_T0(110, lds); if (ON(10) && IN(k0 + 7)) REP(10) phase_topk(p, l, lds); PRB_T1(110, lds);
        PRB_T0(210, lds); SEAM(k0 + 7); PRB_T1(210, lds);
        PRB_T0(111, lds); if (ON(11) && IN(k0 + 8)) REP(11) { phase_scatter(p, l, lds); phase_convert_experts(p, l); } PRB_T1(111, lds);
        PRB_T0(211, lds); SEAM(k0 + 8); PRB_T1(211, lds);
        PRB_T0(112, lds); if (ON(12) && IN(k0 + 9)) REP(12) phase_moe(p, l, lds); PRB_T1(112, lds);
        PRB_T0(212, lds); SEAM(k0 + 9); PRB_T1(212, lds);
        PRB_T0(114, lds); if (ON(14) && IN(k0 + 10)) REP(14) phase_combine(p, l); PRB_T1(114, lds);
        if (l == 0) SEAM(k0 + 10);
    }
#undef IN
#undef SEAM
    if (PROBE_ID != 0 && threadIdx.x == 0 && blockIdx.x == 0) {
        const unsigned long long t0 = __builtin_readcyclecounter(), span = PRB_WORDS(lds)[1] * PROBE_GAIN;
        while (__builtin_readcyclecounter() - t0 < span) __builtin_amdgcn_s_sleep(8);
    }
}

extern "C" void kernel_launch(void* const* d_in, const int* in_sizes, int n_in, void* d_out, int out_size, void* d_ws, size_t ws_size, hipStream_t stream) {
    static int grid = 0;
    if (grid == 0) {
        if (n_in != 20 || ws_size < WS_END || out_size != NB * NLAT * DM) { fprintf(stderr, "kernel_launch: unexpected shapes (n_in %d, ws %zu need %zu, out %d)\n", n_in, ws_size, (size_t)WS_END, out_size); grid = -1; return; }
        int dev = 0, cus = 0, per_cu = 0;
        hipGetDevice(&dev); hipDeviceGetAttribute(&cus, hipDeviceAttributeMultiprocessorCount, dev);
        if (hipFuncSetAttribute((const void*)mega, hipFuncAttributeMaxDynamicSharedMemorySize, LDS_BYTES) != hipSuccess) { fprintf(stderr, "kernel_launch: hipFuncSetAttribute failed\n"); grid = -1; return; }
        if (hipOccupancyMaxActiveBlocksPerMultiprocessor(&per_cu, (const void*)mega, NTHREADS, LDS_BYTES) != hipSuccess || per_cu < 1) { fprintf(stderr, "kernel_launch: occupancy query says %d\n", per_cu); }
        (void)hipGetLastError();
        grid = cus > 0 ? cus : 256;
    }
    if (grid < 0) return;
    hipMemsetAsync((char*)d_ws + WS_CTL, 0, CTL_BYTES, stream);
    Params p{};
    p.x = (const float*)d_in[0]; p.c = (const float*)d_in[1]; p.ctx = (const float*)d_in[2]; p.c_ctx = (const float*)d_in[3];
    p.w_mod = (const float*)d_in[4]; p.b_mod = (const float*)d_in[5]; p.w_in = (const float*)d_in[6]; p.w_out = (const float*)d_in[7];
    p.diff_lambda = (const float*)d_in[8]; p.pool_w = (const float*)d_in[9]; p.pool_scale = (const float*)d_in[10]; p.ret_log_decay = (const float*)d_in[11];
    p.ln_g = (const float*)d_in[12]; p.ln_b = (const float*)d_in[13]; p.w_router = (const float*)d_in[14]; p.router_bias = (const float*)d_in[15];
    p.w_egu = (const float*)d_in[16]; p.w_edn = (const float*)d_in[17]; p.w_sgu = (const float*)d_in[18]; p.w_sdn = (const float*)d_in[19];
    p.out = (float*)d_out; p.ws = (unsigned char*)d_ws;
#if N_LAUNCH_PER_PHASE
    for (int k = 0; k < N_PHASES; ++k) { p.ph_lo = k; p.ph_hi = k + 1; hipLaunchKernelGGL(mega, dim3(grid), dim3(NTHREADS), LDS_BYTES, stream, p); }
#else
    p.ph_lo = 0; p.ph_hi = N_PHASES;
    hipLaunchKernelGGL(mega, dim3(grid), dim3(NTHREADS), LDS_BYTES, stream, p);
#endif
}
```

```cpp
#include <hip/hip_runtime.h>
#include <stdint.h>
#include <stdio.h>

#ifndef N_LAUNCH_PER_PHASE
#define N_LAUNCH_PER_PHASE 0
#endif

#define LAS __attribute__((address_space(3)))
#define DI __device__ __forceinline__
typedef unsigned short bf16_t;
typedef short bf16x8 __attribute__((ext_vector_type(8)));
typedef float f32x2 __attribute__((ext_vector_type(2)));
typedef float f32x4 __attribute__((ext_vector_type(4)));
typedef float f32x16 __attribute__((ext_vector_type(16)));
typedef unsigned u32x2 __attribute__((ext_vector_type(2)));
typedef unsigned u32x4 __attribute__((ext_vector_type(4)));
typedef __bf16 bf16v2 __attribute__((ext_vector_type(2)));

constexpr int NB = 2, NLAT = 8192, NCTX = 256, NT = NLAT + NCTX  , MROWS = NB * NT  ;
constexpr int DM = 1024, INW = 2816, NEXP = 256, TOPK = 8, NASG = MROWS * TOPK  ;
constexpr int NCHUNK = NT / 128;
constexpr float DN_ALPHA = 1.41421356237f;
constexpr float LN_EPS = 1e-6f, RMS_EPS = 1e-5f;
constexpr float LOG2E = 1.44269504089f;
constexpr float QSCALE = 0.125f * LOG2E;
constexpr int NTHREADS = 512;
constexpr int LDS_BYTES = 155648;

constexpr int C_DQ = 0, C_DK = 512, C_DV = 1024, C_PU = 1536, C_RQ = 1792, C_RK = 2048, C_RV = 2304, C_RG = 2560;

constexpr size_t al256(size_t x) { return (x + 255) & ~(size_t)255; }
constexpr size_t WS_CTL = 0;
constexpr size_t CTL_BYTES = 65536;
constexpr size_t CTL_COUNTS = 16384;
constexpr size_t CTL_CURSOR = CTL_COUNTS + 2048;
constexpr size_t CTL_NTILES = CTL_CURSOR + 2048;
constexpr size_t CTL_XRANK = CTL_NTILES + 256;
constexpr size_t WS_MODV = WS_CTL + CTL_BYTES;
constexpr size_t WS_ROPE = al256(WS_MODV + 2 * 3 * 6144 * 4);
constexpr size_t WS_SCAL = al256(WS_ROPE + 128 * 16 * 8);
constexpr size_t WS_WIN = al256(WS_SCAL + 2 * 16 * 4);
constexpr size_t WS_WOUT = al256(WS_WIN + (size_t)2 * INW * DM * 2);
constexpr size_t WS_WR = al256(WS_WOUT + (size_t)2 * DM * DM * 2);
constexpr size_t WS_WIMG = al256(WS_WR + (size_t)2 * 256 * DM * 2);
constexpr size_t WS_XA = al256(WS_WIMG + (size_t)2 * 257 * 48 * 32768);
constexpr size_t WS_XB = al256(WS_XA + (size_t)MROWS * DM * 4);
constexpr size_t WS_V1 = al256(WS_XB + (size_t)MROWS * DM * 4);
constexpr size_t WS_H = al256(WS_V1 + (size_t)MROWS * DM * 4);
constexpr size_t WS_TOK = al256(WS_H + (size_t)MROWS * DM * 2);
constexpr size_t WS_P = al256(WS_TOK + (size_t)MROWS * DM * 2);
constexpr size_t WS_VT = al256(WS_P + (size_t)MROWS * INW * 2);
constexpr size_t WS_RKT = al256(WS_VT + (size_t)NB * 4 * 128 * NT * 2);
constexpr size_t WS_RVT = al256(WS_RKT + (size_t)NB * 4 * 64 * NT * 2);
constexpr size_t WS_MIX = al256(WS_RVT + (size_t)NB * 4 * 64 * NT * 2);
constexpr size_t ST_BYTES = (size_t)NB * 4 * NCHUNK * 4096 * 4;
constexpr size_t WS_UF = al256(WS_MIX + (size_t)MROWS * DM * 2);
constexpr size_t WS_UB = al256(WS_UF + ST_BYTES);
constexpr size_t WS_SF = al256(WS_UB + ST_BYTES);
constexpr size_t WS_SB = al256(WS_SF + ST_BYTES);
constexpr size_t WS_LOGIT = al256(WS_SB + ST_BYTES);
constexpr size_t WS_EIDX = al256(WS_LOGIT + (size_t)MROWS * 256 * 4);
constexpr size_t WS_GATE = al256(WS_EIDX + (size_t)NASG * 4);
constexpr size_t WS_SORT = al256(WS_GATE + (size_t)NASG * 4);
constexpr size_t WS_RANK = al256(WS_SORT + (size_t)NASG * 4);
constexpr size_t WS_HIST = al256(WS_RANK + (size_t)NASG * 4);
constexpr size_t WS_TILES = al256(WS_HIST + (size_t)1024 * 256 * 4);
constexpr size_t WS_YSLOT = al256(WS_TILES + 2048 * 16);
constexpr size_t WS_YSH = al256(WS_YSLOT + (size_t)NASG * DM * 2);
constexpr size_t WS_END = al256(WS_YSH + (size_t)MROWS * DM * 2);

struct Params {
    const float *x, *c, *ctx, *c_ctx, *w_mod, *b_mod, *w_in, *w_out, *diff_lambda, *pool_w, *pool_scale, *ret_log_decay, *ln_g, *ln_b,
        *w_router, *router_bias, *w_egu, *w_edn, *w_sgu, *w_sdn;
    float* out;
    unsigned char* ws;
    int ph_lo, ph_hi;
};


DI Params launder(const Params& a) {
    size_t z = 0; asm volatile("" : "+s"(z));
    Params r = a;
#define LND(f) r.f = (decltype(r.f))((const unsigned char*)a.f + z)
    LND(x); LND(c); LND(ctx); LND(c_ctx); LND(w_mod); LND(b_mod); LND(w_in); LND(w_out); LND(diff_lambda); LND(pool_w); LND(pool_scale); LND(ret_log_decay); LND(ln_g); LND(ln_b);
    LND(w_router); LND(router_bias); LND(w_egu); LND(w_edn); LND(w_sgu); LND(w_sdn);
#undef LND
    r.out = (float*)((unsigned char*)a.out + z); r.ws = a.ws + z;
    return r;
}
DI int launder_s(int v) { asm volatile("" : "+s"(v)); return v; }
DI int tid_() { int t = threadIdx.x; asm volatile("" : "+v"(t)); return t; }
DI int bid_() { int t = blockIdx.x; asm volatile("" : "+s"(t)); return t; }


#ifndef PROBE_ID
#define PROBE_ID 0
#endif
#ifndef PROBE_GAIN
#define PROBE_GAIN 8
#endif
#define PRB_WORDS(lds) ((volatile LAS unsigned long long*)((lds) + LDS_BYTES - 64))
#define PRB_MATCH(id) (PROBE_ID == (id) || (PROBE_ID == 999 && (id) >= 200) || (PROBE_ID == 998 && ((id) == 101 || (id) == 102 || (id) == 104 || (id) == 105 || (id) == 108 || (id) == 109 || (id) == 110 || (id) == 111)))
#define PRB_T0(id, lds) do { if (PRB_MATCH(id) && threadIdx.x == 0 && blockIdx.x == 0) { PRB_WORDS(lds)[0] = __builtin_readcyclecounter(); } } while (0)
#define PRB_T1(id, lds) do { if (PRB_MATCH(id) && threadIdx.x == 0 && blockIdx.x == 0) { PRB_WORDS(lds)[1] += __builtin_readcyclecounter() - PRB_WORDS(lds)[0]; } } while (0)

#define XB_TMO      128
#define XB_XCNT(j)  (256  + 64 * (j))
#define XB_XSUB(j)  (1280 + 64 * (j))
#define XB_XGEN(j)  (2304 + 64 * (j))
#define XB_TOP      3328
#define XB_TOPGEN   3392
#define XCD_BAR_WORDS 3456
#define XB_SPIN_CAP (1u << 20)

__device__ __forceinline__ unsigned xb_ld(unsigned* p)              { return __hip_atomic_load(p, __ATOMIC_RELAXED, __HIP_MEMORY_SCOPE_AGENT); }
__device__ __forceinline__ unsigned xb_add(unsigned* p, unsigned v) { return __hip_atomic_fetch_add(p, v, __ATOMIC_RELAXED, __HIP_MEMORY_SCOPE_AGENT); }
__device__ __forceinline__ unsigned xb_xcc_id() { return (unsigned)__builtin_amdgcn_s_getreg((3 << 11) | 20) & 0xFu; }
#define XB_SPIN(cond, bar) do { unsigned _sp = 0; while (cond) { __builtin_amdgcn_s_sleep(1); \
    if ((++_sp & 255u) == 0u) { if (xb_ld(&(bar)[XB_TMO])) break; if (_sp > XB_SPIN_CAP) { atomicAdd(&(bar)[XB_TMO], 1u); break; } } } } while (0)

struct XcdBarrier { unsigned* bar; unsigned x; volatile LAS unsigned* st; };

__device__ __forceinline__ XcdBarrier xcd_barrier_post(unsigned* bar, volatile LAS unsigned* st) {
    XcdBarrier b; b.bar = bar; b.x = xb_xcc_id(); b.st = st;
    if (threadIdx.x == 0) (void)xb_add(&bar[XB_XCNT(b.x)], 1u);
    return b;
}
__device__ __forceinline__ void xcd_barrier_complete(unsigned* bar, unsigned x, unsigned& nloc, unsigned& nx) {
    const unsigned G = gridDim.x * gridDim.y * gridDim.z;
    unsigned sum, cnt, mine, sp = 0u;
    for (;;) {
        sum = 0u; cnt = 0u; mine = 0u;
#pragma unroll
        for (unsigned j = 0; j < 16; ++j) { const unsigned c = xb_ld(&bar[XB_XCNT(j)]); sum += c; cnt += (c > 0u) ? 1u : 0u; mine = (j == x) ? c : mine; }
        if (sum == G) break;
        __builtin_amdgcn_s_sleep(1);
        if ((++sp & 255u) == 0u) { if (xb_ld(&bar[XB_TMO])) break; if (sp > XB_SPIN_CAP) { atomicAdd(&bar[XB_TMO], 1u); break; } }
    }
    nloc = mine > 0u ? mine : 1u; nx = cnt > 0u ? cnt : 1u;
}
__device__ __forceinline__ void xcd_barrier(const XcdBarrier& b) {
    asm volatile("s_waitcnt vmcnt(0)" ::: "memory");
    __syncthreads();
    if (threadIdx.x == 0) {
        unsigned* bar = b.bar;
        __builtin_amdgcn_s_waitcnt(0);
        unsigned nloc = b.st[0], nx = b.st[1];
        if (nloc == 0u) { xcd_barrier_complete(bar, b.x, nloc, nx); b.st[0] = nloc; b.st[1] = nx; }
        const unsigned old = xb_add(&bar[XB_XSUB(b.x)], 1u);
        const unsigned gen = old / nloc;
        if (old + 1u == (gen + 1u) * nloc) {
            __builtin_amdgcn_fence(__ATOMIC_RELEASE, "agent");
            asm volatile("s_waitcnt vmcnt(0)" ::: "memory");
            const unsigned og = xb_add(&bar[XB_TOP], 1u);
            const unsigned tg = og / nx;
            if (og + 1u == (tg + 1u) * nx) xb_add(&bar[XB_TOPGEN], 1u);
            else XB_SPIN(xb_ld(&bar[XB_TOPGEN]) == tg, bar);
            __builtin_amdgcn_fence(__ATOMIC_ACQUIRE, "agent");
            xb_add(&bar[XB_XGEN(b.x)], 1u);
            asm volatile("s_waitcnt vmcnt(0)" ::: "memory");
        } else {
            XB_SPIN(xb_ld(&bar[XB_XGEN(b.x)]) == gen, bar);
            __builtin_amdgcn_fence(__ATOMIC_ACQUIRE, "agent");
            asm volatile("s_waitcnt vmcnt(0)" ::: "memory");
        }
    }
    __syncthreads();
}

DI unsigned pk_bf16(float a, float b) { f32x2 v = {a, b}; bf16v2 r = __builtin_convertvector(v, bf16v2); return __builtin_bit_cast(unsigned, r); }
DI bf16_t to_bf16(float a) { return (bf16_t)(pk_bf16(a, 0.f) & 0xffffu); }
DI float bf_lo(unsigned u) { return __uint_as_float(u << 16); }
DI float bf_hi(unsigned u) { return __uint_as_float(u & 0xffff0000u); }
DI float bf2f(bf16_t h) { return __uint_as_float(((unsigned)h) << 16); }
DI float wave_sum(float v) {
#pragma unroll
    for (int o = 32; o; o >>= 1) v += __shfl_xor(v, o);
    return v;
}
DI float fast_exp2(float x) { return __builtin_amdgcn_exp2f(x); }
DI float silu_f(float x) { return x / (1.f + __expf(-x)); }
DI bf16x8 as_bf16x8(u32x4 v) { return __builtin_bit_cast(bf16x8, v); }
#define WAIT_VM(n) asm volatile("s_waitcnt vmcnt(" #n ")" ::: "memory")
DI void dma16(const void* g, LAS unsigned char* l) { __builtin_amdgcn_global_load_lds(g, (LAS void*)l, 16, 0, 0); }
#define MFMA32(a, b, c) __builtin_amdgcn_mfma_f32_32x32x16_bf16((a), (b), (c), 0, 0, 0)
#define MFMA16(a, b, c) __builtin_amdgcn_mfma_f32_16x16x32_bf16((a), (b), (c), 0, 0, 0)

DI int row_sel(int r) { const int b = r >= NT; const int p = r - b * NT; return p < NCTX ? 2 : b; }

DI int swz_off(int row, int chunk) { return row * 128 + ((chunk ^ ((row >> 1) & 7)) << 4); }

DI int perm_gu(int n) { const int f = n >> 8, jj = n & 255; return ((jj >> 4) << 5) + (f << 4) + (jj & 15); }
DI void conv_unit(const float* src, int N, int K, bf16_t* dst, int k0, int n0, bool perm, LAS unsigned char* lds) {
    LAS float* tl = (LAS float*)lds;
    const int tid = tid_();
#pragma unroll
    for (int i = 0; i < 8; ++i) {
        const int kk = (tid >> 6) + 8 * i, nn = (tid & 63) * 4;
        const f32x4 v = *(const f32x4*)(src + (size_t)(k0 + kk) * N + n0 + nn);
        tl[kk * 257 + nn] = v[0]; tl[kk * 257 + nn + 1] = v[1]; tl[kk * 257 + nn + 2] = v[2]; tl[kk * 257 + nn + 3] = v[3];
    }
    __syncthreads();
    const int n = tid >> 1, kh = (tid & 1) * 32;
    const int nd = perm ? perm_gu(n0 + n) : (n0 + n);
    bf16_t* d = dst + (size_t)nd * K + k0 + kh;
#pragma unroll
    for (int q = 0; q < 4; ++q) {
        u32x4 w;
#pragma unroll
        for (int j = 0; j < 4; ++j) w[j] = pk_bf16(tl[(kh + q * 8 + 2 * j) * 257 + n], tl[(kh + q * 8 + 2 * j + 1) * 257 + n]);
        *(u32x4*)(d + q * 8) = w;
    }
    __syncthreads();
}

DI void phase_convert(const Params& p0, LAS unsigned char* lds) {
    const Params p = launder(p0);
    constexpr int U_IN = 176, U_OUT = 64, U_R = 16;
    constexpr int U_L = U_IN + U_OUT + U_R;
    for (int u = bid_(); u < 2 * U_L; u += gridDim.x) {
        const int l = u / U_L; int v = u % U_L;
        if (v < U_IN) { conv_unit(p.w_in + (size_t)l * DM * INW, INW, DM, (bf16_t*)(p.ws + WS_WIN) + (size_t)l * INW * DM, (v / 11) * 64, (v % 11) * 256, false, lds); continue; }
        v -= U_IN;
        if (v < U_OUT) { conv_unit(p.w_out + (size_t)l * DM * DM, DM, DM, (bf16_t*)(p.ws + WS_WOUT) + (size_t)l * DM * DM, (v / 4) * 64, (v % 4) * 256, false, lds); continue; }
        v -= U_OUT;
        conv_unit(p.w_router + (size_t)l * DM * 256, 256, DM, (bf16_t*)(p.ws + WS_WR) + (size_t)l * 256 * DM, v * 64, 0, false, lds);
    }
}

DI void phase_mod(const Params& p0, LAS unsigned char* lds) {
    const Params p = launder(p0);
    LAS float* sc = (LAS float*)lds;
    LAS float* red = sc + 3 * 1024;
    const int tid = tid_();
    float* modv = (float*)(p.ws + WS_MODV);
    for (int u = bid_(); u < 193; u += gridDim.x) {
        if (u == 192) {
            float* rope = (float*)(p.ws + WS_ROPE);
            for (int i = tid; i < 128 * 16; i += NTHREADS) {
                const int pos = i >> 4, f = i & 15;
                const float freq = powf(10000.0f, -(float)f / 16.0f);
                const float ang = (float)pos * freq;
                rope[2 * i] = cosf(ang); rope[2 * i + 1] = sinf(ang);
            }
            float* scal = (float*)(p.ws + WS_SCAL);
            if (tid < 2) {
                const int l = tid;
                const float* dl = p.diff_lambda + l * 256;
                float s01 = 0.f, s23 = 0.f;
                for (int i = 0; i < 64; ++i) { s01 += dl[i] * dl[64 + i]; s23 += dl[128 + i] * dl[192 + i]; }
                const float lambda_init = 0.8f - 0.6f * expf(-0.3f * (float)l);
                scal[l * 16 + 0] = expf(s01) - expf(s23) + lambda_init;
                scal[l * 16 + 1] = 1.0f - lambda_init;
                for (int h = 0; h < 4; ++h) {
                    scal[l * 16 + 2 + h] = -expf(p.ret_log_decay[l * 8 + h]) * LOG2E;
                    scal[l * 16 + 6 + h] = -expf(p.ret_log_decay[l * 8 + 4 + h]) * LOG2E;
                }
            }
            continue;
        }
        const int l = u / 96, n0 = (u % 96) * 64;
        for (int i = tid; i < 3 * 1024; i += NTHREADS) {
            const int s = i >> 10, k = i & 1023;
            const float v = s < 2 ? p.c[s * 1024 + k] : p.c_ctx[k];
            sc[i] = silu_f(v);
        }
        __syncthreads();
        const int kq = tid >> 6, nl = tid & 63;
        const float* w = p.w_mod + (size_t)l * DM * 6144 + n0 + nl;
        float a0 = 0.f, a1 = 0.f, a2 = 0.f;
        for (int k = kq * 128; k < kq * 128 + 128; ++k) {
            const float wv = w[(size_t)k * 6144];
            a0 += sc[k] * wv; a1 += sc[1024 + k] * wv; a2 += sc[2048 + k] * wv;
        }
        red[(kq * 3 + 0) * 64 + nl] = a0; red[(kq * 3 + 1) * 64 + nl] = a1; red[(kq * 3 + 2) * 64 + nl] = a2;
        __syncthreads();
        if (tid < 192) {
            const int s = tid >> 6, n = tid & 63;
            float v = 0.f;
            for (int q = 0; q < 8; ++q) v += red[(q * 3 + s) * 64 + n];
            modv[((size_t)l * 3 + s) * 6144 + n0 + n] = v + p.b_mod[l * 6144 + n0 + n];
        }
        __syncthreads();
    }
}

DI void ln_stats(const f32x4 (&v)[4], float& mu, float& rstd) {
    float s = 0.f;
#pragma unroll
    for (int i = 0; i < 4; ++i) s += (v[i][0] + v[i][1]) + (v[i][2] + v[i][3]);
    mu = wave_sum(s) * (1.0f / 1024.0f);
    float q = 0.f;
#pragma unroll
    for (int i = 0; i < 4; ++i)
#pragma unroll
        for (int j = 0; j < 4; ++j) { const float d = v[i][j] - mu; q += d * d; }
    rstd = rsqrtf(wave_sum(q) * (1.0f / 1024.0f) + LN_EPS);
}
DI void modulate_store(const f32x4 (&v)[4], const float* shift, const float* scale, bf16_t* dst, int lane) {
    float mu, rstd; ln_stats(v, mu, rstd);
#pragma unroll
    for (int i = 0; i < 4; ++i) {
        const int c = lane * 4 + i * 256;
        const f32x4 sh = *(const f32x4*)(shift + c), scv = *(const f32x4*)(scale + c);
        float o[4];
#pragma unroll
        for (int j = 0; j < 4; ++j) o[j] = (v[i][j] - mu) * rstd * (1.0f + scv[j]) + sh[j];
        u32x2 w = {pk_bf16(o[0], o[1]), pk_bf16(o[2], o[3])};
        *(u32x2*)(dst + c) = w;
    }
}

DI void phase_ln0(const Params& p0) {
    const Params p = launder(p0);
    const int lane = tid_() & 63, wid = tid_() >> 6;
    float* XA = (float*)(p.ws + WS_XA);
    bf16_t* H = (bf16_t*)(p.ws + WS_H);
    const float* modv = (const float*)(p.ws + WS_MODV);
    for (int r = bid_() * 8 + wid; r < MROWS; r += gridDim.x * 8) {
        const int b = r >= NT, pp = r - b * NT;
        const float* src = pp < NCTX ? p.ctx + ((size_t)b * NCTX + pp) * DM : p.x + ((size_t)b * NLAT + (pp - NCTX)) * DM;
        f32x4 v[4];
#pragma unroll
        for (int i = 0; i < 4; ++i) { v[i] = *(const f32x4*)(src + lane * 4 + i * 256); *(f32x4*)(XA + (size_t)r * DM + lane * 4 + i * 256) = v[i]; }
        const float* mv = modv + (size_t)(0 * 3 + (pp < NCTX ? 2 : b)) * 6144;
        modulate_store(v, mv, mv + 1024, H + (size_t)r * DM, lane);
    }
}

constexpr int G2_STG = 40960;
template <class Epi>
DI void gemm192(const bf16_t* A, int lda, const bf16_t* Bt, int ldb, int nk, int m0, int n0, LAS unsigned char* lds, const Epi& epi) {
    const int t = tid_(), lane = t & 63, wid = __builtin_amdgcn_readfirstlane(t >> 6), fr = lane & 15, fq = lane >> 4, wm = wid >> 1, wn = wid & 1;
    const bf16_t* asrc[3]; const bf16_t* bsrc[2];
#pragma unroll
    for (int i = 0; i < 3; ++i) { const int sl = t + 512 * i, row = sl >> 3, c = (sl & 7) ^ ((row >> 1) & 7); asrc[i] = A + (size_t)(m0 + row) * lda + c * 8; }
#pragma unroll
    for (int i = 0; i < 2; ++i) { const int sl = t + 512 * i, row = sl >> 3, c = (sl & 7) ^ ((row >> 1) & 7); bsrc[i] = Bt + (size_t)(n0 + row) * ldb + c * 8; }
    const int ddst = wid * 1024;
#define G2_ISSUE(S, KT) do { LAS unsigned char* _s = lds + (S) * G2_STG + ddst; const int _k = (KT) * 64; \
        dma16(asrc[0] + _k, _s); dma16(asrc[1] + _k, _s + 8192); dma16(asrc[2] + _k, _s + 16384); dma16(bsrc[0] + _k, _s + 24576); dma16(bsrc[1] + _k, _s + 32768); } while (0)
    f32x4 acc[4][3];
#pragma unroll
    for (int nf = 0; nf < 4; ++nf)
#pragma unroll
        for (int mf = 0; mf < 3; ++mf) acc[nf][mf] = (f32x4){0.f, 0.f, 0.f, 0.f};
    __syncthreads();
    G2_ISSUE(0, 0);
    if (nk > 1) G2_ISSUE(1, 1);
    int st = 0;
    for (int kt = 0; kt < nk; ++kt) {
        if (kt + 1 < nk) WAIT_VM(5); else WAIT_VM(0);
        asm volatile("s_waitcnt lgkmcnt(0)" ::: "memory");
        __builtin_amdgcn_s_barrier();
        const int st2 = st == 0 ? 2 : st - 1;
        if (kt + 2 < nk) G2_ISSUE(st2, kt + 2);
        LAS unsigned char* S = lds + st * G2_STG;
        st = st == 2 ? 0 : st + 1;
#pragma unroll
        for (int kk = 0; kk < 2; ++kk) {
            bf16x8 af[3], bfr[4];
#pragma unroll
            for (int mf = 0; mf < 3; ++mf) af[mf] = *(LAS bf16x8*)(S + swz_off(wm * 48 + mf * 16 + fr, kk * 4 + fq));
#pragma unroll
            for (int nf = 0; nf < 4; ++nf) bfr[nf] = *(LAS bf16x8*)(S + 24576 + swz_off(wn * 64 + nf * 16 + fr, kk * 4 + fq));
#pragma unroll
            for (int nf = 0; nf < 4; ++nf)
#pragma unroll
                for (int mf = 0; mf < 3; ++mf) acc[nf][mf] = MFMA16(bfr[nf], af[mf], acc[nf][mf]);
        }
    }
#undef G2_ISSUE
    __syncthreads();
    epi(acc, wm, wn, fr, fq, lane, wid);
}
DI LAS unsigned char* g2_stage(LAS unsigned char* lds, int wid) { return lds + wid * 13056; }

DI void phase_inproj(const Params& p0, int l, LAS unsigned char* lds) {
    const Params p = launder(p0); l = launder_s(l);
    const bf16_t* H = (const bf16_t*)(p.ws + WS_H);
    const bf16_t* W = (const bf16_t*)(p.ws + WS_WIN) + (size_t)l * INW * DM;
    bf16_t* P = (bf16_t*)(p.ws + WS_P);
    bf16_t* VT = (bf16_t*)(p.ws + WS_VT);
    bf16_t* RKT = (bf16_t*)(p.ws + WS_RKT);
    bf16_t* RVT = (bf16_t*)(p.ws + WS_RVT);
    const f32x2* rope = (const f32x2*)(p.ws + WS_ROPE);
    constexpr int NTN = INW / 128, NTM = MROWS / 192;
    for (int u = bid_(); u < NTM * NTN; u += gridDim.x) {
        const int tm = u / NTN, tn = u % NTN;
        auto epi = [&](f32x4 (&acc)[4][3], int wm, int wn, int fr, int fq, int lane, int wid) {
            const int c0 = tn * 128 + wn * 64;
            const int r0 = tm * 192 + wm * 48;
            LAS unsigned char* W_ = g2_stage(lds, wid);
            if (c0 < C_DV) {
                const float qs = c0 < C_DK ? QSCALE : 1.0f;
#pragma unroll
                for (int mf = 0; mf < 3; ++mf) {
                    const int row = r0 + mf * 16 + fr;
                    const int b = row >= NT, pp = row - b * NT;
                    const bool lat = pp >= NCTX;
                    const int tt = pp - NCTX;
#pragma unroll
                    for (int hb = 0; hb < 2; ++hb) {
                        const int axis = ((c0 >> 5) + hb) & 1;
                        const int pos = axis ? (tt & 63) : (tt >> 6);
#pragma unroll
                        for (int j = 0; j < 4; ++j) {
                            float x1 = acc[2 * hb][mf][j], x2 = acc[2 * hb + 1][mf][j];
                            if (lat) { const f32x2 cs = rope[pos * 16 + 4 * fq + j]; const float o1 = x1 * cs[0] - x2 * cs[1], o2 = x1 * cs[1] + x2 * cs[0]; x1 = o1; x2 = o2; }
                            acc[2 * hb][mf][j] = x1 * qs; acc[2 * hb + 1][mf][j] = x2 * qs;
                        }
                    }
                }
            } else if (c0 >= C_RK && c0 < C_RV) {
#pragma unroll
                for (int nf = 0; nf < 4; ++nf)
#pragma unroll
                    for (int mf = 0; mf < 3; ++mf) acc[nf][mf] *= 0.125f;
            }
#pragma unroll
            for (int nf = 0; nf < 4; ++nf)
#pragma unroll
                for (int mf = 0; mf < 3; ++mf) {
                    const f32x4 v = acc[nf][mf];
                    *(LAS u32x2*)(W_ + (mf * 16 + fr) * 144 + nf * 32 + fq * 8) = (u32x2){pk_bf16(v[0], v[1]), pk_bf16(v[2], v[3])};
                }
#pragma unroll
            for (int it = 0; it < 6; ++it) {
                const int row = it * 8 + (lane >> 3), ch = lane & 7;
                *(u32x4*)(P + (size_t)(r0 + row) * INW + c0 + ch * 8) = *(LAS u32x4*)(W_ + row * 144 + ch * 16);
            }
            const bool isv = c0 >= C_DV && c0 < C_PU, isk = c0 >= C_RK && c0 < C_RV, isr = c0 >= C_RV && c0 < C_RG;
            if (isv || isk || isr) {
                const int frp = isv ? ((fr & 3) | (((fr >> 2) == 1 ? 2 : ((fr >> 2) == 2 ? 1 : (fr >> 2))) << 2)) : fr;
                LAS bf16_t* T_ = (LAS bf16_t*)W_;
#pragma unroll
                for (int nf = 0; nf < 4; ++nf)
#pragma unroll
                    for (int mf = 0; mf < 3; ++mf)
#pragma unroll
                        for (int j = 0; j < 4; ++j) T_[(nf * 16 + 4 * fq + j) * 56 + mf * 16 + frp] = to_bf16(acc[nf][mf][j]);
                const int b = r0 >= NT, pp0 = r0 - b * NT;
                bf16_t* base; int nrows_per_head;
                if (isv) { const int cc = c0 - C_DV; base = VT + ((size_t)(b * 4 + (cc >> 7)) * 128 + (cc & 127)) * NT + pp0; }
                else if (isk) { const int cc = c0 - C_RK; base = RKT + ((size_t)(b * 4 + (cc >> 6)) * 64) * NT + pp0; }
                else { const int cc = c0 - C_RV; base = RVT + ((size_t)(b * 4 + (cc >> 6)) * 64) * NT + pp0; }
                (void)nrows_per_head;
#pragma unroll
                for (int it = 0; it < 6; ++it) {
                    const int sl = it * 64 + lane, n = sl / 6, pc = sl % 6;
                    *(u32x4*)(base + (size_t)n * NT + pc * 8) = *(LAS u32x4*)(W_ + n * 112 + pc * 16);
                }
            }
        };
        gemm192(H, DM, W, DM, DM / 64, tm * 192, tn * 128, lds, epi);
    }
}

DI void phase_ret_sum_pool(const Params& p0, int l, LAS unsigned char* lds) {
    const Params p = launder(p0); l = launder_s(l);
    const int tid = tid_(), lane = tid & 63, wid = tid >> 6, fr = lane & 15, g = lane >> 4;
    const float* scal = (const float*)(p.ws + WS_SCAL) + l * 16;
    const bf16_t* RKT = (const bf16_t*)(p.ws + WS_RKT);
    const bf16_t* RVT = (const bf16_t*)(p.ws + WS_RVT);
    float* UF = (float*)(p.ws + WS_UF);
    float* UB = (float*)(p.ws + WS_UB);
    for (int u = bid_(); u < NB * 4 * NCHUNK; u += gridDim.x) {
        const int c = u % NCHUNK, bh = u / NCHUNK, h = bh & 3;
        const int dir = wid >> 2, eb = wid & 3;
        const float l2 = dir ? scal[6 + h] : scal[2 + h];
        const bf16_t* vrow = RVT + ((size_t)bh * 64 + eb * 16 + fr) * NT + c * 128;
        f32x4 acc[4];
#pragma unroll
        for (int db = 0; db < 4; ++db) acc[db] = (f32x4){0.f, 0.f, 0.f, 0.f};
#pragma unroll
        for (int ks = 0; ks < 4; ++ks) {
            const int j0 = ks * 32 + 8 * g;
            const bf16x8 af = *(const bf16x8*)(vrow + j0);
            float w[8];
#pragma unroll
            for (int jj = 0; jj < 8; ++jj) { const int j = j0 + jj; w[jj] = fast_exp2((dir ? (float)j : (float)(127 - j)) * l2); }
#pragma unroll
            for (int db = 0; db < 4; ++db) {
                const u32x4 kr = *(const u32x4*)(RKT + ((size_t)bh * 64 + db * 16 + fr) * NT + c * 128 + j0);
                u32x4 kw;
#pragma unroll
                for (int q = 0; q < 4; ++q) kw[q] = pk_bf16(bf_lo(kr[q]) * w[2 * q], bf_hi(kr[q]) * w[2 * q + 1]);
                acc[db] = MFMA16(af, as_bf16x8(kw), acc[db]);
            }
        }
        const int cidx = dir ? (c >= 2 ? c - 2 : 64 + c) : c;
        float* U = (dir ? UB : UF) + ((size_t)bh * NCHUNK + cidx) * 4096;
#pragma unroll
        for (int db = 0; db < 4; ++db)
#pragma unroll
            for (int j = 0; j < 4; ++j) U[(eb * 16 + 4 * g + j) * 64 + db * 16 + fr] = acc[db][j];
    }
    LAS float* ul = (LAS float*)lds;
    LAS float* dT = ul + 48 * 256;
    LAS float* pwl = dT + 256 * 36;
    const bf16_t* P = (const bf16_t*)(p.ws + WS_P);
    bf16_t* MIX = (bf16_t*)(p.ws + WS_MIX);
    const float* pw = p.pool_w + (size_t)l * 4 * 64 * 64;
    const float* ps = p.pool_scale + l * 256;
    __syncthreads();
    if (bid_() < MROWS / 32) {
#pragma unroll
        for (int i = 0; i < 8; ++i) *(LAS f32x4*)(pwl + (tid + 512 * i) * 4) = *(const f32x4*)(pw + (tid + 512 * i) * 4);
    }
    for (int u = bid_(); u < MROWS / 32; u += gridDim.x) {
        const int r0 = u * 32;
        const int b = r0 >= NT, pp0 = r0 - b * NT;
        const int s0 = pp0 < NCTX ? b * NT : b * NT + NCTX, s1 = pp0 < NCTX ? b * NT + NCTX : (b + 1) * NT;
        __syncthreads();
        {
            u32x2 wv[6]; bool ok[6];
#pragma unroll
            for (int it = 0; it < 6; ++it) {
                const int i = tid + 512 * it, rr = i >> 6, c4 = (i & 63) * 4, row = r0 - 8 + rr;
                ok[it] = row >= s0 && row < s1;
                wv[it] = ok[it] ? *(const u32x2*)(P + (size_t)row * INW + C_PU + c4) : (u32x2){0u, 0u};
            }
#pragma unroll
            for (int it = 0; it < 6; ++it) {
                const int i = tid + 512 * it, rr = i >> 6, c4 = (i & 63) * 4;
                *(LAS f32x4*)(ul + rr * 256 + c4) = (f32x4){bf_lo(wv[it][0]), bf_hi(wv[it][0]), bf_lo(wv[it][1]), bf_hi(wv[it][1])};
            }
        }
        __syncthreads();
        {
            const int c = tid & 255, gi = c >> 6, rb = tid >> 8;
#define POOL_WIN(HW) do { _Pragma("unroll") for (int it = 0; it < 16; ++it) { const int rr = it * 2 + rb, row = r0 + rr; float sm = 0.f; \
                _Pragma("unroll") for (int q = -(HW); q < (HW); ++q) sm += ul[(rr + 8 + q) * 256 + c]; \
                const int lo = (row - (HW)) < s0 ? s0 : (row - (HW)), hi = (row + (HW)) > s1 ? s1 : (row + (HW)); \
                dT[c * 36 + rr] = sm / (float)(hi - lo) - ul[(rr + 8) * 256 + c]; } } while (0)
            if (gi == 0) POOL_WIN(1); else if (gi == 1) POOL_WIN(2); else if (gi == 2) POOL_WIN(4); else POOL_WIN(8);
#undef POOL_WIN
        }
        __syncthreads();
        {
            const int oc = tid & 255, rh = (tid >> 8) * 16, gi = oc >> 6, e = oc & 63;
            float acc[16];
#pragma unroll
            for (int i = 0; i < 16; ++i) acc[i] = 0.f;
#pragma unroll 8
            for (int c = 0; c < 64; ++c) {
                const float wv = pwl[(gi * 64 + c) * 64 + e];
                const LAS float* dr = dT + (gi * 64 + c) * 36 + rh;
#pragma unroll
                for (int i = 0; i < 4; ++i) { const f32x4 d = *(const LAS f32x4*)(dr + 4 * i); acc[4 * i] += d[0] * wv; acc[4 * i + 1] += d[1] * wv; acc[4 * i + 2] += d[2] * wv; acc[4 * i + 3] += d[3] * wv; }
            }
            const float sc = ps[oc];
#pragma unroll
            for (int i = 0; i < 16; ++i) MIX[(size_t)(r0 + rh + i) * DM + 512 + oc] = to_bf16(acc[i] * sc);
        }
    }
    __syncthreads();
}

DI void phase_ret_scan(const Params& p0, int l) {
    const Params p = launder(p0); l = launder_s(l);
    const float* scal = (const float*)(p.ws + WS_SCAL) + l * 16;
    const float* UF = (const float*)(p.ws + WS_UF); const float* UB = (const float*)(p.ws + WS_UB);
    bf16_t* SF = (bf16_t*)(p.ws + WS_SF); bf16_t* SB = (bf16_t*)(p.ws + WS_SB);
    for (int i = bid_() * NTHREADS + tid_(); i < 2 * NB * 4 * 4096; i += gridDim.x * NTHREADS) {
        const int dir = i / (NB * 4 * 4096), rem = i % (NB * 4 * 4096), bh = rem >> 12, el = rem & 4095, h = bh & 3;
        const float G = fast_exp2(128.0f * (dir ? scal[6 + h] : scal[2 + h]));
        float S = 0.f;
        if (dir == 0) {
#pragma unroll 11
            for (int c = 0; c < NCHUNK; ++c) { const size_t o = ((size_t)bh * NCHUNK + c) * 4096 + el; SF[o] = to_bf16(S); S = S * G + UF[o]; } }
        else {
#pragma unroll 11
            for (int c = NCHUNK - 1; c >= 0; --c) { const size_t o = ((size_t)bh * NCHUNK + c) * 4096 + el; SB[o] = to_bf16(S); S = S * G + UB[o]; } }
    }
}

DI void attn_unit(const Params& p, int b, int h, int q_p0, int ntile, float lam, float oscale, LAS unsigned char* lds) {
    const int tid = tid_(), lane = tid & 63, wid = __builtin_amdgcn_readfirstlane(tid >> 6), map = wid >> 2, wq = wid & 3, r = lane & 31, hh = lane >> 5;
    const bf16_t* P = (const bf16_t*)(p.ws + WS_P);
    const bf16_t* VT = (const bf16_t*)(p.ws + WS_VT);
    bf16_t* MIX = (bf16_t*)(p.ws + WS_MIX);
    const size_t rowbase = (size_t)b * NT;
    const int qrow = q_p0 + wq * 32 + r;
    bf16x8 qf[4];
#pragma unroll
    for (int ks = 0; ks < 4; ++ks) qf[ks] = *(const bf16x8*)(P + (rowbase + qrow) * INW + C_DQ + h * 128 + map * 64 + ks * 16 + hh * 8);
    constexpr int ASTG = 32768;
    const bf16_t* ksrc0; const bf16_t* ksrc1; const bf16_t* vsrc0; const bf16_t* vsrc1;
    { const int key = tid >> 4, ph = tid & 15, c = ph ^ (key & 15);
      ksrc0 = P + (rowbase + key) * INW + C_DK + h * 128 + c * 8; ksrc1 = ksrc0 + (size_t)32 * INW;
      const int e = tid >> 3, pv = tid & 7, cv = pv ^ ((e >> 1) & 7);
      vsrc0 = VT + ((size_t)(b * 4 + h) * 128 + e) * NT + cv * 8; vsrc1 = vsrc0 + (size_t)64 * NT; }
    const int ddst = wid * 1024;
#define ATT_ISSUE(S, KT) do { LAS unsigned char* _s = lds + (S) * ASTG + ddst; const size_t _ko = (size_t)(KT) * 64 * INW; const int _vo = (KT) * 64; \
        dma16(ksrc0 + _ko, _s); dma16(ksrc1 + _ko, _s + 8192); dma16(vsrc0 + _vo, _s + 16384); dma16(vsrc1 + _vo, _s + 24576); } while (0)
    f32x16 o[4];
#pragma unroll
    for (int eb = 0; eb < 4; ++eb)
#pragma unroll
        for (int i = 0; i < 16; ++i) o[eb][i] = 0.f;
    f32x16 negm;
#pragma unroll
    for (int i = 0; i < 16; ++i) negm[i] = 0.f;
    float m_run = 0.f, l_run = 0.f;
    __syncthreads();
    ATT_ISSUE(0, 0);
    if (ntile > 1) ATT_ISSUE(1, 1);
    if (ntile > 2) ATT_ISSUE(2, 2);
    for (int kt = 0; kt < ntile; ++kt) {
        PRB_T0(1, lds);
        if (kt + 2 < ntile) WAIT_VM(8); else if (kt + 1 < ntile) WAIT_VM(4); else WAIT_VM(0);
        asm volatile("s_waitcnt lgkmcnt(0)" ::: "memory");
        __builtin_amdgcn_s_barrier();
        PRB_T1(1, lds); PRB_T0(2, lds);
        const int st = kt & 3, st2 = (kt + 3) & 3;
        if (map == 0 && kt + 3 < ntile) ATT_ISSUE(st2, kt + 3);
        LAS unsigned char* L = lds + st * ASTG;
        bf16x8 kf[8], va[4], vb[4];
#pragma unroll
        for (int ks = 0; ks < 4; ++ks) {
            const int ch = map * 8 + ks * 2 + hh;
            const int off = r * 256 + ((ch ^ (r & 15)) << 4);
            kf[2 * ks] = *(LAS bf16x8*)(L + off);
            kf[2 * ks + 1] = *(LAS bf16x8*)(L + off + 32 * 256);
        }
#define ATT_VREAD(dst, S_) do { _Pragma("unroll") for (int eb = 0; eb < 4; ++eb) { const int e = eb * 32 + r; \
            dst[eb] = *(LAS bf16x8*)(L + 16384 + e * 128 + ((((S_) * 2 + hh) ^ ((e >> 1) & 7)) << 4)); } } while (0)
#define ATT_PACK(dst, SRC, B_) do { u32x4 _pw; _Pragma("unroll") for (int q = 0; q < 4; ++q) _pw[q] = pk_bf16(SRC[(B_) + 2 * q], SRC[(B_) + 2 * q + 1]); dst = as_bf16x8(_pw); } while (0)
#define ATT_EXP8(SRC, B_) do { _Pragma("unroll") for (int i = 0; i < 8; ++i) { SRC[(B_) + i] = fast_exp2(SRC[(B_) + i]); rsum += SRC[(B_) + i]; pmx = fmaxf(pmx, SRC[(B_) + i]); } } while (0)
        ATT_VREAD(va, 0);
        asm volatile("" ::: "memory");
        f32x16 s0 = negm, s1 = negm;
#pragma unroll
        for (int ks = 0; ks < 4; ++ks) { s0 = MFMA32(kf[2 * ks], qf[ks], s0); s1 = MFMA32(kf[2 * ks + 1], qf[ks], s1); }
        if (map == 1 && kt + 3 < ntile) ATT_ISSUE(st2, kt + 3);
        PRB_T1(2, lds); PRB_T0(3, lds);
        if (kt == 0) {
            float mx = fmaxf(fmaxf(s0[0], s0[1]), s0[2]);
#pragma unroll
            for (int i = 3; i < 15; i += 2) mx = fmaxf(fmaxf(mx, s0[i]), s0[i + 1]);
            mx = fmaxf(mx, s0[15]);
#pragma unroll
            for (int i = 0; i < 16; i += 2) mx = fmaxf(fmaxf(mx, s1[i]), s1[i + 1]);
            mx = fmaxf(mx, __shfl_xor(mx, 32));
            m_run = mx;
#pragma unroll
            for (int i = 0; i < 16; ++i) { s0[i] -= mx; s1[i] -= mx; negm[i] = -mx; }
        }
        float rsum = 0.f, pmx = 0.f;
        bf16x8 pb;
        ATT_EXP8(s0, 0); ATT_PACK(pb, s0, 0);
        ATT_VREAD(vb, 1); asm volatile("" ::: "memory");
#pragma unroll
        for (int eb = 0; eb < 4; ++eb) o[eb] = MFMA32(va[eb], pb, o[eb]);
        ATT_EXP8(s0, 8); ATT_PACK(pb, s0, 8);
        ATT_VREAD(va, 2); asm volatile("" ::: "memory");
#pragma unroll
        for (int eb = 0; eb < 4; ++eb) o[eb] = MFMA32(vb[eb], pb, o[eb]);
        ATT_EXP8(s1, 0); ATT_PACK(pb, s1, 0);
        ATT_VREAD(vb, 3); asm volatile("" ::: "memory");
#pragma unroll
        for (int eb = 0; eb < 4; ++eb) o[eb] = MFMA32(va[eb], pb, o[eb]);
        ATT_EXP8(s1, 8); ATT_PACK(pb, s1, 8);
#pragma unroll
        for (int eb = 0; eb < 4; ++eb) o[eb] = MFMA32(vb[eb], pb, o[eb]);
        l_run += rsum;
        PRB_T1(3, lds);
#undef ATT_VREAD
#undef ATT_PACK
#undef ATT_EXP8
        pmx = fmaxf(pmx, __shfl_xor(pmx, 32));
        if (__any(pmx > 256.0f)) {
            const float d = pmx > 256.0f ? __builtin_amdgcn_logf(pmx) : 0.f;
            const float alpha = fast_exp2(-d);
            m_run += d; l_run *= alpha;
#pragma unroll
            for (int i = 0; i < 16; ++i) negm[i] = -m_run;
#pragma unroll
            for (int eb = 0; eb < 4; ++eb)
#pragma unroll
                for (int i = 0; i < 16; ++i) o[eb][i] *= alpha;
        }
    }
#undef ATT_ISSUE
    __syncthreads();
    const float lt = l_run + __shfl_xor(l_run, 32);
    const float inv = 1.0f / lt;
    LAS float* X = (LAS float*)lds;
    if (map == 1) {
#pragma unroll
        for (int eb = 0; eb < 4; ++eb)
#pragma unroll
            for (int i = 0; i < 16; ++i) X[(wq * 64 + eb * 16 + i) * 64 + lane] = o[eb][i] * inv;
    }
    __syncthreads();
    if (map == 0) {
        float ss = 0.f;
#pragma unroll
        for (int eb = 0; eb < 4; ++eb)
#pragma unroll
            for (int i = 0; i < 16; ++i) { const float v = o[eb][i] * inv - lam * X[(wq * 64 + eb * 16 + i) * 64 + lane]; o[eb][i] = v; ss += v * v; }
        ss += __shfl_xor(ss, 32);
        const float sc = rsqrtf(ss * (1.0f / 128.0f) + RMS_EPS) * oscale;
        LAS unsigned char* W = lds + 65536 + wq * 8704;
#pragma unroll
        for (int eb = 0; eb < 4; ++eb)
#pragma unroll
            for (int q = 0; q < 4; ++q) {
                const int e = eb * 32 + 8 * q + 4 * hh;
                const u32x2 w = {pk_bf16(o[eb][4 * q] * sc, o[eb][4 * q + 1] * sc), pk_bf16(o[eb][4 * q + 2] * sc, o[eb][4 * q + 3] * sc)};
                *(LAS u32x2*)(W + r * 272 + e * 2) = w;
            }
#pragma unroll
        for (int it = 0; it < 8; ++it) {
            const int row = it * 4 + (lane >> 4), ch = lane & 15;
            const u32x4 v = *(LAS u32x4*)(W + row * 272 + ch * 16);
            *(u32x4*)(MIX + (rowbase + q_p0 + wq * 32 + row) * DM + h * 128 + ch * 8) = v;
        }
    }
    __syncthreads();
}

DI void ret_unit(const Params& p, int l, int b, int h, int c) {
    const int tid = tid_(), lane = tid & 63, wid = tid >> 6, fr = lane & 15, g = lane >> 4;
    const float* scal = (const float*)(p.ws + WS_SCAL) + l * 16;
    const float lf2 = scal[2 + h], lb2 = scal[6 + h];
    const bf16_t* P = (const bf16_t*)(p.ws + WS_P);
    const bf16_t* RVT = (const bf16_t*)(p.ws + WS_RVT);
    const bf16_t* SF = (const bf16_t*)(p.ws + WS_SF); const bf16_t* SB = (const bf16_t*)(p.ws + WS_SB);
    bf16_t* MIX = (bf16_t*)(p.ws + WS_MIX);
    const int bh = b * 4 + h;
    const size_t row0 = (size_t)b * NT + c * 128;
    const int iloc = wid * 16 + fr;
    u32x4 qraw[2];
#pragma unroll
    for (int ks = 0; ks < 2; ++ks) qraw[ks] = *(const u32x4*)(P + (row0 + iloc) * INW + C_RQ + h * 64 + ks * 32 + 8 * g);
    bf16x8 kf[8][2];
#pragma unroll
    for (int jb = 0; jb < 8; ++jb)
#pragma unroll
        for (int ks = 0; ks < 2; ++ks) kf[jb][ks] = *(const bf16x8*)(P + (row0 + jb * 16 + fr) * INW + C_RK + h * 64 + ks * 32 + 8 * g);
    u32x4 vf[4][4];
#pragma unroll
    for (int jj = 0; jj < 4; ++jj)
#pragma unroll
        for (int eb = 0; eb < 4; ++eb) {
            const bf16_t* vp = RVT + ((size_t)bh * 64 + eb * 16 + fr) * NT + c * 128 + jj * 32 + 4 * g;
            const u32x2 v0 = *(const u32x2*)vp, v1 = *(const u32x2*)(vp + 16);
            vf[jj][eb] = (u32x4){v0[0], v0[1], v1[0], v1[1]};
        }
    f32x4 st[8];
#pragma unroll
    for (int jb = 0; jb < 8; ++jb) {
        st[jb] = (f32x4){0.f, 0.f, 0.f, 0.f};
#pragma unroll
        for (int ks = 0; ks < 2; ++ks) st[jb] = MFMA16(kf[jb][ks], as_bf16x8(qraw[ks]), st[jb]);
    }
    const int vc = c >= 2 ? c - 2 : 64 + c;
    const bf16_t* sf = SF + ((size_t)bh * NCHUNK + c) * 4096 + fr * 64 + 8 * g;
    const bf16_t* sb = SB + ((size_t)bh * NCHUNK + vc) * 4096 + fr * 64 + 8 * g;
    bf16x8 sfa[2][4], sba[2][4];
#pragma unroll
    for (int ks = 0; ks < 2; ++ks)
#pragma unroll
        for (int eb = 0; eb < 4; ++eb) { sfa[ks][eb] = *(const bf16x8*)(sf + eb * 1024 + ks * 32); sba[ks][eb] = *(const bf16x8*)(sb + eb * 1024 + ks * 32); }
    u32x2 gw[4];
#pragma unroll
    for (int eb = 0; eb < 4; ++eb) gw[eb] = *(const u32x2*)(P + (row0 + iloc) * INW + C_RG + h * 64 + eb * 16 + 4 * g);
#pragma unroll
    for (int jb = 0; jb < 8; ++jb)
#pragma unroll
        for (int q = 0; q < 4; ++q) {
            const int j = jb * 16 + 4 * g + q;
            const int d = iloc - j;
            const float w = d > 0 ? fast_exp2((float)d * lf2) : (d < 0 ? fast_exp2((float)(-d) * lb2) : 2.0f);
            st[jb][q] *= w;
        }
    f32x4 ot[4];
#pragma unroll
    for (int eb = 0; eb < 4; ++eb) ot[eb] = (f32x4){0.f, 0.f, 0.f, 0.f};
#pragma unroll
    for (int jj = 0; jj < 4; ++jj) {
        const u32x4 pw = {pk_bf16(st[2 * jj][0], st[2 * jj][1]), pk_bf16(st[2 * jj][2], st[2 * jj][3]), pk_bf16(st[2 * jj + 1][0], st[2 * jj + 1][1]), pk_bf16(st[2 * jj + 1][2], st[2 * jj + 1][3])};
#pragma unroll
        for (int eb = 0; eb < 4; ++eb) ot[eb] = MFMA16(as_bf16x8(vf[jj][eb]), as_bf16x8(pw), ot[eb]);
    }
    const float df = fast_exp2((float)(iloc + 1) * lf2), db = fast_exp2((float)(128 - iloc) * lb2);
#pragma unroll
    for (int ks = 0; ks < 2; ++ks) {
        u32x4 qf, qb;
#pragma unroll
        for (int q = 0; q < 4; ++q) { const float a = bf_lo(qraw[ks][q]), bb = bf_hi(qraw[ks][q]); qf[q] = pk_bf16(a * df, bb * df); qb[q] = pk_bf16(a * db, bb * db); }
#pragma unroll
        for (int eb = 0; eb < 4; ++eb) {
            ot[eb] = MFMA16(sfa[ks][eb], as_bf16x8(qf), ot[eb]);
            ot[eb] = MFMA16(sba[ks][eb], as_bf16x8(qb), ot[eb]);
        }
    }
    float s = 0.f;
#pragma unroll
    for (int eb = 0; eb < 4; ++eb) s += (ot[eb][0] + ot[eb][1]) + (ot[eb][2] + ot[eb][3]);
    s += __shfl_xor(s, 16); s += __shfl_xor(s, 32);
    const float mu = s * (1.0f / 64.0f);
    float q2 = 0.f;
#pragma unroll
    for (int eb = 0; eb < 4; ++eb)
#pragma unroll
        for (int q = 0; q < 4; ++q) { const float d = ot[eb][q] - mu; q2 += d * d; }
    q2 += __shfl_xor(q2, 16); q2 += __shfl_xor(q2, 32);
    const float rstd = rsqrtf(q2 * (1.0f / 64.0f) + LN_EPS);
#pragma unroll
    for (int eb = 0; eb < 4; ++eb) {
        const int e = eb * 16 + 4 * g;
        const float g0 = bf_lo(gw[eb][0]), g1 = bf_hi(gw[eb][0]), g2 = bf_lo(gw[eb][1]), g3 = bf_hi(gw[eb][1]);
        u32x2 w = {pk_bf16((ot[eb][0] - mu) * rstd * silu_f(g0), (ot[eb][1] - mu) * rstd * silu_f(g1)),
                   pk_bf16((ot[eb][2] - mu) * rstd * silu_f(g2), (ot[eb][3] - mu) * rstd * silu_f(g3))};
        *(u32x2*)(MIX + (row0 + iloc) * DM + 768 + h * 64 + e) = w;
    }
}

DI void phase_attn(const Params& p0, int l, LAS unsigned char* lds) {
    const Params p = launder(p0); l = launder_s(l);
    const float* scal = (const float*)(p.ws + WS_SCAL) + l * 16;
    const float lam = scal[0], oscale = scal[1];
    const int nunits = NB * 4 * 64 + (l == 0 ? NB * 4 * 2 : 0);
    for (int u = bid_(); u < nunits; u += gridDim.x) {
        int b, h, q0, ntile;
        if (u < NB * 4 * 64) { const int qt = u & 63; h = (u >> 6) & 3; b = u >> 8; q0 = NCTX + qt * 128; ntile = NT / 64; }
        else { const int v = u - NB * 4 * 64; const int qt = v & 1; h = (v >> 1) & 3; b = v >> 3; q0 = qt * 128; ntile = NCTX / 64; }
        attn_unit(p, b, h, q0, ntile, lam, oscale, lds);
    }
}
DI void phase_ret(const Params& p0, int l) {
    const Params p = launder(p0); l = launder_s(l);
    for (int u = bid_(); u < NB * 4 * NCHUNK; u += gridDim.x) {
        const int c = u % NCHUNK, bh = u / NCHUNK;
        if (l == 1 && c < 2) continue;
        ret_unit(p, l, bh >> 2, bh & 3, c);
    }
}

DI void phase_outproj(const Params& p0, int l, LAS unsigned char* lds) {
    const Params p = launder(p0); l = launder_s(l);
    const float* Xin = (const float*)(p.ws + WS_XA);
    const bf16_t* A = (const bf16_t*)(p.ws + WS_MIX);
    const bf16_t* W = (const bf16_t*)(p.ws + WS_WOUT) + (size_t)l * DM * DM;
    float* V1 = (float*)(p.ws + WS_V1);
    const float* modv = (const float*)(p.ws + WS_MODV) + (size_t)l * 3 * 6144;
    for (int u = bid_(); u < (MROWS / 192) * 8; u += gridDim.x) {
        const int tm = u >> 3, tn = u & 7;
        auto epi = [&](f32x4 (&acc)[4][3], int wm, int wn, int fr, int fq, int lane, int wid) {
            const int c0 = tn * 128 + wn * 64, r0 = tm * 192 + wm * 48;
            LAS unsigned char* W_ = g2_stage(lds, wid);
#pragma unroll
            for (int nf = 0; nf < 4; ++nf)
#pragma unroll
                for (int mf = 0; mf < 3; ++mf) *(LAS f32x4*)(W_ + (mf * 16 + fr) * 272 + nf * 64 + fq * 16) = acc[nf][mf];
#pragma unroll
            for (int it = 0; it < 12; ++it) {
                const int row = it * 4 + (lane >> 4), ch = lane & 15;
                const int grow = r0 + row;
                const f32x4 y = *(LAS f32x4*)(W_ + row * 272 + ch * 16);
                const f32x4 xv = *(const f32x4*)(Xin + (size_t)grow * DM + c0 + ch * 4);
                const f32x4 g2 = *(const f32x4*)(modv + (size_t)row_sel(grow) * 6144 + 2 * 1024 + c0 + ch * 4);
                *(f32x4*)(V1 + (size_t)grow * DM + c0 + ch * 4) = (f32x4){DN_ALPHA * xv[0] + g2[0] * y[0], DN_ALPHA * xv[1] + g2[1] * y[1], DN_ALPHA * xv[2] + g2[2] * y[2], DN_ALPHA * xv[3] + g2[3] * y[3]};
            }
        };
        gemm192(A, DM, W, DM, DM / 64, tm * 192, tn * 128, lds, epi);
    }
}

DI void phase_ln_mid(const Params& p0, int l) {
    const Params p = launder(p0); l = launder_s(l);
    float* Xout = (float*)(p.ws + WS_XB);
    const int lane = tid_() & 63, wid = tid_() >> 6;
    const float* V1 = (const float*)(p.ws + WS_V1);
    bf16_t* TOK = (bf16_t*)(p.ws + WS_TOK);
    const float* modv = (const float*)(p.ws + WS_MODV) + (size_t)l * 3 * 6144;
    const float* lg = p.ln_g + (size_t)(l * 2 + 0) * DM; const float* lb = p.ln_b + (size_t)(l * 2 + 0) * DM;
    for (int r = bid_() * 8 + wid; r < MROWS; r += gridDim.x * 8) {
        f32x4 v[4];
#pragma unroll
        for (int i = 0; i < 4; ++i) v[i] = *(const f32x4*)(V1 + (size_t)r * DM + lane * 4 + i * 256);
        float mu, rstd; ln_stats(v, mu, rstd);
#pragma unroll
        for (int i = 0; i < 4; ++i) {
            const int c = lane * 4 + i * 256;
            const f32x4 gg = *(const f32x4*)(lg + c), bb = *(const f32x4*)(lb + c);
#pragma unroll
            for (int j = 0; j < 4; ++j) v[i][j] = (v[i][j] - mu) * rstd * gg[j] + bb[j];
            *(f32x4*)(Xout + (size_t)r * DM + c) = v[i];
        }
        const float* mv = modv + (size_t)row_sel(r) * 6144;
        modulate_store(v, mv + 3 * 1024, mv + 4 * 1024, TOK + (size_t)r * DM, lane);
    }
}

DI void phase_router(const Params& p0, int l, LAS unsigned char* lds) {
    const Params p = launder(p0); l = launder_s(l);
    const bf16_t* A = (const bf16_t*)(p.ws + WS_TOK);
    const bf16_t* W = (const bf16_t*)(p.ws + WS_WR) + (size_t)l * 256 * DM;
    float* LG = (float*)(p.ws + WS_LOGIT);
    for (int u = bid_(); u < (MROWS / 192) * 2; u += gridDim.x) {
        const int tm = u >> 1, tn = u & 1;
        auto epi = [&](f32x4 (&acc)[4][3], int wm, int wn, int fr, int fq, int lane, int wid) {
            const int c0 = tn * 128 + wn * 64, r0 = tm * 192 + wm * 48;
            LAS unsigned char* W_ = g2_stage(lds, wid);
#pragma unroll
            for (int nf = 0; nf < 4; ++nf)
#pragma unroll
                for (int mf = 0; mf < 3; ++mf) *(LAS f32x4*)(W_ + (mf * 16 + fr) * 272 + nf * 64 + fq * 16) = acc[nf][mf];
#pragma unroll
            for (int it = 0; it < 12; ++it) {
                const int row = it * 4 + (lane >> 4), ch = lane & 15;
                *(f32x4*)(LG + (size_t)(r0 + row) * 256 + c0 + ch * 4) = *(LAS f32x4*)(W_ + row * 272 + ch * 16);
            }
        };
        gemm192(A, DM, W, DM, DM / 64, tm * 192, tn * 128, lds, epi);
    }
}

DI void phase_topk(const Params& p0, int l, LAS unsigned char* lds) {
    const Params p = launder(p0); l = launder_s(l);
    const int lane = tid_() & 63, wid = tid_() >> 6, rs = lane >> 3, g = lane & 7;
    const float* LG = (const float*)(p.ws + WS_LOGIT);
    const float* bias = p.router_bias + l * 256 + g * 32;
    int* EIDX = (int*)(p.ws + WS_EIDX); float* GATE = (float*)(p.ws + WS_GATE);
    int* RANK = (int*)(p.ws + WS_RANK); int* HIST = (int*)(p.ws + WS_HIST);
    LAS int* hist = (LAS int*)lds;
    if (tid_() < 256) hist[tid_()] = 0;
    __syncthreads();
    const int chunk = (MROWS + (int)gridDim.x - 1) / (int)gridDim.x, r_begin = bid_() * chunk, r_end = (r_begin + chunk) < MROWS ? (r_begin + chunk) : MROWS;
    for (int base = r_begin + wid * 8; base < r_end; base += 64) {
        const int row = base + rs; const bool valid = row < r_end;
        const float* lp = LG + (size_t)(valid ? row : r_begin) * 256 + g * 32;
        float sc[32], gv[32];
#pragma unroll
        for (int q = 0; q < 8; ++q) {
            const f32x4 lg = *(const f32x4*)(lp + 4 * q), bv = *(const f32x4*)(bias + 4 * q);
#pragma unroll
            for (int j = 0; j < 4; ++j) { sc[4 * q + j] = 1.0f / (1.0f + __expf(-lg[j])); gv[4 * q + j] = sc[4 * q + j] + bv[j]; }
        }
        float m1 = fmaxf(gv[0], gv[1]), m2 = fminf(gv[0], gv[1]);
#pragma unroll
        for (int i = 2; i < 32; ++i) { const float v = gv[i]; m2 = fmaxf(m2, fminf(m1, v)); m1 = fmaxf(m1, v); }
        const float gs = m1 + m2;
        int rank = 0;
#pragma unroll
        for (int g2 = 0; g2 < 8; ++g2) { const float o = __shfl(gs, (lane & 56) + g2); rank += (o > gs || (o == gs && g2 < g)) ? 1 : 0; }
        if (rank >= 4) {
#pragma unroll
            for (int i = 0; i < 32; ++i) gv[i] = -INFINITY;
        }
        float ssum = 0.f, mysc = 0.f; int myidx = 0;
#pragma unroll 1
        for (int k = 0; k < TOPK; ++k) {
            float bv = gv[0], bs = sc[0]; int bi = 0;
#pragma unroll
            for (int i = 1; i < 32; ++i) { const bool gt = gv[i] > bv; bv = gt ? gv[i] : bv; bs = gt ? sc[i] : bs; bi = gt ? i : bi; }
            int gi = g * 32 + bi;
#pragma unroll
            for (int o = 1; o < 8; o <<= 1) {
                const float ov = __shfl_xor(bv, o), os = __shfl_xor(bs, o); const int oi = __shfl_xor(gi, o);
                const bool tk = ov > bv || (ov == bv && oi < gi);
                bv = tk ? ov : bv; bs = tk ? os : bs; gi = tk ? oi : gi;
            }
            if ((gi >> 5) == g) {
                const int oi = gi & 31;
#pragma unroll
                for (int i = 0; i < 32; ++i) gv[i] = (i == oi) ? -INFINITY : gv[i];
            }
            ssum += bs;
            if (g == k) { mysc = bs; myidx = gi; }
        }
        if (valid) {
            EIDX[(size_t)row * 8 + g] = myidx;
            GATE[(size_t)row * 8 + g] = mysc / ssum * 2.5f;
            RANK[(size_t)row * 8 + g] = __hip_atomic_fetch_add(hist + myidx, 1, __ATOMIC_RELAXED, __HIP_MEMORY_SCOPE_WORKGROUP);
        }
    }
    __syncthreads();
    if (tid_() < 256) HIST[(size_t)bid_() * 256 + tid_()] = hist[tid_()];
    __syncthreads();
}

DI void phase_scatter(const Params& p0, int l, LAS unsigned char* lds) {
    const Params p = launder(p0); l = launder_s(l);
    LAS int* off = (LAS int*)lds;
    LAS int* toff = off + 260;
    LAS int* tot = toff + 260;
    LAS int* base = tot + 256;
    const int tid = tid_(), bid = bid_(), G = gridDim.x;
    const int* HIST = (const int*)(p.ws + WS_HIST);
    const int* RANK = (const int*)(p.ws + WS_RANK);
    int* ntl = (int*)(p.ws + CTL_NTILES) + l;
    int* TILES = (int*)(p.ws + WS_TILES);
    const int* EIDX = (const int*)(p.ws + WS_EIDX);
    int* SORT = (int*)(p.ws + WS_SORT);
    if (tid < 256) {
        int t = 0, bs = 0;
#pragma unroll 16
        for (int b2 = 0; b2 < G; ++b2) { const int v = HIST[(size_t)b2 * 256 + tid]; bs += (b2 < bid) ? v : 0; t += v; }
        tot[tid] = t; base[tid] = bs;
    }
    __syncthreads();
    if (tid == 0) {
        int a = 0, t = 0;
        for (int e = 0; e < 256; ++e) { off[e] = a; toff[e] = t; const int c = tot[e]; a += c; t += (c + 127) >> 7; }
        off[256] = a; toff[256] = t;
    }
    __syncthreads();
    if (bid == 0) {
        if (tid < 256) {
            const int e = tid, c = off[e + 1] - off[e], nt = toff[e + 1] - toff[e];
            for (int t = 0; t < nt; ++t) { int* T = TILES + (size_t)(toff[e] + t) * 4; T[0] = e; T[1] = off[e] + t * 128; T[2] = (c - t * 128) < 128 ? (c - t * 128) : 128; T[3] = 0; }
        }
        if (tid == 0) *ntl = toff[256];
    }
    const int chunk = (MROWS + G - 1) / G, r_begin = bid * chunk, r_end = (r_begin + chunk) < MROWS ? (r_begin + chunk) : MROWS;
    for (int a = r_begin * 8 + tid; a < r_end * 8; a += NTHREADS) {
        const int e = EIDX[a];
        SORT[off[e] + base[e] + RANK[a]] = a;
    }
    __syncthreads();
}

constexpr int MOE_STG = 40960;
constexpr int MOE_HT = 86016;
constexpr int MOE_INFO = MOE_HT + 65536;
constexpr int IMG_BYTES = 32768, IMG_PER_E = 48;
DI int swz64(int row, int chunk) { return row * 64 + ((chunk ^ ((0 - (row >> 2)) & 3)) << 4); }

struct ImgJob { const float* wp; int ldw; unsigned char* d; int g; };
DI ImgJob img_job(const Params& p, int l, int uu, unsigned char* IMG) {
    const int u = (NEXP + 1) * IMG_PER_E - 1 - uu;
    const int e = u / IMG_PER_E, im = u % IMG_PER_E;
    const int np = tid_();
    ImgJob j;
    if (im < 32) {
        const float* W = e < NEXP ? p.w_egu + ((size_t)l * NEXP + e) * DM * 512 : p.w_sgu + (size_t)l * DM * 512;
        j.ldw = 512; j.wp = W + (size_t)(im * 32) * 512 + (((np >> 4) & 1) * 256 + (np >> 5) * 16 + (np & 15));
    } else {
        const float* W = e < NEXP ? p.w_edn + ((size_t)l * NEXP + e) * 256 * DM : p.w_sdn + (size_t)l * 256 * DM;
        j.ldw = DM; j.wp = W + (size_t)(((im - 32) & 7) * 32) * DM + ((im - 32) >> 3) * 512 + np;
    }
    j.d = IMG + (size_t)u * IMG_BYTES + np * 64; j.g = (0 - (np >> 2)) & 3;
    return j;
}
DI void img_load(const ImgJob& j, float (&wb)[32]) {
#pragma unroll
    for (int kk = 0; kk < 32; ++kk) wb[kk] = __builtin_nontemporal_load(j.wp + (size_t)kk * j.ldw);
}
DI void img_store(const ImgJob& j, const float (&wb)[32]) {
#pragma unroll
    for (int c = 0; c < 4; ++c) { const u32x4 w = {pk_bf16(wb[8 * c], wb[8 * c + 1]), pk_bf16(wb[8 * c + 2], wb[8 * c + 3]), pk_bf16(wb[8 * c + 4], wb[8 * c + 5]), pk_bf16(wb[8 * c + 6], wb[8 * c + 7])}; *(u32x4*)(j.d + ((c ^ j.g) << 4)) = w; }
}
DI void phase_convert_experts(const Params& p0, int l) {
    const Params p = launder(p0); l = launder_s(l);
    unsigned char* IMG = p.ws + WS_WIMG + (size_t)l * (NEXP + 1) * IMG_PER_E * IMG_BYTES;
    const int total = (NEXP + 1) * IMG_PER_E, G = gridDim.x;
    float wa[32], wb[32];
    int u = bid_();
    if (u >= total) return;
    ImgJob ja = img_job(p, l, u, IMG), jb = ja;
    img_load(ja, wa);
    for (;;) {
        const bool hb = u + G < total;
        if (hb) { jb = img_job(p, l, u + G, IMG); img_load(jb, wb); }
        img_store(ja, wa);
        if (!hb) break;
        u += G;
        const bool ha = u + G < total;
        if (ha) { ja = img_job(p, l, u + G, IMG); img_load(ja, wa); }
        img_store(jb, wb);
        if (!ha) break;
        u += G;
    }
}

DI void moe_unit(const Params& p, const unsigned char* img, bf16_t* outbase, bool shared, int r0, int nr, LAS unsigned char* lds) {
    const int t = tid_(), lane = t & 63, wid = __builtin_amdgcn_readfirstlane(t >> 6), fr = lane & 15, fq = lane >> 4, wn = wid & 3, wt = wid >> 2;
    const bf16_t* TOK = (const bf16_t*)(p.ws + WS_TOK);
    const int* SORT = (const int*)(p.ws + WS_SORT);
    LAS int* rowout = (LAS int*)(lds + MOE_INFO);
    const int arow = t >> 2;
    int atok = 0, aout = -1;
    if (arow < nr) { if (shared) { atok = r0 + arow; aout = atok; } else { aout = SORT[r0 + arow]; atok = aout >> 3; } }
    const bf16_t* aptr = TOK + (size_t)atok * DM + (((t & 3) ^ ((0 - (arow >> 2)) & 3)) << 3);
    __syncthreads();
    if ((t & 3) == 0) rowout[arow] = aout;
    const unsigned char* wsrc = img + (size_t)t * 16;
    const int adst = wid * 1024, wdst = 8192 + wid * 1024;
#define MOE_ISSUE1(S, KT) do { LAS unsigned char* _s = lds + (S) * MOE_STG; dma16(aptr + (KT) * 32, _s + adst); \
        const unsigned char* _w = wsrc + (size_t)(KT) * IMG_BYTES; \
        dma16(_w, _s + wdst); dma16(_w + 8192, _s + wdst + 8192); dma16(_w + 16384, _s + wdst + 16384); dma16(_w + 24576, _s + wdst + 24576); } while (0)
#define MOE_ISSUE2(S, IM) do { LAS unsigned char* _s = lds + (S) * IMG_BYTES; const unsigned char* _w = wsrc + (size_t)(IM) * IMG_BYTES; \
        dma16(_w, _s + adst); dma16(_w + 8192, _s + adst + 8192); dma16(_w + 16384, _s + adst + 16384); dma16(_w + 24576, _s + adst + 24576); } while (0)
    f32x4 acc[8][4];
#pragma unroll
    for (int nf = 0; nf < 8; ++nf)
#pragma unroll
        for (int tf = 0; tf < 4; ++tf) acc[nf][tf] = (f32x4){0.f, 0.f, 0.f, 0.f};
    MOE_ISSUE1(0, 0);
    MOE_ISSUE1(1, 1);
    int st = 0;
    for (int kt = 0; kt < 32; ++kt) {
        if (kt < 31) WAIT_VM(5); else WAIT_VM(0);
        asm volatile("s_waitcnt lgkmcnt(0)" ::: "memory");
        __builtin_amdgcn_s_barrier();
        const int st2 = st == 0 ? 2 : st - 1;
        if (wt == 0) { if (kt < 30) MOE_ISSUE1(st2, kt + 2); else if (kt == 31) MOE_ISSUE2(0, 32); }
        LAS unsigned char* S = lds + st * MOE_STG;
        bf16x8 tfr[4];
#pragma unroll
        for (int tf = 0; tf < 4; ++tf) tfr[tf] = *(LAS bf16x8*)(S + swz64(wt * 64 + tf * 16 + fr, fq));
#pragma unroll
        for (int nf = 0; nf < 8; ++nf) {
            const bf16x8 wf = *(LAS bf16x8*)(S + 8192 + swz64(wn * 128 + nf * 16 + fr, fq));
#pragma unroll
            for (int tf = 0; tf < 4; ++tf) acc[nf][tf] = MFMA16(wf, tfr[tf], acc[nf][tf]);
            if (nf == 3 && wt == 1) { if (kt < 30) MOE_ISSUE1(st2, kt + 2); else if (kt == 31) MOE_ISSUE2(0, 32); }
        }
        st = st == 2 ? 0 : st + 1;
    }
#pragma unroll
    for (int i = 0; i < 4; ++i)
#pragma unroll
        for (int tf = 0; tf < 4; ++tf) {
            float hv[4];
#pragma unroll
            for (int j = 0; j < 4; ++j) hv[j] = silu_f(acc[2 * i][tf][j]) * acc[2 * i + 1][tf][j];
            const int tok = wt * 64 + tf * 16 + fr, hc = wn * 64 + i * 16 + 4 * fq;
            const u32x2 w = {pk_bf16(hv[0], hv[1]), pk_bf16(hv[2], hv[3])};
            *(LAS u32x2*)(lds + MOE_HT + tok * 512 + (((hc >> 3) ^ (tok & 15)) << 4) + (hc & 7) * 2) = w;
        }
#pragma unroll 1
    for (int nc = 0; nc < 2; ++nc) {
#pragma unroll
        for (int nf = 0; nf < 8; ++nf)
#pragma unroll
            for (int tf = 0; tf < 4; ++tf) acc[nf][tf] = (f32x4){0.f, 0.f, 0.f, 0.f};
        if (nc == 1) MOE_ISSUE2(0, 40);
        for (int kt = 0; kt < 8; ++kt) {
            WAIT_VM(0);
            asm volatile("s_waitcnt lgkmcnt(0)" ::: "memory");
            __builtin_amdgcn_s_barrier();
            if (wt == 0 && kt < 7) MOE_ISSUE2((kt + 1) & 1, 32 + nc * 8 + kt + 1);
            LAS unsigned char* S = lds + (kt & 1) * IMG_BYTES;
            bf16x8 tfr[4];
#pragma unroll
            for (int tf = 0; tf < 4; ++tf) { const int tok = wt * 64 + tf * 16 + fr; tfr[tf] = *(LAS bf16x8*)(lds + MOE_HT + tok * 512 + (((kt * 4 + fq) ^ (tok & 15)) << 4)); }
#pragma unroll
            for (int nf = 0; nf < 8; ++nf) {
                const bf16x8 wf = *(LAS bf16x8*)(S + swz64(wn * 128 + nf * 16 + fr, fq));
#pragma unroll
                for (int tf = 0; tf < 4; ++tf) acc[nf][tf] = MFMA16(wf, tfr[tf], acc[nf][tf]);
                if (nf == 3 && wt == 1 && kt < 7) MOE_ISSUE2((kt + 1) & 1, 32 + nc * 8 + kt + 1);
            }
        }
        __syncthreads();
        LAS unsigned char* W = lds + wid * 9216;
#pragma unroll
        for (int half = 0; half < 2; ++half) {
#pragma unroll
            for (int nh = 0; nh < 4; ++nh)
#pragma unroll
                for (int tf = 0; tf < 4; ++tf) {
                    const f32x4 v = acc[half * 4 + nh][tf];
                    const u32x2 w = {pk_bf16(v[0], v[1]), pk_bf16(v[2], v[3])};
                    *(LAS u32x2*)(W + (tf * 16 + fr) * 144 + nh * 32 + fq * 8) = w;
                }
#pragma unroll
            for (int it = 0; it < 8; ++it) {
                const int row = it * 8 + (lane >> 3), ch = lane & 7;
                const u32x4 v = *(LAS u32x4*)(W + row * 144 + ch * 16);
                const int ro = rowout[wt * 64 + row];
                if (ro >= 0) *(u32x4*)(outbase + (size_t)ro * DM + nc * 512 + wn * 128 + half * 64 + ch * 8) = v;
            }
        }
        __syncthreads();
    }
#undef MOE_ISSUE1
#undef MOE_ISSUE2
}

DI void phase_moe(const Params& p0, int l, LAS unsigned char* lds) {
    const Params p = launder(p0); l = launder_s(l);
    const int* TILES = (const int*)(p.ws + WS_TILES);
    const int ntl = *((const int*)(p.ws + CTL_NTILES) + l);
    const int G = gridDim.x, bid = bid_();
    int vcu = bid;
    if (p.ph_hi - p.ph_lo > 1) {
        volatile LAS unsigned* bst = (volatile LAS unsigned*)(lds + LDS_BYTES - 16);
        const unsigned xc = bst[2]; unsigned pre = 0;
        for (unsigned j = 0; j < 16; ++j) { const unsigned c = xb_ld((unsigned*)(p.ws + WS_CTL) + XB_XCNT(j)); pre += (j < xc) ? c : 0u; }
        vcu = (int)(pre + bst[3]);
    }
    const int total = ntl + MROWS / 128;
    const unsigned char* IMG = p.ws + WS_WIMG + (size_t)l * (NEXP + 1) * IMG_PER_E * IMG_BYTES;
    for (int u = vcu; u < total; u += G) {
        if (u < ntl) {
            const int e = TILES[u * 4], r0 = TILES[u * 4 + 1], nr = TILES[u * 4 + 2];
            moe_unit(p, IMG + (size_t)e * IMG_PER_E * IMG_BYTES, (bf16_t*)(p.ws + WS_YSLOT), false, r0, nr, lds);
        } else {
            const int tm = u - ntl;
            if (l == 1 && (tm % (NT / 128)) < 2) continue;
            moe_unit(p, IMG + (size_t)NEXP * IMG_PER_E * IMG_BYTES, (bf16_t*)(p.ws + WS_YSH), true, tm * 128, 128, lds);
        }
    }
}

DI void phase_combine(const Params& p0, int l) {
    const Params p = launder(p0); l = launder_s(l);
    const float* X1 = (const float*)(p.ws + WS_XB); float* Xnext = (float*)(p.ws + WS_XA);
    const int lane = tid_() & 63, wid = tid_() >> 6;
    const bf16_t* YSL = (const bf16_t*)(p.ws + WS_YSLOT); const bf16_t* YSH = (const bf16_t*)(p.ws + WS_YSH);
    const float* GATE = (const float*)(p.ws + WS_GATE);
    const float* modv = (const float*)(p.ws + WS_MODV);
    const float* lg = p.ln_g + (size_t)(l * 2 + 1) * DM; const float* lb = p.ln_b + (size_t)(l * 2 + 1) * DM;
    bf16_t* H = (bf16_t*)(p.ws + WS_H);
    for (int r = bid_() * 8 + wid; r < MROWS; r += gridDim.x * 8) {
        const int b = r >= NT, pp = r - b * NT;
        if (l == 1 && pp < NCTX) continue;
        const int sel = pp < NCTX ? 2 : b;
        float gt[8];
#pragma unroll
        for (int k = 0; k < 8; ++k) gt[k] = GATE[(size_t)r * 8 + k];
        const float* g5 = modv + ((size_t)l * 3 + sel) * 6144 + 5 * 1024;
        f32x4 v[4];
        u32x2 sl[4][9]; f32x4 xv4[4];
#pragma unroll
        for (int i = 0; i < 4; ++i) {
            const int c = lane * 4 + i * 256;
            sl[i][8] = *(const u32x2*)(YSH + (size_t)r * DM + c);
#pragma unroll
            for (int k = 0; k < 8; ++k) sl[i][k] = *(const u32x2*)(YSL + ((size_t)r * 8 + k) * DM + c);
            xv4[i] = *(const f32x4*)(X1 + (size_t)r * DM + c);
        }
#pragma unroll
        for (int i = 0; i < 4; ++i) {
            const int c = lane * 4 + i * 256;
            float f0 = bf_lo(sl[i][8][0]), f1 = bf_hi(sl[i][8][0]), f2 = bf_lo(sl[i][8][1]), f3 = bf_hi(sl[i][8][1]);
#pragma unroll
            for (int k = 0; k < 8; ++k) { const u32x2 w = sl[i][k]; f0 += gt[k] * bf_lo(w[0]); f1 += gt[k] * bf_hi(w[0]); f2 += gt[k] * bf_lo(w[1]); f3 += gt[k] * bf_hi(w[1]); }
            const f32x4 xv = xv4[i], gv = *(const f32x4*)(g5 + c);
            v[i] = (f32x4){DN_ALPHA * xv[0] + gv[0] * f0, DN_ALPHA * xv[1] + gv[1] * f1, DN_ALPHA * xv[2] + gv[2] * f2, DN_ALPHA * xv[3] + gv[3] * f3};
        }
        float mu, rstd; ln_stats(v, mu, rstd);
#pragma unroll
        for (int i = 0; i < 4; ++i) {
            const int c = lane * 4 + i * 256;
            const f32x4 gg = *(const f32x4*)(lg + c), bb = *(const f32x4*)(lb + c);
#pragma unroll
            for (int j = 0; j < 4; ++j) v[i][j] = (v[i][j] - mu) * rstd * gg[j] + bb[j];
            if (l == 1) *(f32x4*)(p.out + ((size_t)b * NLAT + (pp - NCTX)) * DM + c) = v[i];
            else *(f32x4*)(Xnext + (size_t)r * DM + c) = v[i];
        }
        if (l == 0) { const float* mv = modv + ((size_t)1 * 3 + sel) * 6144; modulate_store(v, mv, mv + 1024, H + (size_t)r * DM, lane); }
    }
}

constexpr int PH_PER_LAYER = 11, N_PHASES = 3 + 2 * PH_PER_LAYER;
__global__ void __launch_bounds__(NTHREADS, 2) mega(Params p) {
    extern __shared__ __attribute__((aligned(16))) unsigned char lds_raw[];
    LAS unsigned char* lds = (LAS unsigned char*)lds_raw;
    volatile LAS unsigned* bst = (volatile LAS unsigned*)(lds + LDS_BYTES - 16);
    if (PROBE_ID != 0 && threadIdx.x == 0) { PRB_WORDS(lds)[0] = 0ull; PRB_WORDS(lds)[1] = 0ull; }
    if (threadIdx.x == 0) { bst[0] = 0u; bst[1] = 0u; const unsigned xc = xb_xcc_id(); bst[2] = xc; bst[3] = xb_add((unsigned*)(p.ws + CTL_XRANK) + xc, 1u); }
    __syncthreads();
    const int lo = p.ph_lo, hi = p.ph_hi;
    XcdBarrier bar; bar.bar = (unsigned*)(p.ws + WS_CTL); bar.x = 0; bar.st = bst;
    if (hi - lo > 1) bar = xcd_barrier_post((unsigned*)(p.ws + WS_CTL), bst);
#ifndef ONLY_PHASE
#define ONLY_PHASE -1
#endif
#define IN(k) (lo <= (k) && (k) < hi)
#define ON(pid) (ONLY_PHASE < 0 || ONLY_PHASE == (pid))
#ifndef DUP_PHASE
#define DUP_PHASE -1
#endif
#define REP(pid) for (int rep_ = 0; rep_ < ((DUP_PHASE == (pid)) ? 2 : 1); ++rep_)
#define SEAM(k) do { if (IN(k) && IN((k) + 1)) xcd_barrier(bar); } while (0)
    PRB_T0(100, lds); if (ON(0) && IN(0)) REP(0) { phase_convert(p, lds); } PRB_T1(100, lds);
    PRB_T0(200, lds); SEAM(0); PRB_T1(200, lds);
    PRB_T0(101, lds); if (ON(1) && IN(1)) REP(1) phase_mod(p, lds); PRB_T1(101, lds);
    PRB_T0(201, lds); SEAM(1); PRB_T1(201, lds);
    PRB_T0(102, lds); if (ON(2) && IN(2)) REP(2) phase_ln0(p); PRB_T1(102, lds);
    PRB_T0(202, lds); SEAM(2); PRB_T1(202, lds);
    for (int l = 0; l < 2; ++l) {
        const int k0 = 3 + l * PH_PER_LAYER;
        PRB_T0(103, lds); if (ON(3) && IN(k0 + 0)) REP(3) phase_inproj(p, l, lds); PRB_T1(103, lds);
        PRB_T0(203, lds); SEAM(k0 + 0); PRB_T1(203, lds);
        PRB_T0(104, lds); if (ON(4) && IN(k0 + 1)) REP(4) phase_ret_sum_pool(p, l, lds); PRB_T1(104, lds);
        PRB_T0(204, lds); SEAM(k0 + 1); PRB_T1(204, lds);
        PRB_T0(105, lds); if (ON(5) && IN(k0 + 2)) REP(5) phase_ret_scan(p, l); PRB_T1(105, lds);
        PRB_T0(205, lds); SEAM(k0 + 2); PRB_T1(205, lds);
        PRB_T0(106, lds); if (ON(6) && IN(k0 + 3)) REP(6) { phase_attn(p, l, lds); phase_ret(p, l); } PRB_T1(106, lds);
        PRB_T0(206, lds); SEAM(k0 + 3); PRB_T1(206, lds);
        PRB_T0(107, lds); if (ON(7) && IN(k0 + 4)) REP(7) phase_outproj(p, l, lds); PRB_T1(107, lds);
        PRB_T0(207, lds); SEAM(k0 + 4); PRB_T1(207, lds);
        PRB_T0(108, lds); if (ON(8) && IN(k0 + 5)) REP(8) phase_ln_mid(p, l); PRB_T1(108, lds);
        PRB_T0(208, lds); SEAM(k0 + 5); PRB_T1(208, lds);
        PRB_T0(109, lds); if (ON(9) && IN(k0 + 6)) REP(9) phase_router(p, l, lds); PRB_T1(109, lds);
        PRB_T0(209, lds); SEAM(k0 + 6); PRB_T1(209, lds);
        PRB_T0(110, lds); if (ON(10) && IN(k0 + 7)) REP(10) phase_topk(p, l, lds); PRB_T1(110, lds);
        PRB_T0(210, lds); SEAM(k0 + 7); PRB_T1(210, lds);
        PRB_T0(111, lds); if (ON(11) && IN(k0 + 8)) REP(11) { phase_scatter(p, l, lds); phase_convert_experts(p, l); } PRB_T1(111, lds);
        PRB_T0(211, lds); SEAM(k0 + 8); PRB_T1(211, lds);
        PRB_T0(112, lds); if (ON(12) && IN(k0 + 9)) REP(12) phase_moe(p, l, lds); PRB_T1(112, lds);
        PRB_T0(212, lds); SEAM(k0 + 9); PRB_T1(212, lds);
        PRB_T0(114, lds); if (ON(14) && IN(k0 + 10)) REP(14) phase_combine(p, l); PRB_T1(114, lds);
        if (l == 0) SEAM(k0 + 10);
    }
#undef IN
#undef SEAM
    if (PROBE_ID != 0 && threadIdx.x == 0 && blockIdx.x == 0) {
        const unsigned long long t0 = __builtin_readcyclecounter(), span = PRB_WORDS(lds)[1] * PROBE_GAIN;
        while (__builtin_readcyclecounter() - t0 < span) __builtin_amdgcn_s_sleep(8);
    }
}

extern "C" void kernel_launch(void* const* d_in, const int* in_sizes, int n_in, void* d_out, int out_size, void* d_ws, size_t ws_size, hipStream_t stream) {
    static int grid = 0;
    if (grid == 0) {
        if (n_in != 20 || ws_size < WS_END || out_size != NB * NLAT * DM) { fprintf(stderr, "kernel_launch: unexpected shapes (n_in %d, ws %zu need %zu, out %d)\n", n_in, ws_size, (size_t)WS_END, out_size); grid = -1; return; }
        int dev = 0, cus = 0, per_cu = 0;
        hipGetDevice(&dev); hipDeviceGetAttribute(&cus, hipDeviceAttributeMultiprocessorCount, dev);
        if (hipFuncSetAttribute((const void*)mega, hipFuncAttributeMaxDynamicSharedMemorySize, LDS_BYTES) != hipSuccess) { fprintf(stderr, "kernel_launch: hipFuncSetAttribute failed\n"); grid = -1; return; }
        if (hipOccupancyMaxActiveBlocksPerMultiprocessor(&per_cu, (const void*)mega, NTHREADS, LDS_BYTES) != hipSuccess || per_cu < 1) { fprintf(stderr, "kernel_launch: occupancy query says %d\n", per_cu); }
        (void)hipGetLastError();
        grid = cus > 0 ? cus : 256;
    }
    if (grid < 0) return;
    hipMemsetAsync((char*)d_ws + WS_CTL, 0, CTL_BYTES, stream);
    Params p{};
    p.x = (const float*)d_in[0]; p.c = (const float*)d_in[1]; p.ctx = (const float*)d_in[2]; p.c_ctx = (const float*)d_in[3];
    p.w_mod = (const float*)d_in[4]; p.b_mod = (const float*)d_in[5]; p.w_in = (const float*)d_in[6]; p.w_out = (const float*)d_in[7];
    p.diff_lambda = (const float*)d_in[8]; p.pool_w = (const float*)d_in[9]; p.pool_scale = (const float*)d_in[10]; p.ret_log_decay = (const float*)d_in[11];
    p.ln_g = (const float*)d_in[12]; p.ln_b = (const float*)d_in[13]; p.w_router = (const float*)d_in[14]; p.router_bias = (const float*)d_in[15];
    p.w_egu = (const float*)d_in[16]; p.w_edn = (const float*)d_in[17]; p.w_sgu = (const float*)d_in[18]; p.w_sdn = (const float*)d_in[19];
    p.out = (float*)d_out; p.ws = (unsigned char*)d_ws;
#if N_LAUNCH_PER_PHASE
    for (int k = 0; k < N_PHASES; ++k) { p.ph_lo = k; p.ph_hi = k + 1; hipLaunchKernelGGL(mega, dim3(grid), dim3(NTHREADS), LDS_BYTES, stream, p); }
#else
    p.ph_lo = 0; p.ph_hi = N_PHASES;
    hipLaunchKernelGGL(mega, dim3(grid), dim3(NTHREADS), LDS_BYTES, stream, p);
#endif
}
```

```cpp
#include <hip/hip_runtime.h>
#include <stdint.h>
#include <stdio.h>

#ifndef N_LAUNCH_PER_PHASE
#define N_LAUNCH_PER_PHASE 0
#endif

#define LAS __attribute__((address_space(3)))
#define DI __device__ __forceinline__
typedef unsigned short bf16_t;
typedef short bf16x8 __attribute__((ext_vector_type(8)));
typedef float f32x2 __attribute__((ext_vector_type(2)));
typedef float f32x4 __attribute__((ext_vector_type(4)));
typedef float f32x16 __attribute__((ext_vector_type(16)));
typedef unsigned u32x2 __attribute__((ext_vector_type(2)));
typedef unsigned u32x4 __attribute__((ext_vector_type(4)));
typedef __bf16 bf16v2 __attribute__((ext_vector_type(2)));

constexpr int NB = 2, NLAT = 8192, NCTX = 256, NT = NLAT + NCTX  , MROWS = NB * NT  ;
constexpr int DM = 1024, INW = 2816, NEXP = 256, TOPK = 8, NASG = MROWS * TOPK  ;
constexpr int NCHUNK = NT / 128;
constexpr float DN_ALPHA = 1.41421356237f;
constexpr float LN_EPS = 1e-6f, RMS_EPS = 1e-5f;
constexpr float LOG2E = 1.44269504089f;
constexpr float QSCALE = 0.125f * LOG2E;
constexpr int NTHREADS = 512;
constexpr int LDS_BYTES = 155648;

constexpr int IMG_BYTES = 32768, IMG_PER_E = 48;
constexpr int C_DQ = 0, C_DK = 512, C_DV = 1024, C_PU = 1536, C_RQ = 1792, C_RK = 2048, C_RV = 2304, C_RG = 2560;

constexpr size_t al256(size_t x) { return (x + 255) & ~(size_t)255; }
constexpr size_t WS_CTL = 0;
constexpr size_t CTL_BYTES = 65536;
constexpr size_t CTL_COUNTS = 16384;
constexpr size_t CTL_CURSOR = CTL_COUNTS + 2048;
constexpr size_t CTL_NTILES = CTL_CURSOR + 2048;
constexpr size_t CTL_XRANK = CTL_NTILES + 256;
constexpr size_t WS_MODV = WS_CTL + CTL_BYTES;
constexpr size_t WS_ROPE = al256(WS_MODV + 2 * 3 * 6144 * 4);
constexpr size_t WS_SCAL = al256(WS_ROPE + 128 * 16 * 8);
constexpr size_t WS_WIN = al256(WS_SCAL + 2 * 16 * 4);
constexpr size_t WS_WOUT = al256(WS_WIN + (size_t)2 * INW * DM * 2);
constexpr size_t WS_WR = al256(WS_WOUT + (size_t)2 * DM * DM * 2);
constexpr size_t WS_WIMG = al256(WS_WR + (size_t)2 * 256 * DM * 2);
constexpr size_t WS_XA = al256(WS_WIMG + (size_t)2 * 257 * 48 * 32768);
constexpr size_t WS_XB = al256(WS_XA + (size_t)MROWS * DM * 4);
constexpr size_t WS_V1 = al256(WS_XB + (size_t)MROWS * DM * 4);
constexpr size_t WS_H = al256(WS_V1 + (size_t)MROWS * DM * 4);
constexpr size_t WS_TOK = al256(WS_H + (size_t)MROWS * DM * 2);
constexpr size_t WS_P = al256(WS_TOK + (size_t)MROWS * DM * 2);
constexpr size_t WS_VT = al256(WS_P + (size_t)MROWS * INW * 2);
constexpr size_t WS_RKT = al256(WS_VT + (size_t)NB * 4 * 128 * NT * 2);
constexpr size_t WS_RVT = al256(WS_RKT + (size_t)NB * 4 * 64 * NT * 2);
constexpr size_t WS_MIX = al256(WS_RVT + (size_t)NB * 4 * 64 * NT * 2);
constexpr size_t ST_BYTES = (size_t)NB * 4 * NCHUNK * 4096 * 4;
constexpr size_t WS_UF = al256(WS_MIX + (size_t)MROWS * DM * 2);
constexpr size_t WS_UB = al256(WS_UF + ST_BYTES);
constexpr size_t WS_SF = al256(WS_UB + ST_BYTES);
constexpr size_t WS_SB = al256(WS_SF + ST_BYTES);
constexpr size_t WS_LOGIT = al256(WS_SB + ST_BYTES);
constexpr size_t WS_EIDX = al256(WS_LOGIT + (size_t)MROWS * 256 * 4);
constexpr size_t WS_GATE = al256(WS_EIDX + (size_t)NASG * 4);
constexpr size_t WS_SORT = al256(WS_GATE + (size_t)NASG * 4);
constexpr size_t WS_RANK = al256(WS_SORT + (size_t)NASG * 4);
constexpr size_t WS_HIST = al256(WS_RANK + (size_t)NASG * 4);
constexpr size_t WS_CONVDONE = al256(WS_HIST + (size_t)1024 * 256 * 4);
constexpr size_t WS_TILES = al256(WS_CONVDONE + 2 * 1024 * 4);
constexpr size_t WS_YSLOT = al256(WS_TILES + 2048 * 16);
constexpr size_t WS_YSH = al256(WS_YSLOT + (size_t)NASG * DM * 2);
constexpr size_t WS_END = al256(WS_YSH + (size_t)MROWS * DM * 2);

struct Params {
    const float *x, *c, *ctx, *c_ctx, *w_mod, *b_mod, *w_in, *w_out, *diff_lambda, *pool_w, *pool_scale, *ret_log_decay, *ln_g, *ln_b,
        *w_router, *router_bias, *w_egu, *w_edn, *w_sgu, *w_sdn;
    float* out;
    unsigned char* ws;
    int ph_lo, ph_hi;
};


DI Params launder(const Params& a) {
    size_t z = 0; asm volatile("" : "+s"(z));
    Params r = a;
#define LND(f) r.f = (decltype(r.f))((const unsigned char*)a.f + z)
    LND(x); LND(c); LND(ctx); LND(c_ctx); LND(w_mod); LND(b_mod); LND(w_in); LND(w_out); LND(diff_lambda); LND(pool_w); LND(pool_scale); LND(ret_log_decay); LND(ln_g); LND(ln_b);
    LND(w_router); LND(router_bias); LND(w_egu); LND(w_edn); LND(w_sgu); LND(w_sdn);
#undef LND
    r.out = (float*)((unsigned char*)a.out + z); r.ws = a.ws + z;
    return r;
}
DI int launder_s(int v) { asm volatile("" : "+s"(v)); return v; }
DI int tid_() { int t = threadIdx.x; asm volatile("" : "+v"(t)); return t; }
DI int bid_() { int t = blockIdx.x; asm volatile("" : "+s"(t)); return t; }


#ifndef PROBE_ID
#define PROBE_ID 0
#endif
#ifndef PROBE_GAIN
#define PROBE_GAIN 8
#endif
#define PRB_WORDS(lds) ((volatile LAS unsigned long long*)((lds) + LDS_BYTES - 64))
#define PRB_MATCH(id) (PROBE_ID == (id) || (PROBE_ID == 999 && (id) >= 200) || (PROBE_ID == 998 && ((id) == 101 || (id) == 102 || (id) == 104 || (id) == 105 || (id) == 108 || (id) == 109 || (id) == 110 || (id) == 111)))
#define PRB_T0(id, lds) do { if (PRB_MATCH(id) && threadIdx.x == 0 && blockIdx.x == 0) { PRB_WORDS(lds)[0] = __builtin_readcyclecounter(); } } while (0)
#define PRB_T1(id, lds) do { if (PRB_MATCH(id) && threadIdx.x == 0 && blockIdx.x == 0) { PRB_WORDS(lds)[1] += __builtin_readcyclecounter() - PRB_WORDS(lds)[0]; } } while (0)

#define XB_TMO      128
#define XB_XCNT(j)  (256  + 64 * (j))
#define XB_XSUB(j)  (1280 + 64 * (j))
#define XB_XGEN(j)  (2304 + 64 * (j))
#define XB_TOP      3328
#define XB_TOPGEN   3392
#define XCD_BAR_WORDS 3456
#define XB_SPIN_CAP (1u << 20)

__device__ __forceinline__ unsigned xb_ld(unsigned* p)              { return __hip_atomic_load(p, __ATOMIC_RELAXED, __HIP_MEMORY_SCOPE_AGENT); }
__device__ __forceinline__ unsigned xb_add(unsigned* p, unsigned v) { return __hip_atomic_fetch_add(p, v, __ATOMIC_RELAXED, __HIP_MEMORY_SCOPE_AGENT); }
__device__ __forceinline__ unsigned xb_xcc_id() { return (unsigned)__builtin_amdgcn_s_getreg((3 << 11) | 20) & 0xFu; }
#define XB_SPIN(cond, bar) do { unsigned _sp = 0; while (cond) { __builtin_amdgcn_s_sleep(1); \
    if ((++_sp & 255u) == 0u) { if (xb_ld(&(bar)[XB_TMO])) break; if (_sp > XB_SPIN_CAP) { atomicAdd(&(bar)[XB_TMO], 1u); break; } } } } while (0)

struct XcdBarrier { unsigned* bar; unsigned x; volatile LAS unsigned* st; };

__device__ __forceinline__ XcdBarrier xcd_barrier_post(unsigned* bar, volatile LAS unsigned* st) {
    XcdBarrier b; b.bar = bar; b.x = xb_xcc_id(); b.st = st;
    if (threadIdx.x == 0) (void)xb_add(&bar[XB_XCNT(b.x)], 1u);
    return b;
}
__device__ __forceinline__ void xcd_barrier_complete(unsigned* bar, unsigned x, unsigned& nloc, unsigned& nx) {
    const unsigned G = gridDim.x * gridDim.y * gridDim.z;
    unsigned sum, cnt, mine, sp = 0u;
    for (;;) {
        sum = 0u; cnt = 0u; mine = 0u;
#pragma unroll
        for (unsigned j = 0; j < 16; ++j) { const unsigned c = xb_ld(&bar[XB_XCNT(j)]); sum += c; cnt += (c > 0u) ? 1u : 0u; mine = (j == x) ? c : mine; }
        if (sum == G) break;
        __builtin_amdgcn_s_sleep(1);
        if ((++sp & 255u) == 0u) { if (xb_ld(&bar[XB_TMO])) break; if (sp > XB_SPIN_CAP) { atomicAdd(&bar[XB_TMO], 1u); break; } }
    }
    nloc = mine > 0u ? mine : 1u; nx = cnt > 0u ? cnt : 1u;
}
__device__ __forceinline__ void xcd_barrier(const XcdBarrier& b) {
    asm volatile("s_waitcnt vmcnt(0)" ::: "memory");
    __syncthreads();
    if (threadIdx.x == 0) {
        unsigned* bar = b.bar;
        __builtin_amdgcn_s_waitcnt(0);
        unsigned nloc = b.st[0], nx = b.st[1];
        if (nloc == 0u) { xcd_barrier_complete(bar, b.x, nloc, nx); b.st[0] = nloc; b.st[1] = nx; }
        const unsigned old = xb_add(&bar[XB_XSUB(b.x)], 1u);
        const unsigned gen = old / nloc;
        if (old + 1u == (gen + 1u) * nloc) {
            __builtin_amdgcn_fence(__ATOMIC_RELEASE, "agent");
            asm volatile("s_waitcnt vmcnt(0)" ::: "memory");
            const unsigned og = xb_add(&bar[XB_TOP], 1u);
            const unsigned tg = og / nx;
            if (og + 1u == (tg + 1u) * nx) xb_add(&bar[XB_TOPGEN], 1u);
            else XB_SPIN(xb_ld(&bar[XB_TOPGEN]) == tg, bar);
            __builtin_amdgcn_fence(__ATOMIC_ACQUIRE, "agent");
            xb_add(&bar[XB_XGEN(b.x)], 1u);
            asm volatile("s_waitcnt vmcnt(0)" ::: "memory");
        } else {
            XB_SPIN(xb_ld(&bar[XB_XGEN(b.x)]) == gen, bar);
            __builtin_amdgcn_fence(__ATOMIC_ACQUIRE, "agent");
            asm volatile("s_waitcnt vmcnt(0)" ::: "memory");
        }
    }
    __syncthreads();
}

DI unsigned pk_bf16(float a, float b) { f32x2 v = {a, b}; bf16v2 r = __builtin_convertvector(v, bf16v2); return __builtin_bit_cast(unsigned, r); }
DI bf16_t to_bf16(float a) { return (bf16_t)(pk_bf16(a, 0.f) & 0xffffu); }
DI float bf_lo(unsigned u) { return __uint_as_float(u << 16); }
DI float bf_hi(unsigned u) { return __uint_as_float(u & 0xffff0000u); }
DI float bf2f(bf16_t h) { return __uint_as_float(((unsigned)h) << 16); }
DI float wave_sum(float v) {
#pragma unroll
    for (int o = 32; o; o >>= 1) v += __shfl_xor(v, o);
    return v;
}
DI float fast_exp2(float x) { return __builtin_amdgcn_exp2f(x); }
DI float silu_f(float x) { return x / (1.f + __expf(-x)); }
DI bf16x8 as_bf16x8(u32x4 v) { return __builtin_bit_cast(bf16x8, v); }
#define WAIT_VM(n) asm volatile("s_waitcnt vmcnt(" #n ")" ::: "memory")
DI void dma16(const void* g, LAS unsigned char* l) { __builtin_amdgcn_global_load_lds(g, (LAS void*)l, 16, 0, 0); }
#define MFMA32(a, b, c) __builtin_amdgcn_mfma_f32_32x32x16_bf16((a), (b), (c), 0, 0, 0)
#define MFMA16(a, b, c) __builtin_amdgcn_mfma_f32_16x16x32_bf16((a), (b), (c), 0, 0, 0)

DI int row_sel(int r) { const int b = r >= NT; const int p = r - b * NT; return p < NCTX ? 2 : b; }

DI int swz_off(int row, int chunk) { return row * 128 + ((chunk ^ ((row >> 1) & 7)) << 4); }

DI int perm_gu(int n) { const int f = n >> 8, jj = n & 255; return ((jj >> 4) << 5) + (f << 4) + (jj & 15); }
DI void conv_unit(const float* src, int N, int K, bf16_t* dst, int k0, int n0, bool perm, LAS unsigned char* lds) {
    LAS float* tl = (LAS float*)lds;
    const int tid = tid_();
#pragma unroll
    for (int i = 0; i < 8; ++i) {
        const int kk = (tid >> 6) + 8 * i, nn = (tid & 63) * 4;
        const f32x4 v = *(const f32x4*)(src + (size_t)(k0 + kk) * N + n0 + nn);
        tl[kk * 257 + nn] = v[0]; tl[kk * 257 + nn + 1] = v[1]; tl[kk * 257 + nn + 2] = v[2]; tl[kk * 257 + nn + 3] = v[3];
    }
    __syncthreads();
    const int n = tid >> 1, kh = (tid & 1) * 32;
    const int nd = perm ? perm_gu(n0 + n) : (n0 + n);
    bf16_t* d = dst + (size_t)nd * K + k0 + kh;
#pragma unroll
    for (int q = 0; q < 4; ++q) {
        u32x4 w;
#pragma unroll
        for (int j = 0; j < 4; ++j) w[j] = pk_bf16(tl[(kh + q * 8 + 2 * j) * 257 + n], tl[(kh + q * 8 + 2 * j + 1) * 257 + n]);
        *(u32x4*)(d + q * 8) = w;
    }
    __syncthreads();
}

DI void phase_convert(const Params& p0, LAS unsigned char* lds) {
    const Params p = launder(p0);
    constexpr int U_IN = 176, U_OUT = 64, U_R = 16;
    constexpr int U_L = U_IN + U_OUT + U_R;
    for (int u = bid_(); u < 2 * U_L; u += gridDim.x) {
        const int l = u / U_L; int v = u % U_L;
        if (v < U_IN) { conv_unit(p.w_in + (size_t)l * DM * INW, INW, DM, (bf16_t*)(p.ws + WS_WIN) + (size_t)l * INW * DM, (v / 11) * 64, (v % 11) * 256, false, lds); continue; }
        v -= U_IN;
        if (v < U_OUT) { conv_unit(p.w_out + (size_t)l * DM * DM, DM, DM, (bf16_t*)(p.ws + WS_WOUT) + (size_t)l * DM * DM, (v / 4) * 64, (v % 4) * 256, false, lds); continue; }
        v -= U_OUT;
        conv_unit(p.w_router + (size_t)l * DM * 256, 256, DM, (bf16_t*)(p.ws + WS_WR) + (size_t)l * 256 * DM, v * 64, 0, false, lds);
    }
}

DI void phase_mod(const Params& p0, LAS unsigned char* lds) {
    const Params p = launder(p0);
    LAS float* sc = (LAS float*)lds;
    LAS float* red = sc + 3 * 1024;
    const int tid = tid_();
    float* modv = (float*)(p.ws + WS_MODV);
    for (int u = bid_(); u < 193; u += gridDim.x) {
        if (u == 192) {
            float* rope = (float*)(p.ws + WS_ROPE);
            for (int i = tid; i < 128 * 16; i += NTHREADS) {
                const int pos = i >> 4, f = i & 15;
                const float freq = powf(10000.0f, -(float)f / 16.0f);
                const float ang = (float)pos * freq;
                rope[2 * i] = cosf(ang); rope[2 * i + 1] = sinf(ang);
            }
            float* scal = (float*)(p.ws + WS_SCAL);
            if (tid < 2) {
                const int l = tid;
                const float* dl = p.diff_lambda + l * 256;
                float s01 = 0.f, s23 = 0.f;
                for (int i = 0; i < 64; ++i) { s01 += dl[i] * dl[64 + i]; s23 += dl[128 + i] * dl[192 + i]; }
                const float lambda_init = 0.8f - 0.6f * expf(-0.3f * (float)l);
                scal[l * 16 + 0] = expf(s01) - expf(s23) + lambda_init;
                scal[l * 16 + 1] = 1.0f - lambda_init;
                for (int h = 0; h < 4; ++h) {
                    scal[l * 16 + 2 + h] = -expf(p.ret_log_decay[l * 8 + h]) * LOG2E;
                    scal[l * 16 + 6 + h] = -expf(p.ret_log_decay[l * 8 + 4 + h]) * LOG2E;
                }
            }
            continue;
        }
        const int l = u / 96, n0 = (u % 96) * 64;
        for (int i = tid; i < 3 * 1024; i += NTHREADS) {
            const int s = i >> 10, k = i & 1023;
            const float v = s < 2 ? p.c[s * 1024 + k] : p.c_ctx[k];
            sc[i] = silu_f(v);
        }
        __syncthreads();
        const int kq = tid >> 6, nl = tid & 63;
        const float* w = p.w_mod + (size_t)l * DM * 6144 + n0 + nl;
        float a0 = 0.f, a1 = 0.f, a2 = 0.f;
        for (int k = kq * 128; k < kq * 128 + 128; ++k) {
            const float wv = w[(size_t)k * 6144];
            a0 += sc[k] * wv; a1 += sc[1024 + k] * wv; a2 += sc[2048 + k] * wv;
        }
        red[(kq * 3 + 0) * 64 + nl] = a0; red[(kq * 3 + 1) * 64 + nl] = a1; red[(kq * 3 + 2) * 64 + nl] = a2;
        __syncthreads();
        if (tid < 192) {
            const int s = tid >> 6, n = tid & 63;
            float v = 0.f;
            for (int q = 0; q < 8; ++q) v += red[(q * 3 + s) * 64 + n];
            modv[((size_t)l * 3 + s) * 6144 + n0 + n] = v + p.b_mod[l * 6144 + n0 + n];
        }
        __syncthreads();
    }
}

DI void ln_stats(const f32x4 (&v)[4], float& mu, float& rstd) {
    float s = 0.f;
#pragma unroll
    for (int i = 0; i < 4; ++i) s += (v[i][0] + v[i][1]) + (v[i][2] + v[i][3]);
    mu = wave_sum(s) * (1.0f / 1024.0f);
    float q = 0.f;
#pragma unroll
    for (int i = 0; i < 4; ++i)
#pragma unroll
        for (int j = 0; j < 4; ++j) { const float d = v[i][j] - mu; q += d * d; }
    rstd = rsqrtf(wave_sum(q) * (1.0f / 1024.0f) + LN_EPS);
}
DI void modulate_store(const f32x4 (&v)[4], const float* shift, const float* scale, bf16_t* dst, int lane) {
    float mu, rstd; ln_stats(v, mu, rstd);
#pragma unroll
    for (int i = 0; i < 4; ++i) {
        const int c = lane * 4 + i * 256;
        const f32x4 sh = *(const f32x4*)(shift + c), scv = *(const f32x4*)(scale + c);
        float o[4];
#pragma unroll
        for (int j = 0; j < 4; ++j) o[j] = (v[i][j] - mu) * rstd * (1.0f + scv[j]) + sh[j];
        u32x2 w = {pk_bf16(o[0], o[1]), pk_bf16(o[2], o[3])};
        *(u32x2*)(dst + c) = w;
    }
}

DI void phase_ln0(const Params& p0) {
    const Params p = launder(p0);
    const int lane = tid_() & 63, wid = tid_() >> 6;
    float* XA = (float*)(p.ws + WS_XA);
    bf16_t* H = (bf16_t*)(p.ws + WS_H);
    const float* modv = (const float*)(p.ws + WS_MODV);
    for (int r = bid_() * 8 + wid; r < MROWS; r += gridDim.x * 8) {
        const int b = r >= NT, pp = r - b * NT;
        const float* src = pp < NCTX ? p.ctx + ((size_t)b * NCTX + pp) * DM : p.x + ((size_t)b * NLAT + (pp - NCTX)) * DM;
        f32x4 v[4];
#pragma unroll
        for (int i = 0; i < 4; ++i) { v[i] = *(const f32x4*)(src + lane * 4 + i * 256); *(f32x4*)(XA + (size_t)r * DM + lane * 4 + i * 256) = v[i]; }
        const float* mv = modv + (size_t)(0 * 3 + (pp < NCTX ? 2 : b)) * 6144;
        modulate_store(v, mv, mv + 1024, H + (size_t)r * DM, lane);
    }
}

constexpr int G2_STG = 40960;
template <class Epi>
DI void gemm192(const bf16_t* A, int lda, const bf16_t* Bt, int ldb, int nk, int m0, int n0, LAS unsigned char* lds, const Epi& epi) {
    const int t = tid_(), lane = t & 63, wid = __builtin_amdgcn_readfirstlane(t >> 6), fr = lane & 15, fq = lane >> 4, wm = wid >> 1, wn = wid & 1;
    const bf16_t* asrc[3]; const bf16_t* bsrc[2];
#pragma unroll
    for (int i = 0; i < 3; ++i) { const int sl = t + 512 * i, row = sl >> 3, c = (sl & 7) ^ ((row >> 1) & 7); asrc[i] = A + (size_t)(m0 + row) * lda + c * 8; }
#pragma unroll
    for (int i = 0; i < 2; ++i) { const int sl = t + 512 * i, row = sl >> 3, c = (sl & 7) ^ ((row >> 1) & 7); bsrc[i] = Bt + (size_t)(n0 + row) * ldb + c * 8; }
    const int ddst = wid * 1024;
#define G2_ISSUE(S, KT) do { LAS unsigned char* _s = lds + (S) * G2_STG + ddst; const int _k = (KT) * 64; \
        dma16(asrc[0] + _k, _s); dma16(asrc[1] + _k, _s + 8192); dma16(asrc[2] + _k, _s + 16384); dma16(bsrc[0] + _k, _s + 24576); dma16(bsrc[1] + _k, _s + 32768); } while (0)
    f32x4 acc[4][3];
#pragma unroll
    for (int nf = 0; nf < 4; ++nf)
#pragma unroll
        for (int mf = 0; mf < 3; ++mf) acc[nf][mf] = (f32x4){0.f, 0.f, 0.f, 0.f};
    __syncthreads();
    G2_ISSUE(0, 0);
    if (nk > 1) G2_ISSUE(1, 1);
    int st = 0;
    for (int kt = 0; kt < nk; ++kt) {
        if (kt + 1 < nk) WAIT_VM(5); else WAIT_VM(0);
        asm volatile("s_waitcnt lgkmcnt(0)" ::: "memory");
        __builtin_amdgcn_s_barrier();
        const int st2 = st == 0 ? 2 : st - 1;
        if (kt + 2 < nk) G2_ISSUE(st2, kt + 2);
        LAS unsigned char* S = lds + st * G2_STG;
        st = st == 2 ? 0 : st + 1;
#pragma unroll
        for (int kk = 0; kk < 2; ++kk) {
            bf16x8 af[3], bfr[4];
#pragma unroll
            for (int mf = 0; mf < 3; ++mf) af[mf] = *(LAS bf16x8*)(S + swz_off(wm * 48 + mf * 16 + fr, kk * 4 + fq));
#pragma unroll
            for (int nf = 0; nf < 4; ++nf) bfr[nf] = *(LAS bf16x8*)(S + 24576 + swz_off(wn * 64 + nf * 16 + fr, kk * 4 + fq));
#pragma unroll
            for (int nf = 0; nf < 4; ++nf)
#pragma unroll
                for (int mf = 0; mf < 3; ++mf) acc[nf][mf] = MFMA16(bfr[nf], af[mf], acc[nf][mf]);
        }
    }
#undef G2_ISSUE
    __syncthreads();
    epi(acc, wm, wn, fr, fq, lane, wid);
}
DI LAS unsigned char* g2_stage(LAS unsigned char* lds, int wid) { return lds + wid * 13056; }

DI void phase_inproj(const Params& p0, int l, LAS unsigned char* lds) {
    const Params p = launder(p0); l = launder_s(l);
    const bf16_t* H = (const bf16_t*)(p.ws + WS_H);
    const bf16_t* W = (const bf16_t*)(p.ws + WS_WIN) + (size_t)l * INW * DM;
    bf16_t* P = (bf16_t*)(p.ws + WS_P);
    bf16_t* VT = (bf16_t*)(p.ws + WS_VT);
    bf16_t* RKT = (bf16_t*)(p.ws + WS_RKT);
    bf16_t* RVT = (bf16_t*)(p.ws + WS_RVT);
    const f32x2* rope = (const f32x2*)(p.ws + WS_ROPE);
    constexpr int NTN = INW / 128, NTM = MROWS / 192;
    for (int u = bid_(); u < NTM * NTN; u += gridDim.x) {
        const int tm = u / NTN, tn = u % NTN;
        auto epi = [&](f32x4 (&acc)[4][3], int wm, int wn, int fr, int fq, int lane, int wid) {
            const int c0 = tn * 128 + wn * 64;
            const int r0 = tm * 192 + wm * 48;
            LAS unsigned char* W_ = g2_stage(lds, wid);
            if (c0 < C_DV) {
                const float qs = c0 < C_DK ? QSCALE : 1.0f;
#pragma unroll
                for (int mf = 0; mf < 3; ++mf) {
                    const int row = r0 + mf * 16 + fr;
                    const int b = row >= NT, pp = row - b * NT;
                    const bool lat = pp >= NCTX;
                    const int tt = pp - NCTX;
#pragma unroll
                    for (int hb = 0; hb < 2; ++hb) {
                        const int axis = ((c0 >> 5) + hb) & 1;
                        const int pos = axis ? (tt & 63) : (tt >> 6);
#pragma unroll
                        for (int j = 0; j < 4; ++j) {
                            float x1 = acc[2 * hb][mf][j], x2 = acc[2 * hb + 1][mf][j];
                            if (lat) { const f32x2 cs = rope[pos * 16 + 4 * fq + j]; const float o1 = x1 * cs[0] - x2 * cs[1], o2 = x1 * cs[1] + x2 * cs[0]; x1 = o1; x2 = o2; }
                            acc[2 * hb][mf][j] = x1 * qs; acc[2 * hb + 1][mf][j] = x2 * qs;
                        }
                    }
                }
            } else if (c0 >= C_RK && c0 < C_RV) {
#pragma unroll
                for (int nf = 0; nf < 4; ++nf)
#pragma unroll
                    for (int mf = 0; mf < 3; ++mf) acc[nf][mf] *= 0.125f;
            }
#pragma unroll
            for (int nf = 0; nf < 4; ++nf)
#pragma unroll
                for (int mf = 0; mf < 3; ++mf) {
                    const f32x4 v = acc[nf][mf];
                    *(LAS u32x2*)(W_ + (mf * 16 + fr) * 144 + nf * 32 + fq * 8) = (u32x2){pk_bf16(v[0], v[1]), pk_bf16(v[2], v[3])};
                }
#pragma unroll
            for (int it = 0; it < 6; ++it) {
                const int row = it * 8 + (lane >> 3), ch = lane & 7;
                *(u32x4*)(P + (size_t)(r0 + row) * INW + c0 + ch * 8) = *(LAS u32x4*)(W_ + row * 144 + ch * 16);
            }
            const bool isv = c0 >= C_DV && c0 < C_PU, isk = c0 >= C_RK && c0 < C_RV, isr = c0 >= C_RV && c0 < C_RG;
            if (isv || isk || isr) {
                const int frp = isv ? ((fr & 3) | (((fr >> 2) == 1 ? 2 : ((fr >> 2) == 2 ? 1 : (fr >> 2))) << 2)) : fr;
                LAS bf16_t* T_ = (LAS bf16_t*)W_;
#pragma unroll
                for (int nf = 0; nf < 4; ++nf)
#pragma unroll
                    for (int mf = 0; mf < 3; ++mf)
#pragma unroll
                        for (int j = 0; j < 4; ++j) T_[(nf * 16 + 4 * fq + j) * 56 + mf * 16 + frp] = to_bf16(acc[nf][mf][j]);
                const int b = r0 >= NT, pp0 = r0 - b * NT;
                bf16_t* base; int nrows_per_head;
                if (isv) { const int cc = c0 - C_DV; base = VT + ((size_t)(b * 4 + (cc >> 7)) * 128 + (cc & 127)) * NT + pp0; }
                else if (isk) { const int cc = c0 - C_RK; base = RKT + ((size_t)(b * 4 + (cc >> 6)) * 64) * NT + pp0; }
                else { const int cc = c0 - C_RV; base = RVT + ((size_t)(b * 4 + (cc >> 6)) * 64) * NT + pp0; }
                (void)nrows_per_head;
#pragma unroll
                for (int it = 0; it < 6; ++it) {
                    const int sl = it * 64 + lane, n = sl / 6, pc = sl % 6;
                    *(u32x4*)(base + (size_t)n * NT + pc * 8) = *(LAS u32x4*)(W_ + n * 112 + pc * 16);
                }
            }
        };
        gemm192(H, DM, W, DM, DM / 64, tm * 192, tn * 128, lds, epi);
    }
}

DI void phase_ret_sum_pool(const Params& p0, int l, LAS unsigned char* lds) {
    const Params p = launder(p0); l = launder_s(l);
    const int tid = tid_(), lane = tid & 63, wid = tid >> 6, fr = lane & 15, g = lane >> 4;
    const float* scal = (const float*)(p.ws + WS_SCAL) + l * 16;
    const bf16_t* RKT = (const bf16_t*)(p.ws + WS_RKT);
    const bf16_t* RVT = (const bf16_t*)(p.ws + WS_RVT);
    float* UF = (float*)(p.ws + WS_UF);
    float* UB = (float*)(p.ws + WS_UB);
    for (int u = bid_(); u < NB * 4 * NCHUNK; u += gridDim.x) {
        const int c = u % NCHUNK, bh = u / NCHUNK, h = bh & 3;
        const int dir = wid >> 2, eb = wid & 3;
        const float l2 = dir ? scal[6 + h] : scal[2 + h];
        const bf16_t* vrow = RVT + ((size_t)bh * 64 + eb * 16 + fr) * NT + c * 128;
        f32x4 acc[4];
#pragma unroll
        for (int db = 0; db < 4; ++db) acc[db] = (f32x4){0.f, 0.f, 0.f, 0.f};
#pragma unroll
        for (int ks = 0; ks < 4; ++ks) {
            const int j0 = ks * 32 + 8 * g;
            const bf16x8 af = *(const bf16x8*)(vrow + j0);
            float w[8];
#pragma unroll
            for (int jj = 0; jj < 8; ++jj) { const int j = j0 + jj; w[jj] = fast_exp2((dir ? (float)j : (float)(127 - j)) * l2); }
#pragma unroll
            for (int db = 0; db < 4; ++db) {
                const u32x4 kr = *(const u32x4*)(RKT + ((size_t)bh * 64 + db * 16 + fr) * NT + c * 128 + j0);
                u32x4 kw;
#pragma unroll
                for (int q = 0; q < 4; ++q) kw[q] = pk_bf16(bf_lo(kr[q]) * w[2 * q], bf_hi(kr[q]) * w[2 * q + 1]);
                acc[db] = MFMA16(af, as_bf16x8(kw), acc[db]);
            }
        }
        const int cidx = dir ? (c >= 2 ? c - 2 : 64 + c) : c;
        float* U = (dir ? UB : UF) + ((size_t)bh * NCHUNK + cidx) * 4096;
#pragma unroll
        for (int db = 0; db < 4; ++db)
#pragma unroll
            for (int j = 0; j < 4; ++j) U[(eb * 16 + 4 * g + j) * 64 + db * 16 + fr] = acc[db][j];
    }
    LAS float* ul = (LAS float*)lds;
    LAS float* dT = ul + 48 * 256;
    LAS float* pwl = dT + 256 * 36;
    const bf16_t* P = (const bf16_t*)(p.ws + WS_P);
    bf16_t* MIX = (bf16_t*)(p.ws + WS_MIX);
    const float* pw = p.pool_w + (size_t)l * 4 * 64 * 64;
    const float* ps = p.pool_scale + l * 256;
    __syncthreads();
    if (bid_() < MROWS / 32) {
#pragma unroll
        for (int i = 0; i < 8; ++i) *(LAS f32x4*)(pwl + (tid + 512 * i) * 4) = *(const f32x4*)(pw + (tid + 512 * i) * 4);
    }
    for (int u = bid_(); u < MROWS / 32; u += gridDim.x) {
        const int r0 = u * 32;
        const int b = r0 >= NT, pp0 = r0 - b * NT;
        const int s0 = pp0 < NCTX ? b * NT : b * NT + NCTX, s1 = pp0 < NCTX ? b * NT + NCTX : (b + 1) * NT;
        __syncthreads();
        {
            u32x2 wv[6]; bool ok[6];
#pragma unroll
            for (int it = 0; it < 6; ++it) {
                const int i = tid + 512 * it, rr = i >> 6, c4 = (i & 63) * 4, row = r0 - 8 + rr;
                ok[it] = row >= s0 && row < s1;
                wv[it] = ok[it] ? *(const u32x2*)(P + (size_t)row * INW + C_PU + c4) : (u32x2){0u, 0u};
            }
#pragma unroll
            for (int it = 0; it < 6; ++it) {
                const int i = tid + 512 * it, rr = i >> 6, c4 = (i & 63) * 4;
                *(LAS f32x4*)(ul + rr * 256 + c4) = (f32x4){bf_lo(wv[it][0]), bf_hi(wv[it][0]), bf_lo(wv[it][1]), bf_hi(wv[it][1])};
            }
        }
        __syncthreads();
        {
            const int c = tid & 255, gi = c >> 6, rb = tid >> 8;
#define POOL_WIN(HW) do { _Pragma("unroll") for (int it = 0; it < 16; ++it) { const int rr = it * 2 + rb, row = r0 + rr; float sm = 0.f; \
                _Pragma("unroll") for (int q = -(HW); q < (HW); ++q) sm += ul[(rr + 8 + q) * 256 + c]; \
                const int lo = (row - (HW)) < s0 ? s0 : (row - (HW)), hi = (row + (HW)) > s1 ? s1 : (row + (HW)); \
                dT[c * 36 + rr] = sm / (float)(hi - lo) - ul[(rr + 8) * 256 + c]; } } while (0)
            if (gi == 0) POOL_WIN(1); else if (gi == 1) POOL_WIN(2); else if (gi == 2) POOL_WIN(4); else POOL_WIN(8);
#undef POOL_WIN
        }
        __syncthreads();
        {
            const int oc = tid & 255, rh = (tid >> 8) * 16, gi = oc >> 6, e = oc & 63;
            float acc[16];
#pragma unroll
            for (int i = 0; i < 16; ++i) acc[i] = 0.f;
#pragma unroll 8
            for (int c = 0; c < 64; ++c) {
                const float wv = pwl[(gi * 64 + c) * 64 + e];
                const LAS float* dr = dT + (gi * 64 + c) * 36 + rh;
#pragma unroll
                for (int i = 0; i < 4; ++i) { const f32x4 d = *(const LAS f32x4*)(dr + 4 * i); acc[4 * i] += d[0] * wv; acc[4 * i + 1] += d[1] * wv; acc[4 * i + 2] += d[2] * wv; acc[4 * i + 3] += d[3] * wv; }
            }
            const float sc = ps[oc];
#pragma unroll
            for (int i = 0; i < 16; ++i) MIX[(size_t)(r0 + rh + i) * DM + 512 + oc] = to_bf16(acc[i] * sc);
        }
    }
    __syncthreads();
}

DI void phase_ret_scan(const Params& p0, int l) {
    const Params p = launder(p0); l = launder_s(l);
    const float* scal = (const float*)(p.ws + WS_SCAL) + l * 16;
    const float* UF = (const float*)(p.ws + WS_UF); const float* UB = (const float*)(p.ws + WS_UB);
    bf16_t* SF = (bf16_t*)(p.ws + WS_SF); bf16_t* SB = (bf16_t*)(p.ws + WS_SB);
    for (int i = bid_() * NTHREADS + tid_(); i < 2 * NB * 4 * 4096; i += gridDim.x * NTHREADS) {
        const int dir = i / (NB * 4 * 4096), rem = i % (NB * 4 * 4096), bh = rem >> 12, el = rem & 4095, h = bh & 3;
        const float G = fast_exp2(128.0f * (dir ? scal[6 + h] : scal[2 + h]));
        float S = 0.f;
        if (dir == 0) {
#pragma unroll 11
            for (int c = 0; c < NCHUNK; ++c) { const size_t o = ((size_t)bh * NCHUNK + c) * 4096 + el; SF[o] = to_bf16(S); S = S * G + UF[o]; } }
        else {
#pragma unroll 11
            for (int c = NCHUNK - 1; c >= 0; --c) { const size_t o = ((size_t)bh * NCHUNK + c) * 4096 + el; SB[o] = to_bf16(S); S = S * G + UB[o]; } }
    }
}

DI void attn_unit(const Params& p, int l, int b, int h, int q_p0, int ntile, float lam, float oscale, int& conv_done, LAS unsigned char* lds) {
    const int tid = tid_(), lane = tid & 63, wid = __builtin_amdgcn_readfirstlane(tid >> 6), map = wid >> 2, wq = wid & 3, r = lane & 31, hh = lane >> 5;
    const bf16_t* P = (const bf16_t*)(p.ws + WS_P);
    const bf16_t* VT = (const bf16_t*)(p.ws + WS_VT);
    bf16_t* MIX = (bf16_t*)(p.ws + WS_MIX);
    const size_t rowbase = (size_t)b * NT;
    const int qrow = q_p0 + wq * 32 + r;
    bf16x8 qf[4];
#pragma unroll
    for (int ks = 0; ks < 4; ++ks) qf[ks] = *(const bf16x8*)(P + (rowbase + qrow) * INW + C_DQ + h * 128 + map * 64 + ks * 16 + hh * 8);
    constexpr int ASTG = 32768, CRING = 98304, CSLOT = 16384;
    const int t8 = tid & 255, w4 = wid & 3;
    const bf16_t* ksrc; const bf16_t* vsrc;
    { const int key = t8 >> 4, ph = t8 & 15, c = ph ^ (key & 15);
      ksrc = P + (rowbase + key) * INW + C_DK + h * 128 + c * 8;
      const int e = t8 >> 3, pv = t8 & 7, cv = pv ^ ((e >> 1) & 7);
      vsrc = VT + ((size_t)(b * 4 + h) * 128 + e) * NT + cv * 8; }
    const int ddst = w4 * 1024;
#define ATT_ISSUE(S, KT) do { LAS unsigned char* _s = lds + (S) * ASTG + ddst; const bf16_t* _k = ksrc + (size_t)(KT) * 64 * INW; const bf16_t* _v = vsrc + (KT) * 64; \
        _Pragma("unroll") for (int m = 0; m < 4; ++m) { dma16(_k + (size_t)m * 16 * INW, _s + m * 4096); dma16(_v + (size_t)m * 32 * NT, _s + 16384 + m * 4096); } } while (0)
    constexpr int NSLICE = (NEXP + 1) * IMG_PER_E * 4;
    const int G_ = gridDim.x, bidc = bid_();
    const int mine = (NSLICE - bidc + G_ - 1) / G_;
    const int lim = __builtin_amdgcn_readfirstlane((mine - conv_done) < (ntile - 2) ? ((mine - conv_done) < 0 ? 0 : (mine - conv_done)) : (ntile - 2));
    const int cbase = conv_done;
    conv_done += lim;
    unsigned char* IMGL = p.ws + WS_WIMG + (size_t)l * (NEXP + 1) * IMG_PER_E * IMG_BYTES;
#define CONV_SRC(SI, SRCP, LDW) do { const int _s = bidc + G_ * (cbase + (SI)); const int _u = _s >> 2, _qd = _s & 3, _e = _u / IMG_PER_E, _im = _u % IMG_PER_E; \
        const int _k = t8 >> 5, _np = 128 * _qd + 4 * (t8 & 31); \
        if (_im < 32) { const float* _W = _e < NEXP ? p.w_egu + ((size_t)l * NEXP + _e) * DM * 512 : p.w_sgu + (size_t)l * DM * 512; LDW = 512; \
            SRCP = _W + (size_t)(_im * 32 + _k) * 512 + (((_np >> 4) & 1) * 256 + (_np >> 5) * 16 + (_np & 15)); } \
        else { const float* _W = _e < NEXP ? p.w_edn + ((size_t)l * NEXP + _e) * 256 * DM : p.w_sdn + (size_t)l * 256 * DM; LDW = DM; \
            SRCP = _W + (size_t)(((_im - 32) & 7) * 32 + _k) * DM + ((_im - 32) >> 3) * 512 + _np; } } while (0)
    f32x16 o[4];
#pragma unroll
    for (int eb = 0; eb < 4; ++eb)
#pragma unroll
        for (int i = 0; i < 16; ++i) o[eb][i] = 0.f;
    f32x16 negm;
#pragma unroll
    for (int i = 0; i < 16; ++i) negm[i] = 0.f;
    float m_run = 0.f, l_run = 0.f;
#pragma unroll
    for (int ks = 0; ks < 4; ++ks) asm volatile("" : "+v"(qf[ks]));
    __syncthreads();
    if (map == 0) { ATT_ISSUE(0, 0); if (ntile > 1) ATT_ISSUE(1, 1); }
    int st = 0;
    for (int kt = 0; kt < ntile; ++kt) {
        PRB_T0(1, lds);
        const bool cproc = kt >= 2 && kt - 2 < lim;
        if (map == 0) { if (kt + 1 < ntile) WAIT_VM(8); else WAIT_VM(0); }
        else if (cproc) {
            const int n = (kt >= 4 ? 2 : 0) + (kt - 1 < lim ? 4 : 0) + (kt >= 3 ? 2 : 0);
            if (n == 8) WAIT_VM(8); else if (n == 6) WAIT_VM(6); else if (n == 4) WAIT_VM(4); else if (n == 2) WAIT_VM(2); else WAIT_VM(0);
        }
        asm volatile("s_waitcnt lgkmcnt(0)" ::: "memory");
        __builtin_amdgcn_s_barrier();
        PRB_T1(1, lds); PRB_T0(2, lds);
        const int st2 = st == 0 ? 2 : st - 1;
        if (map == 0) { if (kt + 2 < ntile) ATT_ISSUE(st2, kt + 2); }
        else if (kt < lim) {
            const float* srcp; int ldw; CONV_SRC(kt, srcp, ldw);
            LAS unsigned char* _d = lds + CRING + (kt % 3) * CSLOT + w4 * 1024;
#pragma unroll
            for (int m = 0; m < 4; ++m) dma16(srcp + (size_t)m * 8 * ldw, _d + m * 4096);
        }
        LAS unsigned char* L = lds + st * ASTG;
        st = st == 2 ? 0 : st + 1;
        bf16x8 kf[8], va[4], vb[4];
#pragma unroll
        for (int ks = 0; ks < 4; ++ks) {
            const int ch = map * 8 + ks * 2 + hh;
            const int off = r * 256 + ((ch ^ (r & 15)) << 4);
            kf[2 * ks] = *(LAS bf16x8*)(L + off);
            kf[2 * ks + 1] = *(LAS bf16x8*)(L + off + 32 * 256);
        }
#define ATT_VREAD(dst, S_) do { _Pragma("unroll") for (int eb = 0; eb < 4; ++eb) { const int e = eb * 32 + r; \
            dst[eb] = *(LAS bf16x8*)(L + 16384 + e * 128 + ((((S_) * 2 + hh) ^ ((e >> 1) & 7)) << 4)); } } while (0)
#define ATT_PACK(dst, SRC, B_) do { u32x4 _pw; _Pragma("unroll") for (int q = 0; q < 4; ++q) _pw[q] = pk_bf16(SRC[(B_) + 2 * q], SRC[(B_) + 2 * q + 1]); dst = as_bf16x8(_pw); } while (0)
#define ATT_EXP8(SRC, B_) do { _Pragma("unroll") for (int i = 0; i < 8; ++i) { SRC[(B_) + i] = fast_exp2(SRC[(B_) + i]); rsum += SRC[(B_) + i]; pmx = fmaxf(pmx, SRC[(B_) + i]); } } while (0)
        ATT_VREAD(va, 0);
        asm volatile("" ::: "memory");
        f32x16 s0 = negm, s1 = negm;
#pragma unroll
        for (int ks = 0; ks < 4; ++ks) { s0 = MFMA32(kf[2 * ks], qf[ks], s0); s1 = MFMA32(kf[2 * ks + 1], qf[ks], s1); }
        if (map == 1 && cproc) {
            const int sj = bidc + G_ * (cbase + kt - 2); const int uu = sj >> 2, qd = sj & 3;
            const LAS float* raw = (const LAS float*)(lds + CRING + ((kt - 2) % 3) * CSLOT);
            unsigned char* img = IMGL + (size_t)uu * IMG_BYTES + (size_t)(128 * qd) * 64;
#pragma unroll
            for (int hcv = 0; hcv < 2; ++hcv) {
                const int cidx = t8 + 256 * hcv, row = cidx >> 2, chunk = cidx & 3;
                float f[8];
#pragma unroll
                for (int kk = 0; kk < 8; ++kk) f[kk] = raw[(chunk * 8 + kk) * 128 + row];
                const u32x4 w = {pk_bf16(f[0], f[1]), pk_bf16(f[2], f[3]), pk_bf16(f[4], f[5]), pk_bf16(f[6], f[7])};
                const int np = 128 * qd + row;
                *(u32x4*)(img + row * 64 + ((chunk ^ ((0 - (np >> 2)) & 3)) << 4)) = w;
            }
        }
        PRB_T1(2, lds); PRB_T0(3, lds);
        if (kt == 0) {
            float mx = fmaxf(fmaxf(s0[0], s0[1]), s0[2]);
#pragma unroll
            for (int i = 3; i < 15; i += 2) mx = fmaxf(fmaxf(mx, s0[i]), s0[i + 1]);
            mx = fmaxf(mx, s0[15]);
#pragma unroll
            for (int i = 0; i < 16; i += 2) mx = fmaxf(fmaxf(mx, s1[i]), s1[i + 1]);
            mx = fmaxf(mx, __shfl_xor(mx, 32));
            m_run = mx;
#pragma unroll
            for (int i = 0; i < 16; ++i) { s0[i] -= mx; s1[i] -= mx; negm[i] = -mx; }
        }
        float rsum = 0.f, pmx = 0.f;
        bf16x8 pb;
        ATT_EXP8(s0, 0); ATT_PACK(pb, s0, 0);
        ATT_VREAD(vb, 1); asm volatile("" ::: "memory");
#pragma unroll
        for (int eb = 0; eb < 4; ++eb) o[eb] = MFMA32(va[eb], pb, o[eb]);
        ATT_EXP8(s0, 8); ATT_PACK(pb, s0, 8);
        ATT_VREAD(va, 2); asm volatile("" ::: "memory");
#pragma unroll
        for (int eb = 0; eb < 4; ++eb) o[eb] = MFMA32(vb[eb], pb, o[eb]);
        ATT_EXP8(s1, 0); ATT_PACK(pb, s1, 0);
        ATT_VREAD(vb, 3); asm volatile("" ::: "memory");
#pragma unroll
        for (int eb = 0; eb < 4; ++eb) o[eb] = MFMA32(va[eb], pb, o[eb]);
        ATT_EXP8(s1, 8); ATT_PACK(pb, s1, 8);
#pragma unroll
        for (int eb = 0; eb < 4; ++eb) o[eb] = MFMA32(vb[eb], pb, o[eb]);
        l_run += rsum;
        PRB_T1(3, lds);
#undef ATT_VREAD
#undef ATT_PACK
#undef ATT_EXP8
        pmx = fmaxf(pmx, __shfl_xor(pmx, 32));
        if (__any(pmx > 256.0f)) {
            const float d = pmx > 256.0f ? __builtin_amdgcn_logf(pmx) : 0.f;
            const float alpha = fast_exp2(-d);
            m_run += d; l_run *= alpha;
#pragma unroll
            for (int i = 0; i < 16; ++i) negm[i] = -m_run;
#pragma unroll
            for (int eb = 0; eb < 4; ++eb)
#pragma unroll
                for (int i = 0; i < 16; ++i) o[eb][i] *= alpha;
        }
    }
#undef ATT_ISSUE
#undef CONV_SRC
    __syncthreads();
    const float lt = l_run + __shfl_xor(l_run, 32);
    const float inv = 1.0f / lt;
    LAS float* X = (LAS float*)lds;
    if (map == 1) {
#pragma unroll
        for (int eb = 0; eb < 4; ++eb)
#pragma unroll
            for (int i = 0; i < 16; ++i) X[(wq * 64 + eb * 16 + i) * 64 + lane] = o[eb][i] * inv;
    }
    __syncthreads();
    if (map == 0) {
        float ss = 0.f;
#pragma unroll
        for (int eb = 0; eb < 4; ++eb)
#pragma unroll
            for (int i = 0; i < 16; ++i) { const float v = o[eb][i] * inv - lam * X[(wq * 64 + eb * 16 + i) * 64 + lane]; o[eb][i] = v; ss += v * v; }
        ss += __shfl_xor(ss, 32);
        const float sc = rsqrtf(ss * (1.0f / 128.0f) + RMS_EPS) * oscale;
        LAS unsigned char* W = lds + 65536 + wq * 8704;
#pragma unroll
        for (int eb = 0; eb < 4; ++eb)
#pragma unroll
            for (int q = 0; q < 4; ++q) {
                const int e = eb * 32 + 8 * q + 4 * hh;
                const u32x2 w = {pk_bf16(o[eb][4 * q] * sc, o[eb][4 * q + 1] * sc), pk_bf16(o[eb][4 * q + 2] * sc, o[eb][4 * q + 3] * sc)};
                *(LAS u32x2*)(W + r * 272 + e * 2) = w;
            }
#pragma unroll
        for (int it = 0; it < 8; ++it) {
            const int row = it * 4 + (lane >> 4), ch = lane & 15;
            const u32x4 v = *(LAS u32x4*)(W + row * 272 + ch * 16);
            *(u32x4*)(MIX + (rowbase + q_p0 + wq * 32 + row) * DM + h * 128 + ch * 8) = v;
        }
    }
    __syncthreads();
}

DI void ret_unit(const Params& p, int l, int b, int h, int c) {
    const int tid = tid_(), lane = tid & 63, wid = tid >> 6, fr = lane & 15, g = lane >> 4;
    const float* scal = (const float*)(p.ws + WS_SCAL) + l * 16;
    const float lf2 = scal[2 + h], lb2 = scal[6 + h];
    const bf16_t* P = (const bf16_t*)(p.ws + WS_P);
    const bf16_t* RVT = (const bf16_t*)(p.ws + WS_RVT);
    const bf16_t* SF = (const bf16_t*)(p.ws + WS_SF); const bf16_t* SB = (const bf16_t*)(p.ws + WS_SB);
    bf16_t* MIX = (bf16_t*)(p.ws + WS_MIX);
    const int bh = b * 4 + h;
    const size_t row0 = (size_t)b * NT + c * 128;
    const int iloc = wid * 16 + fr;
    u32x4 qraw[2];
#pragma unroll
    for (int ks = 0; ks < 2; ++ks) qraw[ks] = *(const u32x4*)(P + (row0 + iloc) * INW + C_RQ + h * 64 + ks * 32 + 8 * g);
    bf16x8 kf[8][2];
#pragma unroll
    for (int jb = 0; jb < 8; ++jb)
#pragma unroll
        for (int ks = 0; ks < 2; ++ks) kf[jb][ks] = *(const bf16x8*)(P + (row0 + jb * 16 + fr) * INW + C_RK + h * 64 + ks * 32 + 8 * g);
    u32x4 vf[4][4];
#pragma unroll
    for (int jj = 0; jj < 4; ++jj)
#pragma unroll
        for (int eb = 0; eb < 4; ++eb) {
            const bf16_t* vp = RVT + ((size_t)bh * 64 + eb * 16 + fr) * NT + c * 128 + jj * 32 + 4 * g;
            const u32x2 v0 = *(const u32x2*)vp, v1 = *(const u32x2*)(vp + 16);
            vf[jj][eb] = (u32x4){v0[0], v0[1], v1[0], v1[1]};
        }
    f32x4 st[8];
#pragma unroll
    for (int jb = 0; jb < 8; ++jb) {
        st[jb] = (f32x4){0.f, 0.f, 0.f, 0.f};
#pragma unroll
        for (int ks = 0; ks < 2; ++ks) st[jb] = MFMA16(kf[jb][ks], as_bf16x8(qraw[ks]), st[jb]);
    }
    const int vc = c >= 2 ? c - 2 : 64 + c;
    const bf16_t* sf = SF + ((size_t)bh * NCHUNK + c) * 4096 + fr * 64 + 8 * g;
    const bf16_t* sb = SB + ((size_t)bh * NCHUNK + vc) * 4096 + fr * 64 + 8 * g;
    bf16x8 sfa[2][4], sba[2][4];
#pragma unroll
    for (int ks = 0; ks < 2; ++ks)
#pragma unroll
        for (int eb = 0; eb < 4; ++eb) { sfa[ks][eb] = *(const bf16x8*)(sf + eb * 1024 + ks * 32); sba[ks][eb] = *(const bf16x8*)(sb + eb * 1024 + ks * 32); }
    u32x2 gw[4];
#pragma unroll
    for (int eb = 0; eb < 4; ++eb) gw[eb] = *(const u32x2*)(P + (row0 + iloc) * INW + C_RG + h * 64 + eb * 16 + 4 * g);
#pragma unroll
    for (int jb = 0; jb < 8; ++jb)
#pragma unroll
        for (int q = 0; q < 4; ++q) {
            const int j = jb * 16 + 4 * g + q;
            const int d = iloc - j;
            const float w = d > 0 ? fast_exp2((float)d * lf2) : (d < 0 ? fast_exp2((float)(-d) * lb2) : 2.0f);
            st[jb][q] *= w;
        }
    f32x4 ot[4];
#pragma unroll
    for (int eb = 0; eb < 4; ++eb) ot[eb] = (f32x4){0.f, 0.f, 0.f, 0.f};
#pragma unroll
    for (int jj = 0; jj < 4; ++jj) {
        const u32x4 pw = {pk_bf16(st[2 * jj][0], st[2 * jj][1]), pk_bf16(st[2 * jj][2], st[2 * jj][3]), pk_bf16(st[2 * jj + 1][0], st[2 * jj + 1][1]), pk_bf16(st[2 * jj + 1][2], st[2 * jj + 1][3])};
#pragma unroll
        for (int eb = 0; eb < 4; ++eb) ot[eb] = MFMA16(as_bf16x8(vf[jj][eb]), as_bf16x8(pw), ot[eb]);
    }
    const float df = fast_exp2((float)(iloc + 1) * lf2), db = fast_exp2((float)(128 - iloc) * lb2);
#pragma unroll
    for (int ks = 0; ks < 2; ++ks) {
        u32x4 qf, qb;
#pragma unroll
        for (int q = 0; q < 4; ++q) { const float a = bf_lo(qraw[ks][q]), bb = bf_hi(qraw[ks][q]); qf[q] = pk_bf16(a * df, bb * df); qb[q] = pk_bf16(a * db, bb * db); }
#pragma unroll
        for (int eb = 0; eb < 4; ++eb) {
            ot[eb] = MFMA16(sfa[ks][eb], as_bf16x8(qf), ot[eb]);
            ot[eb] = MFMA16(sba[ks][eb], as_bf16x8(qb), ot[eb]);
        }
    }
    float s = 0.f;
#pragma unroll
    for (int eb = 0; eb < 4; ++eb) s += (ot[eb][0] + ot[eb][1]) + (ot[eb][2] + ot[eb][3]);
    s += __shfl_xor(s, 16); s += __shfl_xor(s, 32);
    const float mu = s * (1.0f / 64.0f);
    float q2 = 0.f;
#pragma unroll
    for (int eb = 0; eb < 4; ++eb)
#pragma unroll
        for (int q = 0; q < 4; ++q) { const float d = ot[eb][q] - mu; q2 += d * d; }
    q2 += __shfl_xor(q2, 16); q2 += __shfl_xor(q2, 32);
    const float rstd = rsqrtf(q2 * (1.0f / 64.0f) + LN_EPS);
#pragma unroll
    for (int eb = 0; eb < 4; ++eb) {
        const int e = eb * 16 + 4 * g;
        const float g0 = bf_lo(gw[eb][0]), g1 = bf_hi(gw[eb][0]), g2 = bf_lo(gw[eb][1]), g3 = bf_hi(gw[eb][1]);
        u32x2 w = {pk_bf16((ot[eb][0] - mu) * rstd * silu_f(g0), (ot[eb][1] - mu) * rstd * silu_f(g1)),
                   pk_bf16((ot[eb][2] - mu) * rstd * silu_f(g2), (ot[eb][3] - mu) * rstd * silu_f(g3))};
        *(u32x2*)(MIX + (row0 + iloc) * DM + 768 + h * 64 + e) = w;
    }
}

DI void phase_attn(const Params& p0, int l, LAS unsigned char* lds) {
    const Params p = launder(p0); l = launder_s(l);
    const float* scal = (const float*)(p.ws + WS_SCAL) + l * 16;
    const float lam = scal[0], oscale = scal[1];
    const int nunits = NB * 4 * 64 + (l == 0 ? NB * 4 * 2 : 0);
    int conv_done = 0;
    for (int u = bid_(); u < nunits; u += gridDim.x) {
        int b, h, q0, ntile;
        if (u < NB * 4 * 64) { const int qt = u & 63; h = (u >> 6) & 3; b = u >> 8; q0 = NCTX + qt * 128; ntile = NT / 64; }
        else { const int v = u - NB * 4 * 64; const int qt = v & 1; h = (v >> 1) & 3; b = v >> 3; q0 = qt * 128; ntile = NCTX / 64; }
        attn_unit(p, l, b, h, q0, ntile, lam, oscale, conv_done, lds);
    }
    if (tid_() == 0) ((int*)(p.ws + WS_CONVDONE))[l * 1024 + bid_()] = conv_done;
}
DI void phase_ret(const Params& p0, int l) {
    const Params p = launder(p0); l = launder_s(l);
    for (int u = bid_(); u < NB * 4 * NCHUNK; u += gridDim.x) {
        const int c = u % NCHUNK, bh = u / NCHUNK;
        if (l == 1 && c < 2) continue;
        ret_unit(p, l, bh >> 2, bh & 3, c);
    }
}

DI void phase_outproj(const Params& p0, int l, LAS unsigned char* lds) {
    const Params p = launder(p0); l = launder_s(l);
    const float* Xin = (const float*)(p.ws + WS_XA);
    const bf16_t* A = (const bf16_t*)(p.ws + WS_MIX);
    const bf16_t* W = (const bf16_t*)(p.ws + WS_WOUT) + (size_t)l * DM * DM;
    float* V1 = (float*)(p.ws + WS_V1);
    const float* modv = (const float*)(p.ws + WS_MODV) + (size_t)l * 3 * 6144;
    for (int u = bid_(); u < (MROWS / 192) * 8; u += gridDim.x) {
        const int tm = u >> 3, tn = u & 7;
        auto epi = [&](f32x4 (&acc)[4][3], int wm, int wn, int fr, int fq, int lane, int wid) {
            const int c0 = tn * 128 + wn * 64, r0 = tm * 192 + wm * 48;
            LAS unsigned char* W_ = g2_stage(lds, wid);
#pragma unroll
            for (int nf = 0; nf < 4; ++nf)
#pragma unroll
                for (int mf = 0; mf < 3; ++mf) *(LAS f32x4*)(W_ + (mf * 16 + fr) * 272 + nf * 64 + fq * 16) = acc[nf][mf];
#pragma unroll
            for (int it = 0; it < 12; ++it) {
                const int row = it * 4 + (lane >> 4), ch = lane & 15;
                const int grow = r0 + row;
                const f32x4 y = *(LAS f32x4*)(W_ + row * 272 + ch * 16);
                const f32x4 xv = *(const f32x4*)(Xin + (size_t)grow * DM + c0 + ch * 4);
                const f32x4 g2 = *(const f32x4*)(modv + (size_t)row_sel(grow) * 6144 + 2 * 1024 + c0 + ch * 4);
                *(f32x4*)(V1 + (size_t)grow * DM + c0 + ch * 4) = (f32x4){DN_ALPHA * xv[0] + g2[0] * y[0], DN_ALPHA * xv[1] + g2[1] * y[1], DN_ALPHA * xv[2] + g2[2] * y[2], DN_ALPHA * xv[3] + g2[3] * y[3]};
            }
        };
        gemm192(A, DM, W, DM, DM / 64, tm * 192, tn * 128, lds, epi);
    }
}

DI void phase_ln_mid(const Params& p0, int l) {
    const Params p = launder(p0); l = launder_s(l);
    float* Xout = (float*)(p.ws + WS_XB);
    const int lane = tid_() & 63, wid = tid_() >> 6;
    const float* V1 = (const float*)(p.ws + WS_V1);
    bf16_t* TOK = (bf16_t*)(p.ws + WS_TOK);
    const float* modv = (const float*)(p.ws + WS_MODV) + (size_t)l * 3 * 6144;
    const float* lg = p.ln_g + (size_t)(l * 2 + 0) * DM; const float* lb = p.ln_b + (size_t)(l * 2 + 0) * DM;
    for (int r = bid_() * 8 + wid; r < MROWS; r += gridDim.x * 8) {
        f32x4 v[4];
#pragma unroll
        for (int i = 0; i < 4; ++i) v[i] = *(const f32x4*)(V1 + (size_t)r * DM + lane * 4 + i * 256);
        float mu, rstd; ln_stats(v, mu, rstd);
#pragma unroll
        for (int i = 0; i < 4; ++i) {
            const int c = lane * 4 + i * 256;
            const f32x4 gg = *(const f32x4*)(lg + c), bb = *(const f32x4*)(lb + c);
#pragma unroll
            for (int j = 0; j < 4; ++j) v[i][j] = (v[i][j] - mu) * rstd * gg[j] + bb[j];
            *(f32x4*)(Xout + (size_t)r * DM + c) = v[i];
        }
        const float* mv = modv + (size_t)row_sel(r) * 6144;
        modulate_store(v, mv + 3 * 1024, mv + 4 * 1024, TOK + (size_t)r * DM, lane);
    }
}

DI void phase_router(const Params& p0, int l, LAS unsigned char* lds) {
    const Params p = launder(p0); l = launder_s(l);
    const bf16_t* A = (const bf16_t*)(p.ws + WS_TOK);
    const bf16_t* W = (const bf16_t*)(p.ws + WS_WR) + (size_t)l * 256 * DM;
    float* LG = (float*)(p.ws + WS_LOGIT);
    for (int u = bid_(); u < (MROWS / 192) * 2; u += gridDim.x) {
        const int tm = u >> 1, tn = u & 1;
        auto epi = [&](f32x4 (&acc)[4][3], int wm, int wn, int fr, int fq, int lane, int wid) {
            const int c0 = tn * 128 + wn * 64, r0 = tm * 192 + wm * 48;
            LAS unsigned char* W_ = g2_stage(lds, wid);
#pragma unroll
            for (int nf = 0; nf < 4; ++nf)
#pragma unroll
                for (int mf = 0; mf < 3; ++mf) *(LAS f32x4*)(W_ + (mf * 16 + fr) * 272 + nf * 64 + fq * 16) = acc[nf][mf];
#pragma unroll
            for (int it = 0; it < 12; ++it) {
                const int row = it * 4 + (lane >> 4), ch = lane & 15;
                *(f32x4*)(LG + (size_t)(r0 + row) * 256 + c0 + ch * 4) = *(LAS f32x4*)(W_ + row * 272 + ch * 16);
            }
        };
        gemm192(A, DM, W, DM, DM / 64, tm * 192, tn * 128, lds, epi);
    }
}

DI void phase_topk(const Params& p0, int l, LAS unsigned char* lds) {
    const Params p = launder(p0); l = launder_s(l);
    const int lane = tid_() & 63, wid = tid_() >> 6, rs = lane >> 3, g = lane & 7;
    const float* LG = (const float*)(p.ws + WS_LOGIT);
    const float* bias = p.router_bias + l * 256 + g * 32;
    int* EIDX = (int*)(p.ws + WS_EIDX); float* GATE = (float*)(p.ws + WS_GATE);
    int* RANK = (int*)(p.ws + WS_RANK); int* HIST = (int*)(p.ws + WS_HIST);
    LAS int* hist = (LAS int*)lds;
    if (tid_() < 256) hist[tid_()] = 0;
    __syncthreads();
    const int chunk = (MROWS + (int)gridDim.x - 1) / (int)gridDim.x, r_begin = bid_() * chunk, r_end = (r_begin + chunk) < MROWS ? (r_begin + chunk) : MROWS;
    for (int base = r_begin + wid * 8; base < r_end; base += 64) {
        const int row = base + rs; const bool valid = row < r_end;
        const float* lp = LG + (size_t)(valid ? row : r_begin) * 256 + g * 32;
        float sc[32], gv[32];
#pragma unroll
        for (int q = 0; q < 8; ++q) {
            const f32x4 lg = *(const f32x4*)(lp + 4 * q), bv = *(const f32x4*)(bias + 4 * q);
#pragma unroll
            for (int j = 0; j < 4; ++j) { sc[4 * q + j] = 1.0f / (1.0f + __expf(-lg[j])); gv[4 * q + j] = sc[4 * q + j] + bv[j]; }
        }
        float m1 = fmaxf(gv[0], gv[1]), m2 = fminf(gv[0], gv[1]);
#pragma unroll
        for (int i = 2; i < 32; ++i) { const float v = gv[i]; m2 = fmaxf(m2, fminf(m1, v)); m1 = fmaxf(m1, v); }
        const float gs = m1 + m2;
        int rank = 0;
#pragma unroll
        for (int g2 = 0; g2 < 8; ++g2) { const float o = __shfl(gs, (lane & 56) + g2); rank += (o > gs || (o == gs && g2 < g)) ? 1 : 0; }
        if (rank >= 4) {
#pragma unroll
            for (int i = 0; i < 32; ++i) gv[i] = -INFINITY;
        }
        float ssum = 0.f, mysc = 0.f; int myidx = 0;
#pragma unroll 1
        for (int k = 0; k < TOPK; ++k) {
            float bv = gv[0], bs = sc[0]; int bi = 0;
#pragma unroll
            for (int i = 1; i < 32; ++i) { const bool gt = gv[i] > bv; bv = gt ? gv[i] : bv; bs = gt ? sc[i] : bs; bi = gt ? i : bi; }
            int gi = g * 32 + bi;
#pragma unroll
            for (int o = 1; o < 8; o <<= 1) {
                const float ov = __shfl_xor(bv, o), os = __shfl_xor(bs, o); const int oi = __shfl_xor(gi, o);
                const bool tk = ov > bv || (ov == bv && oi < gi);
                bv = tk ? ov : bv; bs = tk ? os : bs; gi = tk ? oi : gi;
            }
            if ((gi >> 5) == g) {
                const int oi = gi & 31;
#pragma unroll
                for (int i = 0; i < 32; ++i) gv[i] = (i == oi) ? -INFINITY : gv[i];
            }
            ssum += bs;
            if (g == k) { mysc = bs; myidx = gi; }
        }
        if (valid) {
            EIDX[(size_t)row * 8 + g] = myidx;
            GATE[(size_t)row * 8 + g] = mysc / ssum * 2.5f;
            RANK[(size_t)row * 8 + g] = __hip_atomic_fetch_add(hist + myidx, 1, __ATOMIC_RELAXED, __HIP_MEMORY_SCOPE_WORKGROUP);
        }
    }
    __syncthreads();
    if (tid_() < 256) HIST[(size_t)bid_() * 256 + tid_()] = hist[tid_()];
    __syncthreads();
}

DI void phase_scatter(const Params& p0, int l, LAS unsigned char* lds) {
    const Params p = launder(p0); l = launder_s(l);
    LAS int* off = (LAS int*)lds;
    LAS int* toff = off + 260;
    LAS int* tot = toff + 260;
    LAS int* base = tot + 256;
    const int tid = tid_(), bid = bid_(), G = gridDim.x;
    const int* HIST = (const int*)(p.ws + WS_HIST);
    const int* RANK = (const int*)(p.ws + WS_RANK);
    int* ntl = (int*)(p.ws + CTL_NTILES) + l;
    int* TILES = (int*)(p.ws + WS_TILES);
    const int* EIDX = (const int*)(p.ws + WS_EIDX);
    int* SORT = (int*)(p.ws + WS_SORT);
    if (tid < 256) {
        int t = 0, bs = 0;
#pragma unroll 16
        for (int b2 = 0; b2 < G; ++b2) { const int v = HIST[(size_t)b2 * 256 + tid]; bs += (b2 < bid) ? v : 0; t += v; }
        tot[tid] = t; base[tid] = bs;
    }
    __syncthreads();
    if (tid == 0) {
        int a = 0, t = 0;
        for (int e = 0; e < 256; ++e) { off[e] = a; toff[e] = t; const int c = tot[e]; a += c; t += (c + 127) >> 7; }
        off[256] = a; toff[256] = t;
    }
    __syncthreads();
    if (bid == 0) {
        if (tid < 256) {
            const int e = tid, c = off[e + 1] - off[e], nt = toff[e + 1] - toff[e];
            for (int t = 0; t < nt; ++t) { int* T = TILES + (size_t)(toff[e] + t) * 4; T[0] = e; T[1] = off[e] + t * 128; T[2] = (c - t * 128) < 128 ? (c - t * 128) : 128; T[3] = 0; }
        }
        if (tid == 0) *ntl = toff[256];
    }
    const int chunk = (MROWS + G - 1) / G, r_begin = bid * chunk, r_end = (r_begin + chunk) < MROWS ? (r_begin + chunk) : MROWS;
    for (int a = r_begin * 8 + tid; a < r_end * 8; a += NTHREADS) {
        const int e = EIDX[a];
        SORT[off[e] + base[e] + RANK[a]] = a;
    }
    __syncthreads();
}

constexpr int MOE_STG = 40960;
constexpr int MOE_HT = 86016;
constexpr int MOE_INFO = MOE_HT + 65536;
DI int swz64(int row, int chunk) { return row * 64 + ((chunk ^ ((0 - (row >> 2)) & 3)) << 4); }

DI void phase_convert_experts(const Params& p0, int l) {
    const Params p = launder(p0); l = launder_s(l);
    unsigned char* IMG = p.ws + WS_WIMG + (size_t)l * (NEXP + 1) * IMG_PER_E * IMG_BYTES;
    constexpr int NSLICE = (NEXP + 1) * IMG_PER_E * 4;
    const int G = gridDim.x, bid = bid_(), t = tid_();
    const int mine = (NSLICE - bid + G - 1) / G;
    const int done = ((const int*)(p.ws + WS_CONVDONE))[l * 1024 + bid];
    for (int i = done; i < mine; ++i) {
        const int sj = bid + G * i, u = sj >> 2, qd = sj & 3, e = u / IMG_PER_E, im = u % IMG_PER_E;
        const int row = t >> 2, chunk = t & 3, np = 128 * qd + row;
        const float* src; int ldw;
        if (im < 32) { const float* W = e < NEXP ? p.w_egu + ((size_t)l * NEXP + e) * DM * 512 : p.w_sgu + (size_t)l * DM * 512; ldw = 512;
            src = W + (size_t)(im * 32 + chunk * 8) * 512 + (((np >> 4) & 1) * 256 + (np >> 5) * 16 + (np & 15)); }
        else { const float* W = e < NEXP ? p.w_edn + ((size_t)l * NEXP + e) * 256 * DM : p.w_sdn + (size_t)l * 256 * DM; ldw = DM;
            src = W + (size_t)(((im - 32) & 7) * 32 + chunk * 8) * DM + ((im - 32) >> 3) * 512 + np; }
        float f[8];
#pragma unroll
        for (int kk = 0; kk < 8; ++kk) f[kk] = src[(size_t)kk * ldw];
        const u32x4 w = {pk_bf16(f[0], f[1]), pk_bf16(f[2], f[3]), pk_bf16(f[4], f[5]), pk_bf16(f[6], f[7])};
        *(u32x4*)(IMG + (size_t)u * IMG_BYTES + (size_t)np * 64 + ((chunk ^ ((0 - (np >> 2)) & 3)) << 4)) = w;
    }
}

DI void moe_unit(const Params& p, const unsigned char* img, bf16_t* outbase, bool shared, int r0, int nr, LAS unsigned char* lds) {
    const int t = tid_(), lane = t & 63, wid = __builtin_amdgcn_readfirstlane(t >> 6), fr = lane & 15, fq = lane >> 4, wn = wid & 3, wt = wid >> 2;
    const bf16_t* TOK = (const bf16_t*)(p.ws + WS_TOK);
    const int* SORT = (const int*)(p.ws + WS_SORT);
    LAS int* rowout = (LAS int*)(lds + MOE_INFO);
    const int arow = t >> 2;
    int atok = 0, aout = -1;
    if (arow < nr) { if (shared) { atok = r0 + arow; aout = atok; } else { aout = SORT[r0 + arow]; atok = aout >> 3; } }
    const bf16_t* aptr = TOK + (size_t)atok * DM + (((t & 3) ^ ((0 - (arow >> 2)) & 3)) << 3);
    __syncthreads();
    if ((t & 3) == 0) rowout[arow] = aout;
    const unsigned char* wsrc = img + (size_t)t * 16;
    const int adst = wid * 1024, wdst = 8192 + wid * 1024;
#define MOE_ISSUE1(S, KT) do { LAS unsigned char* _s = lds + (S) * MOE_STG; dma16(aptr + (KT) * 32, _s + adst); \
        const unsigned char* _w = wsrc + (size_t)(KT) * IMG_BYTES; \
        dma16(_w, _s + wdst); dma16(_w + 8192, _s + wdst + 8192); dma16(_w + 16384, _s + wdst + 16384); dma16(_w + 24576, _s + wdst + 24576); } while (0)
#define MOE_ISSUE2(S, IM) do { LAS unsigned char* _s = lds + (S) * IMG_BYTES; const unsigned char* _w = wsrc + (size_t)(IM) * IMG_BYTES; \
        dma16(_w, _s + adst); dma16(_w + 8192, _s + adst + 8192); dma16(_w + 16384, _s + adst + 16384); dma16(_w + 24576, _s + adst + 24576); } while (0)
    f32x4 acc[8][4];
#pragma unroll
    for (int nf = 0; nf < 8; ++nf)
#pragma unroll
        for (int tf = 0; tf < 4; ++tf) acc[nf][tf] = (f32x4){0.f, 0.f, 0.f, 0.f};
    MOE_ISSUE1(0, 0);
    MOE_ISSUE1(1, 1);
    int st = 0;
    for (int kt = 0; kt < 32; ++kt) {
        if (kt < 31) WAIT_VM(5); else WAIT_VM(0);
        asm volatile("s_waitcnt lgkmcnt(0)" ::: "memory");
        __builtin_amdgcn_s_barrier();
        const int st2 = st == 0 ? 2 : st - 1;
        if (wt == 0) { if (kt < 30) MOE_ISSUE1(st2, kt + 2); else if (kt == 31) MOE_ISSUE2(0, 32); }
        LAS unsigned char* S = lds + st * MOE_STG;
        bf16x8 tfr[4];
#pragma unroll
        for (int tf = 0; tf < 4; ++tf) tfr[tf] = *(LAS bf16x8*)(S + swz64(wt * 64 + tf * 16 + fr, fq));
#pragma unroll
        for (int nf = 0; nf < 8; ++nf) {
            const bf16x8 wf = *(LAS bf16x8*)(S + 8192 + swz64(wn * 128 + nf * 16 + fr, fq));
#pragma unroll
            for (int tf = 0; tf < 4; ++tf) acc[nf][tf] = MFMA16(wf, tfr[tf], acc[nf][tf]);
            if (nf == 3 && wt == 1) { if (kt < 30) MOE_ISSUE1(st2, kt + 2); else if (kt == 31) MOE_ISSUE2(0, 32); }
        }
        st = st == 2 ? 0 : st + 1;
    }
#pragma unroll
    for (int i = 0; i < 4; ++i)
#pragma unroll
        for (int tf = 0; tf < 4; ++tf) {
            float hv[4];
#pragma unroll
            for (int j = 0; j < 4; ++j) hv[j] = silu_f(acc[2 * i][tf][j]) * acc[2 * i + 1][tf][j];
            const int tok = wt * 64 + tf * 16 + fr, hc = wn * 64 + i * 16 + 4 * fq;
            const u32x2 w = {pk_bf16(hv[0], hv[1]), pk_bf16(hv[2], hv[3])};
            *(LAS u32x2*)(lds + MOE_HT + tok * 512 + (((hc >> 3) ^ (tok & 15)) << 4) + (hc & 7) * 2) = w;
        }
#pragma unroll 1
    for (int nc = 0; nc < 2; ++nc) {
#pragma unroll
        for (int nf = 0; nf < 8; ++nf)
#pragma unroll
            for (int tf = 0; tf < 4; ++tf) acc[nf][tf] = (f32x4){0.f, 0.f, 0.f, 0.f};
        if (nc == 1) MOE_ISSUE2(0, 40);
        for (int kt = 0; kt < 8; ++kt) {
            WAIT_VM(0);
            asm volatile("s_waitcnt lgkmcnt(0)" ::: "memory");
            __builtin_amdgcn_s_barrier();
            if (wt == 0 && kt < 7) MOE_ISSUE2((kt + 1) & 1, 32 + nc * 8 + kt + 1);
            LAS unsigned char* S = lds + (kt & 1) * IMG_BYTES;
            bf16x8 tfr[4];
#pragma unroll
            for (int tf = 0; tf < 4; ++tf) { const int tok = wt * 64 + tf * 16 + fr; tfr[tf] = *(LAS bf16x8*)(lds + MOE_HT + tok * 512 + (((kt * 4 + fq) ^ (tok & 15)) << 4)); }
#pragma unroll
            for (int nf = 0; nf < 8; ++nf) {
                const bf16x8 wf = *(LAS bf16x8*)(S + swz64(wn * 128 + nf * 16 + fr, fq));
#pragma unroll
                for (int tf = 0; tf < 4; ++tf) acc[nf][tf] = MFMA16(wf, tfr[tf], acc[nf][tf]);
                if (nf == 3 && wt == 1 && kt < 7) MOE_ISSUE2((kt + 1) & 1, 32 + nc * 8 + kt + 1);
            }
        }
        __syncthreads();
        LAS unsigned char* W = lds + wid * 9216;
#pragma unroll
        for (int half = 0; half < 2; ++half) {
#pragma unroll
            for (int nh = 0; nh < 4; ++nh)
#pragma unroll
                for (int tf = 0; tf < 4; ++tf) {
                    const f32x4 v = acc[half * 4 + nh][tf];
                    const u32x2 w = {pk_bf16(v[0], v[1]), pk_bf16(v[2], v[3])};
                    *(LAS u32x2*)(W + (tf * 16 + fr) * 144 + nh * 32 + fq * 8) = w;
                }
#pragma unroll
            for (int it = 0; it < 8; ++it) {
                const int row = it * 8 + (lane >> 3), ch = lane & 7;
                const u32x4 v = *(LAS u32x4*)(W + row * 144 + ch * 16);
                const int ro = rowout[wt * 64 + row];
                if (ro >= 0) *(u32x4*)(outbase + (size_t)ro * DM + nc * 512 + wn * 128 + half * 64 + ch * 8) = v;
            }
        }
        __syncthreads();
    }
#undef MOE_ISSUE1
#undef MOE_ISSUE2
}

DI void phase_moe(const Params& p0, int l, LAS unsigned char* lds) {
    const Params p = launder(p0); l = launder_s(l);
    const int* TILES = (const int*)(p.ws + WS_TILES);
    const int ntl = *((const int*)(p.ws + CTL_NTILES) + l);
    const int G = gridDim.x, bid = bid_();
    int vcu = bid;
    if (p.ph_hi - p.ph_lo > 1) {
        volatile LAS unsigned* bst = (volatile LAS unsigned*)(lds + LDS_BYTES - 16);
        const unsigned xc = bst[2]; unsigned pre = 0;
        for (unsigned j = 0; j < 16; ++j) { const unsigned c = xb_ld((unsigned*)(p.ws + WS_CTL) + XB_XCNT(j)); pre += (j < xc) ? c : 0u; }
        vcu = (int)(pre + bst[3]);
    }
    const int total = ntl + MROWS / 128;
    const unsigned char* IMG = p.ws + WS_WIMG + (size_t)l * (NEXP + 1) * IMG_PER_E * IMG_BYTES;
    for (int u = vcu; u < total; u += G) {
        if (u < ntl) {
            const int e = TILES[u * 4], r0 = TILES[u * 4 + 1], nr = TILES[u * 4 + 2];
            moe_unit(p, IMG + (size_t)e * IMG_PER_E * IMG_BYTES, (bf16_t*)(p.ws + WS_YSLOT), false, r0, nr, lds);
        } else {
            const int tm = u - ntl;
            if (l == 1 && (tm % (NT / 128)) < 2) continue;
            moe_unit(p, IMG + (size_t)NEXP * IMG_PER_E * IMG_BYTES, (bf16_t*)(p.ws + WS_YSH), true, tm * 128, 128, lds);
        }
    }
}

DI void phase_combine(const Params& p0, int l) {
    const Params p = launder(p0); l = launder_s(l);
    const float* X1 = (const float*)(p.ws + WS_XB); float* Xnext = (float*)(p.ws + WS_XA);
    const int lane = tid_() & 63, wid = tid_() >> 6;
    const bf16_t* YSL = (const bf16_t*)(p.ws + WS_YSLOT); const bf16_t* YSH = (const bf16_t*)(p.ws + WS_YSH);
    const float* GATE = (const float*)(p.ws + WS_GATE);
    const float* modv = (const float*)(p.ws + WS_MODV);
    const float* lg = p.ln_g + (size_t)(l * 2 + 1) * DM; const float* lb = p.ln_b + (size_t)(l * 2 + 1) * DM;
    bf16_t* H = (bf16_t*)(p.ws + WS_H);
    for (int r = bid_() * 8 + wid; r < MROWS; r += gridDim.x * 8) {
        const int b = r >= NT, pp = r - b * NT;
        if (l == 1 && pp < NCTX) continue;
        const int sel = pp < NCTX ? 2 : b;
        float gt[8];
#pragma unroll
        for (int k = 0; k < 8; ++k) gt[k] = GATE[(size_t)r * 8 + k];
        const float* g5 = modv + ((size_t)l * 3 + sel) * 6144 + 5 * 1024;
        f32x4 v[4];
        u32x2 sl[4][9]; f32x4 xv4[4];
#pragma unroll
        for (int i = 0; i < 4; ++i) {
            const int c = lane * 4 + i * 256;
            sl[i][8] = *(const u32x2*)(YSH + (size_t)r * DM + c);
#pragma unroll
            for (int k = 0; k < 8; ++k) sl[i][k] = *(const u32x2*)(YSL + ((size_t)r * 8 + k) * DM + c);
            xv4[i] = *(const f32x4*)(X1 + (size_t)r * DM + c);
        }
#pragma unroll
        for (int i = 0; i < 4; ++i) {
            const int c = lane * 4 + i * 256;
            float f0 = bf_lo(sl[i][8][0]), f1 = bf_hi(sl[i][8][0]), f2 = bf_lo(sl[i][8][1]), f3 = bf_hi(sl[i][8][1]);
#pragma unroll
            for (int k = 0; k < 8; ++k) { const u32x2 w = sl[i][k]; f0 += gt[k] * bf_lo(w[0]); f1 += gt[k] * bf_hi(w[0]); f2 += gt[k] * bf_lo(w[1]); f3 += gt[k] * bf_hi(w[1]); }
            const f32x4 xv = xv4[i], gv = *(const f32x4*)(g5 + c);
            v[i] = (f32x4){DN_ALPHA * xv[0] + gv[0] * f0, DN_ALPHA * xv[1] + gv[1] * f1, DN_ALPHA * xv[2] + gv[2] * f2, DN_ALPHA * xv[3] + gv[3] * f3};
        }
        float mu, rstd; ln_stats(v, mu, rstd);
#pragma unroll
        for (int i = 0; i < 4; ++i) {
            const int c = lane * 4 + i * 256;
            const f32x4 gg = *(const f32x4*)(lg + c), bb = *(const f32x4*)(lb + c);
#pragma unroll
            for (int j = 0; j < 4; ++j) v[i][j] = (v[i][j] - mu) * rstd * gg[j] + bb[j];
            if (l == 1) *(f32x4*)(p.out + ((size_t)b * NLAT + (pp - NCTX)) * DM + c) = v[i];
            else *(f32x4*)(Xnext + (size_t)r * DM + c) = v[i];
        }
        if (l == 0) { const float* mv = modv + ((size_t)1 * 3 + sel) * 6144; modulate_store(v, mv, mv + 1024, H + (size_t)r * DM, lane); }
    }
}

constexpr int PH_PER_LAYER = 11, N_PHASES = 3 + 2 * PH_PER_LAYER;
__global__ void __launch_bounds__(NTHREADS, 2) mega(Params p) {
    extern __shared__ __attribute__((aligned(16))) unsigned char lds_raw[];
    LAS unsigned char* lds = (LAS unsigned char*)lds_raw;
    volatile LAS unsigned* bst = (volatile LAS unsigned*)(lds + LDS_BYTES - 16);
    if (PROBE_ID != 0 && threadIdx.x == 0) { PRB_WORDS(lds)[0] = 0ull; PRB_WORDS(lds)[1] = 0ull; }
    if (threadIdx.x == 0) { bst[0] = 0u; bst[1] = 0u; const unsigned xc = xb_xcc_id(); bst[2] = xc; bst[3] = xb_add((unsigned*)(p.ws + CTL_XRANK) + xc, 1u); }
    __syncthreads();
    const int lo = p.ph_lo, hi = p.ph_hi;
    XcdBarrier bar; bar.bar = (unsigned*)(p.ws + WS_CTL); bar.x = 0; bar.st = bst;
    if (hi - lo > 1) bar = xcd_barrier_post((unsigned*)(p.ws + WS_CTL), bst);
#ifndef ONLY_PHASE
#define ONLY_PHASE -1
#endif
#define IN(k) (lo <= (k) && (k) < hi)
#define ON(pid) (ONLY_PHASE < 0 || ONLY_PHASE == (pid))
#ifndef DUP_PHASE
#define DUP_PHASE -1
#endif
#define REP(pid) for (int rep_ = 0; rep_ < ((DUP_PHASE == (pid)) ? 2 : 1); ++rep_)
#define SEAM(k) do { if (IN(k) && IN((k) + 1)) xcd_barrier(bar); } while (0)
    PRB_T0(100, lds); if (ON(0) && IN(0)) REP(0) { phase_convert(p, lds); } PRB_T1(100, lds);
    PRB_T0(200, lds); SEAM(0); PRB_T1(200, lds);
    PRB_T0(101, lds); if (ON(1) && IN(1)) REP(1) phase_mod(p, lds); PRB_T1(101, lds);
    PRB_T0(201, lds); SEAM(1); PRB_T1(201, lds);
    PRB_T0(102, lds); if (ON(2) && IN(2)) REP(2) phase_ln0(p); PRB_T1(102, lds);
    PRB_T0(202, lds); SEAM(2); PRB_T1(202, lds);
    for (int l = 0; l < 2; ++l) {
        const int k0 = 3 + l * PH_PER_LAYER;
        PRB_T0(103, lds); if (ON(3) && IN(k0 + 0)) REP(3) phase_inproj(p, l, lds); PRB_T1(103, lds);
        PRB_T0(203, lds); SEAM(k0 + 0); PRB_T1(203, lds);
        PRB_T0(104, lds); if (ON(4) && IN(k0 + 1)) REP(4) phase_ret_sum_pool(p, l, lds); PRB_T1(104, lds);
        PRB_T0(204, lds); SEAM(k0 + 1); PRB_T1(204, lds);
        PRB_T0(105, lds); if (ON(5) && IN(k0 + 2)) REP(5) phase_ret_scan(p, l); PRB_T1(105, lds);
        PRB_T0(205, lds); SEAM(k0 + 2); PRB_T1(205, lds);
        PRB_T0(106, lds); if (ON(6) && IN(k0 + 3)) REP(6) { phase_attn(p, l, lds); phase_ret(p, l); } PRB_T1(106, lds);
        PRB_T0(206, lds); SEAM(k0 + 3); PRB_T1(206, lds);
        PRB_T0(107, lds); if (ON(7) && IN(k0 + 4)) REP(7) phase_outproj(p, l, lds); PRB_T1(107, lds);
        PRB_T0(207, lds); SEAM(k0 + 4); PRB_T1(207, lds);
        PRB_T0(108, lds); if (ON(8) && IN(k0 + 5)) REP(8) phase_ln_mid(p, l); PRB_T1(108, lds);
        PRB_T0(208, lds); SEAM(k0 + 5); PRB_T1(208, lds);
        PRB_T0(109, lds); if (ON(9) && IN(k0 + 6)) REP(9) phase_router(p, l, lds); PRB_T1(109, lds);
        PRB_T0(209, lds); SEAM(k0 + 6); PRB_T1(209, lds);
        PRB_T0(110, lds); if (ON(10) && IN(k0 + 7)) REP(10) phase_topk(p, l, lds); PRB_T1(110, lds);
        PRB_T0(210, lds); SEAM(k0 + 7); PRB_T1(210, lds);
        PRB_T0(111, lds); if (ON(11) && IN(k0 + 8)) REP(11) { phase_scatter(p, l, lds); phase_convert_experts(p, l); } PRB_T1(111, lds);
        PRB_T0(211, lds); SEAM(k0 + 8); PRB_T1(211, lds);
        PRB_T0(112, lds); if (ON(12) && IN(k0 + 9)) REP(12) phase_moe(p, l, lds); PRB_T1(112, lds);
        PRB_T0(212, lds); SEAM(k0 + 9); PRB_T1(212, lds);
        PRB_T0(114, lds); if (ON(14) && IN(k0 + 10)) REP(14) phase_combine(p, l); PRB_T1(114, lds);
        if (l == 0) SEAM(k0 + 10);
    }
#undef IN
#undef SEAM
    if (PROBE_ID != 0 && threadIdx.x == 0 && blockIdx.x == 0) {
        const unsigned long long t0 = __builtin_readcyclecounter(), span = PRB_WORDS(lds)[1] * PROBE_GAIN;
        while (__builtin_readcyclecounter() - t0 < span) __builtin_amdgcn_s_sleep(8);
    }
}

extern "C" void kernel_launch(void* const* d_in, const int* in_sizes, int n_in, void* d_out, int out_size, void* d_ws, size_t ws_size, hipStream_t stream) {
    static int grid = 0;
    if (grid == 0) {
        if (n_in != 20 || ws_size < WS_END || out_size != NB * NLAT * DM) { fprintf(stderr, "kernel_launch: unexpected shapes (n_in %d, ws %zu need %zu, out %d)\n", n_in, ws_size, (size_t)WS_END, out_size); grid = -1; return; }
        int dev = 0, cus = 0, per_cu = 0;
        hipGetDevice(&dev); hipDeviceGetAttribute(&cus, hipDeviceAttributeMultiprocessorCount, dev);
        if (hipFuncSetAttribute((const void*)mega, hipFuncAttributeMaxDynamicSharedMemorySize, LDS_BYTES) != hipSuccess) { fprintf(stderr, "kernel_launch: hipFuncSetAttribute failed\n"); grid = -1; return; }
        if (hipOccupancyMaxActiveBlocksPerMultiprocessor(&per_cu, (const void*)mega, NTHREADS, LDS_BYTES) != hipSuccess || per_cu < 1) { fprintf(stderr, "kernel_launch: occupancy query says %d\n", per_cu); }
        (void)hipGetLastError();
        grid = cus > 0 ? cus : 256;
    }
    if (grid < 0) return;
    hipMemsetAsync((char*)d_ws + WS_CTL, 0, CTL_BYTES, stream);
    Params p{};
    p.x = (const float*)d_in[0]; p.c = (const float*)d_in[1]; p.ctx = (const float*)d_in[2]; p.c_ctx = (const float*)d_in[3];
    p.w_mod = (const float*)d_in[4]; p.b_mod = (const float*)d_in[5]; p.w_in = (const float*)d_in[6]; p.w_out = (const float*)d_in[7];
    p.diff_lambda = (const float*)d_in[8]; p.pool_w = (const float*)d_in[9]; p.pool_scale = (const float*)d_in[10]; p.ret_log_decay = (const float*)d_in[11];
    p.ln_g = (const float*)d_in[12]; p.ln_b = (const float*)d_in[13]; p.w_router = (const float*)d_in[14]; p.router_bias = (const float*)d_in[15];
    p.w_egu = (const float*)d_in[16]; p.w_edn = (const float*)d_in[17]; p.w_sgu = (const float*)d_in[18]; p.w_sdn = (const float*)d_in[19];
    p.out = (float*)d_out; p.ws = (unsigned char*)d_ws;
#if N_LAUNCH_PER_PHASE
    for (int k = 0; k < N_PHASES; ++k) { p.ph_lo = k; p.ph_hi = k + 1; hipLaunchKernelGGL(mega, dim3(grid), dim3(NTHREADS), LDS_BYTES, stream, p); }
#else
    p.ph_lo = 0; p.ph_hi = N_PHASES;
    hipLaunchKernelGGL(mega, dim3(grid), dim3(NTHREADS), LDS_BYTES, stream, p);
#endif
}
```

```cpp
#include <hip/hip_runtime.h>
#include <stdint.h>
#include <stdio.h>

#ifndef N_LAUNCH_PER_PHASE
#define N_LAUNCH_PER_PHASE 0
#endif

#define LAS __attribute__((address_space(3)))
#define DI __device__ __forceinline__
typedef unsigned short bf16_t;
typedef short bf16x8 __attribute__((ext_vector_type(8)));
typedef float f32x2 __attribute__((ext_vector_type(2)));
typedef float f32x4 __attribute__((ext_vector_type(4)));
typedef float f32x16 __attribute__((ext_vector_type(16)));
typedef unsigned u32x2 __attribute__((ext_vector_type(2)));
typedef unsigned u32x4 __attribute__((ext_vector_type(4)));
typedef __bf16 bf16v2 __attribute__((ext_vector_type(2)));

constexpr int NB = 2, NLAT = 8192, NCTX = 256, NT = NLAT + NCTX  , MROWS = NB * NT  ;
constexpr int DM = 1024, INW = 2816, NEXP = 256, TOPK = 8, NASG = MROWS * TOPK  ;
constexpr int NCHUNK = NT / 128;
constexpr float DN_ALPHA = 1.41421356237f;
constexpr float LN_EPS = 1e-6f, RMS_EPS = 1e-5f;
constexpr float LOG2E = 1.44269504089f;
constexpr float QSCALE = 0.125f * LOG2E;
constexpr int NTHREADS = 512;
constexpr int LDS_BYTES = 163840;

constexpr int IMG_BYTES = 32768, IMG_PER_E = 48;
constexpr int C_DQ = 0, C_DK = 512, C_DV = 1024, C_PU = 1536, C_RQ = 1792, C_RK = 2048, C_RV = 2304, C_RG = 2560;

constexpr size_t al256(size_t x) { return (x + 255) & ~(size_t)255; }
constexpr size_t WS_CTL = 0;
constexpr size_t CTL_BYTES = 65536;
constexpr size_t CTL_COUNTS = 16384;
constexpr size_t CTL_CURSOR = CTL_COUNTS + 2048;
constexpr size_t CTL_NTILES = CTL_CURSOR + 2048;
constexpr size_t CTL_XRANK = CTL_NTILES + 256;
constexpr size_t WS_MODV = WS_CTL + CTL_BYTES;
constexpr size_t WS_ROPE = al256(WS_MODV + 2 * 3 * 6144 * 4);
constexpr size_t WS_SCAL = al256(WS_ROPE + 128 * 16 * 8);
constexpr size_t WS_WIN = al256(WS_SCAL + 2 * 16 * 4);
constexpr size_t WS_WOUT = al256(WS_WIN + (size_t)2 * INW * DM * 2);
constexpr size_t WS_WR = al256(WS_WOUT + (size_t)2 * DM * DM * 2);
constexpr size_t WS_WIMG = al256(WS_WR + (size_t)2 * 256 * DM * 2);
constexpr size_t WS_XA = al256(WS_WIMG + (size_t)2 * 257 * 48 * 32768);
constexpr size_t WS_XB = al256(WS_XA + (size_t)MROWS * DM * 4);
constexpr size_t WS_V1 = al256(WS_XB + (size_t)MROWS * DM * 4);
constexpr size_t WS_H = al256(WS_V1 + (size_t)MROWS * DM * 4);
constexpr size_t WS_TOK = al256(WS_H + (size_t)MROWS * DM * 2);
constexpr size_t WS_P = al256(WS_TOK + (size_t)MROWS * DM * 2);
constexpr size_t WS_VT = al256(WS_P + (size_t)MROWS * INW * 2);
constexpr size_t WS_RKT = al256(WS_VT + (size_t)NB * 4 * 128 * NT * 2);
constexpr size_t WS_RVT = al256(WS_RKT + (size_t)NB * 4 * 64 * NT * 2);
constexpr size_t WS_MIX = al256(WS_RVT + (size_t)NB * 4 * 64 * NT * 2);
constexpr size_t ST_BYTES = (size_t)NB * 4 * NCHUNK * 4096 * 4;
constexpr size_t WS_UF = al256(WS_MIX + (size_t)MROWS * DM * 2);
constexpr size_t WS_UB = al256(WS_UF + ST_BYTES);
constexpr size_t WS_SF = al256(WS_UB + ST_BYTES);
constexpr size_t WS_SB = al256(WS_SF + ST_BYTES);
constexpr size_t WS_LOGIT = al256(WS_SB + ST_BYTES);
constexpr size_t WS_EIDX = al256(WS_LOGIT + (size_t)MROWS * 256 * 4);
constexpr size_t WS_GATE = al256(WS_EIDX + (size_t)NASG * 4);
constexpr size_t WS_SORT = al256(WS_GATE + (size_t)NASG * 4);
constexpr size_t WS_RANK = al256(WS_SORT + (size_t)NASG * 4);
constexpr size_t WS_HIST = al256(WS_RANK + (size_t)NASG * 4);
constexpr size_t WS_CONVDONE = al256(WS_HIST + (size_t)1024 * 256 * 4);
constexpr size_t WS_TILES = al256(WS_CONVDONE + 2 * 1024 * 4);
constexpr size_t WS_YSLOT = al256(WS_TILES + 2048 * 16);
constexpr size_t WS_YSH = al256(WS_YSLOT + (size_t)NASG * DM * 2);
constexpr size_t WS_END = al256(WS_YSH + (size_t)MROWS * DM * 2);

struct Params {
    const float *x, *c, *ctx, *c_ctx, *w_mod, *b_mod, *w_in, *w_out, *diff_lambda, *pool_w, *pool_scale, *ret_log_decay, *ln_g, *ln_b,
        *w_router, *router_bias, *w_egu, *w_edn, *w_sgu, *w_sdn;
    float* out;
    unsigned char* ws;
    int ph_lo, ph_hi;
};


DI Params launder(const Params& a) {
    size_t z = 0; asm volatile("" : "+s"(z));
    Params r = a;
#define LND(f) r.f = (decltype(r.f))((const unsigned char*)a.f + z)
    LND(x); LND(c); LND(ctx); LND(c_ctx); LND(w_mod); LND(b_mod); LND(w_in); LND(w_out); LND(diff_lambda); LND(pool_w); LND(pool_scale); LND(ret_log_decay); LND(ln_g); LND(ln_b);
    LND(w_router); LND(router_bias); LND(w_egu); LND(w_edn); LND(w_sgu); LND(w_sdn);
#undef LND
    r.out = (float*)((unsigned char*)a.out + z); r.ws = a.ws + z;
    return r;
}
DI int launder_s(int v) { asm volatile("" : "+s"(v)); return v; }
DI int tid_() { int t = threadIdx.x; asm volatile("" : "+v"(t)); return t; }
DI int bid_() { int t = blockIdx.x; asm volatile("" : "+s"(t)); return t; }


#ifndef PROBE_ID
#define PROBE_ID 0
#endif
#ifndef PROBE_GAIN
#define PROBE_GAIN 8
#endif
#define PRB_WORDS(lds) ((volatile LAS unsigned long long*)((lds) + LDS_BYTES - 64))
#define PRB_MATCH(id) (PROBE_ID == (id) || (PROBE_ID == 999 && (id) >= 200) || (PROBE_ID == 998 && ((id) == 101 || (id) == 102 || (id) == 104 || (id) == 105 || (id) == 108 || (id) == 109 || (id) == 110 || (id) == 111)))
#define PRB_T0(id, lds) do { if (PRB_MATCH(id) && threadIdx.x == 0 && blockIdx.x == 0) { PRB_WORDS(lds)[0] = __builtin_readcyclecounter(); } } while (0)
#define PRB_T1(id, lds) do { if (PRB_MATCH(id) && threadIdx.x == 0 && blockIdx.x == 0) { PRB_WORDS(lds)[1] += __builtin_readcyclecounter() - PRB_WORDS(lds)[0]; } } while (0)

#define XB_TMO      128
#define XB_XCNT(j)  (256  + 64 * (j))
#define XB_XSUB(j)  (1280 + 64 * (j))
#define XB_XGEN(j)  (2304 + 64 * (j))
#define XB_TOP      3328
#define XB_TOPGEN   3392
#define XCD_BAR_WORDS 3456
#define XB_SPIN_CAP (1u << 20)

__device__ __forceinline__ unsigned xb_ld(unsigned* p)              { return __hip_atomic_load(p, __ATOMIC_RELAXED, __HIP_MEMORY_SCOPE_AGENT); }
__device__ __forceinline__ unsigned xb_add(unsigned* p, unsigned v) { return __hip_atomic_fetch_add(p, v, __ATOMIC_RELAXED, __HIP_MEMORY_SCOPE_AGENT); }
__device__ __forceinline__ unsigned xb_xcc_id() { return (unsigned)__builtin_amdgcn_s_getreg((3 << 11) | 20) & 0xFu; }
#define XB_SPIN(cond, bar) do { unsigned _sp = 0; while (cond) { __builtin_amdgcn_s_sleep(1); \
    if ((++_sp & 255u) == 0u) { if (xb_ld(&(bar)[XB_TMO])) break; if (_sp > XB_SPIN_CAP) { atomicAdd(&(bar)[XB_TMO], 1u); break; } } } } while (0)

struct XcdBarrier { unsigned* bar; unsigned x; volatile LAS unsigned* st; };

__device__ __forceinline__ XcdBarrier xcd_barrier_post(unsigned* bar, volatile LAS unsigned* st) {
    XcdBarrier b; b.bar = bar; b.x = xb_xcc_id(); b.st = st;
    if (threadIdx.x == 0) (void)xb_add(&bar[XB_XCNT(b.x)], 1u);
    return b;
}
__device__ __forceinline__ void xcd_barrier_complete(unsigned* bar, unsigned x, unsigned& nloc, unsigned& nx) {
    const unsigned G = gridDim.x * gridDim.y * gridDim.z;
    unsigned sum, cnt, mine, sp = 0u;
    for (;;) {
        sum = 0u; cnt = 0u; mine = 0u;
#pragma unroll
        for (unsigned j = 0; j < 16; ++j) { const unsigned c = xb_ld(&bar[XB_XCNT(j)]); sum += c; cnt += (c > 0u) ? 1u : 0u; mine = (j == x) ? c : mine; }
        if (sum == G) break;
        __builtin_amdgcn_s_sleep(1);
        if ((++sp & 255u) == 0u) { if (xb_ld(&bar[XB_TMO])) break; if (sp > XB_SPIN_CAP) { atomicAdd(&bar[XB_TMO], 1u); break; } }
    }
    nloc = mine > 0u ? mine : 1u; nx = cnt > 0u ? cnt : 1u;
}
__device__ __forceinline__ void xcd_barrier(const XcdBarrier& b) {
    asm volatile("s_waitcnt vmcnt(0)" ::: "memory");
    __syncthreads();
    if (threadIdx.x == 0) {
        unsigned* bar = b.bar;
        __builtin_amdgcn_s_waitcnt(0);
        unsigned nloc = b.st[0], nx = b.st[1];
        if (nloc == 0u) { xcd_barrier_complete(bar, b.x, nloc, nx); b.st[0] = nloc; b.st[1] = nx; }
        const unsigned old = xb_add(&bar[XB_XSUB(b.x)], 1u);
        const unsigned gen = old / nloc;
        if (old + 1u == (gen + 1u) * nloc) {
            __builtin_amdgcn_fence(__ATOMIC_RELEASE, "agent");
            asm volatile("s_waitcnt vmcnt(0)" ::: "memory");
            const unsigned og = xb_add(&bar[XB_TOP], 1u);
            const unsigned tg = og / nx;
            if (og + 1u == (tg + 1u) * nx) xb_add(&bar[XB_TOPGEN], 1u);
            else XB_SPIN(xb_ld(&bar[XB_TOPGEN]) == tg, bar);
            __builtin_amdgcn_fence(__ATOMIC_ACQUIRE, "agent");
            xb_add(&bar[XB_XGEN(b.x)], 1u);
            asm volatile("s_waitcnt vmcnt(0)" ::: "memory");
        } else {
            XB_SPIN(xb_ld(&bar[XB_XGEN(b.x)]) == gen, bar);
            __builtin_amdgcn_fence(__ATOMIC_ACQUIRE, "agent");
            asm volatile("s_waitcnt vmcnt(0)" ::: "memory");
        }
    }
    __syncthreads();
}

DI unsigned pk_bf16(float a, float b) { f32x2 v = {a, b}; bf16v2 r = __builtin_convertvector(v, bf16v2); return __builtin_bit_cast(unsigned, r); }
DI bf16_t to_bf16(float a) { return (bf16_t)(pk_bf16(a, 0.f) & 0xffffu); }
DI float bf_lo(unsigned u) { return __uint_as_float(u << 16); }
DI float bf_hi(unsigned u) { return __uint_as_float(u & 0xffff0000u); }
DI float bf2f(bf16_t h) { return __uint_as_float(((unsigned)h) << 16); }
DI float wave_sum(float v) {
#pragma unroll
    for (int o = 32; o; o >>= 1) v += __shfl_xor(v, o);
    return v;
}
DI float fast_exp2(float x) { return __builtin_amdgcn_exp2f(x); }
DI float silu_f(float x) { return x / (1.f + __expf(-x)); }
DI bf16x8 as_bf16x8(u32x4 v) { return __builtin_bit_cast(bf16x8, v); }
#define WAIT_VM(n) asm volatile("s_waitcnt vmcnt(" #n ")" ::: "memory")
DI void dma16(const void* g, LAS unsigned char* l) { __builtin_amdgcn_global_load_lds(g, (LAS void*)l, 16, 0, 0); }
#define MFMA32(a, b, c) __builtin_amdgcn_mfma_f32_32x32x16_bf16((a), (b), (c), 0, 0, 0)
#define MFMA16(a, b, c) __builtin_amdgcn_mfma_f32_16x16x32_bf16((a), (b), (c), 0, 0, 0)

DI int row_sel(int r) { const int b = r >= NT; const int p = r - b * NT; return p < NCTX ? 2 : b; }

DI int swz_off(int row, int chunk) { return row * 128 + ((chunk ^ ((row >> 1) & 7)) << 4); }

DI int perm_gu(int n) { const int f = n >> 8, jj = n & 255; return ((jj >> 4) << 5) + (f << 4) + (jj & 15); }
DI void conv_unit(const float* src, int N, int K, bf16_t* dst, int k0, int n0, bool perm, LAS unsigned char* lds) {
    LAS float* tl = (LAS float*)lds;
    const int tid = tid_();
#pragma unroll
    for (int i = 0; i < 8; ++i) {
        const int kk = (tid >> 6) + 8 * i, nn = (tid & 63) * 4;
        const f32x4 v = *(const f32x4*)(src + (size_t)(k0 + kk) * N + n0 + nn);
        tl[kk * 257 + nn] = v[0]; tl[kk * 257 + nn + 1] = v[1]; tl[kk * 257 + nn + 2] = v[2]; tl[kk * 257 + nn + 3] = v[3];
    }
    __syncthreads();
    const int n = tid >> 1, kh = (tid & 1) * 32;
    const int nd = perm ? perm_gu(n0 + n) : (n0 + n);
    bf16_t* d = dst + (size_t)nd * K + k0 + kh;
#pragma unroll
    for (int q = 0; q < 4; ++q) {
        u32x4 w;
#pragma unroll
        for (int j = 0; j < 4; ++j) w[j] = pk_bf16(tl[(kh + q * 8 + 2 * j) * 257 + n], tl[(kh + q * 8 + 2 * j + 1) * 257 + n]);
        *(u32x4*)(d + q * 8) = w;
    }
    __syncthreads();
}

DI void phase_convert(const Params& p0, LAS unsigned char* lds) {
    const Params p = launder(p0);
    constexpr int U_IN = 176, U_OUT = 64, U_R = 16;
    constexpr int U_L = U_IN + U_OUT + U_R;
    for (int u = bid_(); u < 2 * U_L; u += gridDim.x) {
        const int l = u / U_L; int v = u % U_L;
        if (v < U_IN) { conv_unit(p.w_in + (size_t)l * DM * INW, INW, DM, (bf16_t*)(p.ws + WS_WIN) + (size_t)l * INW * DM, (v / 11) * 64, (v % 11) * 256, false, lds); continue; }
        v -= U_IN;
        if (v < U_OUT) { conv_unit(p.w_out + (size_t)l * DM * DM, DM, DM, (bf16_t*)(p.ws + WS_WOUT) + (size_t)l * DM * DM, (v / 4) * 64, (v % 4) * 256, false, lds); continue; }
        v -= U_OUT;
        conv_unit(p.w_router + (size_t)l * DM * 256, 256, DM, (bf16_t*)(p.ws + WS_WR) + (size_t)l * 256 * DM, v * 64, 0, false, lds);
    }
}

DI void phase_mod(const Params& p0, LAS unsigned char* lds) {
    const Params p = launder(p0);
    LAS float* sc = (LAS float*)lds;
    LAS float* red = sc + 3 * 1024;
    const int tid = tid_();
    float* modv = (float*)(p.ws + WS_MODV);
    for (int u = bid_(); u < 193; u += gridDim.x) {
        if (u == 192) {
            float* rope = (float*)(p.ws + WS_ROPE);
            for (int i = tid; i < 128 * 16; i += NTHREADS) {
                const int pos = i >> 4, f = i & 15;
                const float freq = powf(10000.0f, -(float)f / 16.0f);
                const float ang = (float)pos * freq;
                rope[2 * i] = cosf(ang); rope[2 * i + 1] = sinf(ang);
            }
            float* scal = (float*)(p.ws + WS_SCAL);
            if (tid < 2) {
                const int l = tid;
                const float* dl = p.diff_lambda + l * 256;
                float s01 = 0.f, s23 = 0.f;
                for (int i = 0; i < 64; ++i) { s01 += dl[i] * dl[64 + i]; s23 += dl[128 + i] * dl[192 + i]; }
                const float lambda_init = 0.8f - 0.6f * expf(-0.3f * (float)l);
                scal[l * 16 + 0] = expf(s01) - expf(s23) + lambda_init;
                scal[l * 16 + 1] = 1.0f - lambda_init;
                for (int h = 0; h < 4; ++h) {
                    scal[l * 16 + 2 + h] = -expf(p.ret_log_decay[l * 8 + h]) * LOG2E;
                    scal[l * 16 + 6 + h] = -expf(p.ret_log_decay[l * 8 + 4 + h]) * LOG2E;
                }
            }
            continue;
        }
        const int l = u / 96, n0 = (u % 96) * 64;
        for (int i = tid; i < 3 * 1024; i += NTHREADS) {
            const int s = i >> 10, k = i & 1023;
            const float v = s < 2 ? p.c[s * 1024 + k] : p.c_ctx[k];
            sc[i] = silu_f(v);
        }
        __syncthreads();
        const int kq = tid >> 6, nl = tid & 63;
        const float* w = p.w_mod + (size_t)l * DM * 6144 + n0 + nl;
        float a0 = 0.f, a1 = 0.f, a2 = 0.f;
        for (int k = kq * 128; k < kq * 128 + 128; ++k) {
            const float wv = w[(size_t)k * 6144];
            a0 += sc[k] * wv; a1 += sc[1024 + k] * wv; a2 += sc[2048 + k] * wv;
        }
        red[(kq * 3 + 0) * 64 + nl] = a0; red[(kq * 3 + 1) * 64 + nl] = a1; red[(kq * 3 + 2) * 64 + nl] = a2;
        __syncthreads();
        if (tid < 192) {
            const int s = tid >> 6, n = tid & 63;
            float v = 0.f;
            for (int q = 0; q < 8; ++q) v += red[(q * 3 + s) * 64 + n];
            modv[((size_t)l * 3 + s) * 6144 + n0 + n] = v + p.b_mod[l * 6144 + n0 + n];
        }
        __syncthreads();
    }
}

DI void ln_stats(const f32x4 (&v)[4], float& mu, float& rstd) {
    float s = 0.f;
#pragma unroll
    for (int i = 0; i < 4; ++i) s += (v[i][0] + v[i][1]) + (v[i][2] + v[i][3]);
    mu = wave_sum(s) * (1.0f / 1024.0f);
    float q = 0.f;
#pragma unroll
    for (int i = 0; i < 4; ++i)
#pragma unroll
        for (int j = 0; j < 4; ++j) { const float d = v[i][j] - mu; q += d * d; }
    rstd = rsqrtf(wave_sum(q) * (1.0f / 1024.0f) + LN_EPS);
}
DI void modulate_store(const f32x4 (&v)[4], const float* shift, const float* scale, bf16_t* dst, int lane) {
    float mu, rstd; ln_stats(v, mu, rstd);
#pragma unroll
    for (int i = 0; i < 4; ++i) {
        const int c = lane * 4 + i * 256;
        const f32x4 sh = *(const f32x4*)(shift + c), scv = *(const f32x4*)(scale + c);
        float o[4];
#pragma unroll
        for (int j = 0; j < 4; ++j) o[j] = (v[i][j] - mu) * rstd * (1.0f + scv[j]) + sh[j];
        u32x2 w = {pk_bf16(o[0], o[1]), pk_bf16(o[2], o[3])};
        *(u32x2*)(dst + c) = w;
    }
}

DI void phase_ln0(const Params& p0) {
    const Params p = launder(p0);
    const int lane = tid_() & 63, wid = tid_() >> 6;
    float* XA = (float*)(p.ws + WS_XA);
    bf16_t* H = (bf16_t*)(p.ws + WS_H);
    const float* modv = (const float*)(p.ws + WS_MODV);
    for (int r = bid_() * 8 + wid; r < MROWS; r += gridDim.x * 8) {
        const int b = r >= NT, pp = r - b * NT;
        const float* src = pp < NCTX ? p.ctx + ((size_t)b * NCTX + pp) * DM : p.x + ((size_t)b * NLAT + (pp - NCTX)) * DM;
        f32x4 v[4];
#pragma unroll
        for (int i = 0; i < 4; ++i) { v[i] = *(const f32x4*)(src + lane * 4 + i * 256); *(f32x4*)(XA + (size_t)r * DM + lane * 4 + i * 256) = v[i]; }
        const float* mv = modv + (size_t)(0 * 3 + (pp < NCTX ? 2 : b)) * 6144;
        modulate_store(v, mv, mv + 1024, H + (size_t)r * DM, lane);
    }
}

constexpr int G2_STG = 40960;
template <class Epi>
DI void gemm192(const bf16_t* A, int lda, const bf16_t* Bt, int ldb, int nk, int m0, int n0, LAS unsigned char* lds, const Epi& epi) {
    const int t = tid_(), lane = t & 63, wid = __builtin_amdgcn_readfirstlane(t >> 6), fr = lane & 15, fq = lane >> 4, wm = wid >> 1, wn = wid & 1;
    const bf16_t* asrc[3]; const bf16_t* bsrc[2];
#pragma unroll
    for (int i = 0; i < 3; ++i) { const int sl = t + 512 * i, row = sl >> 3, c = (sl & 7) ^ ((row >> 1) & 7); asrc[i] = A + (size_t)(m0 + row) * lda + c * 8; }
#pragma unroll
    for (int i = 0; i < 2; ++i) { const int sl = t + 512 * i, row = sl >> 3, c = (sl & 7) ^ ((row >> 1) & 7); bsrc[i] = Bt + (size_t)(n0 + row) * ldb + c * 8; }
    const int ddst = wid * 1024;
#define G2_ISSUE(S, KT) do { LAS unsigned char* _s = lds + (S) * G2_STG + ddst; const int _k = (KT) * 64; \
        dma16(asrc[0] + _k, _s); dma16(asrc[1] + _k, _s + 8192); dma16(asrc[2] + _k, _s + 16384); dma16(bsrc[0] + _k, _s + 24576); dma16(bsrc[1] + _k, _s + 32768); } while (0)
    f32x4 acc[4][3];
#pragma unroll
    for (int nf = 0; nf < 4; ++nf)
#pragma unroll
        for (int mf = 0; mf < 3; ++mf) acc[nf][mf] = (f32x4){0.f, 0.f, 0.f, 0.f};
    __syncthreads();
    G2_ISSUE(0, 0);
    if (nk > 1) G2_ISSUE(1, 1);
    int st = 0;
    for (int kt = 0; kt < nk; ++kt) {
        if (kt + 1 < nk) WAIT_VM(5); else WAIT_VM(0);
        asm volatile("s_waitcnt lgkmcnt(0)" ::: "memory");
        __builtin_amdgcn_s_barrier();
        const int st2 = st == 0 ? 2 : st - 1;
        if (kt + 2 < nk) G2_ISSUE(st2, kt + 2);
        LAS unsigned char* S = lds + st * G2_STG;
        st = st == 2 ? 0 : st + 1;
#pragma unroll
        for (int kk = 0; kk < 2; ++kk) {
            bf16x8 af[3], bfr[4];
#pragma unroll
            for (int mf = 0; mf < 3; ++mf) af[mf] = *(LAS bf16x8*)(S + swz_off(wm * 48 + mf * 16 + fr, kk * 4 + fq));
#pragma unroll
            for (int nf = 0; nf < 4; ++nf) bfr[nf] = *(LAS bf16x8*)(S + 24576 + swz_off(wn * 64 + nf * 16 + fr, kk * 4 + fq));
#pragma unroll
            for (int nf = 0; nf < 4; ++nf)
#pragma unroll
                for (int mf = 0; mf < 3; ++mf) acc[nf][mf] = MFMA16(bfr[nf], af[mf], acc[nf][mf]);
        }
    }
#undef G2_ISSUE
    __syncthreads();
    epi(acc, wm, wn, fr, fq, lane, wid);
}
DI LAS unsigned char* g2_stage(LAS unsigned char* lds, int wid) { return lds + wid * 13056; }

DI void phase_inproj(const Params& p0, int l, LAS unsigned char* lds) {
    const Params p = launder(p0); l = launder_s(l);
    const bf16_t* H = (const bf16_t*)(p.ws + WS_H);
    const bf16_t* W = (const bf16_t*)(p.ws + WS_WIN) + (size_t)l * INW * DM;
    bf16_t* P = (bf16_t*)(p.ws + WS_P);
    bf16_t* VT = (bf16_t*)(p.ws + WS_VT);
    bf16_t* RKT = (bf16_t*)(p.ws + WS_RKT);
    bf16_t* RVT = (bf16_t*)(p.ws + WS_RVT);
    const f32x2* rope = (const f32x2*)(p.ws + WS_ROPE);
    constexpr int NTN = INW / 128, NTM = MROWS / 192;
    for (int u = bid_(); u < NTM * NTN; u += gridDim.x) {
        const int tm = u / NTN, tn = u % NTN;
        auto epi = [&](f32x4 (&acc)[4][3], int wm, int wn, int fr, int fq, int lane, int wid) {
            const int c0 = tn * 128 + wn * 64;
            const int r0 = tm * 192 + wm * 48;
            LAS unsigned char* W_ = g2_stage(lds, wid);
            if (c0 < C_DV) {
                const float qs = c0 < C_DK ? QSCALE : 1.0f;
#pragma unroll
                for (int mf = 0; mf < 3; ++mf) {
                    const int row = r0 + mf * 16 + fr;
                    const int b = row >= NT, pp = row - b * NT;
                    const bool lat = pp >= NCTX;
                    const int tt = pp - NCTX;
#pragma unroll
                    for (int hb = 0; hb < 2; ++hb) {
                        const int axis = ((c0 >> 5) + hb) & 1;
                        const int pos = axis ? (tt & 63) : (tt >> 6);
#pragma unroll
                        for (int j = 0; j < 4; ++j) {
                            float x1 = acc[2 * hb][mf][j], x2 = acc[2 * hb + 1][mf][j];
                            if (lat) { const f32x2 cs = rope[pos * 16 + 4 * fq + j]; const float o1 = x1 * cs[0] - x2 * cs[1], o2 = x1 * cs[1] + x2 * cs[0]; x1 = o1; x2 = o2; }
                            acc[2 * hb][mf][j] = x1 * qs; acc[2 * hb + 1][mf][j] = x2 * qs;
                        }
                    }
                }
            } else if (c0 >= C_RK && c0 < C_RV) {
#pragma unroll
                for (int nf = 0; nf < 4; ++nf)
#pragma unroll
                    for (int mf = 0; mf < 3; ++mf) acc[nf][mf] *= 0.125f;
            }
#pragma unroll
            for (int nf = 0; nf < 4; ++nf)
#pragma unroll
                for (int mf = 0; mf < 3; ++mf) {
                    const f32x4 v = acc[nf][mf];
                    *(LAS u32x2*)(W_ + (mf * 16 + fr) * 144 + nf * 32 + fq * 8) = (u32x2){pk_bf16(v[0], v[1]), pk_bf16(v[2], v[3])};
                }
#pragma unroll
            for (int it = 0; it < 6; ++it) {
                const int row = it * 8 + (lane >> 3), ch = lane & 7;
                *(u32x4*)(P + (size_t)(r0 + row) * INW + c0 + ch * 8) = *(LAS u32x4*)(W_ + row * 144 + ch * 16);
            }
            const bool isv = c0 >= C_DV && c0 < C_PU, isk = c0 >= C_RK && c0 < C_RV, isr = c0 >= C_RV && c0 < C_RG;
            if (isv || isk || isr) {
                const int frp = isv ? ((fr & 3) | (((fr >> 2) == 1 ? 2 : ((fr >> 2) == 2 ? 1 : (fr >> 2))) << 2)) : fr;
                LAS bf16_t* T_ = (LAS bf16_t*)W_;
#pragma unroll
                for (int nf = 0; nf < 4; ++nf)
#pragma unroll
                    for (int mf = 0; mf < 3; ++mf)
#pragma unroll
                        for (int j = 0; j < 4; ++j) T_[(nf * 16 + 4 * fq + j) * 56 + mf * 16 + frp] = to_bf16(acc[nf][mf][j]);
                const int b = r0 >= NT, pp0 = r0 - b * NT;
                bf16_t* base; int nrows_per_head;
                if (isv) { const int cc = c0 - C_DV; base = VT + ((size_t)(b * 4 + (cc >> 7)) * 128 + (cc & 127)) * NT + pp0; }
                else if (isk) { const int cc = c0 - C_RK; base = RKT + ((size_t)(b * 4 + (cc >> 6)) * 64) * NT + pp0; }
                else { const int cc = c0 - C_RV; base = RVT + ((size_t)(b * 4 + (cc >> 6)) * 64) * NT + pp0; }
                (void)nrows_per_head;
#pragma unroll
                for (int it = 0; it < 6; ++it) {
                    const int sl = it * 64 + lane, n = sl / 6, pc = sl % 6;
                    *(u32x4*)(base + (size_t)n * NT + pc * 8) = *(LAS u32x4*)(W_ + n * 112 + pc * 16);
                }
            }
        };
        gemm192(H, DM, W, DM, DM / 64, tm * 192, tn * 128, lds, epi);
    }
}

DI void phase_ret_sum_pool(const Params& p0, int l, LAS unsigned char* lds) {
    const Params p = launder(p0); l = launder_s(l);
    const int tid = tid_(), lane = tid & 63, wid = tid >> 6, fr = lane & 15, g = lane >> 4;
    const float* scal = (const float*)(p.ws + WS_SCAL) + l * 16;
    const bf16_t* RKT = (const bf16_t*)(p.ws + WS_RKT);
    const bf16_t* RVT = (const bf16_t*)(p.ws + WS_RVT);
    float* UF = (float*)(p.ws + WS_UF);
    float* UB = (float*)(p.ws + WS_UB);
    for (int u = bid_(); u < NB * 4 * NCHUNK; u += gridDim.x) {
        const int c = u % NCHUNK, bh = u / NCHUNK, h = bh & 3;
        const int dir = wid >> 2, eb = wid & 3;
        const float l2 = dir ? scal[6 + h] : scal[2 + h];
        const bf16_t* vrow = RVT + ((size_t)bh * 64 + eb * 16 + fr) * NT + c * 128;
        f32x4 acc[4];
#pragma unroll
        for (int db = 0; db < 4; ++db) acc[db] = (f32x4){0.f, 0.f, 0.f, 0.f};
#pragma unroll
        for (int ks = 0; ks < 4; ++ks) {
            const int j0 = ks * 32 + 8 * g;
            const bf16x8 af = *(const bf16x8*)(vrow + j0);
            float w[8];
#pragma unroll
            for (int jj = 0; jj < 8; ++jj) { const int j = j0 + jj; w[jj] = fast_exp2((dir ? (float)j : (float)(127 - j)) * l2); }
#pragma unroll
            for (int db = 0; db < 4; ++db) {
                const u32x4 kr = *(const u32x4*)(RKT + ((size_t)bh * 64 + db * 16 + fr) * NT + c * 128 + j0);
                u32x4 kw;
#pragma unroll
                for (int q = 0; q < 4; ++q) kw[q] = pk_bf16(bf_lo(kr[q]) * w[2 * q], bf_hi(kr[q]) * w[2 * q + 1]);
                acc[db] = MFMA16(af, as_bf16x8(kw), acc[db]);
            }
        }
        const int cidx = dir ? (c >= 2 ? c - 2 : 64 + c) : c;
        float* U = (dir ? UB : UF) + ((size_t)bh * NCHUNK + cidx) * 4096;
#pragma unroll
        for (int db = 0; db < 4; ++db)
#pragma unroll
            for (int j = 0; j < 4; ++j) U[(eb * 16 + 4 * g + j) * 64 + db * 16 + fr] = acc[db][j];
    }
    LAS float* ul = (LAS float*)lds;
    LAS float* dT = ul + 48 * 256;
    LAS float* pwl = dT + 256 * 36;
    const bf16_t* P = (const bf16_t*)(p.ws + WS_P);
    bf16_t* MIX = (bf16_t*)(p.ws + WS_MIX);
    const float* pw = p.pool_w + (size_t)l * 4 * 64 * 64;
    const float* ps = p.pool_scale + l * 256;
    __syncthreads();
    if (bid_() < MROWS / 32) {
#pragma unroll
        for (int i = 0; i < 8; ++i) *(LAS f32x4*)(pwl + (tid + 512 * i) * 4) = *(const f32x4*)(pw + (tid + 512 * i) * 4);
    }
    for (int u = bid_(); u < MROWS / 32; u += gridDim.x) {
        const int r0 = u * 32;
        const int b = r0 >= NT, pp0 = r0 - b * NT;
        const int s0 = pp0 < NCTX ? b * NT : b * NT + NCTX, s1 = pp0 < NCTX ? b * NT + NCTX : (b + 1) * NT;
        __syncthreads();
        {
            u32x2 wv[6]; bool ok[6];
#pragma unroll
            for (int it = 0; it < 6; ++it) {
                const int i = tid + 512 * it, rr = i >> 6, c4 = (i & 63) * 4, row = r0 - 8 + rr;
                ok[it] = row >= s0 && row < s1;
                wv[it] = ok[it] ? *(const u32x2*)(P + (size_t)row * INW + C_PU + c4) : (u32x2){0u, 0u};
            }
#pragma unroll
            for (int it = 0; it < 6; ++it) {
                const int i = tid + 512 * it, rr = i >> 6, c4 = (i & 63) * 4;
                *(LAS f32x4*)(ul + rr * 256 + c4) = (f32x4){bf_lo(wv[it][0]), bf_hi(wv[it][0]), bf_lo(wv[it][1]), bf_hi(wv[it][1])};
            }
        }
        __syncthreads();
        {
            const int c = tid & 255, gi = c >> 6, rb = tid >> 8;
#define POOL_WIN(HW) do { _Pragma("unroll") for (int it = 0; it < 16; ++it) { const int rr = it * 2 + rb, row = r0 + rr; float sm = 0.f; \
                _Pragma("unroll") for (int q = -(HW); q < (HW); ++q) sm += ul[(rr + 8 + q) * 256 + c]; \
                const int lo = (row - (HW)) < s0 ? s0 : (row - (HW)), hi = (row + (HW)) > s1 ? s1 : (row + (HW)); \
                dT[c * 36 + rr] = sm / (float)(hi - lo) - ul[(rr + 8) * 256 + c]; } } while (0)
            if (gi == 0) POOL_WIN(1); else if (gi == 1) POOL_WIN(2); else if (gi == 2) POOL_WIN(4); else POOL_WIN(8);
#undef POOL_WIN
        }
        __syncthreads();
        {
            const int oc = tid & 255, rh = (tid >> 8) * 16, gi = oc >> 6, e = oc & 63;
            float acc[16];
#pragma unroll
            for (int i = 0; i < 16; ++i) acc[i] = 0.f;
#pragma unroll 8
            for (int c = 0; c < 64; ++c) {
                const float wv = pwl[(gi * 64 + c) * 64 + e];
                const LAS float* dr = dT + (gi * 64 + c) * 36 + rh;
#pragma unroll
                for (int i = 0; i < 4; ++i) { const f32x4 d = *(const LAS f32x4*)(dr + 4 * i); acc[4 * i] += d[0] * wv; acc[4 * i + 1] += d[1] * wv; acc[4 * i + 2] += d[2] * wv; acc[4 * i + 3] += d[3] * wv; }
            }
            const float sc = ps[oc];
#pragma unroll
            for (int i = 0; i < 16; ++i) MIX[(size_t)(r0 + rh + i) * DM + 512 + oc] = to_bf16(acc[i] * sc);
        }
    }
    __syncthreads();
}

DI void phase_ret_scan(const Params& p0, int l) {
    const Params p = launder(p0); l = launder_s(l);
    const float* scal = (const float*)(p.ws + WS_SCAL) + l * 16;
    const float* UF = (const float*)(p.ws + WS_UF); const float* UB = (const float*)(p.ws + WS_UB);
    bf16_t* SF = (bf16_t*)(p.ws + WS_SF); bf16_t* SB = (bf16_t*)(p.ws + WS_SB);
    for (int i = bid_() * NTHREADS + tid_(); i < 2 * NB * 4 * 4096; i += gridDim.x * NTHREADS) {
        const int dir = i / (NB * 4 * 4096), rem = i % (NB * 4 * 4096), bh = rem >> 12, el = rem & 4095, h = bh & 3;
        const float G = fast_exp2(128.0f * (dir ? scal[6 + h] : scal[2 + h]));
        float S = 0.f;
        if (dir == 0) {
#pragma unroll 11
            for (int c = 0; c < NCHUNK; ++c) { const size_t o = ((size_t)bh * NCHUNK + c) * 4096 + el; SF[o] = to_bf16(S); S = S * G + UF[o]; } }
        else {
#pragma unroll 11
            for (int c = NCHUNK - 1; c >= 0; --c) { const size_t o = ((size_t)bh * NCHUNK + c) * 4096 + el; SB[o] = to_bf16(S); S = S * G + UB[o]; } }
    }
}

DI void attn_unit(const Params& p, int l, int b, int h, int q_p0, int ntile, float lam, float oscale, int& conv_done, LAS unsigned char* lds) {
    const int tid = tid_(), lane = tid & 63, wid = __builtin_amdgcn_readfirstlane(tid >> 6), map = wid >> 2, wq = wid & 3, r = lane & 31, hh = lane >> 5;
    const bf16_t* P = (const bf16_t*)(p.ws + WS_P);
    const bf16_t* VT = (const bf16_t*)(p.ws + WS_VT);
    bf16_t* MIX = (bf16_t*)(p.ws + WS_MIX);
    const size_t rowbase = (size_t)b * NT;
    const int qrow = q_p0 + wq * 32 + r;
    bf16x8 qf[4];
#pragma unroll
    for (int ks = 0; ks < 4; ++ks) qf[ks] = *(const bf16x8*)(P + (rowbase + qrow) * INW + C_DQ + h * 128 + map * 64 + ks * 16 + hh * 8);
    constexpr int ASTG = 32768, CRING = 98304, CSLOT = 16384;
    const int t8 = tid & 255, w4 = wid & 3;
    const bf16_t* ksrc; const bf16_t* vsrc;
    { const int key = t8 >> 4, ph = t8 & 15, c = ph ^ (key & 15);
      ksrc = P + (rowbase + key) * INW + C_DK + h * 128 + c * 8;
      const int e = t8 >> 3, pv = t8 & 7, cv = pv ^ ((e >> 1) & 7);
      vsrc = VT + ((size_t)(b * 4 + h) * 128 + e) * NT + cv * 8; }
    const int ddst = w4 * 1024;
#define ATT_ISSUE(S, KT) do { LAS unsigned char* _s = lds + (S) * ASTG + ddst; const bf16_t* _k = ksrc + (size_t)(KT) * 64 * INW; const bf16_t* _v = vsrc + (KT) * 64; \
        _Pragma("unroll") for (int m = 0; m < 4; ++m) { dma16(_k + (size_t)m * 16 * INW, _s + m * 4096); dma16(_v + (size_t)m * 32 * NT, _s + 16384 + m * 4096); } } while (0)
    constexpr int NSLICE = (NEXP + 1) * IMG_PER_E * 4;
    const int G_ = gridDim.x, bidc = bid_();
    const int mine = (NSLICE - bidc + G_ - 1) / G_;
    const int lim = __builtin_amdgcn_readfirstlane((mine - conv_done) < (ntile - 2) ? ((mine - conv_done) < 0 ? 0 : (mine - conv_done)) : (ntile - 2));
    const int cbase = conv_done;
    conv_done += lim;
    unsigned char* IMGL = p.ws + WS_WIMG + (size_t)l * (NEXP + 1) * IMG_PER_E * IMG_BYTES;
#define CONV_SRC(SI, SRCP, LDW) do { const int _s = bidc + G_ * (cbase + (SI)); const int _u = _s >> 2, _qd = _s & 3, _e = _u / IMG_PER_E, _im = _u % IMG_PER_E; \
        const int _k = t8 >> 5, _np = 128 * _qd + 4 * (t8 & 31); \
        if (_im < 32) { const float* _W = _e < NEXP ? p.w_egu + ((size_t)l * NEXP + _e) * DM * 512 : p.w_sgu + (size_t)l * DM * 512; LDW = 512; \
            SRCP = _W + (size_t)(_im * 32 + _k) * 512 + (((_np >> 4) & 1) * 256 + (_np >> 5) * 16 + (_np & 15)); } \
        else { const float* _W = _e < NEXP ? p.w_edn + ((size_t)l * NEXP + _e) * 256 * DM : p.w_sdn + (size_t)l * 256 * DM; LDW = DM; \
            SRCP = _W + (size_t)(((_im - 32) & 7) * 32 + _k) * DM + ((_im - 32) >> 3) * 512 + _np; } } while (0)
    f32x16 o[4];
#pragma unroll
    for (int eb = 0; eb < 4; ++eb)
#pragma unroll
        for (int i = 0; i < 16; ++i) o[eb][i] = 0.f;
    f32x16 negm;
#pragma unroll
    for (int i = 0; i < 16; ++i) negm[i] = 0.f;
    float m_run = 0.f, l_run = 0.f;
#pragma unroll
    for (int ks = 0; ks < 4; ++ks) asm volatile("" : "+v"(qf[ks]));
    __syncthreads();
    if (map == 0) { ATT_ISSUE(0, 0); if (ntile > 1) ATT_ISSUE(1, 1); }
    int st = 0;
    for (int kt = 0; kt < ntile; ++kt) {
        PRB_T0(1, lds);
        const bool cproc = kt >= 2 && kt - 2 < lim;
        if (map == 0) { if (kt + 1 < ntile) WAIT_VM(8); else WAIT_VM(0); }
        else if (cproc) {
            const int n = (kt >= 4 ? 2 : 0) + (kt - 1 < lim ? 4 : 0) + (kt >= 3 ? 2 : 0);
            if (n == 8) WAIT_VM(8); else if (n == 6) WAIT_VM(6); else if (n == 4) WAIT_VM(4); else if (n == 2) WAIT_VM(2); else WAIT_VM(0);
        }
        asm volatile("s_waitcnt lgkmcnt(0)" ::: "memory");
        __builtin_amdgcn_s_barrier();
        PRB_T1(1, lds); PRB_T0(2, lds);
        const int st2 = st == 0 ? 2 : st - 1;
        if (map == 0) { if (kt + 2 < ntile) ATT_ISSUE(st2, kt + 2); }
        else if (kt < lim) {
            const float* srcp; int ldw; CONV_SRC(kt, srcp, ldw);
            LAS unsigned char* _d = lds + CRING + (kt % 3) * CSLOT + w4 * 1024;
#pragma unroll
            for (int m = 0; m < 4; ++m) dma16(srcp + (size_t)m * 8 * ldw, _d + m * 4096);
        }
        LAS unsigned char* L = lds + st * ASTG;
        st = st == 2 ? 0 : st + 1;
        bf16x8 kf[8], va[4], vb[4];
#pragma unroll
        for (int ks = 0; ks < 4; ++ks) {
            const int ch = map * 8 + ks * 2 + hh;
            const int off = r * 256 + ((ch ^ (r & 15)) << 4);
            kf[2 * ks] = *(LAS bf16x8*)(L + off);
            kf[2 * ks + 1] = *(LAS bf16x8*)(L + off + 32 * 256);
        }
#define ATT_VREAD(dst, S_) do { _Pragma("unroll") for (int eb = 0; eb < 4; ++eb) { const int e = eb * 32 + r; \
            dst[eb] = *(LAS bf16x8*)(L + 16384 + e * 128 + ((((S_) * 2 + hh) ^ ((e >> 1) & 7)) << 4)); } } while (0)
#define ATT_PACK(dst, SRC, B_) do { u32x4 _pw; _Pragma("unroll") for (int q = 0; q < 4; ++q) _pw[q] = pk_bf16(SRC[(B_) + 2 * q], SRC[(B_) + 2 * q + 1]); dst = as_bf16x8(_pw); } while (0)
#define ATT_EXP8(SRC, B_) do { _Pragma("unroll") for (int i = 0; i < 8; ++i) { SRC[(B_) + i] = fast_exp2(SRC[(B_) + i]); rsum += SRC[(B_) + i]; pmx = fmaxf(pmx, SRC[(B_) + i]); } } while (0)
        ATT_VREAD(va, 0);
        asm volatile("" ::: "memory");
        f32x16 s0 = negm, s1 = negm;
#pragma unroll
        for (int ks = 0; ks < 4; ++ks) { s0 = MFMA32(kf[2 * ks], qf[ks], s0); s1 = MFMA32(kf[2 * ks + 1], qf[ks], s1); }
        if (map == 1 && cproc) {
            const int sj = bidc + G_ * (cbase + kt - 2); const int uu = sj >> 2, qd = sj & 3;
            const LAS float* raw = (const LAS float*)(lds + CRING + ((kt - 2) % 3) * CSLOT);
            unsigned char* img = IMGL + (size_t)uu * IMG_BYTES + (size_t)(128 * qd) * 64;
#pragma unroll
            for (int hcv = 0; hcv < 2; ++hcv) {
                const int cidx = t8 + 256 * hcv, row = cidx >> 2, chunk = cidx & 3;
                float f[8];
#pragma unroll
                for (int kk = 0; kk < 8; ++kk) f[kk] = raw[(chunk * 8 + kk) * 128 + row];
                const u32x4 w = {pk_bf16(f[0], f[1]), pk_bf16(f[2], f[3]), pk_bf16(f[4], f[5]), pk_bf16(f[6], f[7])};
                const int np = 128 * qd + row;
                *(u32x4*)(img + row * 64 + ((chunk ^ ((0 - (np >> 2)) & 3)) << 4)) = w;
            }
        }
        PRB_T1(2, lds); PRB_T0(3, lds);
        if (kt == 0) {
            float mx = fmaxf(fmaxf(s0[0], s0[1]), s0[2]);
#pragma unroll
            for (int i = 3; i < 15; i += 2) mx = fmaxf(fmaxf(mx, s0[i]), s0[i + 1]);
            mx = fmaxf(mx, s0[15]);
#pragma unroll
            for (int i = 0; i < 16; i += 2) mx = fmaxf(fmaxf(mx, s1[i]), s1[i + 1]);
            mx = fmaxf(mx, __shfl_xor(mx, 32));
            m_run = mx;
#pragma unroll
            for (int i = 0; i < 16; ++i) { s0[i] -= mx; s1[i] -= mx; negm[i] = -mx; }
        }
        float rsum = 0.f, pmx = 0.f;
        bf16x8 pb;
        ATT_EXP8(s0, 0); ATT_PACK(pb, s0, 0);
        ATT_VREAD(vb, 1); asm volatile("" ::: "memory");
#pragma unroll
        for (int eb = 0; eb < 4; ++eb) o[eb] = MFMA32(va[eb], pb, o[eb]);
        ATT_EXP8(s0, 8); ATT_PACK(pb, s0, 8);
        ATT_VREAD(va, 2); asm volatile("" ::: "memory");
#pragma unroll
        for (int eb = 0; eb < 4; ++eb) o[eb] = MFMA32(vb[eb], pb, o[eb]);
        ATT_EXP8(s1, 0); ATT_PACK(pb, s1, 0);
        ATT_VREAD(vb, 3); asm volatile("" ::: "memory");
#pragma unroll
        for (int eb = 0; eb < 4; ++eb) o[eb] = MFMA32(va[eb], pb, o[eb]);
        ATT_EXP8(s1, 8); ATT_PACK(pb, s1, 8);
#pragma unroll
        for (int eb = 0; eb < 4; ++eb) o[eb] = MFMA32(vb[eb], pb, o[eb]);
        l_run += rsum;
        PRB_T1(3, lds);
#undef ATT_VREAD
#undef ATT_PACK
#undef ATT_EXP8
        pmx = fmaxf(pmx, __shfl_xor(pmx, 32));
        if (__any(pmx > 256.0f)) {
            const float d = pmx > 256.0f ? __builtin_amdgcn_logf(pmx) : 0.f;
            const float alpha = fast_exp2(-d);
            m_run += d; l_run *= alpha;
#pragma unroll
            for (int i = 0; i < 16; ++i) negm[i] = -m_run;
#pragma unroll
            for (int eb = 0; eb < 4; ++eb)
#pragma unroll
                for (int i = 0; i < 16; ++i) o[eb][i] *= alpha;
        }
    }
#undef ATT_ISSUE
#undef CONV_SRC
    __syncthreads();
    const float lt = l_run + __shfl_xor(l_run, 32);
    const float inv = 1.0f / lt;
    LAS float* X = (LAS float*)lds;
    if (map == 1) {
#pragma unroll
        for (int eb = 0; eb < 4; ++eb)
#pragma unroll
            for (int i = 0; i < 16; ++i) X[(wq * 64 + eb * 16 + i) * 64 + lane] = o[eb][i] * inv;
    }
    __syncthreads();
    if (map == 0) {
        float ss = 0.f;
#pragma unroll
        for (int eb = 0; eb < 4; ++eb)
#pragma unroll
            for (int i = 0; i < 16; ++i) { const float v = o[eb][i] * inv - lam * X[(wq * 64 + eb * 16 + i) * 64 + lane]; o[eb][i] = v; ss += v * v; }
        ss += __shfl_xor(ss, 32);
        const float sc = rsqrtf(ss * (1.0f / 128.0f) + RMS_EPS) * oscale;
        LAS unsigned char* W = lds + 65536 + wq * 8704;
#pragma unroll
        for (int eb = 0; eb < 4; ++eb)
#pragma unroll
            for (int q = 0; q < 4; ++q) {
                const int e = eb * 32 + 8 * q + 4 * hh;
                const u32x2 w = {pk_bf16(o[eb][4 * q] * sc, o[eb][4 * q + 1] * sc), pk_bf16(o[eb][4 * q + 2] * sc, o[eb][4 * q + 3] * sc)};
                *(LAS u32x2*)(W + r * 272 + e * 2) = w;
            }
#pragma unroll
        for (int it = 0; it < 8; ++it) {
            const int row = it * 4 + (lane >> 4), ch = lane & 15;
            const u32x4 v = *(LAS u32x4*)(W + row * 272 + ch * 16);
            *(u32x4*)(MIX + (rowbase + q_p0 + wq * 32 + row) * DM + h * 128 + ch * 8) = v;
        }
    }
    __syncthreads();
}

DI void ret_unit(const Params& p, int l, int b, int h, int c) {
    const int tid = tid_(), lane = tid & 63, wid = tid >> 6, fr = lane & 15, g = lane >> 4;
    const float* scal = (const float*)(p.ws + WS_SCAL) + l * 16;
    const float lf2 = scal[2 + h], lb2 = scal[6 + h];
    const bf16_t* P = (const bf16_t*)(p.ws + WS_P);
    const bf16_t* RVT = (const bf16_t*)(p.ws + WS_RVT);
    const bf16_t* SF = (const bf16_t*)(p.ws + WS_SF); const bf16_t* SB = (const bf16_t*)(p.ws + WS_SB);
    bf16_t* MIX = (bf16_t*)(p.ws + WS_MIX);
    const int bh = b * 4 + h;
    const size_t row0 = (size_t)b * NT + c * 128;
    const int iloc = wid * 16 + fr;
    u32x4 qraw[2];
#pragma unroll
    for (int ks = 0; ks < 2; ++ks) qraw[ks] = *(const u32x4*)(P + (row0 + iloc) * INW + C_RQ + h * 64 + ks * 32 + 8 * g);
    bf16x8 kf[8][2];
#pragma unroll
    for (int jb = 0; jb < 8; ++jb)
#pragma unroll
        for (int ks = 0; ks < 2; ++ks) kf[jb][ks] = *(const bf16x8*)(P + (row0 + jb * 16 + fr) * INW + C_RK + h * 64 + ks * 32 + 8 * g);
    u32x4 vf[4][4];
#pragma unroll
    for (int jj = 0; jj < 4; ++jj)
#pragma unroll
        for (int eb = 0; eb < 4; ++eb) {
            const bf16_t* vp = RVT + ((size_t)bh * 64 + eb * 16 + fr) * NT + c * 128 + jj * 32 + 4 * g;
            const u32x2 v0 = *(const u32x2*)vp, v1 = *(const u32x2*)(vp + 16);
            vf[jj][eb] = (u32x4){v0[0], v0[1], v1[0], v1[1]};
        }
    f32x4 st[8];
#pragma unroll
    for (int jb = 0; jb < 8; ++jb) {
        st[jb] = (f32x4){0.f, 0.f, 0.f, 0.f};
#pragma unroll
        for (int ks = 0; ks < 2; ++ks) st[jb] = MFMA16(kf[jb][ks], as_bf16x8(qraw[ks]), st[jb]);
    }
    const int vc = c >= 2 ? c - 2 : 64 + c;
    const bf16_t* sf = SF + ((size_t)bh * NCHUNK + c) * 4096 + fr * 64 + 8 * g;
    const bf16_t* sb = SB + ((size_t)bh * NCHUNK + vc) * 4096 + fr * 64 + 8 * g;
    bf16x8 sfa[2][4], sba[2][4];
#pragma unroll
    for (int ks = 0; ks < 2; ++ks)
#pragma unroll
        for (int eb = 0; eb < 4; ++eb) { sfa[ks][eb] = *(const bf16x8*)(sf + eb * 1024 + ks * 32); sba[ks][eb] = *(const bf16x8*)(sb + eb * 1024 + ks * 32); }
    u32x2 gw[4];
#pragma unroll
    for (int eb = 0; eb < 4; ++eb) gw[eb] = *(const u32x2*)(P + (row0 + iloc) * INW + C_RG + h * 64 + eb * 16 + 4 * g);
#pragma unroll
    for (int jb = 0; jb < 8; ++jb)
#pragma unroll
        for (int q = 0; q < 4; ++q) {
            const int j = jb * 16 + 4 * g + q;
            const int d = iloc - j;
            const float w = d > 0 ? fast_exp2((float)d * lf2) : (d < 0 ? fast_exp2((float)(-d) * lb2) : 2.0f);
            st[jb][q] *= w;
        }
    f32x4 ot[4];
#pragma unroll
    for (int eb = 0; eb < 4; ++eb) ot[eb] = (f32x4){0.f, 0.f, 0.f, 0.f};
#pragma unroll
    for (int jj = 0; jj < 4; ++jj) {
        const u32x4 pw = {pk_bf16(st[2 * jj][0], st[2 * jj][1]), pk_bf16(st[2 * jj][2], st[2 * jj][3]), pk_bf16(st[2 * jj + 1][0], st[2 * jj + 1][1]), pk_bf16(st[2 * jj + 1][2], st[2 * jj + 1][3])};
#pragma unroll
        for (int eb = 0; eb < 4; ++eb) ot[eb] = MFMA16(as_bf16x8(vf[jj][eb]), as_bf16x8(pw), ot[eb]);
    }
    const float df = fast_exp2((float)(iloc + 1) * lf2), db = fast_exp2((float)(128 - iloc) * lb2);
#pragma unroll
    for (int ks = 0; ks < 2; ++ks) {
        u32x4 qf, qb;
#pragma unroll
        for (int q = 0; q < 4; ++q) { const float a = bf_lo(qraw[ks][q]), bb = bf_hi(qraw[ks][q]); qf[q] = pk_bf16(a * df, bb * df); qb[q] = pk_bf16(a * db, bb * db); }
#pragma unroll
        for (int eb = 0; eb < 4; ++eb) {
            ot[eb] = MFMA16(sfa[ks][eb], as_bf16x8(qf), ot[eb]);
            ot[eb] = MFMA16(sba[ks][eb], as_bf16x8(qb), ot[eb]);
        }
    }
    float s = 0.f;
#pragma unroll
    for (int eb = 0; eb < 4; ++eb) s += (ot[eb][0] + ot[eb][1]) + (ot[eb][2] + ot[eb][3]);
    s += __shfl_xor(s, 16); s += __shfl_xor(s, 32);
    const float mu = s * (1.0f / 64.0f);
    float q2 = 0.f;
#pragma unroll
    for (int eb = 0; eb < 4; ++eb)
#pragma unroll
        for (int q = 0; q < 4; ++q) { const float d = ot[eb][q] - mu; q2 += d * d; }
    q2 += __shfl_xor(q2, 16); q2 += __shfl_xor(q2, 32);
    const float rstd = rsqrtf(q2 * (1.0f / 64.0f) + LN_EPS);
#pragma unroll
    for (int eb = 0; eb < 4; ++eb) {
        const int e = eb * 16 + 4 * g;
        const float g0 = bf_lo(gw[eb][0]), g1 = bf_hi(gw[eb][0]), g2 = bf_lo(gw[eb][1]), g3 = bf_hi(gw[eb][1]);
        u32x2 w = {pk_bf16((ot[eb][0] - mu) * rstd * silu_f(g0), (ot[eb][1] - mu) * rstd * silu_f(g1)),
                   pk_bf16((ot[eb][2] - mu) * rstd * silu_f(g2), (ot[eb][3] - mu) * rstd * silu_f(g3))};
        *(u32x2*)(MIX + (row0 + iloc) * DM + 768 + h * 64 + e) = w;
    }
}

DI void phase_attn(const Params& p0, int l, LAS unsigned char* lds) {
    const Params p = launder(p0); l = launder_s(l);
    const float* scal = (const float*)(p.ws + WS_SCAL) + l * 16;
    const float lam = scal[0], oscale = scal[1];
    const int nunits = NB * 4 * 64 + (l == 0 ? NB * 4 * 2 : 0);
    int conv_done = 0;
    for (int u = bid_(); u < nunits; u += gridDim.x) {
        int b, h, q0, ntile;
        if (u < NB * 4 * 64) { const int qt = u & 63; h = (u >> 6) & 3; b = u >> 8; q0 = NCTX + qt * 128; ntile = NT / 64; }
        else { const int v = u - NB * 4 * 64; const int qt = v & 1; h = (v >> 1) & 3; b = v >> 3; q0 = qt * 128; ntile = NCTX / 64; }
        attn_unit(p, l, b, h, q0, ntile, lam, oscale, conv_done, lds);
    }
    if (tid_() == 0) ((int*)(p.ws + WS_CONVDONE))[l * 1024 + bid_()] = conv_done;
}
DI void phase_ret(const Params& p0, int l) {
    const Params p = launder(p0); l = launder_s(l);
    for (int u = bid_(); u < NB * 4 * NCHUNK; u += gridDim.x) {
        const int c = u % NCHUNK, bh = u / NCHUNK;
        if (l == 1 && c < 2) continue;
        ret_unit(p, l, bh >> 2, bh & 3, c);
    }
}

DI void phase_outproj(const Params& p0, int l, LAS unsigned char* lds) {
    const Params p = launder(p0); l = launder_s(l);
    const float* Xin = (const float*)(p.ws + WS_XA);
    const bf16_t* A = (const bf16_t*)(p.ws + WS_MIX);
    const bf16_t* W = (const bf16_t*)(p.ws + WS_WOUT) + (size_t)l * DM * DM;
    float* V1 = (float*)(p.ws + WS_V1);
    const float* modv = (const float*)(p.ws + WS_MODV) + (size_t)l * 3 * 6144;
    for (int u = bid_(); u < (MROWS / 192) * 8; u += gridDim.x) {
        const int tm = u >> 3, tn = u & 7;
        auto epi = [&](f32x4 (&acc)[4][3], int wm, int wn, int fr, int fq, int lane, int wid) {
            const int c0 = tn * 128 + wn * 64, r0 = tm * 192 + wm * 48;
            LAS unsigned char* W_ = g2_stage(lds, wid);
#pragma unroll
            for (int nf = 0; nf < 4; ++nf)
#pragma unroll
                for (int mf = 0; mf < 3; ++mf) *(LAS f32x4*)(W_ + (mf * 16 + fr) * 272 + nf * 64 + fq * 16) = acc[nf][mf];
#pragma unroll
            for (int it = 0; it < 12; ++it) {
                const int row = it * 4 + (lane >> 4), ch = lane & 15;
                const int grow = r0 + row;
                const f32x4 y = *(LAS f32x4*)(W_ + row * 272 + ch * 16);
                const f32x4 xv = *(const f32x4*)(Xin + (size_t)grow * DM + c0 + ch * 4);
                const f32x4 g2 = *(const f32x4*)(modv + (size_t)row_sel(grow) * 6144 + 2 * 1024 + c0 + ch * 4);
                *(f32x4*)(V1 + (size_t)grow * DM + c0 + ch * 4) = (f32x4){DN_ALPHA * xv[0] + g2[0] * y[0], DN_ALPHA * xv[1] + g2[1] * y[1], DN_ALPHA * xv[2] + g2[2] * y[2], DN_ALPHA * xv[3] + g2[3] * y[3]};
            }
        };
        gemm192(A, DM, W, DM, DM / 64, tm * 192, tn * 128, lds, epi);
    }
}

DI void phase_ln_mid(const Params& p0, int l) {
    const Params p = launder(p0); l = launder_s(l);
    float* Xout = (float*)(p.ws + WS_XB);
    const int lane = tid_() & 63, wid = tid_() >> 6;
    const float* V1 = (const float*)(p.ws + WS_V1);
    bf16_t* TOK = (bf16_t*)(p.ws + WS_TOK);
    const float* modv = (const float*)(p.ws + WS_MODV) + (size_t)l * 3 * 6144;
    const float* lg = p.ln_g + (size_t)(l * 2 + 0) * DM; const float* lb = p.ln_b + (size_t)(l * 2 + 0) * DM;
    for (int r = bid_() * 8 + wid; r < MROWS; r += gridDim.x * 8) {
        f32x4 v[4];
#pragma unroll
        for (int i = 0; i < 4; ++i) v[i] = *(const f32x4*)(V1 + (size_t)r * DM + lane * 4 + i * 256);
        float mu, rstd; ln_stats(v, mu, rstd);
#pragma unroll
        for (int i = 0; i < 4; ++i) {
            const int c = lane * 4 + i * 256;
            const f32x4 gg = *(const f32x4*)(lg + c), bb = *(const f32x4*)(lb + c);
#pragma unroll
            for (int j = 0; j < 4; ++j) v[i][j] = (v[i][j] - mu) * rstd * gg[j] + bb[j];
            *(f32x4*)(Xout + (size_t)r * DM + c) = v[i];
        }
        const float* mv = modv + (size_t)row_sel(r) * 6144;
        modulate_store(v, mv + 3 * 1024, mv + 4 * 1024, TOK + (size_t)r * DM, lane);
    }
}

DI void phase_router(const Params& p0, int l, LAS unsigned char* lds) {
    const Params p = launder(p0); l = launder_s(l);
    const bf16_t* A = (const bf16_t*)(p.ws + WS_TOK);
    const bf16_t* W = (const bf16_t*)(p.ws + WS_WR) + (size_t)l * 256 * DM;
    float* LG = (float*)(p.ws + WS_LOGIT);
    for (int u = bid_(); u < (MROWS / 192) * 2; u += gridDim.x) {
        const int tm = u >> 1, tn = u & 1;
        auto epi = [&](f32x4 (&acc)[4][3], int wm, int wn, int fr, int fq, int lane, int wid) {
            const int c0 = tn * 128 + wn * 64, r0 = tm * 192 + wm * 48;
            LAS unsigned char* W_ = g2_stage(lds, wid);
#pragma unroll
            for (int nf = 0; nf < 4; ++nf)
#pragma unroll
                for (int mf = 0; mf < 3; ++mf) *(LAS f32x4*)(W_ + (mf * 16 + fr) * 272 + nf * 64 + fq * 16) = acc[nf][mf];
#pragma unroll
            for (int it = 0; it < 12; ++it) {
                const int row = it * 4 + (lane >> 4), ch = lane & 15;
                *(f32x4*)(LG + (size_t)(r0 + row) * 256 + c0 + ch * 4) = *(LAS f32x4*)(W_ + row * 272 + ch * 16);
            }
        };
        gemm192(A, DM, W, DM, DM / 64, tm * 192, tn * 128, lds, epi);
    }
}

DI void phase_topk(const Params& p0, int l, LAS unsigned char* lds) {
    const Params p = launder(p0); l = launder_s(l);
    const int lane = tid_() & 63, wid = tid_() >> 6, rs = lane >> 3, g = lane & 7;
    const float* LG = (const float*)(p.ws + WS_LOGIT);
    const float* bias = p.router_bias + l * 256 + g * 32;
    int* EIDX = (int*)(p.ws + WS_EIDX); float* GATE = (float*)(p.ws + WS_GATE);
    int* RANK = (int*)(p.ws + WS_RANK); int* HIST = (int*)(p.ws + WS_HIST);
    LAS int* hist = (LAS int*)lds;
    if (tid_() < 256) hist[tid_()] = 0;
    __syncthreads();
    const int chunk = (MROWS + (int)gridDim.x - 1) / (int)gridDim.x, r_begin = bid_() * chunk, r_end = (r_begin + chunk) < MROWS ? (r_begin + chunk) : MROWS;
    for (int base = r_begin + wid * 8; base < r_end; base += 64) {
        const int row = base + rs; const bool valid = row < r_end;
        const float* lp = LG + (size_t)(valid ? row : r_begin) * 256 + g * 32;
        float sc[32], gv[32];
#pragma unroll
        for (int q = 0; q < 8; ++q) {
            const f32x4 lg = *(const f32x4*)(lp + 4 * q), bv = *(const f32x4*)(bias + 4 * q);
#pragma unroll
            for (int j = 0; j < 4; ++j) { sc[4 * q + j] = 1.0f / (1.0f + __expf(-lg[j])); gv[4 * q + j] = sc[4 * q + j] + bv[j]; }
        }
        float m1 = fmaxf(gv[0], gv[1]), m2 = fminf(gv[0], gv[1]);
#pragma unroll
        for (int i = 2; i < 32; ++i) { const float v = gv[i]; m2 = fmaxf(m2, fminf(m1, v)); m1 = fmaxf(m1, v); }
        const float gs = m1 + m2;
        int rank = 0;
#pragma unroll
        for (int g2 = 0; g2 < 8; ++g2) { const float o = __shfl(gs, (lane & 56) + g2); rank += (o > gs || (o == gs && g2 < g)) ? 1 : 0; }
        if (rank >= 4) {
#pragma unroll
            for (int i = 0; i < 32; ++i) gv[i] = -INFINITY;
        }
        float ssum = 0.f, mysc = 0.f; int myidx = 0;
#pragma unroll 1
        for (int k = 0; k < TOPK; ++k) {
            float bv = gv[0], bs = sc[0]; int bi = 0;
#pragma unroll
            for (int i = 1; i < 32; ++i) { const bool gt = gv[i] > bv; bv = gt ? gv[i] : bv; bs = gt ? sc[i] : bs; bi = gt ? i : bi; }
            int gi = g * 32 + bi;
#pragma unroll
            for (int o = 1; o < 8; o <<= 1) {
                const float ov = __shfl_xor(bv, o), os = __shfl_xor(bs, o); const int oi = __shfl_xor(gi, o);
                const bool tk = ov > bv || (ov == bv && oi < gi);
                bv = tk ? ov : bv; bs = tk ? os : bs; gi = tk ? oi : gi;
            }
            if ((gi >> 5) == g) {
                const int oi = gi & 31;
#pragma unroll
                for (int i = 0; i < 32; ++i) gv[i] = (i == oi) ? -INFINITY : gv[i];
            }
            ssum += bs;
            if (g == k) { mysc = bs; myidx = gi; }
        }
        if (valid) {
            EIDX[(size_t)row * 8 + g] = myidx;
            GATE[(size_t)row * 8 + g] = mysc / ssum * 2.5f;
            RANK[(size_t)row * 8 + g] = __hip_atomic_fetch_add(hist + myidx, 1, __ATOMIC_RELAXED, __HIP_MEMORY_SCOPE_WORKGROUP);
        }
    }
    __syncthreads();
    if (tid_() < 256) HIST[(size_t)bid_() * 256 + tid_()] = hist[tid_()];
    __syncthreads();
}

DI void phase_scatter(const Params& p0, int l, LAS unsigned char* lds) {
    const Params p = launder(p0); l = launder_s(l);
    LAS int* off = (LAS int*)lds;
    LAS int* toff = off + 260;
    LAS int* tot = toff + 260;
    LAS int* base = tot + 256;
    const int tid = tid_(), bid = bid_(), G = gridDim.x;
    const int* HIST = (const int*)(p.ws + WS_HIST);
    const int* RANK = (const int*)(p.ws + WS_RANK);
    int* ntl = (int*)(p.ws + CTL_NTILES) + l;
    int* TILES = (int*)(p.ws + WS_TILES);
    const int* EIDX = (const int*)(p.ws + WS_EIDX);
    int* SORT = (int*)(p.ws + WS_SORT);
    if (tid < 256) {
        int t = 0, bs = 0;
#pragma unroll 16
        for (int b2 = 0; b2 < G; ++b2) { const int v = HIST[(size_t)b2 * 256 + tid]; bs += (b2 < bid) ? v : 0; t += v; }
        tot[tid] = t; base[tid] = bs;
    }
    __syncthreads();
    if (tid == 0) {
        int a = 0, t = 0;
        for (int e = 0; e < 256; ++e) { off[e] = a; toff[e] = t; const int c = tot[e]; a += c; t += (c + 127) >> 7; }
        off[256] = a; toff[256] = t;
    }
    __syncthreads();
    if (bid == 0) {
        if (tid < 256) {
            const int e = tid, c = off[e + 1] - off[e], nt = toff[e + 1] - toff[e];
            for (int t = 0; t < nt; ++t) { int* T = TILES + (size_t)(toff[e] + t) * 4; T[0] = e; T[1] = off[e] + t * 128; T[2] = (c - t * 128) < 128 ? (c - t * 128) : 128; T[3] = 0; }
        }
        if (tid == 0) *ntl = toff[256];
    }
    const int chunk = (MROWS + G - 1) / G, r_begin = bid * chunk, r_end = (r_begin + chunk) < MROWS ? (r_begin + chunk) : MROWS;
    for (int a = r_begin * 8 + tid; a < r_end * 8; a += NTHREADS) {
        const int e = EIDX[a];
        SORT[off[e] + base[e] + RANK[a]] = a;
    }
    __syncthreads();
}

constexpr int MOE_STG = 40960;
constexpr int MOE_HT = 86016;
constexpr int MOE_INFO = MOE_HT + 65536;
DI int swz64(int row, int chunk) { return row * 64 + ((chunk ^ ((0 - (row >> 2)) & 3)) << 4); }

DI void phase_convert_experts(const Params& p0, int l) {
    const Params p = launder(p0); l = launder_s(l);
    unsigned char* IMG = p.ws + WS_WIMG + (size_t)l * (NEXP + 1) * IMG_PER_E * IMG_BYTES;
    constexpr int NSLICE = (NEXP + 1) * IMG_PER_E * 4;
    const int G = gridDim.x, bid = bid_(), t = tid_();
    const int mine = (NSLICE - bid + G - 1) / G;
    const int done = ((const int*)(p.ws + WS_CONVDONE))[l * 1024 + bid];
    for (int i = done; i < mine; ++i) {
        const int sj = bid + G * i, u = sj >> 2, qd = sj & 3, e = u / IMG_PER_E, im = u % IMG_PER_E;
        const int row = t >> 2, chunk = t & 3, np = 128 * qd + row;
        const float* src; int ldw;
        if (im < 32) { const float* W = e < NEXP ? p.w_egu + ((size_t)l * NEXP + e) * DM * 512 : p.w_sgu + (size_t)l * DM * 512; ldw = 512;
            src = W + (size_t)(im * 32 + chunk * 8) * 512 + (((np >> 4) & 1) * 256 + (np >> 5) * 16 + (np & 15)); }
        else { const float* W = e < NEXP ? p.w_edn + ((size_t)l * NEXP + e) * 256 * DM : p.w_sdn + (size_t)l * 256 * DM; ldw = DM;
            src = W + (size_t)(((im - 32) & 7) * 32 + chunk * 8) * DM + ((im - 32) >> 3) * 512 + np; }
        float f[8];
#pragma unroll
        for (int kk = 0; kk < 8; ++kk) f[kk] = src[(size_t)kk * ldw];
        const u32x4 w = {pk_bf16(f[0], f[1]), pk_bf16(f[2], f[3]), pk_bf16(f[4], f[5]), pk_bf16(f[6], f[7])};
        *(u32x4*)(IMG + (size_t)u * IMG_BYTES + (size_t)np * 64 + ((chunk ^ ((0 - (np >> 2)) & 3)) << 4)) = w;
    }
}

DI void moe_unit(const Params& p, const unsigned char* img, bf16_t* outbase, bool shared, int r0, int nr, LAS unsigned char* lds) {
    const int t = tid_(), lane = t & 63, wid = __builtin_amdgcn_readfirstlane(t >> 6), fr = lane & 15, fq = lane >> 4, wn = wid & 3, wt = wid >> 2;
    const bf16_t* TOK = (const bf16_t*)(p.ws + WS_TOK);
    const int* SORT = (const int*)(p.ws + WS_SORT);
    LAS int* rowout = (LAS int*)(lds + MOE_INFO);
    const int arow = t >> 2;
    int atok = 0, aout = -1;
    if (arow < nr) { if (shared) { atok = r0 + arow; aout = atok; } else { aout = SORT[r0 + arow]; atok = aout >> 3; } }
    const bf16_t* aptr = TOK + (size_t)atok * DM + (((t & 3) ^ ((0 - (arow >> 2)) & 3)) << 3);
    __syncthreads();
    if ((t & 3) == 0) rowout[arow] = aout;
    const unsigned char* wsrc = img + (size_t)t * 16;
    const int adst = wid * 1024, wdst = 8192 + wid * 1024;
#define MOE_ISSUE1(S, KT) do { LAS unsigned char* _s = lds + (S) * MOE_STG; dma16(aptr + (KT) * 32, _s + adst); \
        const unsigned char* _w = wsrc + (size_t)(KT) * IMG_BYTES; \
        dma16(_w, _s + wdst); dma16(_w + 8192, _s + wdst + 8192); dma16(_w + 16384, _s + wdst + 16384); dma16(_w + 24576, _s + wdst + 24576); } while (0)
#define MOE_ISSUE2(S, IM) do { LAS unsigned char* _s = lds + (S) * IMG_BYTES; const unsigned char* _w = wsrc + (size_t)(IM) * IMG_BYTES; \
        dma16(_w, _s + adst); dma16(_w + 8192, _s + adst + 8192); dma16(_w + 16384, _s + adst + 16384); dma16(_w + 24576, _s + adst + 24576); } while (0)
    f32x4 acc[8][4];
#pragma unroll
    for (int nf = 0; nf < 8; ++nf)
#pragma unroll
        for (int tf = 0; tf < 4; ++tf) acc[nf][tf] = (f32x4){0.f, 0.f, 0.f, 0.f};
    MOE_ISSUE1(0, 0);
    MOE_ISSUE1(1, 1);
    int st = 0;
    for (int kt = 0; kt < 32; ++kt) {
        if (kt < 31) WAIT_VM(5); else WAIT_VM(0);
        asm volatile("s_waitcnt lgkmcnt(0)" ::: "memory");
        __builtin_amdgcn_s_barrier();
        const int st2 = st == 0 ? 2 : st - 1;
        if (wt == 0) { if (kt < 30) MOE_ISSUE1(st2, kt + 2); else if (kt == 31) MOE_ISSUE2(0, 32); }
        LAS unsigned char* S = lds + st * MOE_STG;
        bf16x8 tfr[4];
#pragma unroll
        for (int tf = 0; tf < 4; ++tf) tfr[tf] = *(LAS bf16x8*)(S + swz64(wt * 64 + tf * 16 + fr, fq));
#pragma unroll
        for (int nf = 0; nf < 8; ++nf) {
            const bf16x8 wf = *(LAS bf16x8*)(S + 8192 + swz64(wn * 128 + nf * 16 + fr, fq));
#pragma unroll
            for (int tf = 0; tf < 4; ++tf) acc[nf][tf] = MFMA16(wf, tfr[tf], acc[nf][tf]);
            if (nf == 3 && wt == 1) { if (kt < 30) MOE_ISSUE1(st2, kt + 2); else if (kt == 31) MOE_ISSUE2(0, 32); }
        }
        st = st == 2 ? 0 : st + 1;
    }
#pragma unroll
    for (int i = 0; i < 4; ++i)
#pragma unroll
        for (int tf = 0; tf < 4; ++tf) {
            float hv[4];
#pragma unroll
            for (int j = 0; j < 4; ++j) hv[j] = silu_f(acc[2 * i][tf][j]) * acc[2 * i + 1][tf][j];
            const int tok = wt * 64 + tf * 16 + fr, hc = wn * 64 + i * 16 + 4 * fq;
            const u32x2 w = {pk_bf16(hv[0], hv[1]), pk_bf16(hv[2], hv[3])};
            *(LAS u32x2*)(lds + MOE_HT + tok * 512 + (((hc >> 3) ^ (tok & 15)) << 4) + (hc & 7) * 2) = w;
        }
#pragma unroll 1
    for (int nc = 0; nc < 2; ++nc) {
#pragma unroll
        for (int nf = 0; nf < 8; ++nf)
#pragma unroll
            for (int tf = 0; tf < 4; ++tf) acc[nf][tf] = (f32x4){0.f, 0.f, 0.f, 0.f};
        if (nc == 1) MOE_ISSUE2(0, 40);
        for (int kt = 0; kt < 8; ++kt) {
            WAIT_VM(0);
            asm volatile("s_waitcnt lgkmcnt(0)" ::: "memory");
            __builtin_amdgcn_s_barrier();
            if (wt == 0 && kt < 7) MOE_ISSUE2((kt + 1) & 1, 32 + nc * 8 + kt + 1);
            LAS unsigned char* S = lds + (kt & 1) * IMG_BYTES;
            bf16x8 tfr[4];
#pragma unroll
            for (int tf = 0; tf < 4; ++tf) { const int tok = wt * 64 + tf * 16 + fr; tfr[tf] = *(LAS bf16x8*)(lds + MOE_HT + tok * 512 + (((kt * 4 + fq) ^ (tok & 15)) << 4)); }
#pragma unroll
            for (int nf = 0; nf < 8; ++nf) {
                const bf16x8 wf = *(LAS bf16x8*)(S + swz64(wn * 128 + nf * 16 + fr, fq));
#pragma unroll
                for (int tf = 0; tf < 4; ++tf) acc[nf][tf] = MFMA16(wf, tfr[tf], acc[nf][tf]);
                if (nf == 3 && wt == 1 && kt < 7) MOE_ISSUE2((kt + 1) & 1, 32 + nc * 8 + kt + 1);
            }
        }
        __syncthreads();
        LAS unsigned char* W = lds + wid * 9216;
#pragma unroll
        for (int half = 0; half < 2; ++half) {
#pragma unroll
            for (int nh = 0; nh < 4; ++nh)
#pragma unroll
                for (int tf = 0; tf < 4; ++tf) {
                    const f32x4 v = acc[half * 4 + nh][tf];
                    const u32x2 w = {pk_bf16(v[0], v[1]), pk_bf16(v[2], v[3])};
                    *(LAS u32x2*)(W + (tf * 16 + fr) * 144 + nh * 32 + fq * 8) = w;
                }
#pragma unroll
            for (int it = 0; it < 8; ++it) {
                const int row = it * 8 + (lane >> 3), ch = lane & 7;
                const u32x4 v = *(LAS u32x4*)(W + row * 144 + ch * 16);
                const int ro = rowout[wt * 64 + row];
                if (ro >= 0) *(u32x4*)(outbase + (size_t)ro * DM + nc * 512 + wn * 128 + half * 64 + ch * 8) = v;
            }
        }
        __syncthreads();
    }
#undef MOE_ISSUE1
#undef MOE_ISSUE2
}

DI void phase_moe(const Params& p0, int l, LAS unsigned char* lds) {
    const Params p = launder(p0); l = launder_s(l);
    const int* TILES = (const int*)(p.ws + WS_TILES);
    const int ntl = *((const int*)(p.ws + CTL_NTILES) + l);
    const int G = gridDim.x, bid = bid_();
    int vcu = bid;
    if (p.ph_hi - p.ph_lo > 1) {
        volatile LAS unsigned* bst = (volatile LAS unsigned*)(lds + LDS_BYTES - 16);
        const unsigned xc = bst[2]; unsigned pre = 0;
        for (unsigned j = 0; j < 16; ++j) { const unsigned c = xb_ld((unsigned*)(p.ws + WS_CTL) + XB_XCNT(j)); pre += (j < xc) ? c : 0u; }
        vcu = (int)(pre + bst[3]);
    }
    const int total = ntl + MROWS / 128;
    const unsigned char* IMG = p.ws + WS_WIMG + (size_t)l * (NEXP + 1) * IMG_PER_E * IMG_BYTES;
    for (int u = vcu; u < total; u += G) {
        if (u < ntl) {
            const int e = TILES[u * 4], r0 = TILES[u * 4 + 1], nr = TILES[u * 4 + 2];
            moe_unit(p, IMG + (size_t)e * IMG_PER_E * IMG_BYTES, (bf16_t*)(p.ws + WS_YSLOT), false, r0, nr, lds);
        } else {
            const int tm = u - ntl;
            if (l == 1 && (tm % (NT / 128)) < 2) continue;
            moe_unit(p, IMG + (size_t)NEXP * IMG_PER_E * IMG_BYTES, (bf16_t*)(p.ws + WS_YSH), true, tm * 128, 128, lds);
        }
    }
}

DI void phase_combine(const Params& p0, int l) {
    const Params p = launder(p0); l = launder_s(l);
    const float* X1 = (const float*)(p.ws + WS_XB); float* Xnext = (float*)(p.ws + WS_XA);
    const int lane = tid_() & 63, wid = tid_() >> 6;
    const bf16_t* YSL = (const bf16_t*)(p.ws + WS_YSLOT); const bf16_t* YSH = (const bf16_t*)(p.ws + WS_YSH);
    const float* GATE = (const float*)(p.ws + WS_GATE);
    const float* modv = (const float*)(p.ws + WS_MODV);
    const float* lg = p.ln_g + (size_t)(l * 2 + 1) * DM; const float* lb = p.ln_b + (size_t)(l * 2 + 1) * DM;
    bf16_t* H = (bf16_t*)(p.ws + WS_H);
    for (int r = bid_() * 8 + wid; r < MROWS; r += gridDim.x * 8) {
        const int b = r >= NT, pp = r - b * NT;
        if (l == 1 && pp < NCTX) continue;
        const int sel = pp < NCTX ? 2 : b;
        float gt[8];
#pragma unroll
        for (int k = 0; k < 8; ++k) gt[k] = GATE[(size_t)r * 8 + k];
        const float* g5 = modv + ((size_t)l * 3 + sel) * 6144 + 5 * 1024;
        f32x4 v[4];
        u32x2 sl[4][9]; f32x4 xv4[4];
#pragma unroll
        for (int i = 0; i < 4; ++i) {
            const int c = lane * 4 + i * 256;
            sl[i][8] = *(const u32x2*)(YSH + (size_t)r * DM + c);
#pragma unroll
            for (int k = 0; k < 8; ++k) sl[i][k] = *(const u32x2*)(YSL + ((size_t)r * 8 + k) * DM + c);
            xv4[i] = *(const f32x4*)(X1 + (size_t)r * DM + c);
        }
#pragma unroll
        for (int i = 0; i < 4; ++i) {
            const int c = lane * 4 + i * 256;
            float f0 = bf_lo(sl[i][8][0]), f1 = bf_hi(sl[i][8][0]), f2 = bf_lo(sl[i][8][1]), f3 = bf_hi(sl[i][8][1]);
#pragma unroll
            for (int k = 0; k < 8; ++k) { const u32x2 w = sl[i][k]; f0 += gt[k] * bf_lo(w[0]); f1 += gt[k] * bf_hi(w[0]); f2 += gt[k] * bf_lo(w[1]); f3 += gt[k] * bf_hi(w[1]); }
            const f32x4 xv = xv4[i], gv = *(const f32x4*)(g5 + c);
            v[i] = (f32x4){DN_ALPHA * xv[0] + gv[0] * f0, DN_ALPHA * xv[1] + gv[1] * f1, DN_ALPHA * xv[2] + gv[2] * f2, DN_ALPHA * xv[3] + gv[3] * f3};
        }
        float mu, rstd; ln_stats(v, mu, rstd);
#pragma unroll
        for (int i = 0; i < 4; ++i) {
            const int c = lane * 4 + i * 256;
            const f32x4 gg = *(const f32x4*)(lg + c), bb = *(const f32x4*)(lb + c);
#pragma unroll
            for (int j = 0; j < 4; ++j) v[i][j] = (v[i][j] - mu) * rstd * gg[j] + bb[j];
            if (l == 1) *(f32x4*)(p.out + ((size_t)b * NLAT + (pp - NCTX)) * DM + c) = v[i];
            else *(f32x4*)(Xnext + (size_t)r * DM + c) = v[i];
        }
        if (l == 0) { const float* mv = modv + ((size_t)1 * 3 + sel) * 6144; modulate_store(v, mv, mv + 1024, H + (size_t)r * DM, lane); }
    }
}

constexpr int PH_PER_LAYER = 11, N_PHASES = 3 + 2 * PH_PER_LAYER;
__global__ void __launch_bounds__(NTHREADS, 2) mega(Params p) {
    extern __shared__ __attribute__((aligned(16))) unsigned char lds_raw[];
    LAS unsigned char* lds = (LAS unsigned char*)lds_raw;
    volatile LAS unsigned* bst = (volatile LAS unsigned*)(lds + LDS_BYTES - 16);
    if (PROBE_ID != 0 && threadIdx.x == 0) { PRB_WORDS(lds)[0] = 0ull; PRB_WORDS(lds)[1] = 0ull; }
    if (threadIdx.x == 0) { bst[0] = 0u; bst[1] = 0u; const unsigned xc = xb_xcc_id(); bst[2] = xc; bst[3] = xb_add((unsigned*)(p.ws + CTL_XRANK) + xc, 1u); }
    __syncthreads();
    const int lo = p.ph_lo, hi = p.ph_hi;
    XcdBarrier bar; bar.bar = (unsigned*)(p.ws + WS_CTL); bar.x = 0; bar.st = bst;
    if (hi - lo > 1) bar = xcd_barrier_post((unsigned*)(p.ws + WS_CTL), bst);
#ifndef ONLY_PHASE
#define ONLY_PHASE -1
#endif
#define IN(k) (lo <= (k) && (k) < hi)
#define ON(pid) (ONLY_PHASE < 0 || ONLY_PHASE == (pid))
#ifndef DUP_PHASE
#define DUP_PHASE -1
#endif
#define REP(pid) for (int rep_ = 0; rep_ < ((DUP_PHASE == (pid)) ? 2 : 1); ++rep_)
#define SEAM(k) do { if (IN(k) && IN((k) + 1)) xcd_barrier(bar); } while (0)
    PRB_T0(100, lds); if (ON(0) && IN(0)) REP(0) { phase_convert(p, lds); } PRB_T1(100, lds);
    PRB_T0(200, lds); SEAM(0); PRB_T1(200, lds);
    PRB_T0(101, lds); if (ON(1) && IN(1)) REP(1) phase_mod(p, lds); PRB_T1(101, lds);
    PRB_T0(201, lds); SEAM(1); PRB_T1(201, lds);
    PRB_T0(102, lds); if (ON(2) && IN(2)) REP(2) phase_ln0(p); PRB_T1(102, lds);
    PRB_T0(202, lds); SEAM(2); PRB_T1(202, lds);
    for (int l = 0; l < 2; ++l) {
        const int k0 = 3 + l * PH_PER_LAYER;
        PRB_T0(103, lds); if (ON(3) && IN(k0 + 0)) REP(3) phase_inproj(p, l, lds); PRB_T1(103, lds);
        PRB_T0(203, lds); SEAM(k0 + 0); PRB_T1(203, lds);
        PRB_T0(104, lds); if (ON(4) && IN(k0 + 1)) REP(4) phase_ret_sum_pool(p, l, lds); PRB_T1(104, lds);
        PRB_T0(204, lds); SEAM(k0 + 1); PRB_T1(204, lds);
        PRB_T0(105, lds); if (ON(5) && IN(k0 + 2)) REP(5) phase_ret_scan(p, l); PRB_T1(105, lds);
        PRB_T0(205, lds); SEAM(k0 + 2); PRB_T1(205, lds);
        PRB_T0(106, lds); if (ON(6) && IN(k0 + 3)) REP(6) { phase_attn(p, l, lds); phase_ret(p, l); } PRB_T1(106, lds);
        PRB_T0(206, lds); SEAM(k0 + 3); PRB_T1(206, lds);
        PRB_T0(107, lds); if (ON(7) && IN(k0 + 4)) REP(7) phase_outproj(p, l, lds); PRB_T1(107, lds);
        PRB_T0(207, lds); SEAM(k0 + 4); PRB_T1(207, lds);
        PRB_T0(108, lds); if (ON(8) && IN(k0 + 5)) REP(8) phase_ln_mid(p, l); PRB_T1(108, lds);
        PRB_T0(208, lds); SEAM(k0 + 5); PRB_T1(208, lds);
        PRB_T0(109, lds); if (ON(9) && IN(k0 + 6)) REP(9) phase_router(p, l, lds); PRB_T1(109, lds);
        PRB_T0(209, lds); SEAM(k0 + 6); PRB_T1(209, lds);
        PRB_T0(110, lds); if (ON(10) && IN(k0 + 7)) REP(10) phase_topk(p, l, lds); PRB_T1(110, lds);
        PRB_T0(210, lds); SEAM(k0 + 7); PRB_T1(210, lds);
        PRB_T0(111, lds); if (ON(11) && IN(k0 + 8)) REP(11) { phase_scatter(p, l, lds); phase_convert_experts(p, l); } PRB_T1(111, lds);
        PRB_T0(211, lds); SEAM(k0 + 8); PRB_T1(211, lds);
        PRB_T0(112, lds); if (ON(12) && IN(k0 + 9)) REP(12) phase_moe(p, l, lds); PRB_T1(112, lds);
        PRB_T0(212, lds); SEAM(k0 + 9); PRB_T1(212, lds);
        PRB_T0(114, lds); if (ON(14) && IN(k0 + 10)) REP(14) phase_combine(p, l); PRB_T1(114, lds);
        if (l == 0) SEAM(k0 + 10);
    }
#undef IN
#undef SEAM
    if (PROBE_ID != 0 && threadIdx.x == 0 && blockIdx.x == 0) {
        const unsigned long long t0 = __builtin_readcyclecounter(), span = PRB_WORDS(lds)[1] * PROBE_GAIN;
        while (__builtin_readcyclecounter() - t0 < span) __builtin_amdgcn_s_sleep(8);
    }
}

extern "C" void kernel_launch(void* const* d_in, const int* in_sizes, int n_in, void* d_out, int out_size, void* d_ws, size_t ws_size, hipStream_t stream) {
    static int grid = 0;
    if (grid == 0) {
        if (n_in != 20 || ws_size < WS_END || out_size != NB * NLAT * DM) { fprintf(stderr, "kernel_launch: unexpected shapes (n_in %d, ws %zu need %zu, out %d)\n", n_in, ws_size, (size_t)WS_END, out_size); grid = -1; return; }
        int dev = 0, cus = 0, per_cu = 0;
        hipGetDevice(&dev); hipDeviceGetAttribute(&cus, hipDeviceAttributeMultiprocessorCount, dev);
        if (hipFuncSetAttribute((const void*)mega, hipFuncAttributeMaxDynamicSharedMemorySize, LDS_BYTES) != hipSuccess) { fprintf(stderr, "kernel_launch: hipFuncSetAttribute failed\n"); grid = -1; return; }
        if (hipOccupancyMaxActiveBlocksPerMultiprocessor(&per_cu, (const void*)mega, NTHREADS, LDS_BYTES) != hipSuccess || per_cu < 1) { fprintf(stderr, "kernel_launch: occupancy query says %d\n", per_cu); }
        (void)hipGetLastError();
        grid = cus > 0 ? cus : 256;
    }
    if (grid < 0) return;
    hipMemsetAsync((char*)d_ws + WS_CTL, 0, CTL_BYTES, stream);
    Params p{};
    p.x = (const float*)d_in[0]; p.c = (const float*)d_in[1]; p.ctx = (const float*)d_in[2]; p.c_ctx = (const float*)d_in[3];
    p.w_mod = (const float*)d_in[4]; p.b_mod = (const float*)d_in[5]; p.w_in = (const float*)d_in[6]; p.w_out = (const float*)d_in[7];
    p.diff_lambda = (const float*)d_in[8]; p.pool_w = (const float*)d_in[9]; p.pool_scale = (const float*)d_in[10]; p.ret_log_decay = (const float*)d_in[11];
    p.ln_g = (const float*)d_in[12]; p.ln_b = (const float*)d_in[13]; p.w_router = (const float*)d_in[14]; p.router_bias = (const float*)d_in[15];
    p.w_egu = (const float*)d_in[16]; p.w_edn = (const float*)d_in[17]; p.w_sgu = (const float*)d_in[18]; p.w_sdn = (const float*)d_in[19];
    p.out = (float*)d_out; p.ws = (unsigned char*)d_ws;
#if N_LAUNCH_PER_PHASE
    for (int k = 0; k < N_PHASES; ++k) { p.ph_lo = k; p.ph_hi = k + 1; hipLaunchKernelGGL(mega, dim3(grid), dim3(NTHREADS), LDS_BYTES, stream, p); }
#else
    p.ph_lo = 0; p.ph_hi = N_PHASES;
    hipLaunchKernelGGL(mega, dim3(grid), dim3(NTHREADS), LDS_BYTES, stream, p);
#endif
}
```

```cpp
#include <hip/hip_runtime.h>
#include <stdint.h>
#include <stdio.h>

#ifndef N_LAUNCH_PER_PHASE
#define N_LAUNCH_PER_PHASE 0
#endif

#define LAS __attribute__((address_space(3)))
#define DI __device__ __forceinline__
typedef unsigned short bf16_t;
typedef short bf16x8 __attribute__((ext_vector_type(8)));
typedef float f32x2 __attribute__((ext_vector_type(2)));
typedef float f32x4 __attribute__((ext_vector_type(4)));
typedef float f32x16 __attribute__((ext_vector_type(16)));
typedef unsigned u32x2 __attribute__((ext_vector_type(2)));
typedef unsigned u32x4 __attribute__((ext_vector_type(4)));
typedef __bf16 bf16v2 __attribute__((ext_vector_type(2)));

constexpr int NB = 2, NLAT = 8192, NCTX = 256, NT = NLAT + NCTX  , MROWS = NB * NT  ;
constexpr int DM = 1024, INW = 2816, NEXP = 256, TOPK = 8, NASG = MROWS * TOPK  ;
constexpr int NCHUNK = NT / 128;
constexpr float DN_ALPHA = 1.41421356237f;
constexpr float LN_EPS = 1e-6f, RMS_EPS = 1e-5f;
constexpr float LOG2E = 1.44269504089f;
constexpr float QSCALE = 0.125f * LOG2E;
constexpr int NTHREADS = 512;
constexpr int LDS_BYTES = 163840;

constexpr int IMG_BYTES = 32768, IMG_PER_E = 48;
constexpr int C_DQ = 0, C_DK = 512, C_DV = 1024, C_PU = 1536, C_RQ = 1792, C_RK = 2048, C_RV = 2304, C_RG = 2560;

constexpr size_t al256(size_t x) { return (x + 255) & ~(size_t)255; }
constexpr size_t WS_CTL = 0;
constexpr size_t CTL_BYTES = 65536;
constexpr size_t CTL_COUNTS = 16384;
constexpr size_t CTL_CURSOR = CTL_COUNTS + 2048;
constexpr size_t CTL_NTILES = CTL_CURSOR + 2048;
constexpr size_t CTL_XRANK = CTL_NTILES + 256;
constexpr size_t WS_MODV = WS_CTL + CTL_BYTES;
constexpr size_t WS_ROPE = al256(WS_MODV + 2 * 3 * 6144 * 4);
constexpr size_t WS_SCAL = al256(WS_ROPE + 128 * 16 * 8);
constexpr size_t WS_WIN = al256(WS_SCAL + 2 * 16 * 4);
constexpr size_t WS_WOUT = al256(WS_WIN + (size_t)2 * INW * DM * 2);
constexpr size_t WS_WR = al256(WS_WOUT + (size_t)2 * DM * DM * 2);
constexpr size_t WS_WIMG = al256(WS_WR + (size_t)2 * 256 * DM * 2);
constexpr size_t WS_XA = al256(WS_WIMG + (size_t)2 * 257 * 48 * 32768);
constexpr size_t WS_XB = al256(WS_XA + (size_t)MROWS * DM * 4);
constexpr size_t WS_V1 = al256(WS_XB + (size_t)MROWS * DM * 4);
constexpr size_t WS_H = al256(WS_V1 + (size_t)MROWS * DM * 4);
constexpr size_t WS_TOK = al256(WS_H + (size_t)MROWS * DM * 2);
constexpr size_t WS_P = al256(WS_TOK + (size_t)MROWS * DM * 2);
constexpr size_t WS_VT = al256(WS_P + (size_t)MROWS * INW * 2);
constexpr size_t WS_RKT = al256(WS_VT + (size_t)NB * 4 * 128 * NT * 2);
constexpr size_t WS_RVT = al256(WS_RKT + (size_t)NB * 4 * 64 * NT * 2);
constexpr size_t WS_MIX = al256(WS_RVT + (size_t)NB * 4 * 64 * NT * 2);
constexpr size_t ST_BYTES = (size_t)NB * 4 * NCHUNK * 4096 * 4;
constexpr size_t WS_UF = al256(WS_MIX + (size_t)MROWS * DM * 2);
constexpr size_t WS_UB = al256(WS_UF + ST_BYTES);
constexpr size_t WS_SF = al256(WS_UB + ST_BYTES);
constexpr size_t WS_SB = al256(WS_SF + ST_BYTES);
constexpr size_t WS_LOGIT = al256(WS_SB + ST_BYTES);
constexpr size_t WS_EIDX = al256(WS_LOGIT + (size_t)MROWS * 256 * 4);
constexpr size_t WS_GATE = al256(WS_EIDX + (size_t)NASG * 4);
constexpr size_t WS_SORT = al256(WS_GATE + (size_t)NASG * 4);
constexpr size_t WS_RANK = al256(WS_SORT + (size_t)NASG * 4);
constexpr size_t WS_HIST = al256(WS_RANK + (size_t)NASG * 4);
constexpr size_t WS_CONVDONE = al256(WS_HIST + (size_t)1024 * 256 * 4);
constexpr size_t WS_TILES = al256(WS_CONVDONE + 2 * 1024 * 4);
constexpr size_t WS_YSLOT = al256(WS_TILES + 2048 * 16);
constexpr size_t WS_YSH = al256(WS_YSLOT + (size_t)NASG * DM * 2);
constexpr size_t WS_END = al256(WS_YSH + (size_t)MROWS * DM * 2);

struct Params {
    const float *x, *c, *ctx, *c_ctx, *w_mod, *b_mod, *w_in, *w_out, *diff_lambda, *pool_w, *pool_scale, *ret_log_decay, *ln_g, *ln_b,
        *w_router, *router_bias, *w_egu, *w_edn, *w_sgu, *w_sdn;
    float* out;
    unsigned char* ws;
    int ph_lo, ph_hi;
};


DI Params launder(const Params& a) {
    size_t z = 0; asm volatile("" : "+s"(z));
    Params r = a;
#define LND(f) r.f = (decltype(r.f))((const unsigned char*)a.f + z)
    LND(x); LND(c); LND(ctx); LND(c_ctx); LND(w_mod); LND(b_mod); LND(w_in); LND(w_out); LND(diff_lambda); LND(pool_w); LND(pool_scale); LND(ret_log_decay); LND(ln_g); LND(ln_b);
    LND(w_router); LND(router_bias); LND(w_egu); LND(w_edn); LND(w_sgu); LND(w_sdn);
#undef LND
    r.out = (float*)((unsigned char*)a.out + z); r.ws = a.ws + z;
    return r;
}
DI int launder_s(int v) { asm volatile("" : "+s"(v)); return v; }
DI int tid_() { int t = threadIdx.x; asm volatile("" : "+v"(t)); return t; }
DI int bid_() { int t = blockIdx.x; asm volatile("" : "+s"(t)); return t; }


#ifndef PROBE_ID
#define PROBE_ID 0
#endif
#ifndef PROBE_GAIN
#define PROBE_GAIN 8
#endif
#define PRB_WORDS(lds) ((volatile LAS unsigned long long*)((lds) + LDS_BYTES - 64))
#define PRB_MATCH(id) (PROBE_ID == (id) || (PROBE_ID == 999 && (id) >= 200) || (PROBE_ID == 998 && ((id) == 101 || (id) == 102 || (id) == 104 || (id) == 105 || (id) == 108 || (id) == 109 || (id) == 110 || (id) == 111)))
#define PRB_T0(id, lds) do { if (PRB_MATCH(id) && threadIdx.x == 0 && blockIdx.x == 0) { PRB_WORDS(lds)[0] = __builtin_readcyclecounter(); } } while (0)
#define PRB_T1(id, lds) do { if (PRB_MATCH(id) && threadIdx.x == 0 && blockIdx.x == 0) { PRB_WORDS(lds)[1] += __builtin_readcyclecounter() - PRB_WORDS(lds)[0]; } } while (0)

#define XB_TMO      128
#define XB_XCNT(j)  (256  + 64 * (j))
#define XB_XSUB(j)  (1280 + 64 * (j))
#define XB_XGEN(j)  (2304 + 64 * (j))
#define XB_TOP      3328
#define XB_TOPGEN   3392
#define XCD_BAR_WORDS 3456
#define XB_SPIN_CAP (1u << 20)

__device__ __forceinline__ unsigned xb_ld(unsigned* p)              { return __hip_atomic_load(p, __ATOMIC_RELAXED, __HIP_MEMORY_SCOPE_AGENT); }
__device__ __forceinline__ unsigned xb_add(unsigned* p, unsigned v) { return __hip_atomic_fetch_add(p, v, __ATOMIC_RELAXED, __HIP_MEMORY_SCOPE_AGENT); }
__device__ __forceinline__ unsigned xb_xcc_id() { return (unsigned)__builtin_amdgcn_s_getreg((3 << 11) | 20) & 0xFu; }
#define XB_SPIN(cond, bar) do { unsigned _sp = 0; while (cond) { __builtin_amdgcn_s_sleep(1); \
    if ((++_sp & 255u) == 0u) { if (xb_ld(&(bar)[XB_TMO])) break; if (_sp > XB_SPIN_CAP) { atomicAdd(&(bar)[XB_TMO], 1u); break; } } } } while (0)

struct XcdBarrier { unsigned* bar; unsigned x; volatile LAS unsigned* st; };

__device__ __forceinline__ XcdBarrier xcd_barrier_post(unsigned* bar, volatile LAS unsigned* st) {
    XcdBarrier b; b.bar = bar; b.x = xb_xcc_id(); b.st = st;
    if (threadIdx.x == 0) (void)xb_add(&bar[XB_XCNT(b.x)], 1u);
    return b;
}
__device__ __forceinline__ void xcd_barrier_complete(unsigned* bar, unsigned x, unsigned& nloc, unsigned& nx) {
    const unsigned G = gridDim.x * gridDim.y * gridDim.z;
    unsigned sum, cnt, mine, sp = 0u;
    for (;;) {
        sum = 0u; cnt = 0u; mine = 0u;
#pragma unroll
        for (unsigned j = 0; j < 16; ++j) { const unsigned c = xb_ld(&bar[XB_XCNT(j)]); sum += c; cnt += (c > 0u) ? 1u : 0u; mine = (j == x) ? c : mine; }
        if (sum == G) break;
        __builtin_amdgcn_s_sleep(1);
        if ((++sp & 255u) == 0u) { if (xb_ld(&bar[XB_TMO])) break; if (sp > XB_SPIN_CAP) { atomicAdd(&bar[XB_TMO], 1u); break; } }
    }
    nloc = mine > 0u ? mine : 1u; nx = cnt > 0u ? cnt : 1u;
}
__device__ __forceinline__ void xcd_barrier(const XcdBarrier& b) {
    asm volatile("s_waitcnt vmcnt(0)" ::: "memory");
    __syncthreads();
    if (threadIdx.x == 0) {
        unsigned* bar = b.bar;
        __builtin_amdgcn_s_waitcnt(0);
        unsigned nloc = b.st[0], nx = b.st[1];
        if (nloc == 0u) { xcd_barrier_complete(bar, b.x, nloc, nx); b.st[0] = nloc; b.st[1] = nx; }
        const unsigned old = xb_add(&bar[XB_XSUB(b.x)], 1u);
        const unsigned gen = old / nloc;
        if (old + 1u == (gen + 1u) * nloc) {
            __builtin_amdgcn_fence(__ATOMIC_RELEASE, "agent");
            asm volatile("s_waitcnt vmcnt(0)" ::: "memory");
            const unsigned og = xb_add(&bar[XB_TOP], 1u);
            const unsigned tg = og / nx;
            if (og + 1u == (tg + 1u) * nx) xb_add(&bar[XB_TOPGEN], 1u);
            else XB_SPIN(xb_ld(&bar[XB_TOPGEN]) == tg, bar);
            __builtin_amdgcn_fence(__ATOMIC_ACQUIRE, "agent");
            xb_add(&bar[XB_XGEN(b.x)], 1u);
            asm volatile("s_waitcnt vmcnt(0)" ::: "memory");
        } else {
            XB_SPIN(xb_ld(&bar[XB_XGEN(b.x)]) == gen, bar);
            __builtin_amdgcn_fence(__ATOMIC_ACQUIRE, "agent");
            asm volatile("s_waitcnt vmcnt(0)" ::: "memory");
        }
    }
    __syncthreads();
}

DI unsigned pk_bf16(float a, float b) { f32x2 v = {a, b}; bf16v2 r = __builtin_convertvector(v, bf16v2); return __builtin_bit_cast(unsigned, r); }
DI bf16_t to_bf16(float a) { return (bf16_t)(pk_bf16(a, 0.f) & 0xffffu); }
DI float bf_lo(unsigned u) { return __uint_as_float(u << 16); }
DI float bf_hi(unsigned u) { return __uint_as_float(u & 0xffff0000u); }
DI float bf2f(bf16_t h) { return __uint_as_float(((unsigned)h) << 16); }
DI float wave_sum(float v) {
#pragma unroll
    for (int o = 32; o; o >>= 1) v += __shfl_xor(v, o);
    return v;
}
DI float fast_exp2(float x) { return __builtin_amdgcn_exp2f(x); }
DI float silu_f(float x) { return x / (1.f + __expf(-x)); }
DI bf16x8 as_bf16x8(u32x4 v) { return __builtin_bit_cast(bf16x8, v); }
#define WAIT_VM(n) asm volatile("s_waitcnt vmcnt(" #n ")" ::: "memory")
DI void dma16(const void* g, LAS unsigned char* l) { __builtin_amdgcn_global_load_lds(g, (LAS void*)l, 16, 0, 0); }
#define MFMA32(a, b, c) __builtin_amdgcn_mfma_f32_32x32x16_bf16((a), (b), (c), 0, 0, 0)
#define MFMA16(a, b, c) __builtin_amdgcn_mfma_f32_16x16x32_bf16((a), (b), (c), 0, 0, 0)

DI int row_sel(int r) { const int b = r >= NT; const int p = r - b * NT; return p < NCTX ? 2 : b; }

DI int swz_off(int row, int chunk) { return row * 128 + ((chunk ^ ((row >> 1) & 7)) << 4); }

DI int perm_gu(int n) { const int f = n >> 8, jj = n & 255; return ((jj >> 4) << 5) + (f << 4) + (jj & 15); }
DI void conv_unit(const float* src, int N, int K, bf16_t* dst, int k0, int n0, bool perm, LAS unsigned char* lds) {
    LAS float* tl = (LAS float*)lds;
    const int tid = tid_();
#pragma unroll
    for (int i = 0; i < 8; ++i) {
        const int kk = (tid >> 6) + 8 * i, nn = (tid & 63) * 4;
        const f32x4 v = *(const f32x4*)(src + (size_t)(k0 + kk) * N + n0 + nn);
        tl[kk * 257 + nn] = v[0]; tl[kk * 257 + nn + 1] = v[1]; tl[kk * 257 + nn + 2] = v[2]; tl[kk * 257 + nn + 3] = v[3];
    }
    __syncthreads();
    const int n = tid >> 1, kh = (tid & 1) * 32;
    const int nd = perm ? perm_gu(n0 + n) : (n0 + n);
    bf16_t* d = dst + (size_t)nd * K + k0 + kh;
#pragma unroll
    for (int q = 0; q < 4; ++q) {
        u32x4 w;
#pragma unroll
        for (int j = 0; j < 4; ++j) w[j] = pk_bf16(tl[(kh + q * 8 + 2 * j) * 257 + n], tl[(kh + q * 8 + 2 * j + 1) * 257 + n]);
        *(u32x4*)(d + q * 8) = w;
    }
    __syncthreads();
}

DI void phase_convert(const Params& p0, LAS unsigned char* lds) {
    const Params p = launder(p0);
    constexpr int U_IN = 176, U_OUT = 64, U_R = 16;
    constexpr int U_L = U_IN + U_OUT + U_R;
    for (int u = bid_(); u < 2 * U_L; u += gridDim.x) {
        const int l = u / U_L; int v = u % U_L;
        if (v < U_IN) { conv_unit(p.w_in + (size_t)l * DM * INW, INW, DM, (bf16_t*)(p.ws + WS_WIN) + (size_t)l * INW * DM, (v / 11) * 64, (v % 11) * 256, false, lds); continue; }
        v -= U_IN;
        if (v < U_OUT) { conv_unit(p.w_out + (size_t)l * DM * DM, DM, DM, (bf16_t*)(p.ws + WS_WOUT) + (size_t)l * DM * DM, (v / 4) * 64, (v % 4) * 256, false, lds); continue; }
        v -= U_OUT;
        conv_unit(p.w_router + (size_t)l * DM * 256, 256, DM, (bf16_t*)(p.ws + WS_WR) + (size_t)l * 256 * DM, v * 64, 0, false, lds);
    }
}

DI void phase_mod(const Params& p0, LAS unsigned char* lds) {
    const Params p = launder(p0);
    LAS float* sc = (LAS float*)lds;
    LAS float* red = sc + 3 * 1024;
    const int tid = tid_();
    float* modv = (float*)(p.ws + WS_MODV);
    for (int u = bid_(); u < 193; u += gridDim.x) {
        if (u == 192) {
            float* rope = (float*)(p.ws + WS_ROPE);
            for (int i = tid; i < 128 * 16; i += NTHREADS) {
                const int pos = i >> 4, f = i & 15;
                const float freq = powf(10000.0f, -(float)f / 16.0f);
                const float ang = (float)pos * freq;
                rope[2 * i] = cosf(ang); rope[2 * i + 1] = sinf(ang);
            }
            float* scal = (float*)(p.ws + WS_SCAL);
            if (tid < 2) {
                const int l = tid;
                const float* dl = p.diff_lambda + l * 256;
                float s01 = 0.f, s23 = 0.f;
                for (int i = 0; i < 64; ++i) { s01 += dl[i] * dl[64 + i]; s23 += dl[128 + i] * dl[192 + i]; }
                const float lambda_init = 0.8f - 0.6f * expf(-0.3f * (float)l);
                scal[l * 16 + 0] = expf(s01) - expf(s23) + lambda_init;
                scal[l * 16 + 1] = 1.0f - lambda_init;
                for (int h = 0; h < 4; ++h) {
                    scal[l * 16 + 2 + h] = -expf(p.ret_log_decay[l * 8 + h]) * LOG2E;
                    scal[l * 16 + 6 + h] = -expf(p.ret_log_decay[l * 8 + 4 + h]) * LOG2E;
                }
            }
            continue;
        }
        const int l = u / 96, n0 = (u % 96) * 64;
        for (int i = tid; i < 3 * 1024; i += NTHREADS) {
            const int s = i >> 10, k = i & 1023;
            const float v = s < 2 ? p.c[s * 1024 + k] : p.c_ctx[k];
            sc[i] = silu_f(v);
        }
        __syncthreads();
        const int kq = tid >> 6, nl = tid & 63;
        const float* w = p.w_mod + (size_t)l * DM * 6144 + n0 + nl;
        float a0 = 0.f, a1 = 0.f, a2 = 0.f;
        for (int k = kq * 128; k < kq * 128 + 128; ++k) {
            const float wv = w[(size_t)k * 6144];
            a0 += sc[k] * wv; a1 += sc[1024 + k] * wv; a2 += sc[2048 + k] * wv;
        }
        red[(kq * 3 + 0) * 64 + nl] = a0; red[(kq * 3 + 1) * 64 + nl] = a1; red[(kq * 3 + 2) * 64 + nl] = a2;
        __syncthreads();
        if (tid < 192) {
            const int s = tid >> 6, n = tid & 63;
            float v = 0.f;
            for (int q = 0; q < 8; ++q) v += red[(q * 3 + s) * 64 + n];
            modv[((size_t)l * 3 + s) * 6144 + n0 + n] = v + p.b_mod[l * 6144 + n0 + n];
        }
        __syncthreads();
    }
}

DI void ln_stats(const f32x4 (&v)[4], float& mu, float& rstd) {
    float s = 0.f;
#pragma unroll
    for (int i = 0; i < 4; ++i) s += (v[i][0] + v[i][1]) + (v[i][2] + v[i][3]);
    mu = wave_sum(s) * (1.0f / 1024.0f);
    float q = 0.f;
#pragma unroll
    for (int i = 0; i < 4; ++i)
#pragma unroll
        for (int j = 0; j < 4; ++j) { const float d = v[i][j] - mu; q += d * d; }
    rstd = rsqrtf(wave_sum(q) * (1.0f / 1024.0f) + LN_EPS);
}
DI void modulate_store(const f32x4 (&v)[4], const float* shift, const float* scale, bf16_t* dst, int lane) {
    float mu, rstd; ln_stats(v, mu, rstd);
#pragma unroll
    for (int i = 0; i < 4; ++i) {
        const int c = lane * 4 + i * 256;
        const f32x4 sh = *(const f32x4*)(shift + c), scv = *(const f32x4*)(scale + c);
        float o[4];
#pragma unroll
        for (int j = 0; j < 4; ++j) o[j] = (v[i][j] - mu) * rstd * (1.0f + scv[j]) + sh[j];
        u32x2 w = {pk_bf16(o[0], o[1]), pk_bf16(o[2], o[3])};
        *(u32x2*)(dst + c) = w;
    }
}

DI void phase_ln0(const Params& p0) {
    const Params p = launder(p0);
    const int lane = tid_() & 63, wid = tid_() >> 6;
    float* XA = (float*)(p.ws + WS_XA);
    bf16_t* H = (bf16_t*)(p.ws + WS_H);
    const float* modv = (const float*)(p.ws + WS_MODV);
    for (int r = bid_() * 8 + wid; r < MROWS; r += gridDim.x * 8) {
        const int b = r >= NT, pp = r - b * NT;
        const float* src = pp < NCTX ? p.ctx + ((size_t)b * NCTX + pp) * DM : p.x + ((size_t)b * NLAT + (pp - NCTX)) * DM;
        f32x4 v[4];
#pragma unroll
        for (int i = 0; i < 4; ++i) { v[i] = *(const f32x4*)(src + lane * 4 + i * 256); *(f32x4*)(XA + (size_t)r * DM + lane * 4 + i * 256) = v[i]; }
        const float* mv = modv + (size_t)(0 * 3 + (pp < NCTX ? 2 : b)) * 6144;
        modulate_store(v, mv, mv + 1024, H + (size_t)r * DM, lane);
    }
}

constexpr int G2_STG = 40960;
template <class Epi>
DI void gemm192(const bf16_t* A, int lda, const bf16_t* Bt, int ldb, int nk, int m0, int n0, LAS unsigned char* lds, const Epi& epi) {
    const int t = tid_(), lane = t & 63, wid = __builtin_amdgcn_readfirstlane(t >> 6), fr = lane & 15, fq = lane >> 4, wm = wid >> 1, wn = wid & 1;
    const bf16_t* asrc[3]; const bf16_t* bsrc[2];
#pragma unroll
    for (int i = 0; i < 3; ++i) { const int sl = t + 512 * i, row = sl >> 3, c = (sl & 7) ^ ((row >> 1) & 7); asrc[i] = A + (size_t)(m0 + row) * lda + c * 8; }
#pragma unroll
    for (int i = 0; i < 2; ++i) { const int sl = t + 512 * i, row = sl >> 3, c = (sl & 7) ^ ((row >> 1) & 7); bsrc[i] = Bt + (size_t)(n0 + row) * ldb + c * 8; }
    const int ddst = wid * 1024;
#define G2_ISSUE(S, KT) do { LAS unsigned char* _s = lds + (S) * G2_STG + ddst; const int _k = (KT) * 64; \
        dma16(asrc[0] + _k, _s); dma16(asrc[1] + _k, _s + 8192); dma16(asrc[2] + _k, _s + 16384); dma16(bsrc[0] + _k, _s + 24576); dma16(bsrc[1] + _k, _s + 32768); } while (0)
    f32x4 acc[4][3];
#pragma unroll
    for (int nf = 0; nf < 4; ++nf)
#pragma unroll
        for (int mf = 0; mf < 3; ++mf) acc[nf][mf] = (f32x4){0.f, 0.f, 0.f, 0.f};
    __syncthreads();
    G2_ISSUE(0, 0);
    if (nk > 1) G2_ISSUE(1, 1);
    int st = 0;
    for (int kt = 0; kt < nk; ++kt) {
        if (kt + 1 < nk) WAIT_VM(5); else WAIT_VM(0);
        asm volatile("s_waitcnt lgkmcnt(0)" ::: "memory");
        __builtin_amdgcn_s_barrier();
        const int st2 = st == 0 ? 2 : st - 1;
        if (kt + 2 < nk) G2_ISSUE(st2, kt + 2);
        LAS unsigned char* S = lds + st * G2_STG;
        st = st == 2 ? 0 : st + 1;
#pragma unroll
        for (int kk = 0; kk < 2; ++kk) {
            bf16x8 af[3], bfr[4];
#pragma unroll
            for (int mf = 0; mf < 3; ++mf) af[mf] = *(LAS bf16x8*)(S + swz_off(wm * 48 + mf * 16 + fr, kk * 4 + fq));
#pragma unroll
            for (int nf = 0; nf < 4; ++nf) bfr[nf] = *(LAS bf16x8*)(S + 24576 + swz_off(wn * 64 + nf * 16 + fr, kk * 4 + fq));
#pragma unroll
            for (int nf = 0; nf < 4; ++nf)
#pragma unroll
                for (int mf = 0; mf < 3; ++mf) acc[nf][mf] = MFMA16(bfr[nf], af[mf], acc[nf][mf]);
        }
    }
#undef G2_ISSUE
    __syncthreads();
    epi(acc, wm, wn, fr, fq, lane, wid);
}
DI LAS unsigned char* g2_stage(LAS unsigned char* lds, int wid) { return lds + wid * 13056; }

DI void phase_inproj(const Params& p0, int l, LAS unsigned char* lds) {
    const Params p = launder(p0); l = launder_s(l);
    const bf16_t* H = (const bf16_t*)(p.ws + WS_H);
    const bf16_t* W = (const bf16_t*)(p.ws + WS_WIN) + (size_t)l * INW * DM;
    bf16_t* P = (bf16_t*)(p.ws + WS_P);
    bf16_t* VT = (bf16_t*)(p.ws + WS_VT);
    bf16_t* RKT = (bf16_t*)(p.ws + WS_RKT);
    bf16_t* RVT = (bf16_t*)(p.ws + WS_RVT);
    const f32x2* rope = (const f32x2*)(p.ws + WS_ROPE);
    constexpr int NTN = INW / 128, NTM = MROWS / 192;
    for (int u = bid_(); u < NTM * NTN; u += gridDim.x) {
        const int tm = u / NTN, tn = u % NTN;
        auto epi = [&](f32x4 (&acc)[4][3], int wm, int wn, int fr, int fq, int lane, int wid) {
            const int c0 = tn * 128 + wn * 64;
            const int r0 = tm * 192 + wm * 48;
            LAS unsigned char* W_ = g2_stage(lds, wid);
            if (c0 < C_DV) {
                const float qs = c0 < C_DK ? QSCALE : 1.0f;
#pragma unroll
                for (int mf = 0; mf < 3; ++mf) {
                    const int row = r0 + mf * 16 + fr;
                    const int b = row >= NT, pp = row - b * NT;
                    const bool lat = pp >= NCTX;
                    const int tt = pp - NCTX;
#pragma unroll
                    for (int hb = 0; hb < 2; ++hb) {
                        const int axis = ((c0 >> 5) + hb) & 1;
                        const int pos = axis ? (tt & 63) : (tt >> 6);
#pragma unroll
                        for (int j = 0; j < 4; ++j) {
                            float x1 = acc[2 * hb][mf][j], x2 = acc[2 * hb + 1][mf][j];
                            if (lat) { const f32x2 cs = rope[pos * 16 + 4 * fq + j]; const float o1 = x1 * cs[0] - x2 * cs[1], o2 = x1 * cs[1] + x2 * cs[0]; x1 = o1; x2 = o2; }
                            acc[2 * hb][mf][j] = x1 * qs; acc[2 * hb + 1][mf][j] = x2 * qs;
                        }
                    }
                }
            } else if (c0 >= C_RK && c0 < C_RV) {
#pragma unroll
                for (int nf = 0; nf < 4; ++nf)
#pragma unroll
                    for (int mf = 0; mf < 3; ++mf) acc[nf][mf] *= 0.125f;
            }
#pragma unroll
            for (int nf = 0; nf < 4; ++nf)
#pragma unroll
                for (int mf = 0; mf < 3; ++mf) {
                    const f32x4 v = acc[nf][mf];
                    *(LAS u32x2*)(W_ + (mf * 16 + fr) * 144 + nf * 32 + fq * 8) = (u32x2){pk_bf16(v[0], v[1]), pk_bf16(v[2], v[3])};
                }
#pragma unroll
            for (int it = 0; it < 6; ++it) {
                const int row = it * 8 + (lane >> 3), ch = lane & 7;
                *(u32x4*)(P + (size_t)(r0 + row) * INW + c0 + ch * 8) = *(LAS u32x4*)(W_ + row * 144 + ch * 16);
            }
            const bool isv = c0 >= C_DV && c0 < C_PU, isk = c0 >= C_RK && c0 < C_RV, isr = c0 >= C_RV && c0 < C_RG;
            if (isv || isk || isr) {
                const int frp = isv ? ((fr & 3) | (((fr >> 2) == 1 ? 2 : ((fr >> 2) == 2 ? 1 : (fr >> 2))) << 2)) : fr;
                LAS bf16_t* T_ = (LAS bf16_t*)W_;
#pragma unroll
                for (int nf = 0; nf < 4; ++nf)
#pragma unroll
                    for (int mf = 0; mf < 3; ++mf)
#pragma unroll
                        for (int j = 0; j < 4; ++j) T_[(nf * 16 + 4 * fq + j) * 56 + mf * 16 + frp] = to_bf16(acc[nf][mf][j]);
                const int b = r0 >= NT, pp0 = r0 - b * NT;
                bf16_t* base; int nrows_per_head;
                if (isv) { const int cc = c0 - C_DV; base = VT + ((size_t)(b * 4 + (cc >> 7)) * 128 + (cc & 127)) * NT + pp0; }
                else if (isk) { const int cc = c0 - C_RK; base = RKT + ((size_t)(b * 4 + (cc >> 6)) * 64) * NT + pp0; }
                else { const int cc = c0 - C_RV; base = RVT + ((size_t)(b * 4 + (cc >> 6)) * 64) * NT + pp0; }
                (void)nrows_per_head;
#pragma unroll
                for (int it = 0; it < 6; ++it) {
                    const int sl = it * 64 + lane, n = sl / 6, pc = sl % 6;
                    *(u32x4*)(base + (size_t)n * NT + pc * 8) = *(LAS u32x4*)(W_ + n * 112 + pc * 16);
                }
            }
        };
        gemm192(H, DM, W, DM, DM / 64, tm * 192, tn * 128, lds, epi);
    }
}

DI void phase_ret_sum_pool(const Params& p0, int l, LAS unsigned char* lds) {
    const Params p = launder(p0); l = launder_s(l);
    const int tid = tid_(), lane = tid & 63, wid = tid >> 6, fr = lane & 15, g = lane >> 4;
    const float* scal = (const float*)(p.ws + WS_SCAL) + l * 16;
    const bf16_t* RKT = (const bf16_t*)(p.ws + WS_RKT);
    const bf16_t* RVT = (const bf16_t*)(p.ws + WS_RVT);
    float* UF = (float*)(p.ws + WS_UF);
    float* UB = (float*)(p.ws + WS_UB);
    for (int u = bid_(); u < NB * 4 * NCHUNK; u += gridDim.x) {
        const int c = u % NCHUNK, bh = u / NCHUNK, h = bh & 3;
        const int dir = wid >> 2, eb = wid & 3;
        const float l2 = dir ? scal[6 + h] : scal[2 + h];
        const bf16_t* vrow = RVT + ((size_t)bh * 64 + eb * 16 + fr) * NT + c * 128;
        f32x4 acc[4];
#pragma unroll
        for (int db = 0; db < 4; ++db) acc[db] = (f32x4){0.f, 0.f, 0.f, 0.f};
#pragma unroll
        for (int ks = 0; ks < 4; ++ks) {
            const int j0 = ks * 32 + 8 * g;
            const bf16x8 af = *(const bf16x8*)(vrow + j0);
            float w[8];
#pragma unroll
            for (int jj = 0; jj < 8; ++jj) { const int j = j0 + jj; w[jj] = fast_exp2((dir ? (float)j : (float)(127 - j)) * l2); }
#pragma unroll
            for (int db = 0; db < 4; ++db) {
                const u32x4 kr = *(const u32x4*)(RKT + ((size_t)bh * 64 + db * 16 + fr) * NT + c * 128 + j0);
                u32x4 kw;
#pragma unroll
                for (int q = 0; q < 4; ++q) kw[q] = pk_bf16(bf_lo(kr[q]) * w[2 * q], bf_hi(kr[q]) * w[2 * q + 1]);
                acc[db] = MFMA16(af, as_bf16x8(kw), acc[db]);
            }
        }
        const int cidx = dir ? (c >= 2 ? c - 2 : 64 + c) : c;
        float* U = (dir ? UB : UF) + ((size_t)bh * NCHUNK + cidx) * 4096;
#pragma unroll
        for (int db = 0; db < 4; ++db)
#pragma unroll
            for (int j = 0; j < 4; ++j) U[(eb * 16 + 4 * g + j) * 64 + db * 16 + fr] = acc[db][j];
    }
    LAS float* ul = (LAS float*)lds;
    LAS float* dT = ul + 48 * 256;
    LAS float* pwl = dT + 256 * 36;
    const bf16_t* P = (const bf16_t*)(p.ws + WS_P);
    bf16_t* MIX = (bf16_t*)(p.ws + WS_MIX);
    const float* pw = p.pool_w + (size_t)l * 4 * 64 * 64;
    const float* ps = p.pool_scale + l * 256;
    __syncthreads();
    if (bid_() < MROWS / 32) {
#pragma unroll
        for (int i = 0; i < 8; ++i) *(LAS f32x4*)(pwl + (tid + 512 * i) * 4) = *(const f32x4*)(pw + (tid + 512 * i) * 4);
    }
    for (int u = bid_(); u < MROWS / 32; u += gridDim.x) {
        const int r0 = u * 32;
        const int b = r0 >= NT, pp0 = r0 - b * NT;
        const int s0 = pp0 < NCTX ? b * NT : b * NT + NCTX, s1 = pp0 < NCTX ? b * NT + NCTX : (b + 1) * NT;
        __syncthreads();
        {
            u32x2 wv[6]; bool ok[6];
#pragma unroll
            for (int it = 0; it < 6; ++it) {
                const int i = tid + 512 * it, rr = i >> 6, c4 = (i & 63) * 4, row = r0 - 8 + rr;
                ok[it] = row >= s0 && row < s1;
                wv[it] = ok[it] ? *(const u32x2*)(P + (size_t)row * INW + C_PU + c4) : (u32x2){0u, 0u};
            }
#pragma unroll
            for (int it = 0; it < 6; ++it) {
                const int i = tid + 512 * it, rr = i >> 6, c4 = (i & 63) * 4;
                *(LAS f32x4*)(ul + rr * 256 + c4) = (f32x4){bf_lo(wv[it][0]), bf_hi(wv[it][0]), bf_lo(wv[it][1]), bf_hi(wv[it][1])};
            }
        }
        __syncthreads();
        {
            const int c = tid & 255, gi = c >> 6, rb = tid >> 8;
#define POOL_WIN(HW) do { _Pragma("unroll") for (int it = 0; it < 16; ++it) { const int rr = it * 2 + rb, row = r0 + rr; float sm = 0.f; \
                _Pragma("unroll") for (int q = -(HW); q < (HW); ++q) sm += ul[(rr + 8 + q) * 256 + c]; \
                const int lo = (row - (HW)) < s0 ? s0 : (row - (HW)), hi = (row + (HW)) > s1 ? s1 : (row + (HW)); \
                dT[c * 36 + rr] = sm / (float)(hi - lo) - ul[(rr + 8) * 256 + c]; } } while (0)
            if (gi == 0) POOL_WIN(1); else if (gi == 1) POOL_WIN(2); else if (gi == 2) POOL_WIN(4); else POOL_WIN(8);
#undef POOL_WIN
        }
        __syncthreads();
        {
            const int oc = tid & 255, rh = (tid >> 8) * 16, gi = oc >> 6, e = oc & 63;
            float acc[16];
#pragma unroll
            for (int i = 0; i < 16; ++i) acc[i] = 0.f;
#pragma unroll 8
            for (int c = 0; c < 64; ++c) {
                const float wv = pwl[(gi * 64 + c) * 64 + e];
                const LAS float* dr = dT + (gi * 64 + c) * 36 + rh;
#pragma unroll
                for (int i = 0; i < 4; ++i) { const f32x4 d = *(const LAS f32x4*)(dr + 4 * i); acc[4 * i] += d[0] * wv; acc[4 * i + 1] += d[1] * wv; acc[4 * i + 2] += d[2] * wv; acc[4 * i + 3] += d[3] * wv; }
            }
            const float sc = ps[oc];
#pragma unroll
            for (int i = 0; i < 16; ++i) MIX[(size_t)(r0 + rh + i) * DM + 512 + oc] = to_bf16(acc[i] * sc);
        }
    }
    __syncthreads();
}

DI void phase_ret_scan(const Params& p0, int l) {
    const Params p = launder(p0); l = launder_s(l);
    const float* scal = (const float*)(p.ws + WS_SCAL) + l * 16;
    const float* UF = (const float*)(p.ws + WS_UF); const float* UB = (const float*)(p.ws + WS_UB);
    bf16_t* SF = (bf16_t*)(p.ws + WS_SF); bf16_t* SB = (bf16_t*)(p.ws + WS_SB);
    for (int i = bid_() * NTHREADS + tid_(); i < 2 * NB * 4 * 4096; i += gridDim.x * NTHREADS) {
        const int dir = i / (NB * 4 * 4096), rem = i % (NB * 4 * 4096), bh = rem >> 12, el = rem & 4095, h = bh & 3;
        const float G = fast_exp2(128.0f * (dir ? scal[6 + h] : scal[2 + h]));
        float S = 0.f;
        if (dir == 0) {
#pragma unroll 11
            for (int c = 0; c < NCHUNK; ++c) { const size_t o = ((size_t)bh * NCHUNK + c) * 4096 + el; SF[o] = to_bf16(S); S = S * G + UF[o]; } }
        else {
#pragma unroll 11
            for (int c = NCHUNK - 1; c >= 0; --c) { const size_t o = ((size_t)bh * NCHUNK + c) * 4096 + el; SB[o] = to_bf16(S); S = S * G + UB[o]; } }
    }
}

DI void attn_unit(const Params& p, int l, int b, int h, int q_p0, int ntile, float lam, float oscale, int& conv_done, LAS unsigned char* lds) {
    const int tid = tid_(), lane = tid & 63, wid = __builtin_amdgcn_readfirstlane(tid >> 6), map = wid >> 2, wq = wid & 3, r = lane & 31, hh = lane >> 5;
    const bf16_t* P = (const bf16_t*)(p.ws + WS_P);
    const bf16_t* VT = (const bf16_t*)(p.ws + WS_VT);
    bf16_t* MIX = (bf16_t*)(p.ws + WS_MIX);
    const size_t rowbase = (size_t)b * NT;
    const int qrow = q_p0 + wq * 32 + r;
    bf16x8 qf[4];
#pragma unroll
    for (int ks = 0; ks < 4; ++ks) qf[ks] = *(const bf16x8*)(P + (rowbase + qrow) * INW + C_DQ + h * 128 + map * 64 + ks * 16 + hh * 8);
    constexpr int ASTG = 32768, CRING = 98304, CSLOT = 16384;
    const int t8 = tid & 255, w4 = wid & 3;
    const bf16_t* ksrc; const bf16_t* vsrc;
    { const int key = t8 >> 4, ph = t8 & 15, c = ph ^ (key & 15);
      ksrc = P + (rowbase + key) * INW + C_DK + h * 128 + c * 8;
      const int e = t8 >> 3, pv = t8 & 7, cv = pv ^ ((e >> 1) & 7);
      vsrc = VT + ((size_t)(b * 4 + h) * 128 + e) * NT + cv * 8; }
    const int ddst = w4 * 1024;
#define ATT_ISSUE(S, KT) do { LAS unsigned char* _s = lds + (S) * ASTG + ddst; const bf16_t* _k = ksrc + (size_t)(KT) * 64 * INW; const bf16_t* _v = vsrc + (KT) * 64; \
        _Pragma("unroll") for (int m = 0; m < 4; ++m) { dma16(_k + (size_t)m * 16 * INW, _s + m * 4096); dma16(_v + (size_t)m * 32 * NT, _s + 16384 + m * 4096); } } while (0)
    constexpr int NSLICE = (NEXP + 1) * IMG_PER_E * 4;
    const int G_ = gridDim.x, bidc = bid_();
    const int mine = (NSLICE - bidc + G_ - 1) / G_;
    const int lim = __builtin_amdgcn_readfirstlane((mine - conv_done) < (ntile - 2) ? ((mine - conv_done) < 0 ? 0 : (mine - conv_done)) : (ntile - 2));
    const int cbase = conv_done;
    conv_done += lim;
    unsigned char* IMGL = p.ws + WS_WIMG + (size_t)l * (NEXP + 1) * IMG_PER_E * IMG_BYTES;
#define CONV_SRC(SI, SRCP, LDW) do { const int _s = bidc + G_ * (cbase + (SI)); const int _u = _s >> 2, _qd = _s & 3, _e = _u / IMG_PER_E, _im = _u % IMG_PER_E; \
        const int _k = t8 >> 5, _np = 128 * _qd + 4 * (t8 & 31); \
        if (_im < 32) { const float* _W = _e < NEXP ? p.w_egu + ((size_t)l * NEXP + _e) * DM * 512 : p.w_sgu + (size_t)l * DM * 512; LDW = 512; \
            SRCP = _W + (size_t)(_im * 32 + _k) * 512 + (((_np >> 4) & 1) * 256 + (_np >> 5) * 16 + (_np & 15)); } \
        else { const float* _W = _e < NEXP ? p.w_edn + ((size_t)l * NEXP + _e) * 256 * DM : p.w_sdn + (size_t)l * 256 * DM; LDW = DM; \
            SRCP = _W + (size_t)(((_im - 32) & 7) * 32 + _k) * DM + ((_im - 32) >> 3) * 512 + _np; } } while (0)
    f32x16 o[4];
#pragma unroll
    for (int eb = 0; eb < 4; ++eb)
#pragma unroll
        for (int i = 0; i < 16; ++i) o[eb][i] = 0.f;
    f32x16 negm;
#pragma unroll
    for (int i = 0; i < 16; ++i) negm[i] = 0.f;
    float m_run = 0.f, l_run = 0.f;
#pragma unroll
    for (int ks = 0; ks < 4; ++ks) asm volatile("" : "+v"(qf[ks]));
    __syncthreads();
    if (map == 0) { ATT_ISSUE(0, 0); if (ntile > 1) ATT_ISSUE(1, 1); }
    int st = 0;
    for (int kt = 0; kt < ntile; ++kt) {
        PRB_T0(1, lds);
        const bool cproc = kt >= 2 && kt - 2 < lim;
        if (map == 0) { if (kt + 1 < ntile) WAIT_VM(8); else WAIT_VM(0); }
        else if (cproc) {
            const int n = (kt >= 4 ? 2 : 0) + (kt - 1 < lim ? 4 : 0) + (kt >= 3 ? 2 : 0);
            if (n == 8) WAIT_VM(8); else if (n == 6) WAIT_VM(6); else if (n == 4) WAIT_VM(4); else if (n == 2) WAIT_VM(2); else WAIT_VM(0);
        }
        asm volatile("s_waitcnt lgkmcnt(0)" ::: "memory");
        __builtin_amdgcn_s_barrier();
        PRB_T1(1, lds); PRB_T0(2, lds);
        const int st2 = st == 0 ? 2 : st - 1;
        if (map == 0) { if (kt + 2 < ntile) ATT_ISSUE(st2, kt + 2); }
        else if (kt < lim) {
            const float* srcp; int ldw; CONV_SRC(kt, srcp, ldw);
            LAS unsigned char* _d = lds + CRING + (kt % 3) * CSLOT + w4 * 1024;
#pragma unroll
            for (int m = 0; m < 4; ++m) dma16(srcp + (size_t)m * 8 * ldw, _d + m * 4096);
        }
        LAS unsigned char* L = lds + st * ASTG;
        st = st == 2 ? 0 : st + 1;
        bf16x8 kf[8], va[4], vb[4];
#pragma unroll
        for (int ks = 0; ks < 4; ++ks) {
            const int ch = map * 8 + ks * 2 + hh;
            const int off = r * 256 + ((ch ^ (r & 15)) << 4);
            kf[2 * ks] = *(LAS bf16x8*)(L + off);
            kf[2 * ks + 1] = *(LAS bf16x8*)(L + off + 32 * 256);
        }
#define ATT_VREAD(dst, S_) do { _Pragma("unroll") for (int eb = 0; eb < 4; ++eb) { const int e = eb * 32 + r; \
            dst[eb] = *(LAS bf16x8*)(L + 16384 + e * 128 + ((((S_) * 2 + hh) ^ ((e >> 1) & 7)) << 4)); } } while (0)
#define ATT_PACK(dst, SRC, B_) do { u32x4 _pw; _Pragma("unroll") for (int q = 0; q < 4; ++q) _pw[q] = pk_bf16(SRC[(B_) + 2 * q], SRC[(B_) + 2 * q + 1]); dst = as_bf16x8(_pw); } while (0)
#define ATT_EXP8(SRC, B_) do { _Pragma("unroll") for (int i = 0; i < 8; ++i) { SRC[(B_) + i] = fast_exp2(SRC[(B_) + i]); rsum += SRC[(B_) + i]; pmx = fmaxf(pmx, SRC[(B_) + i]); } } while (0)
        ATT_VREAD(va, 0);
        asm volatile("" ::: "memory");
        f32x16 s0 = negm, s1 = negm;
#pragma unroll
        for (int ks = 0; ks < 4; ++ks) { s0 = MFMA32(kf[2 * ks], qf[ks], s0); s1 = MFMA32(kf[2 * ks + 1], qf[ks], s1); }
        if (map == 1 && cproc) {
            const int sj = bidc + G_ * (cbase + kt - 2); const int uu = sj >> 2, qd = sj & 3;
            const LAS float* raw = (const LAS float*)(lds + CRING + ((kt - 2) % 3) * CSLOT);
            unsigned char* img = IMGL + (size_t)uu * IMG_BYTES + (size_t)(128 * qd) * 64;
#pragma unroll
            for (int hcv = 0; hcv < 2; ++hcv) {
                const int cidx = t8 + 256 * hcv, row = cidx >> 2, chunk = cidx & 3;
                float f[8];
#pragma unroll
                for (int kk = 0; kk < 8; ++kk) f[kk] = raw[(chunk * 8 + kk) * 128 + row];
                const u32x4 w = {pk_bf16(f[0], f[1]), pk_bf16(f[2], f[3]), pk_bf16(f[4], f[5]), pk_bf16(f[6], f[7])};
                const int np = 128 * qd + row;
                *(u32x4*)(img + row * 64 + ((chunk ^ ((0 - (np >> 2)) & 3)) << 4)) = w;
            }
        }
        PRB_T1(2, lds); PRB_T0(3, lds);
        if (kt == 0) {
            float mx = fmaxf(fmaxf(s0[0], s0[1]), s0[2]);
#pragma unroll
            for (int i = 3; i < 15; i += 2) mx = fmaxf(fmaxf(mx, s0[i]), s0[i + 1]);
            mx = fmaxf(mx, s0[15]);
#pragma unroll
            for (int i = 0; i < 16; i += 2) mx = fmaxf(fmaxf(mx, s1[i]), s1[i + 1]);
            mx = fmaxf(mx, __shfl_xor(mx, 32));
            m_run = mx;
#pragma unroll
            for (int i = 0; i < 16; ++i) { s0[i] -= mx; s1[i] -= mx; negm[i] = -mx; }
        }
        float rsum = 0.f, pmx = 0.f;
        bf16x8 pb;
        ATT_EXP8(s0, 0); ATT_PACK(pb, s0, 0);
        ATT_VREAD(vb, 1); asm volatile("" ::: "memory");
#pragma unroll
        for (int eb = 0; eb < 4; ++eb) o[eb] = MFMA32(va[eb], pb, o[eb]);
        ATT_EXP8(s0, 8); ATT_PACK(pb, s0, 8);
        ATT_VREAD(va, 2); asm volatile("" ::: "memory");
#pragma unroll
        for (int eb = 0; eb < 4; ++eb) o[eb] = MFMA32(vb[eb], pb, o[eb]);
        ATT_EXP8(s1, 0); ATT_PACK(pb, s1, 0);
        ATT_VREAD(vb, 3); asm volatile("" ::: "memory");
#pragma unroll
        for (int eb = 0; eb < 4; ++eb) o[eb] = MFMA32(va[eb], pb, o[eb]);
        ATT_EXP8(s1, 8); ATT_PACK(pb, s1, 8);
#pragma unroll
        for (int eb = 0; eb < 4; ++eb) o[eb] = MFMA32(vb[eb], pb, o[eb]);
        l_run += rsum;
        PRB_T1(3, lds);
#undef ATT_VREAD
#undef ATT_PACK
#undef ATT_EXP8
        pmx = fmaxf(pmx, __shfl_xor(pmx, 32));
        if (__any(pmx > 256.0f)) {
            const float d = pmx > 256.0f ? __builtin_amdgcn_logf(pmx) : 0.f;
            const float alpha = fast_exp2(-d);
            m_run += d; l_run *= alpha;
#pragma unroll
            for (int i = 0; i < 16; ++i) negm[i] = -m_run;
#pragma unroll
            for (int eb = 0; eb < 4; ++eb)
#pragma unroll
                for (int i = 0; i < 16; ++i) o[eb][i] *= alpha;
        }
    }
#undef ATT_ISSUE
#undef CONV_SRC
    __syncthreads();
    const float lt = l_run + __shfl_xor(l_run, 32);
    const float inv = 1.0f / lt;
    LAS float* X = (LAS float*)lds;
    if (map == 1) {
#pragma unroll
        for (int eb = 0; eb < 4; ++eb)
#pragma unroll
            for (int i = 0; i < 16; ++i) X[(wq * 64 + eb * 16 + i) * 64 + lane] = o[eb][i] * inv;
    }
    __syncthreads();
    if (map == 0) {
        float ss = 0.f;
#pragma unroll
        for (int eb = 0; eb < 4; ++eb)
#pragma unroll
            for (int i = 0; i < 16; ++i) { const float v = o[eb][i] * inv - lam * X[(wq * 64 + eb * 16 + i) * 64 + lane]; o[eb][i] = v; ss += v * v; }
        ss += __shfl_xor(ss, 32);
        const float sc = rsqrtf(ss * (1.0f / 128.0f) + RMS_EPS) * oscale;
        LAS unsigned char* W = lds + 65536 + wq * 8704;
#pragma unroll
        for (int eb = 0; eb < 4; ++eb)
#pragma unroll
            for (int q = 0; q < 4; ++q) {
                const int e = eb * 32 + 8 * q + 4 * hh;
                const u32x2 w = {pk_bf16(o[eb][4 * q] * sc, o[eb][4 * q + 1] * sc), pk_bf16(o[eb][4 * q + 2] * sc, o[eb][4 * q + 3] * sc)};
                *(LAS u32x2*)(W + r * 272 + e * 2) = w;
            }
#pragma unroll
        for (int it = 0; it < 8; ++it) {
            const int row = it * 4 + (lane >> 4), ch = lane & 15;
            const u32x4 v = *(LAS u32x4*)(W + row * 272 + ch * 16);
            *(u32x4*)(MIX + (rowbase + q_p0 + wq * 32 + row) * DM + h * 128 + ch * 8) = v;
        }
    }
    __syncthreads();
}

DI void ret_unit(const Params& p, int l, int b, int h, int c) {
    const int tid = tid_(), lane = tid & 63, wid = tid >> 6, fr = lane & 15, g = lane >> 4;
    const float* scal = (const float*)(p.ws + WS_SCAL) + l * 16;
    const float lf2 = scal[2 + h], lb2 = scal[6 + h];
    const bf16_t* P = (const bf16_t*)(p.ws + WS_P);
    const bf16_t* RVT = (const bf16_t*)(p.ws + WS_RVT);
    const bf16_t* SF = (const bf16_t*)(p.ws + WS_SF); const bf16_t* SB = (const bf16_t*)(p.ws + WS_SB);
    bf16_t* MIX = (bf16_t*)(p.ws + WS_MIX);
    const int bh = b * 4 + h;
    const size_t row0 = (size_t)b * NT + c * 128;
    const int iloc = wid * 16 + fr;
    u32x4 qraw[2];
#pragma unroll
    for (int ks = 0; ks < 2; ++ks) qraw[ks] = *(const u32x4*)(P + (row0 + iloc) * INW + C_RQ + h * 64 + ks * 32 + 8 * g);
    bf16x8 kf[8][2];
#pragma unroll
    for (int jb = 0; jb < 8; ++jb)
#pragma unroll
        for (int ks = 0; ks < 2; ++ks) kf[jb][ks] = *(const bf16x8*)(P + (row0 + jb * 16 + fr) * INW + C_RK + h * 64 + ks * 32 + 8 * g);
    u32x4 vf[4][4];
#pragma unroll
    for (int jj = 0; jj < 4; ++jj)
#pragma unroll
        for (int eb = 0; eb < 4; ++eb) {
            const bf16_t* vp = RVT + ((size_t)bh * 64 + eb * 16 + fr) * NT + c * 128 + jj * 32 + 4 * g;
            const u32x2 v0 = *(const u32x2*)vp, v1 = *(const u32x2*)(vp + 16);
            vf[jj][eb] = (u32x4){v0[0], v0[1], v1[0], v1[1]};
        }
    f32x4 st[8];
#pragma unroll
    for (int jb = 0; jb < 8; ++jb) {
        st[jb] = (f32x4){0.f, 0.f, 0.f, 0.f};
#pragma unroll
        for (int ks = 0; ks < 2; ++ks) st[jb] = MFMA16(kf[jb][ks], as_bf16x8(qraw[ks]), st[jb]);
    }
    const int vc = c >= 2 ? c - 2 : 64 + c;
    const bf16_t* sf = SF + ((size_t)bh * NCHUNK + c) * 4096 + fr * 64 + 8 * g;
    const bf16_t* sb = SB + ((size_t)bh * NCHUNK + vc) * 4096 + fr * 64 + 8 * g;
    bf16x8 sfa[2][4], sba[2][4];
#pragma unroll
    for (int ks = 0; ks < 2; ++ks)
#pragma unroll
        for (int eb = 0; eb < 4; ++eb) { sfa[ks][eb] = *(const bf16x8*)(sf + eb * 1024 + ks * 32); sba[ks][eb] = *(const bf16x8*)(sb + eb * 1024 + ks * 32); }
    u32x2 gw[4];
#pragma unroll
    for (int eb = 0; eb < 4; ++eb) gw[eb] = *(const u32x2*)(P + (row0 + iloc) * INW + C_RG + h * 64 + eb * 16 + 4 * g);
#pragma unroll
    for (int jb = 0; jb < 8; ++jb)
#pragma unroll
        for (int q = 0; q < 4; ++q) {
            const int j = jb * 16 + 4 * g + q;
            const int d = iloc - j;
            const float w = d > 0 ? fast_exp2((float)d * lf2) : (d < 0 ? fast_exp2((float)(-d) * lb2) : 2.0f);
            st[jb][q] *= w;
        }
    f32x4 ot[4];
#pragma unroll
    for (int eb = 0; eb < 4; ++eb) ot[eb] = (f32x4){0.f, 0.f, 0.f, 0.f};
#pragma unroll
    for (int jj = 0; jj < 4; ++jj) {
        const u32x4 pw = {pk_bf16(st[2 * jj][0], st[2 * jj][1]), pk_bf16(st[2 * jj][2], st[2 * jj][3]), pk_bf16(st[2 * jj + 1][0], st[2 * jj + 1][1]), pk_bf16(st[2 * jj + 1][2], st[2 * jj + 1][3])};
#pragma unroll
        for (int eb = 0; eb < 4; ++eb) ot[eb] = MFMA16(as_bf16x8(vf[jj][eb]), as_bf16x8(pw), ot[eb]);
    }
    const float df = fast_exp2((float)(iloc + 1) * lf2), db = fast_exp2((float)(128 - iloc) * lb2);
#pragma unroll
    for (int ks = 0; ks < 2; ++ks) {
        u32x4 qf, qb;
#pragma unroll
        for (int q = 0; q < 4; ++q) { const float a = bf_lo(qraw[ks][q]), bb = bf_hi(qraw[ks][q]); qf[q] = pk_bf16(a * df, bb * df); qb[q] = pk_bf16(a * db, bb * db); }
#pragma unroll
        for (int eb = 0; eb < 4; ++eb) {
            ot[eb] = MFMA16(sfa[ks][eb], as_bf16x8(qf), ot[eb]);
            ot[eb] = MFMA16(sba[ks][eb], as_bf16x8(qb), ot[eb]);
        }
    }
    float s = 0.f;
#pragma unroll
    for (int eb = 0; eb < 4; ++eb) s += (ot[eb][0] + ot[eb][1]) + (ot[eb][2] + ot[eb][3]);
    s += __shfl_xor(s, 16); s += __shfl_xor(s, 32);
    const float mu = s * (1.0f / 64.0f);
    float q2 = 0.f;
#pragma unroll
    for (int eb = 0; eb < 4; ++eb)
#pragma unroll
        for (int q = 0; q < 4; ++q) { const float d = ot[eb][q] - mu; q2 += d * d; }
    q2 += __shfl_xor(q2, 16); q2 += __shfl_xor(q2, 32);
    const float rstd = rsqrtf(q2 * (1.0f / 64.0f) + LN_EPS);
#pragma unroll
    for (int eb = 0; eb < 4; ++eb) {
        const int e = eb * 16 + 4 * g;
        const float g0 = bf_lo(gw[eb][0]), g1 = bf_hi(gw[eb][0]), g2 = bf_lo(gw[eb][1]), g3 = bf_hi(gw[eb][1]);
        u32x2 w = {pk_bf16((ot[eb][0] - mu) * rstd * silu_f(g0), (ot[eb][1] - mu) * rstd * silu_f(g1)),
                   pk_bf16((ot[eb][2] - mu) * rstd * silu_f(g2), (ot[eb][3] - mu) * rstd * silu_f(g3))};
        *(u32x2*)(MIX + (row0 + iloc) * DM + 768 + h * 64 + e) = w;
    }
}

DI void phase_attn(const Params& p0, int l, LAS unsigned char* lds) {
    const Params p = launder(p0); l = launder_s(l);
    const float* scal = (const float*)(p.ws + WS_SCAL) + l * 16;
    const float lam = scal[0], oscale = scal[1];
    const int nunits = NB * 4 * 64 + (l == 0 ? NB * 4 * 2 : 0);
    int conv_done = 0;
    for (int u = bid_(); u < nunits; u += gridDim.x) {
        int b, h, q0, ntile;
        if (u < NB * 4 * 64) { const int qt = u & 63; h = (u >> 6) & 3; b = u >> 8; q0 = NCTX + qt * 128; ntile = NT / 64; }
        else { const int v = u - NB * 4 * 64; const int qt = v & 1; h = (v >> 1) & 3; b = v >> 3; q0 = qt * 128; ntile = NCTX / 64; }
        attn_unit(p, l, b, h, q0, ntile, lam, oscale, conv_done, lds);
    }
    if (tid_() == 0) ((int*)(p.ws + WS_CONVDONE))[l * 1024 + bid_()] = conv_done;
}
DI void phase_ret(const Params& p0, int l) {
    const Params p = launder(p0); l = launder_s(l);
    for (int u = bid_(); u < NB * 4 * NCHUNK; u += gridDim.x) {
        const int c = u % NCHUNK, bh = u / NCHUNK;
        if (l == 1 && c < 2) continue;
        ret_unit(p, l, bh >> 2, bh & 3, c);
    }
}

DI void phase_outproj(const Params& p0, int l, LAS unsigned char* lds) {
    const Params p = launder(p0); l = launder_s(l);
    const float* Xin = (const float*)(p.ws + WS_XA);
    const bf16_t* A = (const bf16_t*)(p.ws + WS_MIX);
    const bf16_t* W = (const bf16_t*)(p.ws + WS_WOUT) + (size_t)l * DM * DM;
    float* V1 = (float*)(p.ws + WS_V1);
    const float* modv = (const float*)(p.ws + WS_MODV) + (size_t)l * 3 * 6144;
    for (int u = bid_(); u < (MROWS / 192) * 8; u += gridDim.x) {
        const int tm = u >> 3, tn = u & 7;
        auto epi = [&](f32x4 (&acc)[4][3], int wm, int wn, int fr, int fq, int lane, int wid) {
            const int c0 = tn * 128 + wn * 64, r0 = tm * 192 + wm * 48;
            LAS unsigned char* W_ = g2_stage(lds, wid);
            f32x4 xv[12], g2v[12];
#pragma unroll
            for (int it = 0; it < 12; ++it) {
                const int grow = r0 + it * 4 + (lane >> 4), ch = lane & 15;
                xv[it] = *(const f32x4*)(Xin + (size_t)grow * DM + c0 + ch * 4);
                g2v[it] = *(const f32x4*)(modv + (size_t)row_sel(grow) * 6144 + 2 * 1024 + c0 + ch * 4);
            }
#pragma unroll
            for (int nf = 0; nf < 4; ++nf)
#pragma unroll
                for (int mf = 0; mf < 3; ++mf) *(LAS f32x4*)(W_ + (mf * 16 + fr) * 272 + nf * 64 + fq * 16) = acc[nf][mf];
#pragma unroll
            for (int it = 0; it < 12; ++it) {
                const int row = it * 4 + (lane >> 4), ch = lane & 15;
                const int grow = r0 + row;
                const f32x4 y = *(LAS f32x4*)(W_ + row * 272 + ch * 16);
                *(f32x4*)(V1 + (size_t)grow * DM + c0 + ch * 4) = (f32x4){DN_ALPHA * xv[it][0] + g2v[it][0] * y[0], DN_ALPHA * xv[it][1] + g2v[it][1] * y[1], DN_ALPHA * xv[it][2] + g2v[it][2] * y[2], DN_ALPHA * xv[it][3] + g2v[it][3] * y[3]};
            }
        };
        gemm192(A, DM, W, DM, DM / 64, tm * 192, tn * 128, lds, epi);
    }
}

DI void phase_ln_mid(const Params& p0, int l) {
    const Params p = launder(p0); l = launder_s(l);
    float* Xout = (float*)(p.ws + WS_XB);
    const int lane = tid_() & 63, wid = tid_() >> 6;
    const float* V1 = (const float*)(p.ws + WS_V1);
    bf16_t* TOK = (bf16_t*)(p.ws + WS_TOK);
    const float* modv = (const float*)(p.ws + WS_MODV) + (size_t)l * 3 * 6144;
    const float* lg = p.ln_g + (size_t)(l * 2 + 0) * DM; const float* lb = p.ln_b + (size_t)(l * 2 + 0) * DM;
    for (int r = bid_() * 8 + wid; r < MROWS; r += gridDim.x * 8) {
        f32x4 v[4];
#pragma unroll
        for (int i = 0; i < 4; ++i) v[i] = *(const f32x4*)(V1 + (size_t)r * DM + lane * 4 + i * 256);
        float mu, rstd; ln_stats(v, mu, rstd);
#pragma unroll
        for (int i = 0; i < 4; ++i) {
            const int c = lane * 4 + i * 256;
            const f32x4 gg = *(const f32x4*)(lg + c), bb = *(const f32x4*)(lb + c);
#pragma unroll
            for (int j = 0; j < 4; ++j) v[i][j] = (v[i][j] - mu) * rstd * gg[j] + bb[j];
            *(f32x4*)(Xout + (size_t)r * DM + c) = v[i];
        }
        const float* mv = modv + (size_t)row_sel(r) * 6144;
        modulate_store(v, mv + 3 * 1024, mv + 4 * 1024, TOK + (size_t)r * DM, lane);
    }
}

DI void phase_router(const Params& p0, int l, LAS unsigned char* lds) {
    const Params p = launder(p0); l = launder_s(l);
    const bf16_t* A = (const bf16_t*)(p.ws + WS_TOK);
    const bf16_t* W = (const bf16_t*)(p.ws + WS_WR) + (size_t)l * 256 * DM;
    float* LG = (float*)(p.ws + WS_LOGIT);
    for (int u = bid_(); u < (MROWS / 192) * 2; u += gridDim.x) {
        const int tm = u >> 1, tn = u & 1;
        auto epi = [&](f32x4 (&acc)[4][3], int wm, int wn, int fr, int fq, int lane, int wid) {
            const int c0 = tn * 128 + wn * 64, r0 = tm * 192 + wm * 48;
            LAS unsigned char* W_ = g2_stage(lds, wid);
#pragma unroll
            for (int nf = 0; nf < 4; ++nf)
#pragma unroll
                for (int mf = 0; mf < 3; ++mf) *(LAS f32x4*)(W_ + (mf * 16 + fr) * 272 + nf * 64 + fq * 16) = acc[nf][mf];
#pragma unroll
            for (int it = 0; it < 12; ++it) {
                const int row = it * 4 + (lane >> 4), ch = lane & 15;
                *(f32x4*)(LG + (size_t)(r0 + row) * 256 + c0 + ch * 4) = *(LAS f32x4*)(W_ + row * 272 + ch * 16);
            }
        };
        gemm192(A, DM, W, DM, DM / 64, tm * 192, tn * 128, lds, epi);
    }
}

DI void phase_topk(const Params& p0, int l, LAS unsigned char* lds) {
    const Params p = launder(p0); l = launder_s(l);
    const int lane = tid_() & 63, wid = tid_() >> 6, rs = lane >> 3, g = lane & 7;
    const float* LG = (const float*)(p.ws + WS_LOGIT);
    const float* bias = p.router_bias + l * 256 + g * 32;
    int* EIDX = (int*)(p.ws + WS_EIDX); float* GATE = (float*)(p.ws + WS_GATE);
    int* RANK = (int*)(p.ws + WS_RANK); int* HIST = (int*)(p.ws + WS_HIST);
    LAS int* hist = (LAS int*)lds;
    if (tid_() < 256) hist[tid_()] = 0;
    __syncthreads();
    const int chunk = (MROWS + (int)gridDim.x - 1) / (int)gridDim.x, r_begin = bid_() * chunk, r_end = (r_begin + chunk) < MROWS ? (r_begin + chunk) : MROWS;
    for (int base = r_begin + wid * 8; base < r_end; base += 64) {
        const int row = base + rs; const bool valid = row < r_end;
        const float* lp = LG + (size_t)(valid ? row : r_begin) * 256 + g * 32;
        float sc[32], gv[32];
#pragma unroll
        for (int q = 0; q < 8; ++q) {
            const f32x4 lg = *(const f32x4*)(lp + 4 * q), bv = *(const f32x4*)(bias + 4 * q);
#pragma unroll
            for (int j = 0; j < 4; ++j) { sc[4 * q + j] = 1.0f / (1.0f + __expf(-lg[j])); gv[4 * q + j] = sc[4 * q + j] + bv[j]; }
        }
        float m1 = fmaxf(gv[0], gv[1]), m2 = fminf(gv[0], gv[1]);
#pragma unroll
        for (int i = 2; i < 32; ++i) { const float v = gv[i]; m2 = fmaxf(m2, fminf(m1, v)); m1 = fmaxf(m1, v); }
        const float gs = m1 + m2;
        int rank = 0;
#pragma unroll
        for (int g2 = 0; g2 < 8; ++g2) { const float o = __shfl(gs, (lane & 56) + g2); rank += (o > gs || (o == gs && g2 < g)) ? 1 : 0; }
        if (rank >= 4) {
#pragma unroll
            for (int i = 0; i < 32; ++i) gv[i] = -INFINITY;
        }
        float ssum = 0.f, mysc = 0.f; int myidx = 0;
#pragma unroll 1
        for (int k = 0; k < TOPK; ++k) {
            float bv = gv[0], bs = sc[0]; int bi = 0;
#pragma unroll
            for (int i = 1; i < 32; ++i) { const bool gt = gv[i] > bv; bv = gt ? gv[i] : bv; bs = gt ? sc[i] : bs; bi = gt ? i : bi; }
            int gi = g * 32 + bi;
#pragma unroll
            for (int o = 1; o < 8; o <<= 1) {
                const float ov = __shfl_xor(bv, o), os = __shfl_xor(bs, o); const int oi = __shfl_xor(gi, o);
                const bool tk = ov > bv || (ov == bv && oi < gi);
                bv = tk ? ov : bv; bs = tk ? os : bs; gi = tk ? oi : gi;
            }
            if ((gi >> 5) == g) {
                const int oi = gi & 31;
#pragma unroll
                for (int i = 0; i < 32; ++i) gv[i] = (i == oi) ? -INFINITY : gv[i];
            }
            ssum += bs;
            if (g == k) { mysc = bs; myidx = gi; }
        }
        if (valid) {
            EIDX[(size_t)row * 8 + g] = myidx;
            GATE[(size_t)row * 8 + g] = mysc / ssum * 2.5f;
            RANK[(size_t)row * 8 + g] = __hip_atomic_fetch_add(hist + myidx, 1, __ATOMIC_RELAXED, __HIP_MEMORY_SCOPE_WORKGROUP);
        }
    }
    __syncthreads();
    if (tid_() < 256) HIST[(size_t)bid_() * 256 + tid_()] = hist[tid_()];
    __syncthreads();
}

DI void phase_scatter(const Params& p0, int l, LAS unsigned char* lds) {
    const Params p = launder(p0); l = launder_s(l);
    LAS int* off = (LAS int*)lds;
    LAS int* toff = off + 260;
    LAS int* tot = toff + 260;
    LAS int* base = tot + 256;
    const int tid = tid_(), bid = bid_(), G = gridDim.x;
    const int* HIST = (const int*)(p.ws + WS_HIST);
    const int* RANK = (const int*)(p.ws + WS_RANK);
    int* ntl = (int*)(p.ws + CTL_NTILES) + l;
    int* TILES = (int*)(p.ws + WS_TILES);
    const int* EIDX = (const int*)(p.ws + WS_EIDX);
    int* SORT = (int*)(p.ws + WS_SORT);
    if (tid < 256) {
        int t = 0, bs = 0;
#pragma unroll 16
        for (int b2 = 0; b2 < G; ++b2) { const int v = HIST[(size_t)b2 * 256 + tid]; bs += (b2 < bid) ? v : 0; t += v; }
        tot[tid] = t; base[tid] = bs;
    }
    __syncthreads();
    if (tid == 0) {
        int a = 0, t = 0;
        for (int e = 0; e < 256; ++e) { off[e] = a; toff[e] = t; const int c = tot[e]; a += c; t += (c + 127) >> 7; }
        off[256] = a; toff[256] = t;
    }
    __syncthreads();
    if (bid == 0) {
        if (tid < 256) {
            const int e = tid, c = off[e + 1] - off[e], nt = toff[e + 1] - toff[e];
            for (int t = 0; t < nt; ++t) { int* T = TILES + (size_t)(toff[e] + t) * 4; T[0] = e; T[1] = off[e] + t * 128; T[2] = (c - t * 128) < 128 ? (c - t * 128) : 128; T[3] = 0; }
        }
        if (tid == 0) *ntl = toff[256];
    }
    const int chunk = (MROWS + G - 1) / G, r_begin = bid * chunk, r_end = (r_begin + chunk) < MROWS ? (r_begin + chunk) : MROWS;
    for (int a = r_begin * 8 + tid; a < r_end * 8; a += NTHREADS) {
        const int e = EIDX[a];
        SORT[off[e] + base[e] + RANK[a]] = a;
    }
    __syncthreads();
}

constexpr int MOE_STG = 40960;
constexpr int MOE_HT = 86016;
constexpr int MOE_INFO = MOE_HT + 65536;
DI int swz64(int row, int chunk) { return row * 64 + ((chunk ^ ((0 - (row >> 2)) & 3)) << 4); }

DI void phase_convert_experts(const Params& p0, int l) {
    const Params p = launder(p0); l = launder_s(l);
    unsigned char* IMG = p.ws + WS_WIMG + (size_t)l * (NEXP + 1) * IMG_PER_E * IMG_BYTES;
    constexpr int NSLICE = (NEXP + 1) * IMG_PER_E * 4;
    const int G = gridDim.x, bid = bid_(), t = tid_();
    const int mine = (NSLICE - bid + G - 1) / G;
    const int done = ((const int*)(p.ws + WS_CONVDONE))[l * 1024 + bid];
    for (int i = done; i < mine; ++i) {
        const int sj = bid + G * i, u = sj >> 2, qd = sj & 3, e = u / IMG_PER_E, im = u % IMG_PER_E;
        const int row = t >> 2, chunk = t & 3, np = 128 * qd + row;
        const float* src; int ldw;
        if (im < 32) { const float* W = e < NEXP ? p.w_egu + ((size_t)l * NEXP + e) * DM * 512 : p.w_sgu + (size_t)l * DM * 512; ldw = 512;
            src = W + (size_t)(im * 32 + chunk * 8) * 512 + (((np >> 4) & 1) * 256 + (np >> 5) * 16 + (np & 15)); }
        else { const float* W = e < NEXP ? p.w_edn + ((size_t)l * NEXP + e) * 256 * DM : p.w_sdn + (size_t)l * 256 * DM; ldw = DM;
            src = W + (size_t)(((im - 32) & 7) * 32 + chunk * 8) * DM + ((im - 32) >> 3) * 512 + np; }
        float f[8];
#pragma unroll
        for (int kk = 0; kk < 8; ++kk) f[kk] = src[(size_t)kk * ldw];
        const u32x4 w = {pk_bf16(f[0], f[1]), pk_bf16(f[2], f[3]), pk_bf16(f[4], f[5]), pk_bf16(f[6], f[7])};
        *(u32x4*)(IMG + (size_t)u * IMG_BYTES + (size_t)np * 64 + ((chunk ^ ((0 - (np >> 2)) & 3)) << 4)) = w;
    }
}

DI void moe_unit(const Params& p, const unsigned char* img, bf16_t* outbase, bool shared, int r0, int nr, LAS unsigned char* lds) {
    const int t = tid_(), lane = t & 63, wid = __builtin_amdgcn_readfirstlane(t >> 6), fr = lane & 15, fq = lane >> 4, wn = wid & 3, wt = wid >> 2;
    const bf16_t* TOK = (const bf16_t*)(p.ws + WS_TOK);
    const int* SORT = (const int*)(p.ws + WS_SORT);
    LAS int* rowout = (LAS int*)(lds + MOE_INFO);
    const int arow = t >> 2;
    int atok = 0, aout = -1;
    if (arow < nr) { if (shared) { atok = r0 + arow; aout = atok; } else { aout = SORT[r0 + arow]; atok = aout >> 3; } }
    const bf16_t* aptr = TOK + (size_t)atok * DM + (((t & 3) ^ ((0 - (arow >> 2)) & 3)) << 3);
    __syncthreads();
    if ((t & 3) == 0) rowout[arow] = aout;
    const unsigned char* wsrc = img + (size_t)t * 16;
    const int adst = wid * 1024, wdst = 8192 + wid * 1024;
#define MOE_ISSUE1(S, KT) do { LAS unsigned char* _s = lds + (S) * MOE_STG; dma16(aptr + (KT) * 32, _s + adst); \
        const unsigned char* _w = wsrc + (size_t)(KT) * IMG_BYTES; \
        dma16(_w, _s + wdst); dma16(_w + 8192, _s + wdst + 8192); dma16(_w + 16384, _s + wdst + 16384); dma16(_w + 24576, _s + wdst + 24576); } while (0)
#define MOE_ISSUE2(S, IM) do { LAS unsigned char* _s = lds + (S) * IMG_BYTES; const unsigned char* _w = wsrc + (size_t)(IM) * IMG_BYTES; \
        dma16(_w, _s + adst); dma16(_w + 8192, _s + adst + 8192); dma16(_w + 16384, _s + adst + 16384); dma16(_w + 24576, _s + adst + 24576); } while (0)
    f32x4 acc[8][4];
#pragma unroll
    for (int nf = 0; nf < 8; ++nf)
#pragma unroll
        for (int tf = 0; tf < 4; ++tf) acc[nf][tf] = (f32x4){0.f, 0.f, 0.f, 0.f};
    MOE_ISSUE1(0, 0);
    MOE_ISSUE1(1, 1);
    int st = 0;
    for (int kt = 0; kt < 32; ++kt) {
        if (kt < 31) WAIT_VM(5); else WAIT_VM(0);
        asm volatile("s_waitcnt lgkmcnt(0)" ::: "memory");
        __builtin_amdgcn_s_barrier();
        const int st2 = st == 0 ? 2 : st - 1;
        if (wt == 0) { if (kt < 30) MOE_ISSUE1(st2, kt + 2); else if (kt == 31) MOE_ISSUE2(0, 32); }
        LAS unsigned char* S = lds + st * MOE_STG;
        bf16x8 tfr[4];
#pragma unroll
        for (int tf = 0; tf < 4; ++tf) tfr[tf] = *(LAS bf16x8*)(S + swz64(wt * 64 + tf * 16 + fr, fq));
#pragma unroll
        for (int nf = 0; nf < 8; ++nf) {
            const bf16x8 wf = *(LAS bf16x8*)(S + 8192 + swz64(wn * 128 + nf * 16 + fr, fq));
#pragma unroll
            for (int tf = 0; tf < 4; ++tf) acc[nf][tf] = MFMA16(wf, tfr[tf], acc[nf][tf]);
            if (nf == 3 && wt == 1) { if (kt < 30) MOE_ISSUE1(st2, kt + 2); else if (kt == 31) MOE_ISSUE2(0, 32); }
        }
        st = st == 2 ? 0 : st + 1;
    }
#pragma unroll
    for (int i = 0; i < 4; ++i)
#pragma unroll
        for (int tf = 0; tf < 4; ++tf) {
            float hv[4];
#pragma unroll
            for (int j = 0; j < 4; ++j) hv[j] = silu_f(acc[2 * i][tf][j]) * acc[2 * i + 1][tf][j];
            const int tok = wt * 64 + tf * 16 + fr, hc = wn * 64 + i * 16 + 4 * fq;
            const u32x2 w = {pk_bf16(hv[0], hv[1]), pk_bf16(hv[2], hv[3])};
            *(LAS u32x2*)(lds + MOE_HT + tok * 512 + (((hc >> 3) ^ (tok & 15)) << 4) + (hc & 7) * 2) = w;
        }
#pragma unroll 1
    for (int nc = 0; nc < 2; ++nc) {
#pragma unroll
        for (int nf = 0; nf < 8; ++nf)
#pragma unroll
            for (int tf = 0; tf < 4; ++tf) acc[nf][tf] = (f32x4){0.f, 0.f, 0.f, 0.f};
        if (nc == 1) MOE_ISSUE2(0, 40);
        for (int kt = 0; kt < 8; ++kt) {
            WAIT_VM(0);
            asm volatile("s_waitcnt lgkmcnt(0)" ::: "memory");
            __builtin_amdgcn_s_barrier();
            if (wt == 0 && kt < 7) MOE_ISSUE2((kt + 1) & 1, 32 + nc * 8 + kt + 1);
            LAS unsigned char* S = lds + (kt & 1) * IMG_BYTES;
            bf16x8 tfr[4];
#pragma unroll
            for (int tf = 0; tf < 4; ++tf) { const int tok = wt * 64 + tf * 16 + fr; tfr[tf] = *(LAS bf16x8*)(lds + MOE_HT + tok * 512 + (((kt * 4 + fq) ^ (tok & 15)) << 4)); }
#pragma unroll
            for (int nf = 0; nf < 8; ++nf) {
                const bf16x8 wf = *(LAS bf16x8*)(S + swz64(wn * 128 + nf * 16 + fr, fq));
#pragma unroll
                for (int tf = 0; tf < 4; ++tf) acc[nf][tf] = MFMA16(wf, tfr[tf], acc[nf][tf]);
                if (nf == 3 && wt == 1 && kt < 7) MOE_ISSUE2((kt + 1) & 1, 32 + nc * 8 + kt + 1);
            }
        }
        __syncthreads();
        LAS unsigned char* W = lds + wid * 9216;
#pragma unroll
        for (int half = 0; half < 2; ++half) {
#pragma unroll
            for (int nh = 0; nh < 4; ++nh)
#pragma unroll
                for (int tf = 0; tf < 4; ++tf) {
                    const f32x4 v = acc[half * 4 + nh][tf];
                    const u32x2 w = {pk_bf16(v[0], v[1]), pk_bf16(v[2], v[3])};
                    *(LAS u32x2*)(W + (tf * 16 + fr) * 144 + nh * 32 + fq * 8) = w;
                }
#pragma unroll
            for (int it = 0; it < 8; ++it) {
                const int row = it * 8 + (lane >> 3), ch = lane & 7;
                const u32x4 v = *(LAS u32x4*)(W + row * 144 + ch * 16);
                const int ro = rowout[wt * 64 + row];
                if (ro >= 0) *(u32x4*)(outbase + (size_t)ro * DM + nc * 512 + wn * 128 + half * 64 + ch * 8) = v;
            }
        }
        __syncthreads();
    }
#undef MOE_ISSUE1
#undef MOE_ISSUE2
}

DI void phase_moe(const Params& p0, int l, LAS unsigned char* lds) {
    const Params p = launder(p0); l = launder_s(l);
    const int* TILES = (const int*)(p.ws + WS_TILES);
    const int ntl = *((const int*)(p.ws + CTL_NTILES) + l);
    const int G = gridDim.x, bid = bid_();
    int vcu = bid;
    if (p.ph_hi - p.ph_lo > 1) {
        volatile LAS unsigned* bst = (volatile LAS unsigned*)(lds + LDS_BYTES - 16);
        const unsigned xc = bst[2]; unsigned pre = 0;
        for (unsigned j = 0; j < 16; ++j) { const unsigned c = xb_ld((unsigned*)(p.ws + WS_CTL) + XB_XCNT(j)); pre += (j < xc) ? c : 0u; }
        vcu = (int)(pre + bst[3]);
    }
    const int total = ntl + MROWS / 128;
    const unsigned char* IMG = p.ws + WS_WIMG + (size_t)l * (NEXP + 1) * IMG_PER_E * IMG_BYTES;
    for (int u = vcu; u < total; u += G) {
        if (u < ntl) {
            const int e = TILES[u * 4], r0 = TILES[u * 4 + 1], nr = TILES[u * 4 + 2];
            moe_unit(p, IMG + (size_t)e * IMG_PER_E * IMG_BYTES, (bf16_t*)(p.ws + WS_YSLOT), false, r0, nr, lds);
        } else {
            const int tm = u - ntl;
            if (l == 1 && (tm % (NT / 128)) < 2) continue;
            moe_unit(p, IMG + (size_t)NEXP * IMG_PER_E * IMG_BYTES, (bf16_t*)(p.ws + WS_YSH), true, tm * 128, 128, lds);
        }
    }
}

DI void phase_combine(const Params& p0, int l) {
    const Params p = launder(p0); l = launder_s(l);
    const float* X1 = (const float*)(p.ws + WS_XB); float* Xnext = (float*)(p.ws + WS_XA);
    const int lane = tid_() & 63, wid = tid_() >> 6;
    const bf16_t* YSL = (const bf16_t*)(p.ws + WS_YSLOT); const bf16_t* YSH = (const bf16_t*)(p.ws + WS_YSH);
    const float* GATE = (const float*)(p.ws + WS_GATE);
    const float* modv = (const float*)(p.ws + WS_MODV);
    const float* lg = p.ln_g + (size_t)(l * 2 + 1) * DM; const float* lb = p.ln_b + (size_t)(l * 2 + 1) * DM;
    bf16_t* H = (bf16_t*)(p.ws + WS_H);
    for (int r = bid_() * 8 + wid; r < MROWS; r += gridDim.x * 8) {
        const int b = r >= NT, pp = r - b * NT;
        if (l == 1 && pp < NCTX) continue;
        const int sel = pp < NCTX ? 2 : b;
        float gt[8];
#pragma unroll
        for (int k = 0; k < 8; ++k) gt[k] = GATE[(size_t)r * 8 + k];
        const float* g5 = modv + ((size_t)l * 3 + sel) * 6144 + 5 * 1024;
        f32x4 v[4];
        u32x2 sl[4][9]; f32x4 xv4[4];
#pragma unroll
        for (int i = 0; i < 4; ++i) {
            const int c = lane * 4 + i * 256;
            sl[i][8] = *(const u32x2*)(YSH + (size_t)r * DM + c);
#pragma unroll
            for (int k = 0; k < 8; ++k) sl[i][k] = *(const u32x2*)(YSL + ((size_t)r * 8 + k) * DM + c);
            xv4[i] = *(const f32x4*)(X1 + (size_t)r * DM + c);
        }
#pragma unroll
        for (int i = 0; i < 4; ++i) {
            const int c = lane * 4 + i * 256;
            float f0 = bf_lo(sl[i][8][0]), f1 = bf_hi(sl[i][8][0]), f2 = bf_lo(sl[i][8][1]), f3 = bf_hi(sl[i][8][1]);
#pragma unroll
            for (int k = 0; k < 8; ++k) { const u32x2 w = sl[i][k]; f0 += gt[k] * bf_lo(w[0]); f1 += gt[k] * bf_hi(w[0]); f2 += gt[k] * bf_lo(w[1]); f3 += gt[k] * bf_hi(w[1]); }
            const f32x4 xv = xv4[i], gv = *(const f32x4*)(g5 + c);
            v[i] = (f32x4){DN_ALPHA * xv[0] + gv[0] * f0, DN_ALPHA * xv[1] + gv[1] * f1, DN_ALPHA * xv[2] + gv[2] * f2, DN_ALPHA * xv[3] + gv[3] * f3};
        }
        float mu, rstd; ln_stats(v, mu, rstd);
#pragma unroll
        for (int i = 0; i < 4; ++i) {
            const int c = lane * 4 + i * 256;
            const f32x4 gg = *(const f32x4*)(lg + c), bb = *(const f32x4*)(lb + c);
#pragma unroll
            for (int j = 0; j < 4; ++j) v[i][j] = (v[i][j] - mu) * rstd * gg[j] + bb[j];
            if (l == 1) *(f32x4*)(p.out + ((size_t)b * NLAT + (pp - NCTX)) * DM + c) = v[i];
            else *(f32x4*)(Xnext + (size_t)r * DM + c) = v[i];
        }
        if (l == 0) { const float* mv = modv + ((size_t)1 * 3 + sel) * 6144; modulate_store(v, mv, mv + 1024, H + (size_t)r * DM, lane); }
    }
}

constexpr int PH_PER_LAYER = 11, N_PHASES = 3 + 2 * PH_PER_LAYER;
__global__ void __launch_bounds__(NTHREADS, 2) mega(Params p) {
    extern __shared__ __attribute__((aligned(16))) unsigned char lds_raw[];
    LAS unsigned char* lds = (LAS unsigned char*)lds_raw;
    volatile LAS unsigned* bst = (volatile LAS unsigned*)(lds + LDS_BYTES - 16);
    if (PROBE_ID != 0 && threadIdx.x == 0) { PRB_WORDS(lds)[0] = 0ull; PRB_WORDS(lds)[1] = 0ull; }
    if (threadIdx.x == 0) { bst[0] = 0u; bst[1] = 0u; const unsigned xc = xb_xcc_id(); bst[2] = xc; bst[3] = xb_add((unsigned*)(p.ws + CTL_XRANK) + xc, 1u); }
    __syncthreads();
    const int lo = p.ph_lo, hi = p.ph_hi;
    XcdBarrier bar; bar.bar = (unsigned*)(p.ws + WS_CTL); bar.x = 0; bar.st = bst;
    if (hi - lo > 1) bar = xcd_barrier_post((unsigned*)(p.ws + WS_CTL), bst);
#ifndef ONLY_PHASE
#define ONLY_PHASE -1
#endif
#define IN(k) (lo <= (k) && (k) < hi)
#define ON(pid) (ONLY_PHASE < 0 || ONLY_PHASE == (pid))
#ifndef DUP_PHASE
#define DUP_PHASE -1
#endif
#define REP(pid) for (int rep_ = 0; rep_ < ((DUP_PHASE == (pid)) ? 2 : 1); ++rep_)
#define SEAM(k) do { if (IN(k) && IN((k) + 1)) xcd_barrier(bar); } while (0)
    PRB_T0(100, lds); if (ON(0) && IN(0)) REP(0) { phase_convert(p, lds); } PRB_T1(100, lds);
    PRB_T0(200, lds); SEAM(0); PRB_T1(200, lds);
    PRB_T0(101, lds); if (ON(1) && IN(1)) REP(1) phase_mod(p, lds); PRB_T1(101, lds);
    PRB_T0(201, lds); SEAM(1); PRB_T1(201, lds);
    PRB_T0(102, lds); if (ON(2) && IN(2)) REP(2) phase_ln0(p); PRB_T1(102, lds);
    PRB_T0(202, lds); SEAM(2); PRB_T1(202, lds);
    for (int l = 0; l < 2; ++l) {
        const int k0 = 3 + l * PH_PER_LAYER;
        PRB_T0(103, lds); if (ON(3) && IN(k0 + 0)) REP(3) phase_inproj(p, l, lds); PRB_T1(103, lds);
        PRB_T0(203, lds); SEAM(k0 + 0); PRB_T1(203, lds);
        PRB_T0(104, lds); if (ON(4) && IN(k0 + 1)) REP(4) phase_ret_sum_pool(p, l, lds); PRB_T1(104, lds);
        PRB_T0(204, lds); SEAM(k0 + 1); PRB_T1(204, lds);
        PRB_T0(105, lds); if (ON(5) && IN(k0 + 2)) REP(5) phase_ret_scan(p, l); PRB_T1(105, lds);
        PRB_T0(205, lds); SEAM(k0 + 2); PRB_T1(205, lds);
        PRB_T0(106, lds); if (ON(6) && IN(k0 + 3)) REP(6) { phase_attn(p, l, lds); phase_ret(p, l); } PRB_T1(106, lds);
        PRB_T0(206, lds); SEAM(k0 + 3); PRB_T1(206, lds);
        PRB_T0(107, lds); if (ON(7) && IN(k0 + 4)) REP(7) phase_outproj(p, l, lds); PRB_T1(107, lds);
        PRB_T0(207, lds); SEAM(k0 + 4); PRB_T1(207, lds);
        PRB_T0(108, lds); if (ON(8) && IN(k0 + 5)) REP(8) phase_ln_mid(p, l); PRB_T1(108, lds);
        PRB_T0(208, lds); SEAM(k0 + 5); PRB_T1(208, lds);
        PRB_T0(109, lds); if (ON(9) && IN(k0 + 6)) REP(9) phase_router(p, l, lds); PRB_T1(109, lds);
        PRB_T0(209, lds); SEAM(k0 + 6); PRB_T1(209, lds);
        PRB_T0(110, lds); if (ON(10) && IN(k0 + 7)) REP(10) phase_topk(p, l, lds); PRB_T1(110, lds);
        PRB_T0(210, lds); SEAM(k0 + 7); PRB_T1(210, lds);
        PRB_T0(111, lds); if (ON(11) && IN(k0 + 8)) REP(11) { phase_scatter(p, l, lds); phase_convert_experts(p, l); } PRB_T1(111, lds);
        PRB_T0(211, lds); SEAM(k0 + 8); PRB_T1(211, lds);
        PRB_T0(112, lds); if (ON(12) && IN(k0 + 9)) REP(12) phase_moe(p, l, lds); PRB_T1(112, lds);
        PRB_T0(212, lds); SEAM(k0 + 9); PRB_T1(212, lds);
        PRB_T0(114, lds); if (ON(14) && IN(k0 + 10)) REP(14) phase_combine(p, l); PRB_T1(114, lds);
        if (l == 0) SEAM(k0 + 10);
    }
#undef IN
#undef SEAM
    if (PROBE_ID != 0 && threadIdx.x == 0 && blockIdx.x == 0) {
        const unsigned long long t0 = __builtin_readcyclecounter(), span = PRB_WORDS(lds)[1] * PROBE_GAIN;
        while (__builtin_readcyclecounter() - t0 < span) __builtin_amdgcn_s_sleep(8);
    }
}

extern "C" void kernel_launch(void* const* d_in, const int* in_sizes, int n_in, void* d_out, int out_size, void* d_ws, size_t ws_size, hipStream_t stream) {
    static int grid = 0;
    if (grid == 0) {
        if (n_in != 20 || ws_size < WS_END || out_size != NB * NLAT * DM) { fprintf(stderr, "kernel_launch: unexpected shapes (n_in %d, ws %zu need %zu, out %d)\n", n_in, ws_size, (size_t)WS_END, out_size); grid = -1; return; }
        int dev = 0, cus = 0, per_cu = 0;
        hipGetDevice(&dev); hipDeviceGetAttribute(&cus, hipDeviceAttributeMultiprocessorCount, dev);
        if (hipFuncSetAttribute((const void*)mega, hipFuncAttributeMaxDynamicSharedMemorySize, LDS_BYTES) != hipSuccess) { fprintf(stderr, "kernel_launch: hipFuncSetAttribute failed\n"); grid = -1; return; }
        if (hipOccupancyMaxActiveBlocksPerMultiprocessor(&per_cu, (const void*)mega, NTHREADS, LDS_BYTES) != hipSuccess || per_cu < 1) { fprintf(stderr, "kernel_launch: occupancy query says %d\n", per_cu); }
        (void)hipGetLastError();
        grid = cus > 0 ? cus : 256;
    }
    if (grid < 0) return;
    hipMemsetAsync((char*)d_ws + WS_CTL, 0, CTL_BYTES, stream);
    Params p{};
    p.x = (const float*)d_in[0]; p.c = (const float*)d_in[1]; p.ctx = (const float*)d_in[2]; p.c_ctx = (const float*)d_in[3];
    p.w_mod = (const float*)d_in[4]; p.b_mod = (const float*)d_in[5]; p.w_in = (const float*)d_in[6]; p.w_out = (const float*)d_in[7];
    p.diff_lambda = (const float*)d_in[8]; p.pool_w = (const float*)d_in[9]; p.pool_scale = (const float*)d_in[10]; p.ret_log_decay = (const float*)d_in[11];
    p.ln_g = (const float*)d_in[12]; p.ln_b = (const float*)d_in[13]; p.w_router = (const float*)d_in[14]; p.router_bias = (const float*)d_in[15];
    p.w_egu = (const float*)d_in[16]; p.w_edn = (const float*)d_in[17]; p.w_sgu = (const float*)d_in[18]; p.w_sdn = (const float*)d_in[19];
    p.out = (float*)d_out; p.ws = (unsigned char*)d_ws;
#if N_LAUNCH_PER_PHASE
    for (int k = 0; k < N_PHASES; ++k) { p.ph_lo = k; p.ph_hi = k + 1; hipLaunchKernelGGL(mega, dim3(grid), dim3(NTHREADS), LDS_BYTES, stream, p); }
#else
    p.ph_lo = 0; p.ph_hi = N_PHASES;
    hipLaunchKernelGGL(mega, dim3(grid), dim3(NTHREADS), LDS_BYTES, stream, p);
#endif
}
```

```cpp
#include <hip/hip_runtime.h>
#include <stdint.h>
#include <stdio.h>

#ifndef N_LAUNCH_PER_PHASE
#define N_LAUNCH_PER_PHASE 0
#endif

#define LAS __attribute__((address_space(3)))
#define DI __device__ __forceinline__
typedef unsigned short bf16_t;
typedef short bf16x8 __attribute__((ext_vector_type(8)));
typedef float f32x2 __attribute__((ext_vector_type(2)));
typedef float f32x4 __attribute__((ext_vector_type(4)));
typedef float f32x16 __attribute__((ext_vector_type(16)));
typedef unsigned u32x2 __attribute__((ext_vector_type(2)));
typedef unsigned u32x4 __attribute__((ext_vector_type(4)));
typedef __bf16 bf16v2 __attribute__((ext_vector_type(2)));

constexpr int NB = 2, NLAT = 8192, NCTX = 256, NT = NLAT + NCTX  , MROWS = NB * NT  ;
constexpr int DM = 1024, INW = 2816, NEXP = 256, TOPK = 8, NASG = MROWS * TOPK  ;
constexpr int NCHUNK = NT / 128;
constexpr float DN_ALPHA = 1.41421356237f;
constexpr float LN_EPS = 1e-6f, RMS_EPS = 1e-5f;
constexpr float LOG2E = 1.44269504089f;
constexpr float QSCALE = 0.125f * LOG2E;
constexpr int NTHREADS = 512;
constexpr int LDS_BYTES = 163840;

constexpr int IMG_BYTES = 32768, IMG_PER_E = 48;
constexpr int C_DQ = 0, C_DK = 512, C_DV = 1024, C_PU = 1536, C_RQ = 1792, C_RK = 2048, C_RV = 2304, C_RG = 2560;

constexpr size_t al256(size_t x) { return (x + 255) & ~(size_t)255; }
constexpr size_t WS_CTL = 0;
constexpr size_t CTL_BYTES = 65536;
constexpr size_t CTL_COUNTS = 16384;
constexpr size_t CTL_CURSOR = CTL_COUNTS + 2048;
constexpr size_t CTL_NTILES = CTL_CURSOR + 2048;
constexpr size_t CTL_XRANK = CTL_NTILES + 256;
constexpr size_t WS_MODV = WS_CTL + CTL_BYTES;
constexpr size_t WS_ROPE = al256(WS_MODV + 2 * 3 * 6144 * 4);
constexpr size_t WS_SCAL = al256(WS_ROPE + 128 * 16 * 8);
constexpr size_t WS_WIN = al256(WS_SCAL + 2 * 16 * 4);
constexpr size_t WS_WOUT = al256(WS_WIN + (size_t)2 * INW * DM * 2);
constexpr size_t WS_WR = al256(WS_WOUT + (size_t)2 * DM * DM * 2);
constexpr size_t WS_WIMG = al256(WS_WR + (size_t)2 * 256 * DM * 2);
constexpr size_t WS_XA = al256(WS_WIMG + (size_t)2 * 257 * 48 * 32768);
constexpr size_t WS_XB = al256(WS_XA + (size_t)MROWS * DM * 4);
constexpr size_t WS_V1 = al256(WS_XB + (size_t)MROWS * DM * 4);
constexpr size_t WS_H = al256(WS_V1 + (size_t)MROWS * DM * 4);
constexpr size_t WS_TOK = al256(WS_H + (size_t)MROWS * DM * 2);
constexpr size_t WS_P = al256(WS_TOK + (size_t)MROWS * DM * 2);
constexpr size_t WS_VT = al256(WS_P + (size_t)MROWS * INW * 2);
constexpr size_t WS_RKT = al256(WS_VT + (size_t)NB * 4 * 128 * NT * 2);
constexpr size_t WS_RVT = al256(WS_RKT + (size_t)NB * 4 * 64 * NT * 2);
constexpr size_t WS_MIX = al256(WS_RVT + (size_t)NB * 4 * 64 * NT * 2);
constexpr size_t ST_BYTES = (size_t)NB * 4 * NCHUNK * 4096 * 4;
constexpr size_t WS_UF = al256(WS_MIX + (size_t)MROWS * DM * 2);
constexpr size_t WS_UB = al256(WS_UF + ST_BYTES);
constexpr size_t WS_SF = al256(WS_UB + ST_BYTES);
constexpr size_t WS_SB = al256(WS_SF + ST_BYTES);
constexpr size_t WS_LOGIT = al256(WS_SB + ST_BYTES);
constexpr size_t WS_EIDX = al256(WS_LOGIT + (size_t)MROWS * 256 * 4);
constexpr size_t WS_GATE = al256(WS_EIDX + (size_t)NASG * 4);
constexpr size_t WS_SORT = al256(WS_GATE + (size_t)NASG * 4);
constexpr size_t WS_RANK = al256(WS_SORT + (size_t)NASG * 4);
constexpr size_t WS_HIST = al256(WS_RANK + (size_t)NASG * 4);
constexpr size_t WS_CONVDONE = al256(WS_HIST + (size_t)1024 * 256 * 4);
constexpr size_t WS_TILES = al256(WS_CONVDONE + 2 * 1024 * 4);
constexpr size_t WS_YSLOT = al256(WS_TILES + 2048 * 16);
constexpr size_t WS_YSH = al256(WS_YSLOT + (size_t)NASG * DM * 2);
constexpr size_t WS_END = al256(WS_YSH + (size_t)MROWS * DM * 2);

struct Params {
    const float *x, *c, *ctx, *c_ctx, *w_mod, *b_mod, *w_in, *w_out, *diff_lambda, *pool_w, *pool_scale, *ret_log_decay, *ln_g, *ln_b,
        *w_router, *router_bias, *w_egu, *w_edn, *w_sgu, *w_sdn;
    float* out;
    unsigned char* ws;
    int ph_lo, ph_hi;
};


DI Params launder(const Params& a) {
    size_t z = 0; asm volatile("" : "+s"(z));
    Params r = a;
#define LND(f) r.f = (decltype(r.f))((const unsigned char*)a.f + z)
    LND(x); LND(c); LND(ctx); LND(c_ctx); LND(w_mod); LND(b_mod); LND(w_in); LND(w_out); LND(diff_lambda); LND(pool_w); LND(pool_scale); LND(ret_log_decay); LND(ln_g); LND(ln_b);
    LND(w_router); LND(router_bias); LND(w_egu); LND(w_edn); LND(w_sgu); LND(w_sdn);
#undef LND
    r.out = (float*)((unsigned char*)a.out + z); r.ws = a.ws + z;
    return r;
}
DI int launder_s(int v) { asm volatile("" : "+s"(v)); return v; }
DI int tid_() { int t = threadIdx.x; asm volatile("" : "+v"(t)); return t; }
DI int bid_() { int t = blockIdx.x; asm volatile("" : "+s"(t)); return t; }


#ifndef PROBE_ID
#define PROBE_ID 0
#endif
#ifndef PROBE_GAIN
#define PROBE_GAIN 8
#endif
#define PRB_WORDS(lds) ((volatile LAS unsigned long long*)((lds) + LDS_BYTES - 64))
#define PRB_MATCH(id) (PROBE_ID == (id) || (PROBE_ID == 999 && (id) >= 200) || (PROBE_ID == 998 && ((id) == 101 || (id) == 102 || (id) == 104 || (id) == 105 || (id) == 108 || (id) == 109 || (id) == 110 || (id) == 111)))
#define PRB_T0(id, lds) do { if (PRB_MATCH(id) && threadIdx.x == 0 && blockIdx.x == 0) { PRB_WORDS(lds)[0] = __builtin_readcyclecounter(); } } while (0)
#define PRB_T1(id, lds) do { if (PRB_MATCH(id) && threadIdx.x == 0 && blockIdx.x == 0) { PRB_WORDS(lds)[1] += __builtin_readcyclecounter() - PRB_WORDS(lds)[0]; } } while (0)

#define XB_TMO      128
#define XB_XCNT(j)  (256  + 64 * (j))
#define XB_XSUB(j)  (1280 + 64 * (j))
#define XB_XGEN(j)  (2304 + 64 * (j))
#define XB_TOP      3328
#define XB_TOPGEN   3392
#define XCD_BAR_WORDS 3456
#define XB_SPIN_CAP (1u << 20)

__device__ __forceinline__ unsigned xb_ld(unsigned* p)              { return __hip_atomic_load(p, __ATOMIC_RELAXED, __HIP_MEMORY_SCOPE_AGENT); }
__device__ __forceinline__ unsigned xb_add(unsigned* p, unsigned v) { return __hip_atomic_fetch_add(p, v, __ATOMIC_RELAXED, __HIP_MEMORY_SCOPE_AGENT); }
__device__ __forceinline__ unsigned xb_xcc_id() { return (unsigned)__builtin_amdgcn_s_getreg((3 << 11) | 20) & 0xFu; }
#define XB_SPIN(cond, bar) do { unsigned _sp = 0; while (cond) { __builtin_amdgcn_s_sleep(1); \
    if ((++_sp & 255u) == 0u) { if (xb_ld(&(bar)[XB_TMO])) break; if (_sp > XB_SPIN_CAP) { atomicAdd(&(bar)[XB_TMO], 1u); break; } } } } while (0)

struct XcdBarrier { unsigned* bar; unsigned x; volatile LAS unsigned* st; };

__device__ __forceinline__ XcdBarrier xcd_barrier_post(unsigned* bar, volatile LAS unsigned* st) {
    XcdBarrier b; b.bar = bar; b.x = xb_xcc_id(); b.st = st;
    if (threadIdx.x == 0) (void)xb_add(&bar[XB_XCNT(b.x)], 1u);
    return b;
}
__device__ __forceinline__ void xcd_barrier_complete(unsigned* bar, unsigned x, unsigned& nloc, unsigned& nx) {
    const unsigned G = gridDim.x * gridDim.y * gridDim.z;
    unsigned sum, cnt, mine, sp = 0u;
    for (;;) {
        sum = 0u; cnt = 0u; mine = 0u;
#pragma unroll
        for (unsigned j = 0; j < 16; ++j) { const unsigned c = xb_ld(&bar[XB_XCNT(j)]); sum += c; cnt += (c > 0u) ? 1u : 0u; mine = (j == x) ? c : mine; }
        if (sum == G) break;
        __builtin_amdgcn_s_sleep(1);
        if ((++sp & 255u) == 0u) { if (xb_ld(&bar[XB_TMO])) break; if (sp > XB_SPIN_CAP) { atomicAdd(&bar[XB_TMO], 1u); break; } }
    }
    nloc = mine > 0u ? mine : 1u; nx = cnt > 0u ? cnt : 1u;
}
__device__ __forceinline__ void xcd_barrier(const XcdBarrier& b) {
    asm volatile("s_waitcnt vmcnt(0)" ::: "memory");
    __syncthreads();
    if (threadIdx.x == 0) {
        unsigned* bar = b.bar;
        __builtin_amdgcn_s_waitcnt(0);
        unsigned nloc = b.st[0], nx = b.st[1];
        if (nloc == 0u) { xcd_barrier_complete(bar, b.x, nloc, nx); b.st[0] = nloc; b.st[1] = nx; }
        const unsigned old = xb_add(&bar[XB_XSUB(b.x)], 1u);
        const unsigned gen = old / nloc;
        if (old + 1u == (gen + 1u) * nloc) {
            __builtin_amdgcn_fence(__ATOMIC_RELEASE, "agent");
            asm volatile("s_waitcnt vmcnt(0)" ::: "memory");
            const unsigned og = xb_add(&bar[XB_TOP], 1u);
            const unsigned tg = og / nx;
            if (og + 1u == (tg + 1u) * nx) xb_add(&bar[XB_TOPGEN], 1u);
            else XB_SPIN(xb_ld(&bar[XB_TOPGEN]) == tg, bar);
            __builtin_amdgcn_fence(__ATOMIC_ACQUIRE, "agent");
            xb_add(&bar[XB_XGEN(b.x)], 1u);
            asm volatile("s_waitcnt vmcnt(0)" ::: "memory");
        } else {
            XB_SPIN(xb_ld(&bar[XB_XGEN(b.x)]) == gen, bar);
            __builtin_amdgcn_fence(__ATOMIC_ACQUIRE, "agent");
            asm volatile("s_waitcnt vmcnt(0)" ::: "memory");
        }
    }
    __syncthreads();
}

DI unsigned pk_bf16(float a, float b) { f32x2 v = {a, b}; bf16v2 r = __builtin_convertvector(v, bf16v2); return __builtin_bit_cast(unsigned, r); }
DI bf16_t to_bf16(float a) { return (bf16_t)(pk_bf16(a, 0.f) & 0xffffu); }
DI float bf_lo(unsigned u) { return __uint_as_float(u << 16); }
DI float bf_hi(unsigned u) { return __uint_as_float(u & 0xffff0000u); }
DI float bf2f(bf16_t h) { return __uint_as_float(((unsigned)h) << 16); }
DI float wave_sum(float v) {
#pragma unroll
    for (int o = 32; o; o >>= 1) v += __shfl_xor(v, o);
    return v;
}
DI float fast_exp2(float x) { return __builtin_amdgcn_exp2f(x); }
DI float silu_f(float x) { return x / (1.f + __expf(-x)); }
DI bf16x8 as_bf16x8(u32x4 v) { return __builtin_bit_cast(bf16x8, v); }
#define WAIT_VM(n) asm volatile("s_waitcnt vmcnt(" #n ")" ::: "memory")
DI void dma16(const void* g, LAS unsigned char* l) { __builtin_amdgcn_global_load_lds(g, (LAS void*)l, 16, 0, 0); }
#define MFMA32(a, b, c) __builtin_amdgcn_mfma_f32_32x32x16_bf16((a), (b), (c), 0, 0, 0)
#define MFMA16(a, b, c) __builtin_amdgcn_mfma_f32_16x16x32_bf16((a), (b), (c), 0, 0, 0)

DI int row_sel(int r) { const int b = r >= NT; const int p = r - b * NT; return p < NCTX ? 2 : b; }

DI int swz_off(int row, int chunk) { return row * 128 + ((chunk ^ ((row >> 1) & 7)) << 4); }

DI int perm_gu(int n) { const int f = n >> 8, jj = n & 255; return ((jj >> 4) << 5) + (f << 4) + (jj & 15); }
DI void conv_unit(const float* src, int N, int K, bf16_t* dst, int k0, int n0, bool perm, LAS unsigned char* lds) {
    LAS float* tl = (LAS float*)lds;
    const int tid = tid_();
#pragma unroll
    for (int i = 0; i < 8; ++i) {
        const int kk = (tid >> 6) + 8 * i, nn = (tid & 63) * 4;
        const f32x4 v = *(const f32x4*)(src + (size_t)(k0 + kk) * N + n0 + nn);
        tl[kk * 257 + nn] = v[0]; tl[kk * 257 + nn + 1] = v[1]; tl[kk * 257 + nn + 2] = v[2]; tl[kk * 257 + nn + 3] = v[3];
    }
    __syncthreads();
    const int n = tid >> 1, kh = (tid & 1) * 32;
    const int nd = perm ? perm_gu(n0 + n) : (n0 + n);
    bf16_t* d = dst + (size_t)nd * K + k0 + kh;
#pragma unroll
    for (int q = 0; q < 4; ++q) {
        u32x4 w;
#pragma unroll
        for (int j = 0; j < 4; ++j) w[j] = pk_bf16(tl[(kh + q * 8 + 2 * j) * 257 + n], tl[(kh + q * 8 + 2 * j + 1) * 257 + n]);
        *(u32x4*)(d + q * 8) = w;
    }
    __syncthreads();
}

DI void phase_convert(const Params& p0, LAS unsigned char* lds) {
    const Params p = launder(p0);
    constexpr int U_IN = 176, U_OUT = 64, U_R = 16;
    constexpr int U_L = U_IN + U_OUT + U_R;
    for (int u = bid_(); u < 2 * U_L; u += gridDim.x) {
        const int l = u / U_L; int v = u % U_L;
        if (v < U_IN) { conv_unit(p.w_in + (size_t)l * DM * INW, INW, DM, (bf16_t*)(p.ws + WS_WIN) + (size_t)l * INW * DM, (v / 11) * 64, (v % 11) * 256, false, lds); continue; }
        v -= U_IN;
        if (v < U_OUT) { conv_unit(p.w_out + (size_t)l * DM * DM, DM, DM, (bf16_t*)(p.ws + WS_WOUT) + (size_t)l * DM * DM, (v / 4) * 64, (v % 4) * 256, false, lds); continue; }
        v -= U_OUT;
        conv_unit(p.w_router + (size_t)l * DM * 256, 256, DM, (bf16_t*)(p.ws + WS_WR) + (size_t)l * 256 * DM, v * 64, 0, false, lds);
    }
}

DI void phase_mod(const Params& p0, LAS unsigned char* lds) {
    const Params p = launder(p0);
    LAS float* sc = (LAS float*)lds;
    LAS float* red = sc + 3 * 1024;
    const int tid = tid_();
    float* modv = (float*)(p.ws + WS_MODV);
    for (int u = bid_(); u < 193; u += gridDim.x) {
        if (u == 192) {
            float* rope = (float*)(p.ws + WS_ROPE);
            for (int i = tid; i < 128 * 16; i += NTHREADS) {
                const int pos = i >> 4, f = i & 15;
                const float freq = powf(10000.0f, -(float)f / 16.0f);
                const float ang = (float)pos * freq;
                rope[2 * i] = cosf(ang); rope[2 * i + 1] = sinf(ang);
            }
            float* scal = (float*)(p.ws + WS_SCAL);
            if (tid < 2) {
                const int l = tid;
                const float* dl = p.diff_lambda + l * 256;
                float s01 = 0.f, s23 = 0.f;
                for (int i = 0; i < 64; ++i) { s01 += dl[i] * dl[64 + i]; s23 += dl[128 + i] * dl[192 + i]; }
                const float lambda_init = 0.8f - 0.6f * expf(-0.3f * (float)l);
                scal[l * 16 + 0] = expf(s01) - expf(s23) + lambda_init;
                scal[l * 16 + 1] = 1.0f - lambda_init;
                for (int h = 0; h < 4; ++h) {
                    scal[l * 16 + 2 + h] = -expf(p.ret_log_decay[l * 8 + h]) * LOG2E;
                    scal[l * 16 + 6 + h] = -expf(p.ret_log_decay[l * 8 + 4 + h]) * LOG2E;
                }
            }
            continue;
        }
        const int l = u / 96, n0 = (u % 96) * 64;
        for (int i = tid; i < 3 * 1024; i += NTHREADS) {
            const int s = i >> 10, k = i & 1023;
            const float v = s < 2 ? p.c[s * 1024 + k] : p.c_ctx[k];
            sc[i] = silu_f(v);
        }
        __syncthreads();
        const int kq = tid >> 6, nl = tid & 63;
        const float* w = p.w_mod + (size_t)l * DM * 6144 + n0 + nl;
        float a0 = 0.f, a1 = 0.f, a2 = 0.f;
        for (int k = kq * 128; k < kq * 128 + 128; ++k) {
            const float wv = w[(size_t)k * 6144];
            a0 += sc[k] * wv; a1 += sc[1024 + k] * wv; a2 += sc[2048 + k] * wv;
        }
        red[(kq * 3 + 0) * 64 + nl] = a0; red[(kq * 3 + 1) * 64 + nl] = a1; red[(kq * 3 + 2) * 64 + nl] = a2;
        __syncthreads();
        if (tid < 192) {
            const int s = tid >> 6, n = tid & 63;
            float v = 0.f;
            for (int q = 0; q < 8; ++q) v += red[(q * 3 + s) * 64 + n];
            modv[((size_t)l * 3 + s) * 6144 + n0 + n] = v + p.b_mod[l * 6144 + n0 + n];
        }
        __syncthreads();
    }
}

DI void ln_stats(const f32x4 (&v)[4], float& mu, float& rstd) {
    float s = 0.f;
#pragma unroll
    for (int i = 0; i < 4; ++i) s += (v[i][0] + v[i][1]) + (v[i][2] + v[i][3]);
    mu = wave_sum(s) * (1.0f / 1024.0f);
    float q = 0.f;
#pragma unroll
    for (int i = 0; i < 4; ++i)
#pragma unroll
        for (int j = 0; j < 4; ++j) { const float d = v[i][j] - mu; q += d * d; }
    rstd = rsqrtf(wave_sum(q) * (1.0f / 1024.0f) + LN_EPS);
}
DI void modulate_store(const f32x4 (&v)[4], const float* shift, const float* scale, bf16_t* dst, int lane) {
    float mu, rstd; ln_stats(v, mu, rstd);
#pragma unroll
    for (int i = 0; i < 4; ++i) {
        const int c = lane * 4 + i * 256;
        const f32x4 sh = *(const f32x4*)(shift + c), scv = *(const f32x4*)(scale + c);
        float o[4];
#pragma unroll
        for (int j = 0; j < 4; ++j) o[j] = (v[i][j] - mu) * rstd * (1.0f + scv[j]) + sh[j];
        u32x2 w = {pk_bf16(o[0], o[1]), pk_bf16(o[2], o[3])};
        *(u32x2*)(dst + c) = w;
    }
}

DI void phase_ln0(const Params& p0) {
    const Params p = launder(p0);
    const int lane = tid_() & 63, wid = tid_() >> 6;
    float* XA = (float*)(p.ws + WS_XA);
    bf16_t* H = (bf16_t*)(p.ws + WS_H);
    const float* modv = (const float*)(p.ws + WS_MODV);
    for (int r = bid_() * 8 + wid; r < MROWS; r += gridDim.x * 8) {
        const int b = r >= NT, pp = r - b * NT;
        const float* src = pp < NCTX ? p.ctx + ((size_t)b * NCTX + pp) * DM : p.x + ((size_t)b * NLAT + (pp - NCTX)) * DM;
        f32x4 v[4];
#pragma unroll
        for (int i = 0; i < 4; ++i) { v[i] = *(const f32x4*)(src + lane * 4 + i * 256); *(f32x4*)(XA + (size_t)r * DM + lane * 4 + i * 256) = v[i]; }
        const float* mv = modv + (size_t)(0 * 3 + (pp < NCTX ? 2 : b)) * 6144;
        modulate_store(v, mv, mv + 1024, H + (size_t)r * DM, lane);
    }
}

constexpr int G2_STG = 40960;
template <class Epi>
DI void gemm192(const bf16_t* A, int lda, const bf16_t* Bt, int ldb, int nk, int m0, int n0, LAS unsigned char* lds, const Epi& epi) {
    const int t = tid_(), lane = t & 63, wid = __builtin_amdgcn_readfirstlane(t >> 6), fr = lane & 15, fq = lane >> 4, wm = wid >> 1, wn = wid & 1;
    const bf16_t* asrc[3]; const bf16_t* bsrc[2];
#pragma unroll
    for (int i = 0; i < 3; ++i) { const int sl = t + 512 * i, row = sl >> 3, c = (sl & 7) ^ ((row >> 1) & 7); asrc[i] = A + (size_t)(m0 + row) * lda + c * 8; }
#pragma unroll
    for (int i = 0; i < 2; ++i) { const int sl = t + 512 * i, row = sl >> 3, c = (sl & 7) ^ ((row >> 1) & 7); bsrc[i] = Bt + (size_t)(n0 + row) * ldb + c * 8; }
    const int ddst = wid * 1024;
#define G2_ISSUE(S, KT) do { LAS unsigned char* _s = lds + (S) * G2_STG + ddst; const int _k = (KT) * 64; \
        dma16(asrc[0] + _k, _s); dma16(asrc[1] + _k, _s + 8192); dma16(asrc[2] + _k, _s + 16384); dma16(bsrc[0] + _k, _s + 24576); dma16(bsrc[1] + _k, _s + 32768); } while (0)
    f32x4 acc[4][3];
#pragma unroll
    for (int nf = 0; nf < 4; ++nf)
#pragma unroll
        for (int mf = 0; mf < 3; ++mf) acc[nf][mf] = (f32x4){0.f, 0.f, 0.f, 0.f};
    __syncthreads();
    G2_ISSUE(0, 0);
    if (nk > 1) G2_ISSUE(1, 1);
    int st = 0;
    for (int kt = 0; kt < nk; ++kt) {
        if (kt + 1 < nk) WAIT_VM(5); else WAIT_VM(0);
        asm volatile("s_waitcnt lgkmcnt(0)" ::: "memory");
        __builtin_amdgcn_s_barrier();
        const int st2 = st == 0 ? 2 : st - 1;
        if (kt + 2 < nk) G2_ISSUE(st2, kt + 2);
        LAS unsigned char* S = lds + st * G2_STG;
        st = st == 2 ? 0 : st + 1;
#pragma unroll
        for (int kk = 0; kk < 2; ++kk) {
            bf16x8 af[3], bfr[4];
#pragma unroll
            for (int mf = 0; mf < 3; ++mf) af[mf] = *(LAS bf16x8*)(S + swz_off(wm * 48 + mf * 16 + fr, kk * 4 + fq));
#pragma unroll
            for (int nf = 0; nf < 4; ++nf) bfr[nf] = *(LAS bf16x8*)(S + 24576 + swz_off(wn * 64 + nf * 16 + fr, kk * 4 + fq));
#pragma unroll
            for (int nf = 0; nf < 4; ++nf)
#pragma unroll
                for (int mf = 0; mf < 3; ++mf) acc[nf][mf] = MFMA16(bfr[nf], af[mf], acc[nf][mf]);
        }
    }
#undef G2_ISSUE
    __syncthreads();
    epi(acc, wm, wn, fr, fq, lane, wid);
}
DI LAS unsigned char* g2_stage(LAS unsigned char* lds, int wid) { return lds + wid * 13056; }

DI void phase_inproj(const Params& p0, int l, LAS unsigned char* lds) {
    const Params p = launder(p0); l = launder_s(l);
    const bf16_t* H = (const bf16_t*)(p.ws + WS_H);
    const bf16_t* W = (const bf16_t*)(p.ws + WS_WIN) + (size_t)l * INW * DM;
    bf16_t* P = (bf16_t*)(p.ws + WS_P);
    bf16_t* VT = (bf16_t*)(p.ws + WS_VT);
    bf16_t* RKT = (bf16_t*)(p.ws + WS_RKT);
    bf16_t* RVT = (bf16_t*)(p.ws + WS_RVT);
    const f32x2* rope = (const f32x2*)(p.ws + WS_ROPE);
    constexpr int NTN = INW / 128, NTM = MROWS / 192;
    for (int u = bid_(); u < NTM * NTN; u += gridDim.x) {
        const int tm = u / NTN, tn = u % NTN;
        auto epi = [&](f32x4 (&acc)[4][3], int wm, int wn, int fr, int fq, int lane, int wid) {
            const int c0 = tn * 128 + wn * 64;
            const int r0 = tm * 192 + wm * 48;
            LAS unsigned char* W_ = g2_stage(lds, wid);
            if (c0 < C_DV) {
                const float qs = c0 < C_DK ? QSCALE : 1.0f;
#pragma unroll
                for (int mf = 0; mf < 3; ++mf) {
                    const int row = r0 + mf * 16 + fr;
                    const int b = row >= NT, pp = row - b * NT;
                    const bool lat = pp >= NCTX;
                    const int tt = pp - NCTX;
#pragma unroll
                    for (int hb = 0; hb < 2; ++hb) {
                        const int axis = ((c0 >> 5) + hb) & 1;
                        const int pos = axis ? (tt & 63) : (tt >> 6);
#pragma unroll
                        for (int j = 0; j < 4; ++j) {
                            float x1 = acc[2 * hb][mf][j], x2 = acc[2 * hb + 1][mf][j];
                            if (lat) { const f32x2 cs = rope[pos * 16 + 4 * fq + j]; const float o1 = x1 * cs[0] - x2 * cs[1], o2 = x1 * cs[1] + x2 * cs[0]; x1 = o1; x2 = o2; }
                            acc[2 * hb][mf][j] = x1 * qs; acc[2 * hb + 1][mf][j] = x2 * qs;
                        }
                    }
                }
            } else if (c0 >= C_RK && c0 < C_RV) {
#pragma unroll
                for (int nf = 0; nf < 4; ++nf)
#pragma unroll
                    for (int mf = 0; mf < 3; ++mf) acc[nf][mf] *= 0.125f;
            }
#pragma unroll
            for (int nf = 0; nf < 4; ++nf)
#pragma unroll
                for (int mf = 0; mf < 3; ++mf) {
                    const f32x4 v = acc[nf][mf];
                    *(LAS u32x2*)(W_ + (mf * 16 + fr) * 144 + nf * 32 + fq * 8) = (u32x2){pk_bf16(v[0], v[1]), pk_bf16(v[2], v[3])};
                }
#pragma unroll
            for (int it = 0; it < 6; ++it) {
                const int row = it * 8 + (lane >> 3), ch = lane & 7;
                *(u32x4*)(P + (size_t)(r0 + row) * INW + c0 + ch * 8) = *(LAS u32x4*)(W_ + row * 144 + ch * 16);
            }
            const bool isv = c0 >= C_DV && c0 < C_PU, isk = c0 >= C_RK && c0 < C_RV, isr = c0 >= C_RV && c0 < C_RG;
            if (isv || isk || isr) {
                const int frp = isv ? ((fr & 3) | (((fr >> 2) == 1 ? 2 : ((fr >> 2) == 2 ? 1 : (fr >> 2))) << 2)) : fr;
                LAS bf16_t* T_ = (LAS bf16_t*)W_;
#pragma unroll
                for (int nf = 0; nf < 4; ++nf)
#pragma unroll
                    for (int mf = 0; mf < 3; ++mf)
#pragma unroll
                        for (int j = 0; j < 4; ++j) T_[(nf * 16 + 4 * fq + j) * 56 + mf * 16 + frp] = to_bf16(acc[nf][mf][j]);
                const int b = r0 >= NT, pp0 = r0 - b * NT;
                bf16_t* base; int nrows_per_head;
                if (isv) { const int cc = c0 - C_DV; base = VT + ((size_t)(b * 4 + (cc >> 7)) * 128 + (cc & 127)) * NT + pp0; }
                else if (isk) { const int cc = c0 - C_RK; base = RKT + ((size_t)(b * 4 + (cc >> 6)) * 64) * NT + pp0; }
                else { const int cc = c0 - C_RV; base = RVT + ((size_t)(b * 4 + (cc >> 6)) * 64) * NT + pp0; }
                (void)nrows_per_head;
#pragma unroll
                for (int it = 0; it < 6; ++it) {
                    const int sl = it * 64 + lane, n = sl / 6, pc = sl % 6;
                    *(u32x4*)(base + (size_t)n * NT + pc * 8) = *(LAS u32x4*)(W_ + n * 112 + pc * 16);
                }
            }
        };
        gemm192(H, DM, W, DM, DM / 64, tm * 192, tn * 128, lds, epi);
    }
}

DI void phase_ret_sum_pool(const Params& p0, int l, LAS unsigned char* lds) {
    const Params p = launder(p0); l = launder_s(l);
    const int tid = tid_(), lane = tid & 63, wid = tid >> 6, fr = lane & 15, g = lane >> 4;
    const float* scal = (const float*)(p.ws + WS_SCAL) + l * 16;
    const bf16_t* RKT = (const bf16_t*)(p.ws + WS_RKT);
    const bf16_t* RVT = (const bf16_t*)(p.ws + WS_RVT);
    float* UF = (float*)(p.ws + WS_UF);
    float* UB = (float*)(p.ws + WS_UB);
    for (int u = bid_(); u < NB * 4 * NCHUNK; u += gridDim.x) {
        const int c = u % NCHUNK, bh = u / NCHUNK, h = bh & 3;
        const int dir = wid >> 2, eb = wid & 3;
        const float l2 = dir ? scal[6 + h] : scal[2 + h];
        const bf16_t* vrow = RVT + ((size_t)bh * 64 + eb * 16 + fr) * NT + c * 128;
        f32x4 acc[4];
#pragma unroll
        for (int db = 0; db < 4; ++db) acc[db] = (f32x4){0.f, 0.f, 0.f, 0.f};
#pragma unroll
        for (int ks = 0; ks < 4; ++ks) {
            const int j0 = ks * 32 + 8 * g;
            const bf16x8 af = *(const bf16x8*)(vrow + j0);
            float w[8];
#pragma unroll
            for (int jj = 0; jj < 8; ++jj) { const int j = j0 + jj; w[jj] = fast_exp2((dir ? (float)j : (float)(127 - j)) * l2); }
#pragma unroll
            for (int db = 0; db < 4; ++db) {
                const u32x4 kr = *(const u32x4*)(RKT + ((size_t)bh * 64 + db * 16 + fr) * NT + c * 128 + j0);
                u32x4 kw;
#pragma unroll
                for (int q = 0; q < 4; ++q) kw[q] = pk_bf16(bf_lo(kr[q]) * w[2 * q], bf_hi(kr[q]) * w[2 * q + 1]);
                acc[db] = MFMA16(af, as_bf16x8(kw), acc[db]);
            }
        }
        const int cidx = dir ? (c >= 2 ? c - 2 : 64 + c) : c;
        float* U = (dir ? UB : UF) + ((size_t)bh * NCHUNK + cidx) * 4096;
#pragma unroll
        for (int db = 0; db < 4; ++db)
#pragma unroll
            for (int j = 0; j < 4; ++j) U[(eb * 16 + 4 * g + j) * 64 + db * 16 + fr] = acc[db][j];
    }
    LAS float* ul = (LAS float*)lds;
    LAS float* dT = ul + 48 * 256;
    LAS float* pwl = dT + 256 * 36;
    const bf16_t* P = (const bf16_t*)(p.ws + WS_P);
    bf16_t* MIX = (bf16_t*)(p.ws + WS_MIX);
    const float* pw = p.pool_w + (size_t)l * 4 * 64 * 64;
    const float* ps = p.pool_scale + l * 256;
    __syncthreads();
    if (bid_() < MROWS / 32) {
#pragma unroll
        for (int i = 0; i < 8; ++i) *(LAS f32x4*)(pwl + (tid + 512 * i) * 4) = *(const f32x4*)(pw + (tid + 512 * i) * 4);
    }
    for (int u = bid_(); u < MROWS / 32; u += gridDim.x) {
        const int r0 = u * 32;
        const int b = r0 >= NT, pp0 = r0 - b * NT;
        const int s0 = pp0 < NCTX ? b * NT : b * NT + NCTX, s1 = pp0 < NCTX ? b * NT + NCTX : (b + 1) * NT;
        __syncthreads();
        {
            u32x2 wv[6]; bool ok[6];
#pragma unroll
            for (int it = 0; it < 6; ++it) {
                const int i = tid + 512 * it, rr = i >> 6, c4 = (i & 63) * 4, row = r0 - 8 + rr;
                ok[it] = row >= s0 && row < s1;
                wv[it] = ok[it] ? *(const u32x2*)(P + (size_t)row * INW + C_PU + c4) : (u32x2){0u, 0u};
            }
#pragma unroll
            for (int it = 0; it < 6; ++it) {
                const int i = tid + 512 * it, rr = i >> 6, c4 = (i & 63) * 4;
                *(LAS f32x4*)(ul + rr * 256 + c4) = (f32x4){bf_lo(wv[it][0]), bf_hi(wv[it][0]), bf_lo(wv[it][1]), bf_hi(wv[it][1])};
            }
        }
        __syncthreads();
        {
            const int c = tid & 255, gi = c >> 6, rb = tid >> 8;
#define POOL_WIN(HW) do { _Pragma("unroll") for (int it = 0; it < 16; ++it) { const int rr = it * 2 + rb, row = r0 + rr; float sm = 0.f; \
                _Pragma("unroll") for (int q = -(HW); q < (HW); ++q) sm += ul[(rr + 8 + q) * 256 + c]; \
                const int lo = (row - (HW)) < s0 ? s0 : (row - (HW)), hi = (row + (HW)) > s1 ? s1 : (row + (HW)); \
                dT[c * 36 + rr] = sm / (float)(hi - lo) - ul[(rr + 8) * 256 + c]; } } while (0)
            if (gi == 0) POOL_WIN(1); else if (gi == 1) POOL_WIN(2); else if (gi == 2) POOL_WIN(4); else POOL_WIN(8);
#undef POOL_WIN
        }
        __syncthreads();
        {
            const int oc = tid & 255, rh = (tid >> 8) * 16, gi = oc >> 6, e = oc & 63;
            float acc[16];
#pragma unroll
            for (int i = 0; i < 16; ++i) acc[i] = 0.f;
#pragma unroll 8
            for (int c = 0; c < 64; ++c) {
                const float wv = pwl[(gi * 64 + c) * 64 + e];
                const LAS float* dr = dT + (gi * 64 + c) * 36 + rh;
#pragma unroll
                for (int i = 0; i < 4; ++i) { const f32x4 d = *(const LAS f32x4*)(dr + 4 * i); acc[4 * i] += d[0] * wv; acc[4 * i + 1] += d[1] * wv; acc[4 * i + 2] += d[2] * wv; acc[4 * i + 3] += d[3] * wv; }
            }
            const float sc = ps[oc];
#pragma unroll
            for (int i = 0; i < 16; ++i) MIX[(size_t)(r0 + rh + i) * DM + 512 + oc] = to_bf16(acc[i] * sc);
        }
    }
    __syncthreads();
}

DI void phase_ret_scan(const Params& p0, int l) {
    const Params p = launder(p0); l = launder_s(l);
    const float* scal = (const float*)(p.ws + WS_SCAL) + l * 16;
    const float* UF = (const float*)(p.ws + WS_UF); const float* UB = (const float*)(p.ws + WS_UB);
    bf16_t* SF = (bf16_t*)(p.ws + WS_SF); bf16_t* SB = (bf16_t*)(p.ws + WS_SB);
    for (int i = bid_() * NTHREADS + tid_(); i < 2 * NB * 4 * 4096; i += gridDim.x * NTHREADS) {
        const int dir = i / (NB * 4 * 4096), rem = i % (NB * 4 * 4096), bh = rem >> 12, el = rem & 4095, h = bh & 3;
        const float G = fast_exp2(128.0f * (dir ? scal[6 + h] : scal[2 + h]));
        float S = 0.f;
        if (dir == 0) {
#pragma unroll 11
            for (int c = 0; c < NCHUNK; ++c) { const size_t o = ((size_t)bh * NCHUNK + c) * 4096 + el; SF[o] = to_bf16(S); S = S * G + UF[o]; } }
        else {
#pragma unroll 11
            for (int c = NCHUNK - 1; c >= 0; --c) { const size_t o = ((size_t)bh * NCHUNK + c) * 4096 + el; SB[o] = to_bf16(S); S = S * G + UB[o]; } }
    }
}

DI void attn_unit(const Params& p, int l, int b, int h, int q_p0, int ntile, float lam, float oscale, int& conv_done, LAS unsigned char* lds) {
    const int tid = tid_(), lane = tid & 63, wid = __builtin_amdgcn_readfirstlane(tid >> 6), map = wid >> 2, wq = wid & 3, r = lane & 31, hh = lane >> 5;
    const bf16_t* P = (const bf16_t*)(p.ws + WS_P);
    const bf16_t* VT = (const bf16_t*)(p.ws + WS_VT);
    bf16_t* MIX = (bf16_t*)(p.ws + WS_MIX);
    const size_t rowbase = (size_t)b * NT;
    const int qrow = q_p0 + wq * 32 + r;
    bf16x8 qf[4];
#pragma unroll
    for (int ks = 0; ks < 4; ++ks) qf[ks] = *(const bf16x8*)(P + (rowbase + qrow) * INW + C_DQ + h * 128 + map * 64 + ks * 16 + hh * 8);
    constexpr int ASTG = 32768, CRING = 98304, CSLOT = 16384;
    const int t8 = tid & 255, w4 = wid & 3;
    const bf16_t* ksrc; const bf16_t* vsrc;
    { const int key = t8 >> 4, ph = t8 & 15, c = ph ^ (key & 15);
      ksrc = P + (rowbase + key) * INW + C_DK + h * 128 + c * 8;
      const int e = t8 >> 3, pv = t8 & 7, cv = pv ^ ((e >> 1) & 7);
      vsrc = VT + ((size_t)(b * 4 + h) * 128 + e) * NT + cv * 8; }
    const int ddst = w4 * 1024;
#define ATT_ISSUE(S, KT) do { LAS unsigned char* _s = lds + (S) * ASTG + ddst; const bf16_t* _k = ksrc + (size_t)(KT) * 64 * INW; const bf16_t* _v = vsrc + (KT) * 64; \
        _Pragma("unroll") for (int m = 0; m < 4; ++m) { dma16(_k + (size_t)m * 16 * INW, _s + m * 4096); dma16(_v + (size_t)m * 32 * NT, _s + 16384 + m * 4096); } } while (0)
    constexpr int NSLICE = (NEXP + 1) * IMG_PER_E * 4;
    const int G_ = gridDim.x, bidc = bid_();
    const int mine = (NSLICE - bidc + G_ - 1) / G_;
    const int lim = __builtin_amdgcn_readfirstlane((mine - conv_done) < (ntile - 2) ? ((mine - conv_done) < 0 ? 0 : (mine - conv_done)) : (ntile - 2));
    const int cbase = conv_done;
    conv_done += lim;
    unsigned char* IMGL = p.ws + WS_WIMG + (size_t)l * (NEXP + 1) * IMG_PER_E * IMG_BYTES;
#define CONV_SRC(SI, SRCP, LDW) do { const int _s = bidc + G_ * (cbase + (SI)); const int _u = _s >> 2, _qd = _s & 3, _e = _u / IMG_PER_E, _im = _u % IMG_PER_E; \
        const int _k = t8 >> 5, _np = 128 * _qd + 4 * (t8 & 31); \
        if (_im < 32) { const float* _W = _e < NEXP ? p.w_egu + ((size_t)l * NEXP + _e) * DM * 512 : p.w_sgu + (size_t)l * DM * 512; LDW = 512; \
            SRCP = _W + (size_t)(_im * 32 + _k) * 512 + (((_np >> 4) & 1) * 256 + (_np >> 5) * 16 + (_np & 15)); } \
        else { const float* _W = _e < NEXP ? p.w_edn + ((size_t)l * NEXP + _e) * 256 * DM : p.w_sdn + (size_t)l * 256 * DM; LDW = DM; \
            SRCP = _W + (size_t)(((_im - 32) & 7) * 32 + _k) * DM + ((_im - 32) >> 3) * 512 + _np; } } while (0)
    f32x16 o[4];
#pragma unroll
    for (int eb = 0; eb < 4; ++eb)
#pragma unroll
        for (int i = 0; i < 16; ++i) o[eb][i] = 0.f;
    f32x16 negm;
#pragma unroll
    for (int i = 0; i < 16; ++i) negm[i] = 0.f;
    float m_run = 0.f, l_run = 0.f;
#pragma unroll
    for (int ks = 0; ks < 4; ++ks) asm volatile("" : "+v"(qf[ks]));
    __syncthreads();
    if (map == 0) { ATT_ISSUE(0, 0); if (ntile > 1) ATT_ISSUE(1, 1); }
    int st = 0;
    for (int kt = 0; kt < ntile; ++kt) {
        PRB_T0(1, lds);
        const bool cproc = kt >= 2 && kt - 2 < lim;
        if (map == 0) { if (kt + 1 < ntile) WAIT_VM(8); else WAIT_VM(0); }
        else if (cproc) {
            const int n = (kt >= 4 ? 2 : 0) + (kt - 1 < lim ? 4 : 0) + (kt >= 3 ? 2 : 0);
            if (n == 8) WAIT_VM(8); else if (n == 6) WAIT_VM(6); else if (n == 4) WAIT_VM(4); else if (n == 2) WAIT_VM(2); else WAIT_VM(0);
        }
        asm volatile("s_waitcnt lgkmcnt(0)" ::: "memory");
        __builtin_amdgcn_s_barrier();
        PRB_T1(1, lds); PRB_T0(2, lds);
        const int st2 = st == 0 ? 2 : st - 1;
        if (map == 0) { if (kt + 2 < ntile) ATT_ISSUE(st2, kt + 2); }
        else if (kt < lim) {
            const float* srcp; int ldw; CONV_SRC(kt, srcp, ldw);
            LAS unsigned char* _d = lds + CRING + (kt % 3) * CSLOT + w4 * 1024;
#pragma unroll
            for (int m = 0; m < 4; ++m) dma16(srcp + (size_t)m * 8 * ldw, _d + m * 4096);
        }
        LAS unsigned char* L = lds + st * ASTG;
        st = st == 2 ? 0 : st + 1;
        bf16x8 kf[8], va[4], vb[4];
#pragma unroll
        for (int ks = 0; ks < 4; ++ks) {
            const int ch = map * 8 + ks * 2 + hh;
            const int off = r * 256 + ((ch ^ (r & 15)) << 4);
            kf[2 * ks] = *(LAS bf16x8*)(L + off);
            kf[2 * ks + 1] = *(LAS bf16x8*)(L + off + 32 * 256);
        }
#define ATT_VREAD(dst, S_) do { _Pragma("unroll") for (int eb = 0; eb < 4; ++eb) { const int e = eb * 32 + r; \
            dst[eb] = *(LAS bf16x8*)(L + 16384 + e * 128 + ((((S_) * 2 + hh) ^ ((e >> 1) & 7)) << 4)); } } while (0)
#define ATT_PACK(dst, SRC, B_) do { u32x4 _pw; _Pragma("unroll") for (int q = 0; q < 4; ++q) _pw[q] = pk_bf16(SRC[(B_) + 2 * q], SRC[(B_) + 2 * q + 1]); dst = as_bf16x8(_pw); } while (0)
#define ATT_EXP8(SRC, B_) do { _Pragma("unroll") for (int i = 0; i < 8; ++i) { SRC[(B_) + i] = fast_exp2(SRC[(B_) + i]); rsum += SRC[(B_) + i]; pmx = fmaxf(pmx, SRC[(B_) + i]); } } while (0)
        ATT_VREAD(va, 0);
        asm volatile("" ::: "memory");
        f32x16 s0 = negm, s1 = negm;
#pragma unroll
        for (int ks = 0; ks < 4; ++ks) { s0 = MFMA32(kf[2 * ks], qf[ks], s0); s1 = MFMA32(kf[2 * ks + 1], qf[ks], s1); }
        if (map == 1 && cproc) {
            const int sj = bidc + G_ * (cbase + kt - 2); const int uu = sj >> 2, qd = sj & 3;
            const LAS float* raw = (const LAS float*)(lds + CRING + ((kt - 2) % 3) * CSLOT);
            unsigned char* img = IMGL + (size_t)uu * IMG_BYTES + (size_t)(128 * qd) * 64;
#pragma unroll
            for (int hcv = 0; hcv < 2; ++hcv) {
                const int cidx = t8 + 256 * hcv, row = cidx >> 2, chunk = cidx & 3;
                float f[8];
#pragma unroll
                for (int kk = 0; kk < 8; ++kk) f[kk] = raw[(chunk * 8 + kk) * 128 + row];
                const u32x4 w = {pk_bf16(f[0], f[1]), pk_bf16(f[2], f[3]), pk_bf16(f[4], f[5]), pk_bf16(f[6], f[7])};
                const int np = 128 * qd + row;
                *(u32x4*)(img + row * 64 + ((chunk ^ ((0 - (np >> 2)) & 3)) << 4)) = w;
            }
        }
        PRB_T1(2, lds); PRB_T0(3, lds);
        if (kt == 0) {
            float mx = fmaxf(fmaxf(s0[0], s0[1]), s0[2]);
#pragma unroll
            for (int i = 3; i < 15; i += 2) mx = fmaxf(fmaxf(mx, s0[i]), s0[i + 1]);
            mx = fmaxf(mx, s0[15]);
#pragma unroll
            for (int i = 0; i < 16; i += 2) mx = fmaxf(fmaxf(mx, s1[i]), s1[i + 1]);
            mx = fmaxf(mx, __shfl_xor(mx, 32));
            m_run = mx;
#pragma unroll
            for (int i = 0; i < 16; ++i) { s0[i] -= mx; s1[i] -= mx; negm[i] = -mx; }
        }
        float rsum = 0.f, pmx = 0.f;
        bf16x8 pb;
        ATT_EXP8(s0, 0); ATT_PACK(pb, s0, 0);
        ATT_VREAD(vb, 1); asm volatile("" ::: "memory");
#pragma unroll
        for (int eb = 0; eb < 4; ++eb) o[eb] = MFMA32(va[eb], pb, o[eb]);
        ATT_EXP8(s0, 8); ATT_PACK(pb, s0, 8);
        ATT_VREAD(va, 2); asm volatile("" ::: "memory");
#pragma unroll
        for (int eb = 0; eb < 4; ++eb) o[eb] = MFMA32(vb[eb], pb, o[eb]);
        ATT_EXP8(s1, 0); ATT_PACK(pb, s1, 0);
        ATT_VREAD(vb, 3); asm volatile("" ::: "memory");
#pragma unroll
        for (int eb = 0; eb < 4; ++eb) o[eb] = MFMA32(va[eb], pb, o[eb]);
        ATT_EXP8(s1, 8); ATT_PACK(pb, s1, 8);
#pragma unroll
        for (int eb = 0; eb < 4; ++eb) o[eb] = MFMA32(vb[eb], pb, o[eb]);
        l_run += rsum;
        PRB_T1(3, lds);
#undef ATT_VREAD
#undef ATT_PACK
#undef ATT_EXP8
        pmx = fmaxf(pmx, __shfl_xor(pmx, 32));
        if (__any(pmx > 256.0f)) {
            const float d = pmx > 256.0f ? __builtin_amdgcn_logf(pmx) : 0.f;
            const float alpha = fast_exp2(-d);
            m_run += d; l_run *= alpha;
#pragma unroll
            for (int i = 0; i < 16; ++i) negm[i] = -m_run;
#pragma unroll
            for (int eb = 0; eb < 4; ++eb)
#pragma unroll
                for (int i = 0; i < 16; ++i) o[eb][i] *= alpha;
        }
    }
#undef ATT_ISSUE
#undef CONV_SRC
    __syncthreads();
    const float lt = l_run + __shfl_xor(l_run, 32);
    const float inv = 1.0f / lt;
    LAS float* X = (LAS float*)lds;
    if (map == 1) {
#pragma unroll
        for (int eb = 0; eb < 4; ++eb)
#pragma unroll
            for (int i = 0; i < 16; ++i) X[(wq * 64 + eb * 16 + i) * 64 + lane] = o[eb][i] * inv;
    }
    __syncthreads();
    if (map == 0) {
        float ss = 0.f;
#pragma unroll
        for (int eb = 0; eb < 4; ++eb)
#pragma unroll
            for (int i = 0; i < 16; ++i) { const float v = o[eb][i] * inv - lam * X[(wq * 64 + eb * 16 + i) * 64 + lane]; o[eb][i] = v; ss += v * v; }
        ss += __shfl_xor(ss, 32);
        const float sc = rsqrtf(ss * (1.0f / 128.0f) + RMS_EPS) * oscale;
        LAS unsigned char* W = lds + 65536 + wq * 8704;
#pragma unroll
        for (int eb = 0; eb < 4; ++eb)
#pragma unroll
            for (int q = 0; q < 4; ++q) {
                const int e = eb * 32 + 8 * q + 4 * hh;
                const u32x2 w = {pk_bf16(o[eb][4 * q] * sc, o[eb][4 * q + 1] * sc), pk_bf16(o[eb][4 * q + 2] * sc, o[eb][4 * q + 3] * sc)};
                *(LAS u32x2*)(W + r * 272 + e * 2) = w;
            }
#pragma unroll
        for (int it = 0; it < 8; ++it) {
            const int row = it * 4 + (lane >> 4), ch = lane & 15;
            const u32x4 v = *(LAS u32x4*)(W + row * 272 + ch * 16);
            *(u32x4*)(MIX + (rowbase + q_p0 + wq * 32 + row) * DM + h * 128 + ch * 8) = v;
        }
    }
    __syncthreads();
}

DI void ret_unit(const Params& p, int l, int b, int h, int c) {
    const int tid = tid_(), lane = tid & 63, wid = tid >> 6, fr = lane & 15, g = lane >> 4;
    const float* scal = (const float*)(p.ws + WS_SCAL) + l * 16;
    const float lf2 = scal[2 + h], lb2 = scal[6 + h];
    const bf16_t* P = (const bf16_t*)(p.ws + WS_P);
    const bf16_t* RVT = (const bf16_t*)(p.ws + WS_RVT);
    const bf16_t* SF = (const bf16_t*)(p.ws + WS_SF); const bf16_t* SB = (const bf16_t*)(p.ws + WS_SB);
    bf16_t* MIX = (bf16_t*)(p.ws + WS_MIX);
    const int bh = b * 4 + h;
    const size_t row0 = (size_t)b * NT + c * 128;
    const int iloc = wid * 16 + fr;
    u32x4 qraw[2];
#pragma unroll
    for (int ks = 0; ks < 2; ++ks) qraw[ks] = *(const u32x4*)(P + (row0 + iloc) * INW + C_RQ + h * 64 + ks * 32 + 8 * g);
    bf16x8 kf[8][2];
#pragma unroll
    for (int jb = 0; jb < 8; ++jb)
#pragma unroll
        for (int ks = 0; ks < 2; ++ks) kf[jb][ks] = *(const bf16x8*)(P + (row0 + jb * 16 + fr) * INW + C_RK + h * 64 + ks * 32 + 8 * g);
    u32x4 vf[4][4];
#pragma unroll
    for (int jj = 0; jj < 4; ++jj)
#pragma unroll
        for (int eb = 0; eb < 4; ++eb) {
            const bf16_t* vp = RVT + ((size_t)bh * 64 + eb * 16 + fr) * NT + c * 128 + jj * 32 + 4 * g;
            const u32x2 v0 = *(const u32x2*)vp, v1 = *(const u32x2*)(vp + 16);
            vf[jj][eb] = (u32x4){v0[0], v0[1], v1[0], v1[1]};
        }
    f32x4 st[8];
#pragma unroll
    for (int jb = 0; jb < 8; ++jb) {
        st[jb] = (f32x4){0.f, 0.f, 0.f, 0.f};
#pragma unroll
        for (int ks = 0; ks < 2; ++ks) st[jb] = MFMA16(kf[jb][ks], as_bf16x8(qraw[ks]), st[jb]);
    }
    const int vc = c >= 2 ? c - 2 : 64 + c;
    const bf16_t* sf = SF + ((size_t)bh * NCHUNK + c) * 4096 + fr * 64 + 8 * g;
    const bf16_t* sb = SB + ((size_t)bh * NCHUNK + vc) * 4096 + fr * 64 + 8 * g;
    bf16x8 sfa[2][4], sba[2][4];
#pragma unroll
    for (int ks = 0; ks < 2; ++ks)
#pragma unroll
        for (int eb = 0; eb < 4; ++eb) { sfa[ks][eb] = *(const bf16x8*)(sf + eb * 1024 + ks * 32); sba[ks][eb] = *(const bf16x8*)(sb + eb * 1024 + ks * 32); }
    u32x2 gw[4];
#pragma unroll
    for (int eb = 0; eb < 4; ++eb) gw[eb] = *(const u32x2*)(P + (row0 + iloc) * INW + C_RG + h * 64 + eb * 16 + 4 * g);
#pragma unroll
    for (int jb = 0; jb < 8; ++jb)
#pragma unroll
        for (int q = 0; q < 4; ++q) {
            const int j = jb * 16 + 4 * g + q;
            const int d = iloc - j;
            const float w = d > 0 ? fast_exp2((float)d * lf2) : (d < 0 ? fast_exp2((float)(-d) * lb2) : 2.0f);
            st[jb][q] *= w;
        }
    f32x4 ot[4];
#pragma unroll
    for (int eb = 0; eb < 4; ++eb) ot[eb] = (f32x4){0.f, 0.f, 0.f, 0.f};
#pragma unroll
    for (int jj = 0; jj < 4; ++jj) {
        const u32x4 pw = {pk_bf16(st[2 * jj][0], st[2 * jj][1]), pk_bf16(st[2 * jj][2], st[2 * jj][3]), pk_bf16(st[2 * jj + 1][0], st[2 * jj + 1][1]), pk_bf16(st[2 * jj + 1][2], st[2 * jj + 1][3])};
#pragma unroll
        for (int eb = 0; eb < 4; ++eb) ot[eb] = MFMA16(as_bf16x8(vf[jj][eb]), as_bf16x8(pw), ot[eb]);
    }
    const float df = fast_exp2((float)(iloc + 1) * lf2), db = fast_exp2((float)(128 - iloc) * lb2);
#pragma unroll
    for (int ks = 0; ks < 2; ++ks) {
        u32x4 qf, qb;
#pragma unroll
        for (int q = 0; q < 4; ++q) { const float a = bf_lo(qraw[ks][q]), bb = bf_hi(qraw[ks][q]); qf[q] = pk_bf16(a * df, bb * df); qb[q] = pk_bf16(a * db, bb * db); }
#pragma unroll
        for (int eb = 0; eb < 4; ++eb) {
            ot[eb] = MFMA16(sfa[ks][eb], as_bf16x8(qf), ot[eb]);
            ot[eb] = MFMA16(sba[ks][eb], as_bf16x8(qb), ot[eb]);
        }
    }
    float s = 0.f;
#pragma unroll
    for (int eb = 0; eb < 4; ++eb) s += (ot[eb][0] + ot[eb][1]) + (ot[eb][2] + ot[eb][3]);
    s += __shfl_xor(s, 16); s += __shfl_xor(s, 32);
    const float mu = s * (1.0f / 64.0f);
    float q2 = 0.f;
#pragma unroll
    for (int eb = 0; eb < 4; ++eb)
#pragma unroll
        for (int q = 0; q < 4; ++q) { const float d = ot[eb][q] - mu; q2 += d * d; }
    q2 += __shfl_xor(q2, 16); q2 += __shfl_xor(q2, 32);
    const float rstd = rsqrtf(q2 * (1.0f / 64.0f) + LN_EPS);
#pragma unroll
    for (int eb = 0; eb < 4; ++eb) {
        const int e = eb * 16 + 4 * g;
        const float g0 = bf_lo(gw[eb][0]), g1 = bf_hi(gw[eb][0]), g2 = bf_lo(gw[eb][1]), g3 = bf_hi(gw[eb][1]);
        u32x2 w = {pk_bf16((ot[eb][0] - mu) * rstd * silu_f(g0), (ot[eb][1] - mu) * rstd * silu_f(g1)),
                   pk_bf16((ot[eb][2] - mu) * rstd * silu_f(g2), (ot[eb][3] - mu) * rstd * silu_f(g3))};
        *(u32x2*)(MIX + (row0 + iloc) * DM + 768 + h * 64 + e) = w;
    }
}

DI void phase_attn(const Params& p0, int l, LAS unsigned char* lds) {
    const Params p = launder(p0); l = launder_s(l);
    const float* scal = (const float*)(p.ws + WS_SCAL) + l * 16;
    const float lam = scal[0], oscale = scal[1];
    const int nunits = NB * 4 * 64 + (l == 0 ? NB * 4 * 2 : 0);
    int conv_done = 0;
    for (int u = bid_(); u < nunits; u += gridDim.x) {
        int b, h, q0, ntile;
        if (u < NB * 4 * 64) { const int qt = u & 63; h = (u >> 6) & 3; b = u >> 8; q0 = NCTX + qt * 128; ntile = NT / 64; }
        else { const int v = u - NB * 4 * 64; const int qt = v & 1; h = (v >> 1) & 3; b = v >> 3; q0 = qt * 128; ntile = NCTX / 64; }
        attn_unit(p, l, b, h, q0, ntile, lam, oscale, conv_done, lds);
    }
    if (tid_() == 0) ((int*)(p.ws + WS_CONVDONE))[l * 1024 + bid_()] = conv_done;
}
DI void phase_ret(const Params& p0, int l) {
    const Params p = launder(p0); l = launder_s(l);
    for (int u = bid_(); u < NB * 4 * NCHUNK; u += gridDim.x) {
        const int c = u % NCHUNK, bh = u / NCHUNK;
        if (l == 1 && c < 2) continue;
        ret_unit(p, l, bh >> 2, bh & 3, c);
    }
}

DI void phase_outproj(const Params& p0, int l, LAS unsigned char* lds) {
    const Params p = launder(p0); l = launder_s(l);
    const float* Xin = (const float*)(p.ws + WS_XA);
    const bf16_t* A = (const bf16_t*)(p.ws + WS_MIX);
    const bf16_t* W = (const bf16_t*)(p.ws + WS_WOUT) + (size_t)l * DM * DM;
    float* V1 = (float*)(p.ws + WS_V1);
    const float* modv = (const float*)(p.ws + WS_MODV) + (size_t)l * 3 * 6144;
    for (int u = bid_(); u < (MROWS / 192) * 8; u += gridDim.x) {
        const int tm = u >> 3, tn = u & 7;
        auto epi = [&](f32x4 (&acc)[4][3], int wm, int wn, int fr, int fq, int lane, int wid) {
            const int c0 = tn * 128 + wn * 64, r0 = tm * 192 + wm * 48;
            LAS unsigned char* W_ = g2_stage(lds, wid);
            f32x4 xv[12], g2v[12];
#pragma unroll
            for (int it = 0; it < 12; ++it) {
                const int grow = r0 + it * 4 + (lane >> 4), ch = lane & 15;
                xv[it] = *(const f32x4*)(Xin + (size_t)grow * DM + c0 + ch * 4);
                g2v[it] = *(const f32x4*)(modv + (size_t)row_sel(grow) * 6144 + 2 * 1024 + c0 + ch * 4);
            }
#pragma unroll
            for (int nf = 0; nf < 4; ++nf)
#pragma unroll
                for (int mf = 0; mf < 3; ++mf) *(LAS f32x4*)(W_ + (mf * 16 + fr) * 272 + nf * 64 + fq * 16) = acc[nf][mf];
#pragma unroll
            for (int it = 0; it < 12; ++it) {
                const int row = it * 4 + (lane >> 4), ch = lane & 15;
                const int grow = r0 + row;
                const f32x4 y = *(LAS f32x4*)(W_ + row * 272 + ch * 16);
                *(f32x4*)(V1 + (size_t)grow * DM + c0 + ch * 4) = (f32x4){DN_ALPHA * xv[it][0] + g2v[it][0] * y[0], DN_ALPHA * xv[it][1] + g2v[it][1] * y[1], DN_ALPHA * xv[it][2] + g2v[it][2] * y[2], DN_ALPHA * xv[it][3] + g2v[it][3] * y[3]};
            }
        };
        gemm192(A, DM, W, DM, DM / 64, tm * 192, tn * 128, lds, epi);
    }
}

DI void phase_ln_mid(const Params& p0, int l) {
    const Params p = launder(p0); l = launder_s(l);
    float* Xout = (float*)(p.ws + WS_XB);
    const int lane = tid_() & 63, wid = tid_() >> 6;
    const float* V1 = (const float*)(p.ws + WS_V1);
    bf16_t* TOK = (bf16_t*)(p.ws + WS_TOK);
    const float* modv = (const float*)(p.ws + WS_MODV) + (size_t)l * 3 * 6144;
    const float* lg = p.ln_g + (size_t)(l * 2 + 0) * DM; const float* lb = p.ln_b + (size_t)(l * 2 + 0) * DM;
    for (int r = bid_() * 8 + wid; r < MROWS; r += gridDim.x * 8) {
        f32x4 v[4];
#pragma unroll
        for (int i = 0; i < 4; ++i) v[i] = *(const f32x4*)(V1 + (size_t)r * DM + lane * 4 + i * 256);
        float mu, rstd; ln_stats(v, mu, rstd);
#pragma unroll
        for (int i = 0; i < 4; ++i) {
            const int c = lane * 4 + i * 256;
            const f32x4 gg = *(const f32x4*)(lg + c), bb = *(const f32x4*)(lb + c);
#pragma unroll
            for (int j = 0; j < 4; ++j) v[i][j] = (v[i][j] - mu) * rstd * gg[j] + bb[j];
            *(f32x4*)(Xout + (size_t)r * DM + c) = v[i];
        }
        const float* mv = modv + (size_t)row_sel(r) * 6144;
        modulate_store(v, mv + 3 * 1024, mv + 4 * 1024, TOK + (size_t)r * DM, lane);
    }
}

DI void phase_router(const Params& p0, int l, LAS unsigned char* lds) {
    const Params p = launder(p0); l = launder_s(l);
    const bf16_t* A = (const bf16_t*)(p.ws + WS_TOK);
    const bf16_t* W = (const bf16_t*)(p.ws + WS_WR) + (size_t)l * 256 * DM;
    float* LG = (float*)(p.ws + WS_LOGIT);
    for (int u = bid_(); u < (MROWS / 192) * 2; u += gridDim.x) {
        const int tm = u >> 1, tn = u & 1;
        auto epi = [&](f32x4 (&acc)[4][3], int wm, int wn, int fr, int fq, int lane, int wid) {
            const int c0 = tn * 128 + wn * 64, r0 = tm * 192 + wm * 48;
            LAS unsigned char* W_ = g2_stage(lds, wid);
#pragma unroll
            for (int nf = 0; nf < 4; ++nf)
#pragma unroll
                for (int mf = 0; mf < 3; ++mf) *(LAS f32x4*)(W_ + (mf * 16 + fr) * 272 + nf * 64 + fq * 16) = acc[nf][mf];
#pragma unroll
            for (int it = 0; it < 12; ++it) {
                const int row = it * 4 + (lane >> 4), ch = lane & 15;
                *(f32x4*)(LG + (size_t)(r0 + row) * 256 + c0 + ch * 4) = *(LAS f32x4*)(W_ + row * 272 + ch * 16);
            }
        };
        gemm192(A, DM, W, DM, DM / 64, tm * 192, tn * 128, lds, epi);
    }
}

DI void phase_topk(const Params& p0, int l, LAS unsigned char* lds) {
    const Params p = launder(p0); l = launder_s(l);
    const int lane = tid_() & 63, wid = tid_() >> 6, rs = lane >> 3, g = lane & 7;
    const float* LG = (const float*)(p.ws + WS_LOGIT);
    const float* bias = p.router_bias + l * 256 + g * 32;
    int* EIDX = (int*)(p.ws + WS_EIDX); float* GATE = (float*)(p.ws + WS_GATE);
    int* RANK = (int*)(p.ws + WS_RANK); int* HIST = (int*)(p.ws + WS_HIST);
    LAS int* hist = (LAS int*)lds;
    if (tid_() < 256) hist[tid_()] = 0;
    __syncthreads();
    const int chunk = (MROWS + (int)gridDim.x - 1) / (int)gridDim.x, r_begin = bid_() * chunk, r_end = (r_begin + chunk) < MROWS ? (r_begin + chunk) : MROWS;
    for (int base = r_begin + wid * 8; base < r_end; base += 64) {
        const int row = base + rs; const bool valid = row < r_end;
        const float* lp = LG + (size_t)(valid ? row : r_begin) * 256 + g * 32;
        float sc[32], gv[32];
#pragma unroll
        for (int q = 0; q < 8; ++q) {
            const f32x4 lg = *(const f32x4*)(lp + 4 * q), bv = *(const f32x4*)(bias + 4 * q);
#pragma unroll
            for (int j = 0; j < 4; ++j) { sc[4 * q + j] = 1.0f / (1.0f + __expf(-lg[j])); gv[4 * q + j] = sc[4 * q + j] + bv[j]; }
        }
        float m1 = fmaxf(gv[0], gv[1]), m2 = fminf(gv[0], gv[1]);
#pragma unroll
        for (int i = 2; i < 32; ++i) { const float v = gv[i]; m2 = fmaxf(m2, fminf(m1, v)); m1 = fmaxf(m1, v); }
        const float gs = m1 + m2;
        int rank = 0;
#pragma unroll
        for (int g2 = 0; g2 < 8; ++g2) { const float o = __shfl(gs, (lane & 56) + g2); rank += (o > gs || (o == gs && g2 < g)) ? 1 : 0; }
        if (rank >= 4) {
#pragma unroll
            for (int i = 0; i < 32; ++i) gv[i] = -INFINITY;
        }
        float ssum = 0.f, mysc = 0.f; int myidx = 0;
#pragma unroll 1
        for (int k = 0; k < TOPK; ++k) {
            float bv = gv[0], bs = sc[0]; int bi = 0;
#pragma unroll
            for (int i = 1; i < 32; ++i) { const bool gt = gv[i] > bv; bv = gt ? gv[i] : bv; bs = gt ? sc[i] : bs; bi = gt ? i : bi; }
            int gi = g * 32 + bi;
#pragma unroll
            for (int o = 1; o < 8; o <<= 1) {
                const float ov = __shfl_xor(bv, o), os = __shfl_xor(bs, o); const int oi = __shfl_xor(gi, o);
                const bool tk = ov > bv || (ov == bv && oi < gi);
                bv = tk ? ov : bv; bs = tk ? os : bs; gi = tk ? oi : gi;
            }
            if ((gi >> 5) == g) {
                const int oi = gi & 31;
#pragma unroll
                for (int i = 0; i < 32; ++i) gv[i] = (i == oi) ? -INFINITY : gv[i];
            }
            ssum += bs;
            if (g == k) { mysc = bs; myidx = gi; }
        }
        if (valid) {
            EIDX[(size_t)row * 8 + g] = myidx;
            GATE[(size_t)row * 8 + g] = mysc / ssum * 2.5f;
            RANK[(size_t)row * 8 + g] = __hip_atomic_fetch_add(hist + myidx, 1, __ATOMIC_RELAXED, __HIP_MEMORY_SCOPE_WORKGROUP);
        }
    }
    __syncthreads();
    if (tid_() < 256) HIST[(size_t)bid_() * 256 + tid_()] = hist[tid_()];
    __syncthreads();
}

DI void phase_scatter(const Params& p0, int l, LAS unsigned char* lds) {
    const Params p = launder(p0); l = launder_s(l);
    LAS int* off = (LAS int*)lds;
    LAS int* toff = off + 260;
    LAS int* tot = toff + 260;
    LAS int* base = tot + 256;
    const int tid = tid_(), bid = bid_(), G = gridDim.x;
    const int* HIST = (const int*)(p.ws + WS_HIST);
    const int* RANK = (const int*)(p.ws + WS_RANK);
    int* ntl = (int*)(p.ws + CTL_NTILES) + l;
    int* TILES = (int*)(p.ws + WS_TILES);
    const int* EIDX = (const int*)(p.ws + WS_EIDX);
    int* SORT = (int*)(p.ws + WS_SORT);
    {
        const int e = tid & 255, hf = tid >> 8, bh = (G + 1) >> 1, b_lo = hf * bh, b_hi = (b_lo + bh) < G ? (b_lo + bh) : G;
        int t = 0, bs = 0;
#pragma unroll 32
        for (int b2 = b_lo; b2 < b_hi; ++b2) { const int v = HIST[(size_t)b2 * 256 + e]; bs += (b2 < bid) ? v : 0; t += v; }
        if (hf) { tot[e] = t; base[e] = bs; }
        __syncthreads();
        if (!hf) { tot[e] += t; base[e] += bs; }
    }
    __syncthreads();
    if (tid < 64) {
        int c[4], tt[4], a = 0, t = 0;
#pragma unroll
        for (int i = 0; i < 4; ++i) { c[i] = tot[tid * 4 + i]; tt[i] = (c[i] + 127) >> 7; a += c[i]; t += tt[i]; }
        int pa = a, pt = t;
#pragma unroll
        for (int o = 1; o < 64; o <<= 1) { const int ua = __shfl_up(pa, o), ut = __shfl_up(pt, o); if (tid >= o) { pa += ua; pt += ut; } }
        int ea = pa - a, et = pt - t;
#pragma unroll
        for (int i = 0; i < 4; ++i) { off[tid * 4 + i] = ea; toff[tid * 4 + i] = et; ea += c[i]; et += tt[i]; }
        if (tid == 63) { off[256] = ea; toff[256] = et; }
    }
    __syncthreads();
    if (bid == 0) {
        if (tid < 256) {
            const int e = tid, c = off[e + 1] - off[e], nt = toff[e + 1] - toff[e];
            for (int t = 0; t < nt; ++t) { int* T = TILES + (size_t)(toff[e] + t) * 4; T[0] = e; T[1] = off[e] + t * 128; T[2] = (c - t * 128) < 128 ? (c - t * 128) : 128; T[3] = 0; }
        }
        if (tid == 0) *ntl = toff[256];
    }
    const int chunk = (MROWS + G - 1) / G, r_begin = bid * chunk, r_end = (r_begin + chunk) < MROWS ? (r_begin + chunk) : MROWS;
    for (int a = r_begin * 8 + tid; a < r_end * 8; a += NTHREADS) {
        const int e = EIDX[a];
        SORT[off[e] + base[e] + RANK[a]] = a;
    }
    __syncthreads();
}

constexpr int MOE_STG = 40960;
constexpr int MOE_HT = 86016;
constexpr int MOE_INFO = MOE_HT + 65536;
DI int swz64(int row, int chunk) { return row * 64 + ((chunk ^ ((0 - (row >> 2)) & 3)) << 4); }

DI void phase_convert_experts(const Params& p0, int l) {
    const Params p = launder(p0); l = launder_s(l);
    unsigned char* IMG = p.ws + WS_WIMG + (size_t)l * (NEXP + 1) * IMG_PER_E * IMG_BYTES;
    constexpr int NSLICE = (NEXP + 1) * IMG_PER_E * 4;
    const int G = gridDim.x, bid = bid_(), t = tid_();
    const int mine = (NSLICE - bid + G - 1) / G;
    const int done = ((const int*)(p.ws + WS_CONVDONE))[l * 1024 + bid];
    for (int i = done; i < mine; ++i) {
        const int sj = bid + G * i, u = sj >> 2, qd = sj & 3, e = u / IMG_PER_E, im = u % IMG_PER_E;
        const int row = t >> 2, chunk = t & 3, np = 128 * qd + row;
        const float* src; int ldw;
        if (im < 32) { const float* W = e < NEXP ? p.w_egu + ((size_t)l * NEXP + e) * DM * 512 : p.w_sgu + (size_t)l * DM * 512; ldw = 512;
            src = W + (size_t)(im * 32 + chunk * 8) * 512 + (((np >> 4) & 1) * 256 + (np >> 5) * 16 + (np & 15)); }
        else { const float* W = e < NEXP ? p.w_edn + ((size_t)l * NEXP + e) * 256 * DM : p.w_sdn + (size_t)l * 256 * DM; ldw = DM;
            src = W + (size_t)(((im - 32) & 7) * 32 + chunk * 8) * DM + ((im - 32) >> 3) * 512 + np; }
        float f[8];
#pragma unroll
        for (int kk = 0; kk < 8; ++kk) f[kk] = src[(size_t)kk * ldw];
        const u32x4 w = {pk_bf16(f[0], f[1]), pk_bf16(f[2], f[3]), pk_bf16(f[4], f[5]), pk_bf16(f[6], f[7])};
        *(u32x4*)(IMG + (size_t)u * IMG_BYTES + (size_t)np * 64 + ((chunk ^ ((0 - (np >> 2)) & 3)) << 4)) = w;
    }
}

DI void moe_unit(const Params& p, const unsigned char* img, bf16_t* outbase, bool shared, int r0, int nr, LAS unsigned char* lds) {
    const int t = tid_(), lane = t & 63, wid = __builtin_amdgcn_readfirstlane(t >> 6), fr = lane & 15, fq = lane >> 4, wn = wid & 3, wt = wid >> 2;
    const bf16_t* TOK = (const bf16_t*)(p.ws + WS_TOK);
    const int* SORT = (const int*)(p.ws + WS_SORT);
    LAS int* rowout = (LAS int*)(lds + MOE_INFO);
    const int arow = t >> 2;
    int atok = 0, aout = -1;
    if (arow < nr) { if (shared) { atok = r0 + arow; aout = atok; } else { aout = SORT[r0 + arow]; atok = aout >> 3; } }
    const bf16_t* aptr = TOK + (size_t)atok * DM + (((t & 3) ^ ((0 - (arow >> 2)) & 3)) << 3);
    __syncthreads();
    if ((t & 3) == 0) rowout[arow] = aout;
    const unsigned char* wsrc = img + (size_t)t * 16;
    const int adst = wid * 1024, wdst = 8192 + wid * 1024;
#define MOE_ISSUE1(S, KT) do { LAS unsigned char* _s = lds + (S) * MOE_STG; dma16(aptr + (KT) * 32, _s + adst); \
        const unsigned char* _w = wsrc + (size_t)(KT) * IMG_BYTES; \
        dma16(_w, _s + wdst); dma16(_w + 8192, _s + wdst + 8192); dma16(_w + 16384, _s + wdst + 16384); dma16(_w + 24576, _s + wdst + 24576); } while (0)
#define MOE_ISSUE2(S, IM) do { LAS unsigned char* _s = lds + (S) * IMG_BYTES; const unsigned char* _w = wsrc + (size_t)(IM) * IMG_BYTES; \
        dma16(_w, _s + adst); dma16(_w + 8192, _s + adst + 8192); dma16(_w + 16384, _s + adst + 16384); dma16(_w + 24576, _s + adst + 24576); } while (0)
    f32x4 acc[8][4];
#pragma unroll
    for (int nf = 0; nf < 8; ++nf)
#pragma unroll
        for (int tf = 0; tf < 4; ++tf) acc[nf][tf] = (f32x4){0.f, 0.f, 0.f, 0.f};
    MOE_ISSUE1(0, 0);
    MOE_ISSUE1(1, 1);
    int st = 0;
    for (int kt = 0; kt < 32; ++kt) {
        if (kt < 31) WAIT_VM(5); else WAIT_VM(0);
        asm volatile("s_waitcnt lgkmcnt(0)" ::: "memory");
        __builtin_amdgcn_s_barrier();
        const int st2 = st == 0 ? 2 : st - 1;
        if (wt == 0) { if (kt < 30) MOE_ISSUE1(st2, kt + 2); else if (kt == 31) MOE_ISSUE2(0, 32); }
        LAS unsigned char* S = lds + st * MOE_STG;
        bf16x8 tfr[4];
#pragma unroll
        for (int tf = 0; tf < 4; ++tf) tfr[tf] = *(LAS bf16x8*)(S + swz64(wt * 64 + tf * 16 + fr, fq));
#pragma unroll
        for (int nf = 0; nf < 8; ++nf) {
            const bf16x8 wf = *(LAS bf16x8*)(S + 8192 + swz64(wn * 128 + nf * 16 + fr, fq));
#pragma unroll
            for (int tf = 0; tf < 4; ++tf) acc[nf][tf] = MFMA16(wf, tfr[tf], acc[nf][tf]);
            if (nf == 3 && wt == 1) { if (kt < 30) MOE_ISSUE1(st2, kt + 2); else if (kt == 31) MOE_ISSUE2(0, 32); }
        }
        st = st == 2 ? 0 : st + 1;
    }
#pragma unroll
    for (int i = 0; i < 4; ++i)
#pragma unroll
        for (int tf = 0; tf < 4; ++tf) {
            float hv[4];
#pragma unroll
            for (int j = 0; j < 4; ++j) hv[j] = silu_f(acc[2 * i][tf][j]) * acc[2 * i + 1][tf][j];
            const int tok = wt * 64 + tf * 16 + fr, hc = wn * 64 + i * 16 + 4 * fq;
            const u32x2 w = {pk_bf16(hv[0], hv[1]), pk_bf16(hv[2], hv[3])};
            *(LAS u32x2*)(lds + MOE_HT + tok * 512 + (((hc >> 3) ^ (tok & 15)) << 4) + (hc & 7) * 2) = w;
        }
#pragma unroll 1
    for (int nc = 0; nc < 2; ++nc) {
#pragma unroll
        for (int nf = 0; nf < 8; ++nf)
#pragma unroll
            for (int tf = 0; tf < 4; ++tf) acc[nf][tf] = (f32x4){0.f, 0.f, 0.f, 0.f};
        if (nc == 1) MOE_ISSUE2(0, 40);
        for (int kt = 0; kt < 8; ++kt) {
            WAIT_VM(0);
            asm volatile("s_waitcnt lgkmcnt(0)" ::: "memory");
            __builtin_amdgcn_s_barrier();
            if (wt == 0 && kt < 7) MOE_ISSUE2((kt + 1) & 1, 32 + nc * 8 + kt + 1);
            LAS unsigned char* S = lds + (kt & 1) * IMG_BYTES;
            bf16x8 tfr[4];
#pragma unroll
            for (int tf = 0; tf < 4; ++tf) { const int tok = wt * 64 + tf * 16 + fr; tfr[tf] = *(LAS bf16x8*)(lds + MOE_HT + tok * 512 + (((kt * 4 + fq) ^ (tok & 15)) << 4)); }
#pragma unroll
            for (int nf = 0; nf < 8; ++nf) {
                const bf16x8 wf = *(LAS bf16x8*)(S + swz64(wn * 128 + nf * 16 + fr, fq));
#pragma unroll
                for (int tf = 0; tf < 4; ++tf) acc[nf][tf] = MFMA16(wf, tfr[tf], acc[nf][tf]);
                if (nf == 3 && wt == 1 && kt < 7) MOE_ISSUE2((kt + 1) & 1, 32 + nc * 8 + kt + 1);
            }
        }
        __syncthreads();
        LAS unsigned char* W = lds + wid * 9216;
#pragma unroll
        for (int half = 0; half < 2; ++half) {
#pragma unroll
            for (int nh = 0; nh < 4; ++nh)
#pragma unroll
                for (int tf = 0; tf < 4; ++tf) {
                    const f32x4 v = acc[half * 4 + nh][tf];
                    const u32x2 w = {pk_bf16(v[0], v[1]), pk_bf16(v[2], v[3])};
                    *(LAS u32x2*)(W + (tf * 16 + fr) * 144 + nh * 32 + fq * 8) = w;
                }
#pragma unroll
            for (int it = 0; it < 8; ++it) {
                const int row = it * 8 + (lane >> 3), ch = lane & 7;
                const u32x4 v = *(LAS u32x4*)(W + row * 144 + ch * 16);
                const int ro = rowout[wt * 64 + row];
                if (ro >= 0) *(u32x4*)(outbase + (size_t)ro * DM + nc * 512 + wn * 128 + half * 64 + ch * 8) = v;
            }
        }
        __syncthreads();
    }
#undef MOE_ISSUE1
#undef MOE_ISSUE2
}

DI void phase_moe(const Params& p0, int l, LAS unsigned char* lds) {
    const Params p = launder(p0); l = launder_s(l);
    const int* TILES = (const int*)(p.ws + WS_TILES);
    const int ntl = *((const int*)(p.ws + CTL_NTILES) + l);
    const int G = gridDim.x, bid = bid_();
    int vcu = bid;
    if (p.ph_hi - p.ph_lo > 1) {
        volatile LAS unsigned* bst = (volatile LAS unsigned*)(lds + LDS_BYTES - 16);
        const unsigned xc = bst[2]; unsigned pre = 0;
        for (unsigned j = 0; j < 16; ++j) { const unsigned c = xb_ld((unsigned*)(p.ws + WS_CTL) + XB_XCNT(j)); pre += (j < xc) ? c : 0u; }
        vcu = (int)(pre + bst[3]);
    }
    const int total = ntl + MROWS / 128;
    const unsigned char* IMG = p.ws + WS_WIMG + (size_t)l * (NEXP + 1) * IMG_PER_E * IMG_BYTES;
    for (int u = vcu; u < total; u += G) {
        if (u < ntl) {
            const int e = TILES[u * 4], r0 = TILES[u * 4 + 1], nr = TILES[u * 4 + 2];
            moe_unit(p, IMG + (size_t)e * IMG_PER_E * IMG_BYTES, (bf16_t*)(p.ws + WS_YSLOT), false, r0, nr, lds);
        } else {
            const int tm = u - ntl;
            if (l == 1 && (tm % (NT / 128)) < 2) continue;
            moe_unit(p, IMG + (size_t)NEXP * IMG_PER_E * IMG_BYTES, (bf16_t*)(p.ws + WS_YSH), true, tm * 128, 128, lds);
        }
    }
}

DI void phase_combine(const Params& p0, int l) {
    const Params p = launder(p0); l = launder_s(l);
    const float* X1 = (const float*)(p.ws + WS_XB); float* Xnext = (float*)(p.ws + WS_XA);
    const int lane = tid_() & 63, wid = tid_() >> 6;
    const bf16_t* YSL = (const bf16_t*)(p.ws + WS_YSLOT); const bf16_t* YSH = (const bf16_t*)(p.ws + WS_YSH);
    const float* GATE = (const float*)(p.ws + WS_GATE);
    const float* modv = (const float*)(p.ws + WS_MODV);
    const float* lg = p.ln_g + (size_t)(l * 2 + 1) * DM; const float* lb = p.ln_b + (size_t)(l * 2 + 1) * DM;
    bf16_t* H = (bf16_t*)(p.ws + WS_H);
    for (int r = bid_() * 8 + wid; r < MROWS; r += gridDim.x * 8) {
        const int b = r >= NT, pp = r - b * NT;
        if (l == 1 && pp < NCTX) continue;
        const int sel = pp < NCTX ? 2 : b;
        float gt[8];
#pragma unroll
        for (int k = 0; k < 8; ++k) gt[k] = GATE[(size_t)r * 8 + k];
        const float* g5 = modv + ((size_t)l * 3 + sel) * 6144 + 5 * 1024;
        f32x4 v[4];
        u32x2 sl[4][9]; f32x4 xv4[4];
#pragma unroll
        for (int i = 0; i < 4; ++i) {
            const int c = lane * 4 + i * 256;
            sl[i][8] = *(const u32x2*)(YSH + (size_t)r * DM + c);
#pragma unroll
            for (int k = 0; k < 8; ++k) sl[i][k] = *(const u32x2*)(YSL + ((size_t)r * 8 + k) * DM + c);
            xv4[i] = *(const f32x4*)(X1 + (size_t)r * DM + c);
        }
#pragma unroll
        for (int i = 0; i < 4; ++i) {
            const int c = lane * 4 + i * 256;
            float f0 = bf_lo(sl[i][8][0]), f1 = bf_hi(sl[i][8][0]), f2 = bf_lo(sl[i][8][1]), f3 = bf_hi(sl[i][8][1]);
#pragma unroll
            for (int k = 0; k < 8; ++k) { const u32x2 w = sl[i][k]; f0 += gt[k] * bf_lo(w[0]); f1 += gt[k] * bf_hi(w[0]); f2 += gt[k] * bf_lo(w[1]); f3 += gt[k] * bf_hi(w[1]); }
            const f32x4 xv = xv4[i], gv = *(const f32x4*)(g5 + c);
            v[i] = (f32x4){DN_ALPHA * xv[0] + gv[0] * f0, DN_ALPHA * xv[1] + gv[1] * f1, DN_ALPHA * xv[2] + gv[2] * f2, DN_ALPHA * xv[3] + gv[3] * f3};
        }
        float mu, rstd; ln_stats(v, mu, rstd);
#pragma unroll
        for (int i = 0; i < 4; ++i) {
            const int c = lane * 4 + i * 256;
            const f32x4 gg = *(const f32x4*)(lg + c), bb = *(const f32x4*)(lb + c);
#pragma unroll
            for (int j = 0; j < 4; ++j) v[i][j] = (v[i][j] - mu) * rstd * gg[j] + bb[j];
            if (l == 1) *(f32x4*)(p.out + ((size_t)b * NLAT + (pp - NCTX)) * DM + c) = v[i];
            else *(f32x4*)(Xnext + (size_t)r * DM + c) = v[i];
        }
        if (l == 0) { const float* mv = modv + ((size_t)1 * 3 + sel) * 6144; modulate_store(v, mv, mv + 1024, H + (size_t)r * DM, lane); }
    }
}

constexpr int PH_PER_LAYER = 11, N_PHASES = 3 + 2 * PH_PER_LAYER;
__global__ void __launch_bounds__(NTHREADS, 2) mega(Params p) {
    extern __shared__ __attribute__((aligned(16))) unsigned char lds_raw[];
    LAS unsigned char* lds = (LAS unsigned char*)lds_raw;
    volatile LAS unsigned* bst = (volatile LAS unsigned*)(lds + LDS_BYTES - 16);
    if (PROBE_ID != 0 && threadIdx.x == 0) { PRB_WORDS(lds)[0] = 0ull; PRB_WORDS(lds)[1] = 0ull; }
    if (threadIdx.x == 0) { bst[0] = 0u; bst[1] = 0u; const unsigned xc = xb_xcc_id(); bst[2] = xc; bst[3] = xb_add((unsigned*)(p.ws + CTL_XRANK) + xc, 1u); }
    __syncthreads();
    const int lo = p.ph_lo, hi = p.ph_hi;
    XcdBarrier bar; bar.bar = (unsigned*)(p.ws + WS_CTL); bar.x = 0; bar.st = bst;
    if (hi - lo > 1) bar = xcd_barrier_post((unsigned*)(p.ws + WS_CTL), bst);
#ifndef ONLY_PHASE
#define ONLY_PHASE -1
#endif
#define IN(k) (lo <= (k) && (k) < hi)
#define ON(pid) (ONLY_PHASE < 0 || ONLY_PHASE == (pid))
#ifndef DUP_PHASE
#define DUP_PHASE -1
#endif
#define REP(pid) for (int rep_ = 0; rep_ < ((DUP_PHASE == (pid)) ? 2 : 1); ++rep_)
#define SEAM(k) do { if (IN(k) && IN((k) + 1)) xcd_barrier(bar); } while (0)
    PRB_T0(100, lds); if (ON(0) && IN(0)) REP(0) { phase_convert(p, lds); } PRB_T1(100, lds);
    PRB_T0(200, lds); SEAM(0); PRB_T1(200, lds);
    PRB_T0(101, lds); if (ON(1) && IN(1)) REP(1) phase_mod(p, lds); PRB_T1(101, lds);
    PRB_T0(201, lds); SEAM(1); PRB_T1(201, lds);
    PRB_T0(102, lds); if (ON(2) && IN(2)) REP(2) phase_ln0(p); PRB_T1(102, lds);
    PRB_T0(202, lds); SEAM(2); PRB_T1(202, lds);
    for (int l = 0; l < 2; ++l) {
        const int k0 = 3 + l * PH_PER_LAYER;
        PRB_T0(103, lds); if (ON(3) && IN(k0 + 0)) REP(3) phase_inproj(p, l, lds); PRB_T1(103, lds);
        PRB_T0(203, lds); SEAM(k0 + 0); PRB_T1(203, lds);
        PRB_T0(104, lds); if (ON(4) && IN(k0 + 1)) REP(4) phase_ret_sum_pool(p, l, lds); PRB_T1(104, lds);
        PRB_T0(204, lds); SEAM(k0 + 1); PRB_T1(204, lds);
        PRB_T0(105, lds); if (ON(5) && IN(k0 + 2)) REP(5) phase_ret_scan(p, l); PRB_T1(105, lds);
        PRB_T0(205, lds); SEAM(k0 + 2); PRB_T1(205, lds);
        PRB_T0(106, lds); if (ON(6) && IN(k0 + 3)) REP(6) { phase_attn(p, l, lds); phase_ret(p, l); } PRB_T1(106, lds);
        PRB_T0(206, lds); SEAM(k0 + 3); PRB_T1(206, lds);
        PRB_T0(107, lds); if (ON(7) && IN(k0 + 4)) REP(7) phase_outproj(p, l, lds); PRB_T1(107, lds);
        PRB_T0(207, lds); SEAM(k0 + 4); PRB_T1(207, lds);
        PRB_T0(108, lds); if (ON(8) && IN(k0 + 5)) REP(8) phase_ln_mid(p, l); PRB_T1(108, lds);
        PRB_T0(208, lds); SEAM(k0 + 5); PRB_T1(208, lds);
        PRB_T0(109, lds); if (ON(9) && IN(k0 + 6)) REP(9) phase_router(p, l, lds); PRB_T1(109, lds);
        PRB_T0(209, lds); SEAM(k0 + 6); PRB_T1(209, lds);
        PRB_T0(110, lds); if (ON(10) && IN(k0 + 7)) REP(10) phase_topk(p, l, lds); PRB_T1(110, lds);
        PRB_T0(210, lds); SEAM(k0 + 7); PRB_T1(210, lds);
        PRB_T0(111, lds); if (ON(11) && IN(k0 + 8)) REP(11) { phase_scatter(p, l, lds); phase_convert_experts(p, l); } PRB_T1(111, lds);
        PRB_T0(211, lds); SEAM(k0 + 8); PRB_T1(211, lds);
        PRB_T0(112, lds); if (ON(12) && IN(k0 + 9)) REP(12) phase_moe(p, l, lds); PRB_T1(112, lds);
        PRB_T0(212, lds); SEAM(k0 + 9); PRB_T1(212, lds);
        PRB_T0(114, lds); if (ON(14) && IN(k0 + 10)) REP(14) phase_combine(p, l); PRB_T1(114, lds);
        if (l == 0) SEAM(k0 + 10);
    }
#undef IN
#undef SEAM
    if (PROBE_ID != 0 && threadIdx.x == 0 && blockIdx.x == 0) {
        const unsigned long long t0 = __builtin_readcyclecounter(), span = PRB_WORDS(lds)[1] * PROBE_GAIN;
        while (__builtin_readcyclecounter() - t0 < span) __builtin_amdgcn_s_sleep(8);
    }
}

extern "C" void kernel_launch(void* const* d_in, const int* in_sizes, int n_in, void* d_out, int out_size, void* d_ws, size_t ws_size, hipStream_t stream) {
    static int grid = 0;
    if (grid == 0) {
        if (n_in != 20 || ws_size < WS_END || out_size != NB * NLAT * DM) { fprintf(stderr, "kernel_launch: unexpected shapes (n_in %d, ws %zu need %zu, out %d)\n", n_in, ws_size, (size_t)WS_END, out_size); grid = -1; return; }
        int dev = 0, cus = 0, per_cu = 0;
        hipGetDevice(&dev); hipDeviceGetAttribute(&cus, hipDeviceAttributeMultiprocessorCount, dev);
        if (hipFuncSetAttribute((const void*)mega, hipFuncAttributeMaxDynamicSharedMemorySize, LDS_BYTES) != hipSuccess) { fprintf(stderr, "kernel_launch: hipFuncSetAttribute failed\n"); grid = -1; return; }
        if (hipOccupancyMaxActiveBlocksPerMultiprocessor(&per_cu, (const void*)mega, NTHREADS, LDS_BYTES) != hipSuccess || per_cu < 1) { fprintf(stderr, "kernel_launch: occupancy query says %d\n", per_cu); }
        (void)hipGetLastError();
        grid = cus > 0 ? cus : 256;
    }
    if (grid < 0) return;
    hipMemsetAsync((char*)d_ws + WS_CTL, 0, CTL_BYTES, stream);
    Params p{};
    p.x = (const float*)d_in[0]; p.c = (const float*)d_in[1]; p.ctx = (const float*)d_in[2]; p.c_ctx = (const float*)d_in[3];
    p.w_mod = (const float*)d_in[4]; p.b_mod = (const float*)d_in[5]; p.w_in = (const float*)d_in[6]; p.w_out = (const float*)d_in[7];
    p.diff_lambda = (const float*)d_in[8]; p.pool_w = (const float*)d_in[9]; p.pool_scale = (const float*)d_in[10]; p.ret_log_decay = (const float*)d_in[11];
    p.ln_g = (const float*)d_in[12]; p.ln_b = (const float*)d_in[13]; p.w_router = (const float*)d_in[14]; p.router_bias = (const float*)d_in[15];
    p.w_egu = (const float*)d_in[16]; p.w_edn = (const float*)d_in[17]; p.w_sgu = (const float*)d_in[18]; p.w_sdn = (const float*)d_in[19];
    p.out = (float*)d_out; p.ws = (unsigned char*)d_ws;
#if N_LAUNCH_PER_PHASE
    for (int k = 0; k < N_PHASES; ++k) { p.ph_lo = k; p.ph_hi = k + 1; hipLaunchKernelGGL(mega, dim3(grid), dim3(NTHREADS), LDS_BYTES, stream, p); }
#else
    p.ph_lo = 0; p.ph_hi = N_PHASES;
    hipLaunchKernelGGL(mega, dim3(grid), dim3(NTHREADS), LDS_BYTES, stream, p);
#endif
}
```

```cpp
#include <hip/hip_runtime.h>
#include <stdint.h>
#include <stdio.h>

#ifndef N_LAUNCH_PER_PHASE
#define N_LAUNCH_PER_PHASE 0
#endif

#define LAS __attribute__((address_space(3)))
#define DI __device__ __forceinline__
typedef unsigned short bf16_t;
typedef short bf16x8 __attribute__((ext_vector_type(8)));
typedef float f32x2 __attribute__((ext_vector_type(2)));
typedef float f32x4 __attribute__((ext_vector_type(4)));
typedef float f32x16 __attribute__((ext_vector_type(16)));
typedef unsigned u32x2 __attribute__((ext_vector_type(2)));
typedef unsigned u32x4 __attribute__((ext_vector_type(4)));
typedef __bf16 bf16v2 __attribute__((ext_vector_type(2)));

constexpr int NB = 2, NLAT = 8192, NCTX = 256, NT = NLAT + NCTX  , MROWS = NB * NT  ;
constexpr int DM = 1024, INW = 2816, NEXP = 256, TOPK = 8, NASG = MROWS * TOPK  ;
constexpr int NCHUNK = NT / 128;
constexpr float DN_ALPHA = 1.41421356237f;
constexpr float LN_EPS = 1e-6f, RMS_EPS = 1e-5f;
constexpr float LOG2E = 1.44269504089f;
constexpr float QSCALE = 0.125f * LOG2E;
constexpr int NTHREADS = 512;
constexpr int LDS_BYTES = 163840;

constexpr int MOE_T = 144;
constexpr int IMG_BYTES = 32768, IMG_PER_E = 48;
constexpr int C_DQ = 0, C_DK = 512, C_DV = 1024, C_PU = 1536, C_RQ = 1792, C_RK = 2048, C_RV = 2304, C_RG = 2560;

constexpr size_t al256(size_t x) { return (x + 255) & ~(size_t)255; }
constexpr size_t WS_CTL = 0;
constexpr size_t CTL_BYTES = 65536;
constexpr size_t CTL_COUNTS = 16384;
constexpr size_t CTL_CURSOR = CTL_COUNTS + 2048;
constexpr size_t CTL_NTILES = CTL_CURSOR + 2048;
constexpr size_t CTL_XRANK = CTL_NTILES + 256;
constexpr size_t WS_MODV = WS_CTL + CTL_BYTES;
constexpr size_t WS_ROPE = al256(WS_MODV + 2 * 3 * 6144 * 4);
constexpr size_t WS_SCAL = al256(WS_ROPE + 128 * 16 * 8);
constexpr size_t WS_WIN = al256(WS_SCAL + 2 * 16 * 4);
constexpr size_t WS_WOUT = al256(WS_WIN + (size_t)2 * INW * DM * 2);
constexpr size_t WS_WR = al256(WS_WOUT + (size_t)2 * DM * DM * 2);
constexpr size_t WS_WIMG = al256(WS_WR + (size_t)2 * 256 * DM * 2);
constexpr size_t WS_XA = al256(WS_WIMG + (size_t)2 * 257 * 48 * 32768);
constexpr size_t WS_XB = al256(WS_XA + (size_t)MROWS * DM * 4);
constexpr size_t WS_V1 = al256(WS_XB + (size_t)MROWS * DM * 4);
constexpr size_t WS_H = al256(WS_V1 + (size_t)MROWS * DM * 4);
constexpr size_t WS_TOK = al256(WS_H + (size_t)MROWS * DM * 2);
constexpr size_t WS_P = al256(WS_TOK + (size_t)MROWS * DM * 2);
constexpr size_t WS_VT = al256(WS_P + (size_t)MROWS * INW * 2);
constexpr size_t WS_RKT = al256(WS_VT + (size_t)NB * 4 * 128 * NT * 2);
constexpr size_t WS_RVT = al256(WS_RKT + (size_t)NB * 4 * 64 * NT * 2);
constexpr size_t WS_MIX = al256(WS_RVT + (size_t)NB * 4 * 64 * NT * 2);
constexpr size_t ST_BYTES = (size_t)NB * 4 * NCHUNK * 4096 * 4;
constexpr size_t WS_UF = al256(WS_MIX + (size_t)MROWS * DM * 2);
constexpr size_t WS_UB = al256(WS_UF + ST_BYTES);
constexpr size_t WS_SF = al256(WS_UB + ST_BYTES);
constexpr size_t WS_SB = al256(WS_SF + ST_BYTES);
constexpr size_t WS_LOGIT = al256(WS_SB + ST_BYTES);
constexpr size_t WS_EIDX = al256(WS_LOGIT + (size_t)MROWS * 256 * 4);
constexpr size_t WS_GATE = al256(WS_EIDX + (size_t)NASG * 4);
constexpr size_t WS_SORT = al256(WS_GATE + (size_t)NASG * 4);
constexpr size_t WS_RANK = al256(WS_SORT + (size_t)NASG * 4);
constexpr size_t WS_HIST = al256(WS_RANK + (size_t)NASG * 4);
constexpr size_t WS_CONVDONE = al256(WS_HIST + (size_t)1024 * 256 * 4);
constexpr size_t WS_TILES = al256(WS_CONVDONE + 2 * 1024 * 4);
constexpr size_t WS_YSLOT = al256(WS_TILES + 2048 * 16);
constexpr size_t WS_YSH = al256(WS_YSLOT + (size_t)NASG * DM * 2);
constexpr size_t WS_END = al256(WS_YSH + (size_t)MROWS * DM * 2);
constexpr size_t WS_OM = WS_YSLOT;

struct Params {
    const float *x, *c, *ctx, *c_ctx, *w_mod, *b_mod, *w_in, *w_out, *diff_lambda, *pool_w, *pool_scale, *ret_log_decay, *ln_g, *ln_b,
        *w_router, *router_bias, *w_egu, *w_edn, *w_sgu, *w_sdn;
    float* out;
    unsigned char* ws;
    int ph_lo, ph_hi;
};


DI Params launder(const Params& a) {
    size_t z = 0; asm volatile("" : "+s"(z));
    Params r = a;
#define LND(f) r.f = (decltype(r.f))((const unsigned char*)a.f + z)
    LND(x); LND(c); LND(ctx); LND(c_ctx); LND(w_mod); LND(b_mod); LND(w_in); LND(w_out); LND(diff_lambda); LND(pool_w); LND(pool_scale); LND(ret_log_decay); LND(ln_g); LND(ln_b);
    LND(w_router); LND(router_bias); LND(w_egu); LND(w_edn); LND(w_sgu); LND(w_sdn);
#undef LND
    r.out = (float*)((unsigned char*)a.out + z); r.ws = a.ws + z;
    return r;
}
DI int launder_s(int v) { asm volatile("" : "+s"(v)); return v; }
DI int tid_() { int t = threadIdx.x; asm volatile("" : "+v"(t)); return t; }
DI int bid_() { int t = blockIdx.x; asm volatile("" : "+s"(t)); return t; }


#ifndef PROBE_ID
#define PROBE_ID 0
#endif
#ifndef PROBE_GAIN
#define PROBE_GAIN 8
#endif
#define PRB_WORDS(lds) ((volatile LAS unsigned long long*)((lds) + LDS_BYTES - 64))
#define PRB_MATCH(id) (PROBE_ID == (id) || (PROBE_ID == 999 && (id) >= 200) || (PROBE_ID == 998 && ((id) == 101 || (id) == 102 || (id) == 104 || (id) == 105 || (id) == 108 || (id) == 109 || (id) == 110 || (id) == 111)))
#define PRB_T0(id, lds) do { if (PRB_MATCH(id) && threadIdx.x == 0 && blockIdx.x == 0) { PRB_WORDS(lds)[0] = __builtin_readcyclecounter(); } } while (0)
#define PRB_T1(id, lds) do { if (PRB_MATCH(id) && threadIdx.x == 0 && blockIdx.x == 0) { PRB_WORDS(lds)[1] += __builtin_readcyclecounter() - PRB_WORDS(lds)[0]; } } while (0)

#define XB_TMO      128
#define XB_XCNT(j)  (256  + 64 * (j))
#define XB_XSUB(j)  (1280 + 64 * (j))
#define XB_XGEN(j)  (2304 + 64 * (j))
#define XB_TOP      3328
#define XB_TOPGEN   3392
#define XCD_BAR_WORDS 3456
#define XB_SPIN_CAP (1u << 20)

__device__ __forceinline__ unsigned xb_ld(unsigned* p)              { return __hip_atomic_load(p, __ATOMIC_RELAXED, __HIP_MEMORY_SCOPE_AGENT); }
__device__ __forceinline__ unsigned xb_add(unsigned* p, unsigned v) { return __hip_atomic_fetch_add(p, v, __ATOMIC_RELAXED, __HIP_MEMORY_SCOPE_AGENT); }
__device__ __forceinline__ unsigned xb_xcc_id() { return (unsigned)__builtin_amdgcn_s_getreg((3 << 11) | 20) & 0xFu; }
#define XB_SPIN(cond, bar) do { unsigned _sp = 0; while (cond) { __builtin_amdgcn_s_sleep(1); \
    if ((++_sp & 255u) == 0u) { if (xb_ld(&(bar)[XB_TMO])) break; if (_sp > XB_SPIN_CAP) { atomicAdd(&(bar)[XB_TMO], 1u); break; } } } } while (0)

struct XcdBarrier { unsigned* bar; unsigned x; volatile LAS unsigned* st; };

__device__ __forceinline__ XcdBarrier xcd_barrier_post(unsigned* bar, volatile LAS unsigned* st) {
    XcdBarrier b; b.bar = bar; b.x = xb_xcc_id(); b.st = st;
    if (threadIdx.x == 0) (void)xb_add(&bar[XB_XCNT(b.x)], 1u);
    return b;
}
__device__ __forceinline__ void xcd_barrier_complete(unsigned* bar, unsigned x, unsigned& nloc, unsigned& nx) {
    const unsigned G = gridDim.x * gridDim.y * gridDim.z;
    unsigned sum, cnt, mine, sp = 0u;
    for (;;) {
        sum = 0u; cnt = 0u; mine = 0u;
#pragma unroll
        for (unsigned j = 0; j < 16; ++j) { const unsigned c = xb_ld(&bar[XB_XCNT(j)]); sum += c; cnt += (c > 0u) ? 1u : 0u; mine = (j == x) ? c : mine; }
        if (sum == G) break;
        __builtin_amdgcn_s_sleep(1);
        if ((++sp & 255u) == 0u) { if (xb_ld(&bar[XB_TMO])) break; if (sp > XB_SPIN_CAP) { atomicAdd(&bar[XB_TMO], 1u); break; } }
    }
    nloc = mine > 0u ? mine : 1u; nx = cnt > 0u ? cnt : 1u;
}
__device__ __forceinline__ void xcd_barrier(const XcdBarrier& b) {
    asm volatile("s_waitcnt vmcnt(0)" ::: "memory");
    __syncthreads();
    if (threadIdx.x == 0) {
        unsigned* bar = b.bar;
        __builtin_amdgcn_s_waitcnt(0);
        unsigned nloc = b.st[0], nx = b.st[1];
        if (nloc == 0u) { xcd_barrier_complete(bar, b.x, nloc, nx); b.st[0] = nloc; b.st[1] = nx; }
        const unsigned old = xb_add(&bar[XB_XSUB(b.x)], 1u);
        const unsigned gen = old / nloc;
        if (old + 1u == (gen + 1u) * nloc) {
            __builtin_amdgcn_fence(__ATOMIC_RELEASE, "agent");
            asm volatile("s_waitcnt vmcnt(0)" ::: "memory");
            const unsigned og = xb_add(&bar[XB_TOP], 1u);
            const unsigned tg = og / nx;
            if (og + 1u == (tg + 1u) * nx) xb_add(&bar[XB_TOPGEN], 1u);
            else XB_SPIN(xb_ld(&bar[XB_TOPGEN]) == tg, bar);
            __builtin_amdgcn_fence(__ATOMIC_ACQUIRE, "agent");
            xb_add(&bar[XB_XGEN(b.x)], 1u);
            asm volatile("s_waitcnt vmcnt(0)" ::: "memory");
        } else {
            XB_SPIN(xb_ld(&bar[XB_XGEN(b.x)]) == gen, bar);
            __builtin_amdgcn_fence(__ATOMIC_ACQUIRE, "agent");
            asm volatile("s_waitcnt vmcnt(0)" ::: "memory");
        }
    }
    __syncthreads();
}

DI unsigned pk_bf16(float a, float b) { f32x2 v = {a, b}; bf16v2 r = __builtin_convertvector(v, bf16v2); return __builtin_bit_cast(unsigned, r); }
DI bf16_t to_bf16(float a) { return (bf16_t)(pk_bf16(a, 0.f) & 0xffffu); }
DI float bf_lo(unsigned u) { return __uint_as_float(u << 16); }
DI float bf_hi(unsigned u) { return __uint_as_float(u & 0xffff0000u); }
DI float bf2f(bf16_t h) { return __uint_as_float(((unsigned)h) << 16); }
DI float wave_sum(float v) {
#pragma unroll
    for (int o = 32; o; o >>= 1) v += __shfl_xor(v, o);
    return v;
}
DI float fast_exp2(float x) { return __builtin_amdgcn_exp2f(x); }
DI float silu_f(float x) { return x / (1.f + __expf(-x)); }
DI bf16x8 as_bf16x8(u32x4 v) { return __builtin_bit_cast(bf16x8, v); }
#define WAIT_VM(n) asm volatile("s_waitcnt vmcnt(" #n ")" ::: "memory")
DI void dma16(const void* g, LAS unsigned char* l) { __builtin_amdgcn_global_load_lds(g, (LAS void*)l, 16, 0, 0); }
DI void dma16u(const unsigned char* ubase, unsigned voff, LAS unsigned char* l) { __builtin_amdgcn_global_load_lds(ubase + voff, (LAS void*)l, 16, 0, 0); }
#define MFMA32(a, b, c) __builtin_amdgcn_mfma_f32_32x32x16_bf16((a), (b), (c), 0, 0, 0)
#define MFMA16(a, b, c) __builtin_amdgcn_mfma_f32_16x16x32_bf16((a), (b), (c), 0, 0, 0)

DI int row_sel(int r) { const int b = r >= NT; const int p = r - b * NT; return p < NCTX ? 2 : b; }

DI int swz_off(int row, int chunk) { return row * 128 + ((chunk ^ ((row >> 1) & 7)) << 4); }

DI int perm_gu(int n) { const int f = n >> 8, jj = n & 255; return ((jj >> 4) << 5) + (f << 4) + (jj & 15); }
DI void conv_unit(const float* src, int N, int K, bf16_t* dst, int k0, int n0, bool perm, LAS unsigned char* lds) {
    LAS float* tl = (LAS float*)lds;
    const int tid = tid_();
#pragma unroll
    for (int i = 0; i < 8; ++i) {
        const int kk = (tid >> 6) + 8 * i, nn = (tid & 63) * 4;
        const f32x4 v = *(const f32x4*)(src + (size_t)(k0 + kk) * N + n0 + nn);
        tl[kk * 257 + nn] = v[0]; tl[kk * 257 + nn + 1] = v[1]; tl[kk * 257 + nn + 2] = v[2]; tl[kk * 257 + nn + 3] = v[3];
    }
    __syncthreads();
    const int n = tid >> 1, kh = (tid & 1) * 32;
    const int nd = perm ? perm_gu(n0 + n) : (n0 + n);
    bf16_t* d = dst + (size_t)nd * K + k0 + kh;
#pragma unroll
    for (int q = 0; q < 4; ++q) {
        u32x4 w;
#pragma unroll
        for (int j = 0; j < 4; ++j) w[j] = pk_bf16(tl[(kh + q * 8 + 2 * j) * 257 + n], tl[(kh + q * 8 + 2 * j + 1) * 257 + n]);
        *(u32x4*)(d + q * 8) = w;
    }
    __syncthreads();
}

DI void phase_convert(const Params& p0, LAS unsigned char* lds) {
    const Params p = launder(p0);
    constexpr int U_IN = 176, U_OUT = 64, U_R = 16;
    constexpr int U_L = U_IN + U_OUT + U_R;
    for (int u = bid_(); u < 2 * U_L; u += gridDim.x) {
        const int l = u / U_L; int v = u % U_L;
        if (v < U_IN) { conv_unit(p.w_in + (size_t)l * DM * INW, INW, DM, (bf16_t*)(p.ws + WS_WIN) + (size_t)l * INW * DM, (v / 11) * 64, (v % 11) * 256, false, lds); continue; }
        v -= U_IN;
        if (v < U_OUT) { conv_unit(p.w_out + (size_t)l * DM * DM, DM, DM, (bf16_t*)(p.ws + WS_WOUT) + (size_t)l * DM * DM, (v / 4) * 64, (v % 4) * 256, false, lds); continue; }
        v -= U_OUT;
        conv_unit(p.w_router + (size_t)l * DM * 256, 256, DM, (bf16_t*)(p.ws + WS_WR) + (size_t)l * 256 * DM, v * 64, 0, false, lds);
    }
}

DI void phase_mod(const Params& p0, LAS unsigned char* lds) {
    const Params p = launder(p0);
    LAS float* sc = (LAS float*)lds;
    LAS float* red = sc + 3 * 1024;
    const int tid = tid_();
    float* modv = (float*)(p.ws + WS_MODV);
    for (int u = bid_(); u < 193; u += gridDim.x) {
        if (u == 192) {
            float* rope = (float*)(p.ws + WS_ROPE);
            for (int i = tid; i < 128 * 16; i += NTHREADS) {
                const int pos = i >> 4, f = i & 15;
                const float freq = powf(10000.0f, -(float)f / 16.0f);
                const float ang = (float)pos * freq;
                rope[2 * i] = cosf(ang); rope[2 * i + 1] = sinf(ang);
            }
            float* scal = (float*)(p.ws + WS_SCAL);
            if (tid < 2) {
                const int l = tid;
                const float* dl = p.diff_lambda + l * 256;
                float s01 = 0.f, s23 = 0.f;
                for (int i = 0; i < 64; ++i) { s01 += dl[i] * dl[64 + i]; s23 += dl[128 + i] * dl[192 + i]; }
                const float lambda_init = 0.8f - 0.6f * expf(-0.3f * (float)l);
                scal[l * 16 + 0] = expf(s01) - expf(s23) + lambda_init;
                scal[l * 16 + 1] = 1.0f - lambda_init;
                for (int h = 0; h < 4; ++h) {
                    scal[l * 16 + 2 + h] = -expf(p.ret_log_decay[l * 8 + h]) * LOG2E;
                    scal[l * 16 + 6 + h] = -expf(p.ret_log_decay[l * 8 + 4 + h]) * LOG2E;
                }
            }
            continue;
        }
        const int l = u / 96, n0 = (u % 96) * 64;
        for (int i = tid; i < 3 * 1024; i += NTHREADS) {
            const int s = i >> 10, k = i & 1023;
            const float v = s < 2 ? p.c[s * 1024 + k] : p.c_ctx[k];
            sc[i] = silu_f(v);
        }
        __syncthreads();
        const int kq = tid >> 6, nl = tid & 63;
        const float* w = p.w_mod + (size_t)l * DM * 6144 + n0 + nl;
        float a0 = 0.f, a1 = 0.f, a2 = 0.f;
        for (int k = kq * 128; k < kq * 128 + 128; ++k) {
            const float wv = w[(size_t)k * 6144];
            a0 += sc[k] * wv; a1 += sc[1024 + k] * wv; a2 += sc[2048 + k] * wv;
        }
        red[(kq * 3 + 0) * 64 + nl] = a0; red[(kq * 3 + 1) * 64 + nl] = a1; red[(kq * 3 + 2) * 64 + nl] = a2;
        __syncthreads();
        if (tid < 192) {
            const int s = tid >> 6, n = tid & 63;
            float v = 0.f;
            for (int q = 0; q < 8; ++q) v += red[(q * 3 + s) * 64 + n];
            modv[((size_t)l * 3 + s) * 6144 + n0 + n] = v + p.b_mod[l * 6144 + n0 + n];
        }
        __syncthreads();
    }
}

DI void ln_stats(const f32x4 (&v)[4], float& mu, float& rstd) {
    float s = 0.f;
#pragma unroll
    for (int i = 0; i < 4; ++i) s += (v[i][0] + v[i][1]) + (v[i][2] + v[i][3]);
    mu = wave_sum(s) * (1.0f / 1024.0f);
    float q = 0.f;
#pragma unroll
    for (int i = 0; i < 4; ++i)
#pragma unroll
        for (int j = 0; j < 4; ++j) { const float d = v[i][j] - mu; q += d * d; }
    rstd = rsqrtf(wave_sum(q) * (1.0f / 1024.0f) + LN_EPS);
}
DI void modulate_store(const f32x4 (&v)[4], const float* shift, const float* scale, bf16_t* dst, int lane) {
    float mu, rstd; ln_stats(v, mu, rstd);
#pragma unroll
    for (int i = 0; i < 4; ++i) {
        const int c = lane * 4 + i * 256;
        const f32x4 sh = *(const f32x4*)(shift + c), scv = *(const f32x4*)(scale + c);
        float o[4];
#pragma unroll
        for (int j = 0; j < 4; ++j) o[j] = (v[i][j] - mu) * rstd * (1.0f + scv[j]) + sh[j];
        u32x2 w = {pk_bf16(o[0], o[1]), pk_bf16(o[2], o[3])};
        *(u32x2*)(dst + c) = w;
    }
}
DI int col8(int lane, int i) { return lane * 8 + (i & 1) * 4 + (i >> 1) * 512; }
DI void modulate_store8(const f32x4 (&v)[4], const float* shift, const float* scale, bf16_t* dst, int lane) {
    float mu, rstd; ln_stats(v, mu, rstd);
#pragma unroll
    for (int h = 0; h < 2; ++h) {
        u32x4 w;
#pragma unroll
        for (int k = 0; k < 2; ++k) {
            const int i = 2 * h + k, c = col8(lane, i);
            const f32x4 sh = *(const f32x4*)(shift + c), scv = *(const f32x4*)(scale + c);
            float o[4];
#pragma unroll
            for (int j = 0; j < 4; ++j) o[j] = (v[i][j] - mu) * rstd * (1.0f + scv[j]) + sh[j];
            w[2 * k] = pk_bf16(o[0], o[1]); w[2 * k + 1] = pk_bf16(o[2], o[3]);
        }
        *(u32x4*)(dst + lane * 8 + h * 512) = w;
    }
}

DI void phase_ln0(const Params& p0) {
    const Params p = launder(p0);
    const int lane = tid_() & 63, wid = tid_() >> 6;
    bf16_t* XA = (bf16_t*)(p.ws + WS_XA);
    bf16_t* H = (bf16_t*)(p.ws + WS_H);
    const float* modv = (const float*)(p.ws + WS_MODV);
    for (int r = bid_() * 8 + wid; r < MROWS; r += gridDim.x * 8) {
        const int b = r >= NT, pp = r - b * NT;
        const float* src = pp < NCTX ? p.ctx + ((size_t)b * NCTX + pp) * DM : p.x + ((size_t)b * NLAT + (pp - NCTX)) * DM;
        f32x4 v[4];
#pragma unroll
        for (int i = 0; i < 4; ++i) v[i] = *(const f32x4*)(src + col8(lane, i));
#pragma unroll
        for (int h = 0; h < 2; ++h)
            *(u32x4*)(XA + (size_t)r * DM + lane * 8 + h * 512) = (u32x4){pk_bf16(v[2 * h][0], v[2 * h][1]), pk_bf16(v[2 * h][2], v[2 * h][3]), pk_bf16(v[2 * h + 1][0], v[2 * h + 1][1]), pk_bf16(v[2 * h + 1][2], v[2 * h + 1][3])};
        const float* mv = modv + (size_t)(0 * 3 + (pp < NCTX ? 2 : b)) * 6144;
        modulate_store8(v, mv, mv + 1024, H + (size_t)r * DM, lane);
    }
}

#define FOR_UNITS_XCD(u, total) \
    for (int _G = gridDim.x, _b = bid_(), _ok = ((_G & 7) == 0 && ((total) & 7) == 0), _per = _ok ? (total) / 8 : (total), _st = _ok ? _G / 8 : _G, \
             _l = _ok ? _b / 8 : _b, u = (_ok ? (_b & 7) * _per : 0) + _l; _l < _per; _l += _st, u += _st)
#define FOR_UNITS_XCD_REV(u, total) \
    for (int _G = gridDim.x, _b = bid_(), _ok = ((_G & 7) == 0 && ((total) & 7) == 0), _per = _ok ? (total) / 8 : (total), _st = _ok ? _G / 8 : _G, \
             _l = _ok ? (_G / 8 - 1 - _b / 8) : _b, u = (_ok ? (_b & 7) * _per : 0) + _l; _l < _per; _l += _st, u += _st)
constexpr int G2_STG = 40960;
template <class Epi>
DI void gemm192(const bf16_t* A, int lda, const bf16_t* Bt, int ldb, int nk, int m0, int n0, LAS unsigned char* lds, const Epi& epi) {
    const int t = tid_(), lane = t & 63, wid = __builtin_amdgcn_readfirstlane(t >> 6), fr = lane & 15, fq = lane >> 4, wm = wid >> 1, wn = wid & 1;
    const bf16_t* asrc[3]; const bf16_t* bsrc[2];
#pragma unroll
    for (int i = 0; i < 3; ++i) { const int sl = t + 512 * i, row = sl >> 3, c = (sl & 7) ^ ((row >> 1) & 7); asrc[i] = A + (size_t)(m0 + row) * lda + c * 8; }
#pragma unroll
    for (int i = 0; i < 2; ++i) { const int sl = t + 512 * i, row = sl >> 3, c = (sl & 7) ^ ((row >> 1) & 7); bsrc[i] = Bt + (size_t)(n0 + row) * ldb + c * 8; }
    const int ddst = wid * 1024;
#define G2_ISSUE(S, KT) do { LAS unsigned char* _s = lds + (S) * G2_STG + ddst; const int _k = (KT) * 64; \
        dma16(asrc[0] + _k, _s); dma16(asrc[1] + _k, _s + 8192); dma16(asrc[2] + _k, _s + 16384); dma16(bsrc[0] + _k, _s + 24576); dma16(bsrc[1] + _k, _s + 32768); } while (0)
    f32x4 acc[4][3];
#pragma unroll
    for (int nf = 0; nf < 4; ++nf)
#pragma unroll
        for (int mf = 0; mf < 3; ++mf) acc[nf][mf] = (f32x4){0.f, 0.f, 0.f, 0.f};
    __syncthreads();
    G2_ISSUE(0, 0);
    if (nk > 1) G2_ISSUE(1, 1);
    int st = 0;
    for (int kt = 0; kt < nk; ++kt) {
        if (kt + 1 < nk) WAIT_VM(5); else WAIT_VM(0);
        asm volatile("s_waitcnt lgkmcnt(0)" ::: "memory");
        __builtin_amdgcn_s_barrier();
        const int st2 = st == 0 ? 2 : st - 1;
        if (kt + 2 < nk) G2_ISSUE(st2, kt + 2);
        LAS unsigned char* S = lds + st * G2_STG;
        st = st == 2 ? 0 : st + 1;
#pragma unroll
        for (int kk = 0; kk < 2; ++kk) {
            bf16x8 af[3], bfr[4];
#pragma unroll
            for (int mf = 0; mf < 3; ++mf) af[mf] = *(LAS bf16x8*)(S + swz_off(wm * 48 + mf * 16 + fr, kk * 4 + fq));
#pragma unroll
            for (int nf = 0; nf < 4; ++nf) bfr[nf] = *(LAS bf16x8*)(S + 24576 + swz_off(wn * 64 + nf * 16 + fr, kk * 4 + fq));
#pragma unroll
            for (int nf = 0; nf < 4; ++nf)
#pragma unroll
                for (int mf = 0; mf < 3; ++mf) acc[nf][mf] = MFMA16(bfr[nf], af[mf], acc[nf][mf]);
        }
    }
#undef G2_ISSUE
    __syncthreads();
    epi(acc, wm, wn, fr, fq, lane, wid);
}
DI LAS unsigned char* g2_stage(LAS unsigned char* lds, int wid) { return lds + wid * 13056; }

DI void phase_inproj(const Params& p0, int l, LAS unsigned char* lds) {
    const Params p = launder(p0); l = launder_s(l);
    const bf16_t* H = (const bf16_t*)(p.ws + WS_H);
    const bf16_t* W = (const bf16_t*)(p.ws + WS_WIN) + (size_t)l * INW * DM;
    bf16_t* P = (bf16_t*)(p.ws + WS_P);
    bf16_t* VT = (bf16_t*)(p.ws + WS_VT);
    bf16_t* RKT = (bf16_t*)(p.ws + WS_RKT);
    bf16_t* RVT = (bf16_t*)(p.ws + WS_RVT);
    const f32x2* rope = (const f32x2*)(p.ws + WS_ROPE);
    constexpr int NTN = INW / 128, NTM = MROWS / 192;
    FOR_UNITS_XCD(u, NTM * NTN) {
        const int tm = u / NTN, tn = u % NTN;
        auto epi = [&](f32x4 (&acc)[4][3], int wm, int wn, int fr, int fq, int lane, int wid) {
            const int c0 = tn * 128 + wn * 64;
            const int r0 = tm * 192 + wm * 48;
            LAS unsigned char* W_ = g2_stage(lds, wid);
            if (c0 < C_DV) {
                const float qs = c0 < C_DK ? QSCALE : 1.0f;
#pragma unroll
                for (int mf = 0; mf < 3; ++mf) {
                    const int row = r0 + mf * 16 + fr;
                    const int b = row >= NT, pp = row - b * NT;
                    const bool lat = pp >= NCTX;
                    const int tt = pp - NCTX;
#pragma unroll
                    for (int hb = 0; hb < 2; ++hb) {
                        const int axis = ((c0 >> 5) + hb) & 1;
                        const int pos = axis ? (tt & 63) : (tt >> 6);
#pragma unroll
                        for (int j = 0; j < 4; ++j) {
                            float x1 = acc[2 * hb][mf][j], x2 = acc[2 * hb + 1][mf][j];
                            if (lat) { const f32x2 cs = rope[pos * 16 + 4 * fq + j]; const float o1 = x1 * cs[0] - x2 * cs[1], o2 = x1 * cs[1] + x2 * cs[0]; x1 = o1; x2 = o2; }
                            acc[2 * hb][mf][j] = x1 * qs; acc[2 * hb + 1][mf][j] = x2 * qs;
                        }
                    }
                }
            } else if (c0 >= C_RK && c0 < C_RV) {
#pragma unroll
                for (int nf = 0; nf < 4; ++nf)
#pragma unroll
                    for (int mf = 0; mf < 3; ++mf) acc[nf][mf] *= 0.125f;
            }
#pragma unroll
            for (int nf = 0; nf < 4; ++nf)
#pragma unroll
                for (int mf = 0; mf < 3; ++mf) {
                    const f32x4 v = acc[nf][mf];
                    *(LAS u32x2*)(W_ + (mf * 16 + fr) * 144 + nf * 32 + fq * 8) = (u32x2){pk_bf16(v[0], v[1]), pk_bf16(v[2], v[3])};
                }
#pragma unroll
            for (int it = 0; it < 6; ++it) {
                const int row = it * 8 + (lane >> 3), ch = lane & 7;
                *(u32x4*)(P + (size_t)(r0 + row) * INW + c0 + ch * 8) = *(LAS u32x4*)(W_ + row * 144 + ch * 16);
            }
            const bool isv = c0 >= C_DV && c0 < C_PU, isk = c0 >= C_RK && c0 < C_RV, isr = c0 >= C_RV && c0 < C_RG;
            if (isv || isk || isr) {
                const int frp = isv ? ((fr & 3) | (((fr >> 2) == 1 ? 2 : ((fr >> 2) == 2 ? 1 : (fr >> 2))) << 2)) : fr;
                LAS bf16_t* T_ = (LAS bf16_t*)W_;
#pragma unroll
                for (int nf = 0; nf < 4; ++nf)
#pragma unroll
                    for (int mf = 0; mf < 3; ++mf)
#pragma unroll
                        for (int j = 0; j < 4; ++j) T_[(nf * 16 + 4 * fq + j) * 56 + mf * 16 + frp] = to_bf16(acc[nf][mf][j]);
                const int b = r0 >= NT, pp0 = r0 - b * NT;
                bf16_t* base; int nrows_per_head;
                if (isv) { const int cc = c0 - C_DV; base = VT + ((size_t)(b * 4 + (cc >> 7)) * 128 + (cc & 127)) * NT + pp0; }
                else if (isk) { const int cc = c0 - C_RK; base = RKT + ((size_t)(b * 4 + (cc >> 6)) * 64) * NT + pp0; }
                else { const int cc = c0 - C_RV; base = RVT + ((size_t)(b * 4 + (cc >> 6)) * 64) * NT + pp0; }
                (void)nrows_per_head;
#pragma unroll
                for (int it = 0; it < 6; ++it) {
                    const int sl = it * 64 + lane, n = sl / 6, pc = sl % 6;
                    *(u32x4*)(base + (size_t)n * NT + pc * 8) = *(LAS u32x4*)(W_ + n * 112 + pc * 16);
                }
            }
        };
        gemm192(H, DM, W, DM, DM / 64, tm * 192, tn * 128, lds, epi);
    }
}

DI void phase_ret_sum_pool(const Params& p0, int l, LAS unsigned char* lds) {
    const Params p = launder(p0); l = launder_s(l);
    const int tid = tid_(), lane = tid & 63, wid = tid >> 6, fr = lane & 15, g = lane >> 4;
    const float* scal = (const float*)(p.ws + WS_SCAL) + l * 16;
    const bf16_t* RKT = (const bf16_t*)(p.ws + WS_RKT);
    const bf16_t* RVT = (const bf16_t*)(p.ws + WS_RVT);
    float* UF = (float*)(p.ws + WS_UF);
    float* UB = (float*)(p.ws + WS_UB);
    FOR_UNITS_XCD(u, NB * 4 * NCHUNK) {
        const int c = u % NCHUNK, bh = u / NCHUNK, h = bh & 3;
        const int dir = wid >> 2, eb = wid & 3;
        const float l2 = dir ? scal[6 + h] : scal[2 + h];
        const bf16_t* vrow = RVT + ((size_t)bh * 64 + eb * 16 + fr) * NT + c * 128;
        f32x4 acc[4];
#pragma unroll
        for (int db = 0; db < 4; ++db) acc[db] = (f32x4){0.f, 0.f, 0.f, 0.f};
#pragma unroll
        for (int ks = 0; ks < 4; ++ks) {
            const int j0 = ks * 32 + 8 * g;
            const bf16x8 af = *(const bf16x8*)(vrow + j0);
            float w[8];
#pragma unroll
            for (int jj = 0; jj < 8; ++jj) { const int j = j0 + jj; w[jj] = fast_exp2((dir ? (float)j : (float)(127 - j)) * l2); }
#pragma unroll
            for (int db = 0; db < 4; ++db) {
                const u32x4 kr = *(const u32x4*)(RKT + ((size_t)bh * 64 + db * 16 + fr) * NT + c * 128 + j0);
                u32x4 kw;
#pragma unroll
                for (int q = 0; q < 4; ++q) kw[q] = pk_bf16(bf_lo(kr[q]) * w[2 * q], bf_hi(kr[q]) * w[2 * q + 1]);
                acc[db] = MFMA16(af, as_bf16x8(kw), acc[db]);
            }
        }
        const int cidx = dir ? (c >= 2 ? c - 2 : 64 + c) : c;
        float* U = (dir ? UB : UF) + ((size_t)bh * NCHUNK + cidx) * 4096;
#pragma unroll
        for (int db = 0; db < 4; ++db)
#pragma unroll
            for (int j = 0; j < 4; ++j) U[(eb * 16 + 4 * g + j) * 64 + db * 16 + fr] = acc[db][j];
    }
    LAS float* ul = (LAS float*)lds;
    LAS float* dT = ul + 48 * 256;
    LAS float* pwl = dT + 256 * 36;
    const bf16_t* P = (const bf16_t*)(p.ws + WS_P);
    bf16_t* MIX = (bf16_t*)(p.ws + WS_MIX);
    const float* pw = p.pool_w + (size_t)l * 4 * 64 * 64;
    const float* ps = p.pool_scale + l * 256;
    __syncthreads();
    if (bid_() < MROWS / 32) {
#pragma unroll
        for (int i = 0; i < 8; ++i) *(LAS f32x4*)(pwl + (tid + 512 * i) * 4) = *(const f32x4*)(pw + (tid + 512 * i) * 4);
    }
    for (int u = bid_(); u < MROWS / 32; u += gridDim.x) {
        const int r0 = u * 32;
        const int b = r0 >= NT, pp0 = r0 - b * NT;
        const int s0 = pp0 < NCTX ? b * NT : b * NT + NCTX, s1 = pp0 < NCTX ? b * NT + NCTX : (b + 1) * NT;
        __syncthreads();
        {
            u32x4 wv[3];
#pragma unroll
            for (int it = 0; it < 3; ++it) {
                const int i = tid + 512 * it, rr = i >> 5, c8 = (i & 31) * 8, row = r0 - 8 + rr;
                const bool ok = row >= s0 && row < s1;
                wv[it] = ok ? *(const u32x4*)(P + (size_t)row * INW + C_PU + c8) : (u32x4){0u, 0u, 0u, 0u};
            }
#pragma unroll
            for (int it = 0; it < 3; ++it) {
                const int i = tid + 512 * it, rr = i >> 5, c8 = (i & 31) * 8;
                *(LAS f32x4*)(ul + rr * 256 + c8) = (f32x4){bf_lo(wv[it][0]), bf_hi(wv[it][0]), bf_lo(wv[it][1]), bf_hi(wv[it][1])};
                *(LAS f32x4*)(ul + rr * 256 + c8 + 4) = (f32x4){bf_lo(wv[it][2]), bf_hi(wv[it][2]), bf_lo(wv[it][3]), bf_hi(wv[it][3])};
            }
        }
        __syncthreads();
        {
            const int c = tid & 255, gi = c >> 6, rb = tid >> 8;
#define POOL_WIN(HW) do { _Pragma("unroll") for (int it = 0; it < 16; ++it) { const int rr = it * 2 + rb, row = r0 + rr; float sm = 0.f; \
                _Pragma("unroll") for (int q = -(HW); q < (HW); ++q) sm += ul[(rr + 8 + q) * 256 + c]; \
                const int lo = (row - (HW)) < s0 ? s0 : (row - (HW)), hi = (row + (HW)) > s1 ? s1 : (row + (HW)); \
                dT[c * 36 + rr] = sm / (float)(hi - lo) - ul[(rr + 8) * 256 + c]; } } while (0)
            if (gi == 0) POOL_WIN(1); else if (gi == 1) POOL_WIN(2); else if (gi == 2) POOL_WIN(4); else POOL_WIN(8);
#undef POOL_WIN
        }
        __syncthreads();
        {
            const int oc = (tid & 127) * 2, rh = (tid >> 7) * 8, gi = oc >> 6, e = oc & 63;
            float acc0[8], acc1[8];
#pragma unroll
            for (int i = 0; i < 8; ++i) { acc0[i] = 0.f; acc1[i] = 0.f; }
#pragma unroll 8
            for (int c = 0; c < 64; ++c) {
                const f32x2 wv = *(const LAS f32x2*)(pwl + (gi * 64 + c) * 64 + e);
                const LAS float* dr = dT + (gi * 64 + c) * 36 + rh;
#pragma unroll
                for (int i = 0; i < 2; ++i) { const f32x4 d = *(const LAS f32x4*)(dr + 4 * i);
#pragma unroll
                    for (int j = 0; j < 4; ++j) { acc0[4 * i + j] += d[j] * wv[0]; acc1[4 * i + j] += d[j] * wv[1]; } }
            }
            const float sc0 = ps[oc], sc1 = ps[oc + 1];
#pragma unroll
            for (int i = 0; i < 8; ++i) *(unsigned*)(MIX + (size_t)(r0 + rh + i) * DM + 512 + oc) = pk_bf16(acc0[i] * sc0, acc1[i] * sc1);
        }
    }
    __syncthreads();
}

DI void phase_ret_scan(const Params& p0, int l) {
    const Params p = launder(p0); l = launder_s(l);
    const float* scal = (const float*)(p.ws + WS_SCAL) + l * 16;
    const float* UF = (const float*)(p.ws + WS_UF); const float* UB = (const float*)(p.ws + WS_UB);
    bf16_t* SF = (bf16_t*)(p.ws + WS_SF); bf16_t* SB = (bf16_t*)(p.ws + WS_SB);
    for (int i = bid_() * NTHREADS + tid_(); i < 2 * NB * 4 * 4096; i += gridDim.x * NTHREADS) {
        const int dir = i / (NB * 4 * 4096), rem = i % (NB * 4 * 4096), bh = rem >> 12, el = rem & 4095, h = bh & 3;
        const float G = fast_exp2(128.0f * (dir ? scal[6 + h] : scal[2 + h]));
        float S = 0.f;
        if (dir == 0) {
#pragma unroll 11
            for (int c = 0; c < NCHUNK; ++c) { const size_t o = ((size_t)bh * NCHUNK + c) * 4096 + el; SF[o] = to_bf16(S); S = S * G + UF[o]; } }
        else {
#pragma unroll 11
            for (int c = NCHUNK - 1; c >= 0; --c) { const size_t o = ((size_t)bh * NCHUNK + c) * 4096 + el; SB[o] = to_bf16(S); S = S * G + UB[o]; } }
    }
}

DI void attn_unit(const Params& p, int l, int b, int h, int map, int q_p0, int ntile, int& conv_done, LAS unsigned char* lds) {
    const int tid = tid_(), lane = tid & 63, wid = __builtin_amdgcn_readfirstlane(tid >> 6), io = wid >> 2, wq = wid, r = lane & 31, hh = lane >> 5;
    const bf16_t* P = (const bf16_t*)(p.ws + WS_P);
    const bf16_t* VT = (const bf16_t*)(p.ws + WS_VT);
    bf16_t* OM = (bf16_t*)(p.ws + WS_OM);
    const size_t rowbase = (size_t)b * NT;
    const int qrow = q_p0 + wq * 32 + r;
    bf16x8 qf[4];
#pragma unroll
    for (int ks = 0; ks < 4; ++ks) qf[ks] = *(const bf16x8*)(P + (rowbase + qrow) * INW + C_DQ + h * 128 + map * 64 + ks * 16 + hh * 8);
    constexpr int ASTG = 32768, CRING = 98304, CSLOT = 16384;
    const int t8 = tid & 255, w4 = wid & 3;
    const bf16_t* ksrc; const bf16_t* vsrc;
    { const int key = t8 >> 3, ph = t8 & 7, c = ph ^ ((key >> 1) & 7);
      ksrc = P + (rowbase + key) * INW + C_DK + h * 128 + map * 64 + c * 8;
      const int e = t8 >> 3, pv = t8 & 7, cv = pv ^ ((e >> 1) & 7);
      vsrc = VT + ((size_t)(b * 4 + h) * 128 + e) * NT + cv * 8; }
    const int ddst = w4 * 1024;
#define ATT_ISSUE(S, KT) do { LAS unsigned char* _s = lds + (S) * ASTG + ddst; const bf16_t* _k = ksrc + (size_t)(KT) * 64 * INW; const bf16_t* _v = vsrc + (KT) * 64; \
        dma16(_k, _s); dma16(_k + (size_t)32 * INW, _s + 4096); \
        _Pragma("unroll") for (int m = 0; m < 4; ++m) dma16(_v + (size_t)m * 32 * NT, _s + 16384 + m * 4096); } while (0)
    constexpr int NSLICE = (NEXP + 1) * IMG_PER_E * 4;
    const int G_ = gridDim.x, bidc = bid_();
    const int mine = (NSLICE - bidc + G_ - 1) / G_;
    const int lim = __builtin_amdgcn_readfirstlane((mine - conv_done) < (ntile - 2) ? ((mine - conv_done) < 0 ? 0 : (mine - conv_done)) : (ntile - 2));
    const int cbase = conv_done;
    conv_done += lim;
    unsigned char* IMGL = p.ws + WS_WIMG + (size_t)l * (NEXP + 1) * IMG_PER_E * IMG_BYTES;
#define CONV_SRC(SI, SRCP, LDW) do { const int _s = bidc + G_ * (cbase + (SI)); const int _u = _s >> 2, _qd = _s & 3, _e = _u / IMG_PER_E, _im = _u % IMG_PER_E; \
        const int _k = t8 >> 5, _np = 128 * _qd + 4 * (t8 & 31); \
        if (_im < 32) { const float* _W = _e < NEXP ? p.w_egu + ((size_t)l * NEXP + _e) * DM * 512 : p.w_sgu + (size_t)l * DM * 512; LDW = 512; \
            SRCP = _W + (size_t)(_im * 32 + _k) * 512 + (((_np >> 4) & 1) * 256 + (_np >> 5) * 16 + (_np & 15)); } \
        else { const float* _W = _e < NEXP ? p.w_edn + ((size_t)l * NEXP + _e) * 256 * DM : p.w_sdn + (size_t)l * 256 * DM; LDW = DM; \
            SRCP = _W + (size_t)(((_im - 32) & 7) * 32 + _k) * DM + ((_im - 32) >> 3) * 512 + _np; } } while (0)
    f32x16 o[4];
#pragma unroll
    for (int eb = 0; eb < 4; ++eb)
#pragma unroll
        for (int i = 0; i < 16; ++i) o[eb][i] = 0.f;
    f32x16 negm;
#pragma unroll
    for (int i = 0; i < 16; ++i) negm[i] = 0.f;
    float m_run = 0.f, l_run = 0.f;
#pragma unroll
    for (int ks = 0; ks < 4; ++ks) asm volatile("" : "+v"(qf[ks]));
    __syncthreads();
    if (io == 0) { ATT_ISSUE(0, 0); if (ntile > 1) ATT_ISSUE(1, 1); }
    int st = 0;
    for (int kt = 0; kt < ntile; ++kt) {
        PRB_T0(1, lds);
        const bool cproc = kt >= 2 && kt - 2 < lim;
        if (io == 0) {
            if (kt + 1 >= ntile) WAIT_VM(0); else if (kt >= 4 && kt - 1 < lim) WAIT_VM(12); else WAIT_VM(6);
        } else if (cproc) {
            if (kt - 1 < lim) WAIT_VM(2); else WAIT_VM(0);
        }
        asm volatile("s_waitcnt lgkmcnt(0)" ::: "memory");
        __builtin_amdgcn_s_barrier();
        PRB_T1(1, lds); PRB_T0(2, lds);
        const int st2 = st == 0 ? 2 : st - 1;
        if (io == 0) { if (kt + 2 < ntile) ATT_ISSUE(st2, kt + 2); }
        if (kt < lim) {
            const float* srcp; int ldw; CONV_SRC(kt, srcp, ldw);
            LAS unsigned char* _d = lds + CRING + (kt % 3) * CSLOT + w4 * 1024;
            const int m0 = io == 1 ? 0 : 2;
            dma16(srcp + (size_t)m0 * 8 * ldw, _d + m0 * 4096); dma16(srcp + (size_t)(m0 + 1) * 8 * ldw, _d + (m0 + 1) * 4096);
        }
        LAS unsigned char* L = lds + st * ASTG;
        st = st == 2 ? 0 : st + 1;
        bf16x8 kf[8], va[4], vb[4];
#pragma unroll
        for (int ks = 0; ks < 4; ++ks) {
            const int ch = ks * 2 + hh;
            const int off = r * 128 + ((ch ^ ((r >> 1) & 7)) << 4);
            kf[2 * ks] = *(LAS bf16x8*)(L + off);
            kf[2 * ks + 1] = *(LAS bf16x8*)(L + off + 32 * 128);
        }
#define ATT_VREAD(dst, S_) do { _Pragma("unroll") for (int eb = 0; eb < 4; ++eb) { const int e = eb * 32 + r; \
            dst[eb] = *(LAS bf16x8*)(L + 16384 + e * 128 + ((((S_) * 2 + hh) ^ ((e >> 1) & 7)) << 4)); } } while (0)
#define ATT_PACK(dst, SRC, B_) do { u32x4 _pw; _Pragma("unroll") for (int q = 0; q < 4; ++q) _pw[q] = pk_bf16(SRC[(B_) + 2 * q], SRC[(B_) + 2 * q + 1]); dst = as_bf16x8(_pw); } while (0)
#define ATT_EXP8(SRC, B_) do { _Pragma("unroll") for (int i = 0; i < 8; ++i) { SRC[(B_) + i] = fast_exp2(SRC[(B_) + i]); rsum += SRC[(B_) + i]; pmx = fmaxf(pmx, SRC[(B_) + i]); } } while (0)
        ATT_VREAD(va, 0);
        asm volatile("" ::: "memory");
        f32x16 s0 = negm, s1 = negm;
#pragma unroll
        for (int ks = 0; ks < 4; ++ks) { s0 = MFMA32(kf[2 * ks], qf[ks], s0); s1 = MFMA32(kf[2 * ks + 1], qf[ks], s1); }
        if (io == 0 && cproc) {
            const int sj = bidc + G_ * (cbase + kt - 2); const int uu = sj >> 2, qd = sj & 3;
            const LAS float* raw = (const LAS float*)(lds + CRING + ((kt - 2) % 3) * CSLOT);
            unsigned char* img = IMGL + (size_t)uu * IMG_BYTES + (size_t)(128 * qd) * 64;
#pragma unroll
            for (int hcv = 0; hcv < 2; ++hcv) {
                const int cidx = t8 + 256 * hcv, row = cidx >> 2, chunk = cidx & 3;
                float f[8];
#pragma unroll
                for (int kk = 0; kk < 8; ++kk) f[kk] = raw[(chunk * 8 + kk) * 128 + row];
                const u32x4 w = {pk_bf16(f[0], f[1]), pk_bf16(f[2], f[3]), pk_bf16(f[4], f[5]), pk_bf16(f[6], f[7])};
                const int np = 128 * qd + row;
                *(u32x4*)(img + row * 64 + ((chunk ^ ((0 - (np >> 2)) & 3)) << 4)) = w;
            }
        }
        PRB_T1(2, lds); PRB_T0(3, lds);
        if (kt == 0) {
            float mx = fmaxf(fmaxf(s0[0], s0[1]), s0[2]);
#pragma unroll
            for (int i = 3; i < 15; i += 2) mx = fmaxf(fmaxf(mx, s0[i]), s0[i + 1]);
            mx = fmaxf(mx, s0[15]);
#pragma unroll
            for (int i = 0; i < 16; i += 2) mx = fmaxf(fmaxf(mx, s1[i]), s1[i + 1]);
            mx = fmaxf(mx, __shfl_xor(mx, 32));
            m_run = mx;
#pragma unroll
            for (int i = 0; i < 16; ++i) { s0[i] -= mx; s1[i] -= mx; negm[i] = -mx; }
        }
        float rsum = 0.f, pmx = 0.f;
        bf16x8 pb;
        ATT_EXP8(s0, 0); ATT_PACK(pb, s0, 0);
        ATT_VREAD(vb, 1); asm volatile("" ::: "memory");
#pragma unroll
        for (int eb = 0; eb < 4; ++eb) o[eb] = MFMA32(va[eb], pb, o[eb]);
        ATT_EXP8(s0, 8); ATT_PACK(pb, s0, 8);
        ATT_VREAD(va, 2); asm volatile("" ::: "memory");
#pragma unroll
        for (int eb = 0; eb < 4; ++eb) o[eb] = MFMA32(vb[eb], pb, o[eb]);
        ATT_EXP8(s1, 0); ATT_PACK(pb, s1, 0);
        ATT_VREAD(vb, 3); asm volatile("" ::: "memory");
#pragma unroll
        for (int eb = 0; eb < 4; ++eb) o[eb] = MFMA32(va[eb], pb, o[eb]);
        ATT_EXP8(s1, 8); ATT_PACK(pb, s1, 8);
#pragma unroll
        for (int eb = 0; eb < 4; ++eb) o[eb] = MFMA32(vb[eb], pb, o[eb]);
        l_run += rsum;
        PRB_T1(3, lds);
#undef ATT_VREAD
#undef ATT_PACK
#undef ATT_EXP8
        pmx = fmaxf(pmx, __shfl_xor(pmx, 32));
        if (__any(pmx > 256.0f)) {
            const float d = pmx > 256.0f ? __builtin_amdgcn_logf(pmx) : 0.f;
            const float alpha = fast_exp2(-d);
            m_run += d; l_run *= alpha;
#pragma unroll
            for (int i = 0; i < 16; ++i) negm[i] = -m_run;
#pragma unroll
            for (int eb = 0; eb < 4; ++eb)
#pragma unroll
                for (int i = 0; i < 16; ++i) o[eb][i] *= alpha;
        }
    }
#undef ATT_ISSUE
#undef CONV_SRC
    __syncthreads();
    const float lt = l_run + __shfl_xor(l_run, 32);
    const float inv = 1.0f / lt;
    {
        LAS unsigned char* W = lds + wq * 8704;
#pragma unroll
        for (int eb = 0; eb < 4; ++eb)
#pragma unroll
            for (int q = 0; q < 4; ++q) {
                const int e = eb * 32 + 8 * q + 4 * hh;
                const u32x2 w = {pk_bf16(o[eb][4 * q] * inv, o[eb][4 * q + 1] * inv), pk_bf16(o[eb][4 * q + 2] * inv, o[eb][4 * q + 3] * inv)};
                *(LAS u32x2*)(W + r * 272 + e * 2) = w;
            }
#pragma unroll
        for (int it = 0; it < 8; ++it) {
            const int row = it * 4 + (lane >> 4), ch = lane & 15;
            const u32x4 v = *(LAS u32x4*)(W + row * 272 + ch * 16);
            *(u32x4*)(OM + ((size_t)map * MROWS + rowbase + q_p0 + wq * 32 + row) * 512 + h * 128 + ch * 8) = v;
        }
    }
    __syncthreads();
}

DI void ret_unit(const Params& p, int l, int b, int h, int c) {
    const int tid = tid_(), lane = tid & 63, wid = tid >> 6, fr = lane & 15, g = lane >> 4;
    const float* scal = (const float*)(p.ws + WS_SCAL) + l * 16;
    const float lf2 = scal[2 + h], lb2 = scal[6 + h];
    const bf16_t* P = (const bf16_t*)(p.ws + WS_P);
    const bf16_t* RVT = (const bf16_t*)(p.ws + WS_RVT);
    const bf16_t* SF = (const bf16_t*)(p.ws + WS_SF); const bf16_t* SB = (const bf16_t*)(p.ws + WS_SB);
    bf16_t* MIX = (bf16_t*)(p.ws + WS_MIX);
    const int bh = b * 4 + h;
    const size_t row0 = (size_t)b * NT + c * 128;
    const int iloc = wid * 16 + fr;
    u32x4 qraw[2];
#pragma unroll
    for (int ks = 0; ks < 2; ++ks) qraw[ks] = *(const u32x4*)(P + (row0 + iloc) * INW + C_RQ + h * 64 + ks * 32 + 8 * g);
    bf16x8 kf[8][2];
#pragma unroll
    for (int jb = 0; jb < 8; ++jb)
#pragma unroll
        for (int ks = 0; ks < 2; ++ks) kf[jb][ks] = *(const bf16x8*)(P + (row0 + jb * 16 + fr) * INW + C_RK + h * 64 + ks * 32 + 8 * g);
    u32x4 vf[4][4];
#pragma unroll
    for (int jj = 0; jj < 4; ++jj)
#pragma unroll
        for (int eb = 0; eb < 4; ++eb) {
            const bf16_t* vp = RVT + ((size_t)bh * 64 + eb * 16 + fr) * NT + c * 128 + jj * 32 + 4 * g;
            const u32x2 v0 = *(const u32x2*)vp, v1 = *(const u32x2*)(vp + 16);
            vf[jj][eb] = (u32x4){v0[0], v0[1], v1[0], v1[1]};
        }
    f32x4 st[8];
#pragma unroll
    for (int jb = 0; jb < 8; ++jb) {
        st[jb] = (f32x4){0.f, 0.f, 0.f, 0.f};
#pragma unroll
        for (int ks = 0; ks < 2; ++ks) st[jb] = MFMA16(kf[jb][ks], as_bf16x8(qraw[ks]), st[jb]);
    }
    const int vc = c >= 2 ? c - 2 : 64 + c;
    const bf16_t* sf = SF + ((size_t)bh * NCHUNK + c) * 4096 + fr * 64 + 8 * g;
    const bf16_t* sb = SB + ((size_t)bh * NCHUNK + vc) * 4096 + fr * 64 + 8 * g;
    bf16x8 sfa[2][4], sba[2][4];
#pragma unroll
    for (int ks = 0; ks < 2; ++ks)
#pragma unroll
        for (int eb = 0; eb < 4; ++eb) { sfa[ks][eb] = *(const bf16x8*)(sf + eb * 1024 + ks * 32); sba[ks][eb] = *(const bf16x8*)(sb + eb * 1024 + ks * 32); }
    u32x2 gw[4];
#pragma unroll
    for (int eb = 0; eb < 4; ++eb) gw[eb] = *(const u32x2*)(P + (row0 + iloc) * INW + C_RG + h * 64 + eb * 16 + 4 * g);
#pragma unroll
    for (int jb = 0; jb < 8; ++jb)
#pragma unroll
        for (int q = 0; q < 4; ++q) {
            const int j = jb * 16 + 4 * g + q;
            const int d = iloc - j;
            const float w = d > 0 ? fast_exp2((float)d * lf2) : (d < 0 ? fast_exp2((float)(-d) * lb2) : 2.0f);
            st[jb][q] *= w;
        }
    f32x4 ot[4];
#pragma unroll
    for (int eb = 0; eb < 4; ++eb) ot[eb] = (f32x4){0.f, 0.f, 0.f, 0.f};
#pragma unroll
    for (int jj = 0; jj < 4; ++jj) {
        const u32x4 pw = {pk_bf16(st[2 * jj][0], st[2 * jj][1]), pk_bf16(st[2 * jj][2], st[2 * jj][3]), pk_bf16(st[2 * jj + 1][0], st[2 * jj + 1][1]), pk_bf16(st[2 * jj + 1][2], st[2 * jj + 1][3])};
#pragma unroll
        for (int eb = 0; eb < 4; ++eb) ot[eb] = MFMA16(as_bf16x8(vf[jj][eb]), as_bf16x8(pw), ot[eb]);
    }
    const float df = fast_exp2((float)(iloc + 1) * lf2), db = fast_exp2((float)(128 - iloc) * lb2);
#pragma unroll
    for (int ks = 0; ks < 2; ++ks) {
        u32x4 qf, qb;
#pragma unroll
        for (int q = 0; q < 4; ++q) { const float a = bf_lo(qraw[ks][q]), bb = bf_hi(qraw[ks][q]); qf[q] = pk_bf16(a * df, bb * df); qb[q] = pk_bf16(a * db, bb * db); }
#pragma unroll
        for (int eb = 0; eb < 4; ++eb) {
            ot[eb] = MFMA16(sfa[ks][eb], as_bf16x8(qf), ot[eb]);
            ot[eb] = MFMA16(sba[ks][eb], as_bf16x8(qb), ot[eb]);
        }
    }
    float s = 0.f;
#pragma unroll
    for (int eb = 0; eb < 4; ++eb) s += (ot[eb][0] + ot[eb][1]) + (ot[eb][2] + ot[eb][3]);
    s += __shfl_xor(s, 16); s += __shfl_xor(s, 32);
    const float mu = s * (1.0f / 64.0f);
    float q2 = 0.f;
#pragma unroll
    for (int eb = 0; eb < 4; ++eb)
#pragma unroll
        for (int q = 0; q < 4; ++q) { const float d = ot[eb][q] - mu; q2 += d * d; }
    q2 += __shfl_xor(q2, 16); q2 += __shfl_xor(q2, 32);
    const float rstd = rsqrtf(q2 * (1.0f / 64.0f) + LN_EPS);
#pragma unroll
    for (int eb = 0; eb < 4; ++eb) {
        const int e = eb * 16 + 4 * g;
        const float g0 = bf_lo(gw[eb][0]), g1 = bf_hi(gw[eb][0]), g2 = bf_lo(gw[eb][1]), g3 = bf_hi(gw[eb][1]);
        u32x2 w = {pk_bf16((ot[eb][0] - mu) * rstd * silu_f(g0), (ot[eb][1] - mu) * rstd * silu_f(g1)),
                   pk_bf16((ot[eb][2] - mu) * rstd * silu_f(g2), (ot[eb][3] - mu) * rstd * silu_f(g3))};
        *(u32x2*)(MIX + (row0 + iloc) * DM + 768 + h * 64 + e) = w;
    }
}

DI void phase_attn(const Params& p0, int l, LAS unsigned char* lds) {
    const Params p = launder(p0); l = launder_s(l);
    const int per_bh = 64 + (l == 0 ? 2 : 0);
    int conv_done = 0;
    FOR_UNITS_XCD(u, NB * 4 * per_bh) {
        const int bh = u / per_bh, loc = u % per_bh;
        const int b = bh >> 2, h = bh & 3;
        int q0, ntile, mapu;
        if (loc < 64) { q0 = NCTX + (loc >> 1) * 256; ntile = NT / 64; mapu = loc & 1; }
        else { q0 = 0; ntile = NCTX / 64; mapu = loc - 64; }
        attn_unit(p, l, b, h, mapu, q0, ntile, conv_done, lds);
    }
    if (tid_() == 0) ((int*)(p.ws + WS_CONVDONE))[l * 1024 + bid_()] = conv_done;
}
DI void phase_ret(const Params& p0, int l) {
    const Params p = launder(p0); l = launder_s(l);
    FOR_UNITS_XCD_REV(u, NB * 4 * NCHUNK) {

        const int c = u % NCHUNK, bh = u / NCHUNK;
        if (l == 1 && c < 2) continue;
        ret_unit(p, l, bh >> 2, bh & 3, c);
    }
}

DI void phase_mapcombine(const Params& p0, int l) {
    const Params p = launder(p0); l = launder_s(l);
    const float* scal = (const float*)(p.ws + WS_SCAL) + l * 16;
    const float lam = scal[0], oscale = scal[1];
    const bf16_t* OM = (const bf16_t*)(p.ws + WS_OM);
    bf16_t* MIX = (bf16_t*)(p.ws + WS_MIX);
    const int lane = tid_() & 63, wid = tid_() >> 6;
    for (int r = bid_() * 8 + wid; r < MROWS; r += gridDim.x * 8) {
        const int b = r >= NT, pp = r - b * NT;
        if (l == 1 && pp < NCTX) continue;
        const u32x4 a0 = *(const u32x4*)(OM + (size_t)r * 512 + lane * 8), a1 = *(const u32x4*)(OM + ((size_t)MROWS + r) * 512 + lane * 8);
        float v[8]; float ss = 0.f;
#pragma unroll
        for (int i = 0; i < 4; ++i) {
            v[2 * i] = bf_lo(a0[i]) - lam * bf_lo(a1[i]); v[2 * i + 1] = bf_hi(a0[i]) - lam * bf_hi(a1[i]);
            ss += v[2 * i] * v[2 * i] + v[2 * i + 1] * v[2 * i + 1];
        }
        ss += __shfl_xor(ss, 1); ss += __shfl_xor(ss, 2); ss += __shfl_xor(ss, 4); ss += __shfl_xor(ss, 8);
        const float sc = rsqrtf(ss * (1.0f / 128.0f) + RMS_EPS) * oscale;
        const u32x4 w = {pk_bf16(v[0] * sc, v[1] * sc), pk_bf16(v[2] * sc, v[3] * sc), pk_bf16(v[4] * sc, v[5] * sc), pk_bf16(v[6] * sc, v[7] * sc)};
        *(u32x4*)(MIX + (size_t)r * DM + lane * 8) = w;
    }
}

DI void phase_outproj(const Params& p0, int l, LAS unsigned char* lds) {
    const Params p = launder(p0); l = launder_s(l);
    const bf16_t* Xin = (const bf16_t*)(p.ws + WS_XA);
    const bf16_t* A = (const bf16_t*)(p.ws + WS_MIX);
    const bf16_t* W = (const bf16_t*)(p.ws + WS_WOUT) + (size_t)l * DM * DM;
    bf16_t* V1 = (bf16_t*)(p.ws + WS_V1);
    const float* modv = (const float*)(p.ws + WS_MODV) + (size_t)l * 3 * 6144;
    FOR_UNITS_XCD(u, (MROWS / 192) * 8) {
        const int tm = u >> 3, tn = u & 7;
        auto epi = [&](f32x4 (&acc)[4][3], int wm, int wn, int fr, int fq, int lane, int wid) {
            const int c0 = tn * 128 + wn * 64, r0 = tm * 192 + wm * 48;
            LAS unsigned char* W_ = g2_stage(lds, wid);
            u32x4 xw[6]; f32x4 g2v[6][2];
#pragma unroll
            for (int it = 0; it < 6; ++it) {
                const int grow = r0 + it * 8 + (lane >> 3), ch = lane & 7;
                xw[it] = *(const u32x4*)(Xin + (size_t)grow * DM + c0 + ch * 8);
                const float* g2p = modv + (size_t)row_sel(grow) * 6144 + 2 * 1024 + c0 + ch * 8;
                g2v[it][0] = *(const f32x4*)g2p; g2v[it][1] = *(const f32x4*)(g2p + 4);
            }
#pragma unroll
            for (int nf = 0; nf < 4; ++nf)
#pragma unroll
                for (int mf = 0; mf < 3; ++mf) *(LAS f32x4*)(W_ + (mf * 16 + fr) * 272 + nf * 64 + fq * 16) = acc[nf][mf];
#pragma unroll
            for (int it = 0; it < 6; ++it) {
                const int row = it * 8 + (lane >> 3), ch = lane & 7;
                const int grow = r0 + row;
                const f32x4 y0 = *(LAS f32x4*)(W_ + row * 272 + ch * 32), y1 = *(LAS f32x4*)(W_ + row * 272 + ch * 32 + 16);
                const u32x4 x = xw[it]; const f32x4 ga = g2v[it][0], gb = g2v[it][1];
                *(u32x4*)(V1 + (size_t)grow * DM + c0 + ch * 8) = (u32x4){
                    pk_bf16(DN_ALPHA * bf_lo(x[0]) + ga[0] * y0[0], DN_ALPHA * bf_hi(x[0]) + ga[1] * y0[1]), pk_bf16(DN_ALPHA * bf_lo(x[1]) + ga[2] * y0[2], DN_ALPHA * bf_hi(x[1]) + ga[3] * y0[3]),
                    pk_bf16(DN_ALPHA * bf_lo(x[2]) + gb[0] * y1[0], DN_ALPHA * bf_hi(x[2]) + gb[1] * y1[1]), pk_bf16(DN_ALPHA * bf_lo(x[3]) + gb[2] * y1[2], DN_ALPHA * bf_hi(x[3]) + gb[3] * y1[3])};
            }
        };
        gemm192(A, DM, W, DM, DM / 64, tm * 192, tn * 128, lds, epi);
    }
}

DI void phase_ln_mid(const Params& p0, int l) {
    const Params p = launder(p0); l = launder_s(l);
    bf16_t* Xout = (bf16_t*)(p.ws + WS_XB);
    const int lane = tid_() & 63, wid = tid_() >> 6;
    const bf16_t* V1 = (const bf16_t*)(p.ws + WS_V1);
    bf16_t* TOK = (bf16_t*)(p.ws + WS_TOK);
    const float* modv = (const float*)(p.ws + WS_MODV) + (size_t)l * 3 * 6144;
    const float* lg = p.ln_g + (size_t)(l * 2 + 0) * DM; const float* lb = p.ln_b + (size_t)(l * 2 + 0) * DM;
    for (int r = bid_() * 8 + wid; r < MROWS; r += gridDim.x * 8) {
        f32x4 v[4];
#pragma unroll
        for (int h = 0; h < 2; ++h) { const u32x4 w = *(const u32x4*)(V1 + (size_t)r * DM + lane * 8 + h * 512);
            v[2 * h] = (f32x4){bf_lo(w[0]), bf_hi(w[0]), bf_lo(w[1]), bf_hi(w[1])}; v[2 * h + 1] = (f32x4){bf_lo(w[2]), bf_hi(w[2]), bf_lo(w[3]), bf_hi(w[3])}; }
        float mu, rstd; ln_stats(v, mu, rstd);
#pragma unroll
        for (int i = 0; i < 4; ++i) {
            const int c = col8(lane, i);
            const f32x4 gg = *(const f32x4*)(lg + c), bb = *(const f32x4*)(lb + c);
#pragma unroll
            for (int j = 0; j < 4; ++j) v[i][j] = (v[i][j] - mu) * rstd * gg[j] + bb[j];
        }
#pragma unroll
        for (int h = 0; h < 2; ++h)
            *(u32x4*)(Xout + (size_t)r * DM + lane * 8 + h * 512) = (u32x4){pk_bf16(v[2 * h][0], v[2 * h][1]), pk_bf16(v[2 * h][2], v[2 * h][3]), pk_bf16(v[2 * h + 1][0], v[2 * h + 1][1]), pk_bf16(v[2 * h + 1][2], v[2 * h + 1][3])};
        const float* mv = modv + (size_t)row_sel(r) * 6144;
        modulate_store8(v, mv + 3 * 1024, mv + 4 * 1024, TOK + (size_t)r * DM, lane);
    }
}

DI void phase_router(const Params& p0, int l, LAS unsigned char* lds) {
    const Params p = launder(p0); l = launder_s(l);
    const bf16_t* A = (const bf16_t*)(p.ws + WS_TOK);
    const bf16_t* W = (const bf16_t*)(p.ws + WS_WR) + (size_t)l * 256 * DM;
    float* LG = (float*)(p.ws + WS_LOGIT);
    FOR_UNITS_XCD(u, (MROWS / 192) * 2) {
        const int tm = u >> 1, tn = u & 1;
        auto epi = [&](f32x4 (&acc)[4][3], int wm, int wn, int fr, int fq, int lane, int wid) {
            const int c0 = tn * 128 + wn * 64, r0 = tm * 192 + wm * 48;
            LAS unsigned char* W_ = g2_stage(lds, wid);
#pragma unroll
            for (int nf = 0; nf < 4; ++nf)
#pragma unroll
                for (int mf = 0; mf < 3; ++mf) *(LAS f32x4*)(W_ + (mf * 16 + fr) * 272 + nf * 64 + fq * 16) = acc[nf][mf];
#pragma unroll
            for (int it = 0; it < 12; ++it) {
                const int row = it * 4 + (lane >> 4), ch = lane & 15;
                *(f32x4*)(LG + (size_t)(r0 + row) * 256 + c0 + ch * 4) = *(LAS f32x4*)(W_ + row * 272 + ch * 16);
            }
        };
        gemm192(A, DM, W, DM, DM / 64, tm * 192, tn * 128, lds, epi);
    }
}

DI void phase_topk(const Params& p0, int l, LAS unsigned char* lds) {
    const Params p = launder(p0); l = launder_s(l);
    const int lane = tid_() & 63, wid = tid_() >> 6, rs = lane >> 3, g = lane & 7;
    const float* LG = (const float*)(p.ws + WS_LOGIT);
    const float* bias = p.router_bias + l * 256 + g * 32;
    int* EIDX = (int*)(p.ws + WS_EIDX); float* GATE = (float*)(p.ws + WS_GATE);
    int* RANK = (int*)(p.ws + WS_RANK); int* HIST = (int*)(p.ws + WS_HIST);
    LAS int* hist = (LAS int*)lds;
    if (tid_() < 256) hist[tid_()] = 0;
    __syncthreads();
    const int chunk = (MROWS + (int)gridDim.x - 1) / (int)gridDim.x, r_begin = bid_() * chunk, r_end = (r_begin + chunk) < MROWS ? (r_begin + chunk) : MROWS;
    for (int base = r_begin + wid * 8; base < r_end; base += 64) {
        const int row = base + rs; const bool valid = row < r_end;
        const float* lp = LG + (size_t)(valid ? row : r_begin) * 256 + g * 32;
        float sc[32], gv[32];
#pragma unroll
        for (int q = 0; q < 8; ++q) {
            const f32x4 lg = *(const f32x4*)(lp + 4 * q), bv = *(const f32x4*)(bias + 4 * q);
#pragma unroll
            for (int j = 0; j < 4; ++j) { sc[4 * q + j] = 1.0f / (1.0f + __expf(-lg[j])); gv[4 * q + j] = sc[4 * q + j] + bv[j]; }
        }
        float m1 = fmaxf(gv[0], gv[1]), m2 = fminf(gv[0], gv[1]);
#pragma unroll
        for (int i = 2; i < 32; ++i) { const float v = gv[i]; m2 = fmaxf(m2, fminf(m1, v)); m1 = fmaxf(m1, v); }
        const float gs = m1 + m2;
        int rank = 0;
#pragma unroll
        for (int g2 = 0; g2 < 8; ++g2) { const float o = __shfl(gs, (lane & 56) + g2); rank += (o > gs || (o == gs && g2 < g)) ? 1 : 0; }
        if (rank >= 4) {
#pragma unroll
            for (int i = 0; i < 32; ++i) gv[i] = -INFINITY;
        }
        float ssum = 0.f, mysc = 0.f; int myidx = 0;
#pragma unroll 1
        for (int k = 0; k < TOPK; ++k) {
            float bv = gv[0], bs = sc[0]; int bi = 0;
#pragma unroll
            for (int i = 1; i < 32; ++i) { const bool gt = gv[i] > bv; bv = gt ? gv[i] : bv; bs = gt ? sc[i] : bs; bi = gt ? i : bi; }
            int gi = g * 32 + bi;
#pragma unroll
            for (int o = 1; o < 8; o <<= 1) {
                const float ov = __shfl_xor(bv, o), os = __shfl_xor(bs, o); const int oi = __shfl_xor(gi, o);
                const bool tk = ov > bv || (ov == bv && oi < gi);
                bv = tk ? ov : bv; bs = tk ? os : bs; gi = tk ? oi : gi;
            }
            if ((gi >> 5) == g) {
                const int oi = gi & 31;
#pragma unroll
                for (int i = 0; i < 32; ++i) gv[i] = (i == oi) ? -INFINITY : gv[i];
            }
            ssum += bs;
            if (g == k) { mysc = bs; myidx = gi; }
        }
        if (valid) {
            EIDX[(size_t)row * 8 + g] = myidx;
            GATE[(size_t)row * 8 + g] = mysc / ssum * 2.5f;
            RANK[(size_t)row * 8 + g] = __hip_atomic_fetch_add(hist + myidx, 1, __ATOMIC_RELAXED, __HIP_MEMORY_SCOPE_WORKGROUP);
        }
    }
    __syncthreads();
    if (tid_() < 256) HIST[(size_t)bid_() * 256 + tid_()] = hist[tid_()];
    __syncthreads();
}

DI void phase_scatter(const Params& p0, int l, LAS unsigned char* lds) {
    const Params p = launder(p0); l = launder_s(l);
    LAS int* off = (LAS int*)lds;
    LAS int* toff = off + 260;
    LAS int* tot = toff + 260;
    LAS int* base = tot + 256;
    const int tid = tid_(), bid = bid_(), G = gridDim.x;
    const int* HIST = (const int*)(p.ws + WS_HIST);
    const int* RANK = (const int*)(p.ws + WS_RANK);
    int* ntl = (int*)(p.ws + CTL_NTILES) + l;
    int* TILES = (int*)(p.ws + WS_TILES);
    const int* EIDX = (const int*)(p.ws + WS_EIDX);
    int* SORT = (int*)(p.ws + WS_SORT);
    {
        const int e = tid & 255, hf = tid >> 8, bh = (G + 1) >> 1, b_lo = hf * bh, b_hi = (b_lo + bh) < G ? (b_lo + bh) : G;
        int t = 0, bs = 0;
#pragma unroll 32
        for (int b2 = b_lo; b2 < b_hi; ++b2) { const int v = HIST[(size_t)b2 * 256 + e]; bs += (b2 < bid) ? v : 0; t += v; }
        if (hf) { tot[e] = t; base[e] = bs; }
        __syncthreads();
        if (!hf) { tot[e] += t; base[e] += bs; }
    }
    __syncthreads();
    if (tid < 64) {
        int c[4], tt[4], a = 0, t = 0;
#pragma unroll
        for (int i = 0; i < 4; ++i) { c[i] = tot[tid * 4 + i]; tt[i] = (c[i] + MOE_T - 1) / MOE_T; a += c[i]; t += tt[i]; }
        int pa = a, pt = t;
#pragma unroll
        for (int o = 1; o < 64; o <<= 1) { const int ua = __shfl_up(pa, o), ut = __shfl_up(pt, o); if (tid >= o) { pa += ua; pt += ut; } }
        int ea = pa - a, et = pt - t;
#pragma unroll
        for (int i = 0; i < 4; ++i) { off[tid * 4 + i] = ea; toff[tid * 4 + i] = et; ea += c[i]; et += tt[i]; }
        if (tid == 63) { off[256] = ea; toff[256] = et; }
    }
    __syncthreads();
    if (bid == 0) {
        if (tid < 256) {
            const int e = tid, c = off[e + 1] - off[e], nt = toff[e + 1] - toff[e];
            for (int t = 0; t < nt; ++t) { int* T = TILES + (size_t)(toff[e] + t) * 4; T[0] = e; T[1] = off[e] + t * MOE_T; T[2] = (c - t * MOE_T) < MOE_T ? (c - t * MOE_T) : MOE_T; T[3] = 0; }
        }
        if (tid == 0) *ntl = toff[256];
    }
    const int chunk = (MROWS + G - 1) / G, r_begin = bid * chunk, r_end = (r_begin + chunk) < MROWS ? (r_begin + chunk) : MROWS;
    for (int a = r_begin * 8 + tid; a < r_end * 8; a += NTHREADS) {
        const int e = EIDX[a];
        SORT[off[e] + base[e] + RANK[a]] = a;
    }
    __syncthreads();
}

constexpr int MOE_STG = 9216 + 32768;
constexpr int MOE_HT = 2 * MOE_STG;
constexpr int MOE_INFO = MOE_HT + MOE_T * 512;
static_assert(MOE_INFO + MOE_T * 4 <= LDS_BYTES - 64, "MoE LDS map");
DI int swz64(int row, int chunk) { return row * 64 + ((chunk ^ ((0 - (row >> 2)) & 3)) << 4); }

DI void phase_convert_experts(const Params& p0, int l) {
    const Params p = launder(p0); l = launder_s(l);
    unsigned char* IMG = p.ws + WS_WIMG + (size_t)l * (NEXP + 1) * IMG_PER_E * IMG_BYTES;
    constexpr int NSLICE = (NEXP + 1) * IMG_PER_E * 4;
    const int G = gridDim.x, bid = bid_(), t = tid_();
    const int mine = (NSLICE - bid + G - 1) / G;
    const int done = ((const int*)(p.ws + WS_CONVDONE))[l * 1024 + bid];
    for (int i = done; i < mine; ++i) {
        const int sj = bid + G * i, u = sj >> 2, qd = sj & 3, e = u / IMG_PER_E, im = u % IMG_PER_E;
        const int row = t >> 2, chunk = t & 3, np = 128 * qd + row;
        const float* src; int ldw;
        if (im < 32) { const float* W = e < NEXP ? p.w_egu + ((size_t)l * NEXP + e) * DM * 512 : p.w_sgu + (size_t)l * DM * 512; ldw = 512;
            src = W + (size_t)(im * 32 + chunk * 8) * 512 + (((np >> 4) & 1) * 256 + (np >> 5) * 16 + (np & 15)); }
        else { const float* W = e < NEXP ? p.w_edn + ((size_t)l * NEXP + e) * 256 * DM : p.w_sdn + (size_t)l * 256 * DM; ldw = DM;
            src = W + (size_t)(((im - 32) & 7) * 32 + chunk * 8) * DM + ((im - 32) >> 3) * 512 + np; }
        float f[8];
#pragma unroll
        for (int kk = 0; kk < 8; ++kk) f[kk] = src[(size_t)kk * ldw];
        const u32x4 w = {pk_bf16(f[0], f[1]), pk_bf16(f[2], f[3]), pk_bf16(f[4], f[5]), pk_bf16(f[6], f[7])};
        *(u32x4*)(IMG + (size_t)u * IMG_BYTES + (size_t)np * 64 + ((chunk ^ ((0 - (np >> 2)) & 3)) << 4)) = w;
    }
}

DI void moe_unit(const Params& p, const unsigned char* img, bf16_t* outbase, bool shared, int r0, int nr, LAS unsigned char* lds) {
    const int t = tid_(), lane = t & 63, wid = __builtin_amdgcn_readfirstlane(t >> 6), fr = lane & 15, fq = lane >> 4, wn = wid;
    const bool late = (wid & 4) != 0;
    const bf16_t* TOK = (const bf16_t*)(p.ws + WS_TOK);
    const int* SORT = (const int*)(p.ws + WS_SORT);
    LAS int* rowout = (LAS int*)(lds + MOE_INFO);
    const int arow = t >> 2, arow2 = 128 + (t >> 2);
    int atok = 0, aout = -1, atok2 = 0, aout2 = -1;
    if (arow < nr) { if (shared) { atok = r0 + arow; aout = atok; } else { aout = SORT[r0 + arow]; atok = aout >> 3; } }
    if (wid == 0 && arow2 < nr) { if (shared) { atok2 = r0 + arow2; aout2 = atok2; } else { aout2 = SORT[r0 + arow2]; atok2 = aout2 >> 3; } }
    const unsigned char* TOKb = (const unsigned char*)TOK;
    const unsigned aoff = (unsigned)(atok * DM + ((((t & 3) ^ ((0 - (arow >> 2)) & 3))) << 3)) * 2u;
    const unsigned aoff2 = (unsigned)(atok2 * DM + ((((t & 3) ^ ((0 - (arow2 >> 2)) & 3))) << 3)) * 2u;
    __syncthreads();
    if ((t & 3) == 0) { rowout[arow] = aout; if (wid == 0) rowout[arow2] = aout2; }
    const unsigned woff = (unsigned)t * 16u;
    const int adst = wid * 1024, wdst = 9216 + wid * 1024;
#define MOE_WPIECES(W_, D_) do { if (!late) { dma16u((W_), woff, (D_) + adst); dma16u((W_) + 8192, woff, (D_) + adst + 8192); dma16u((W_) + 16384, woff, (D_) + adst + 16384); dma16u((W_) + 24576, woff, (D_) + adst + 24576); \
            dma16u((W_), woff + 4096u, (D_) + adst + 4096); dma16u((W_) + 8192, woff + 4096u, (D_) + adst + 4096 + 8192); } \
        else { dma16u((W_) + 16384, woff, (D_) + adst + 16384); dma16u((W_) + 24576, woff, (D_) + adst + 24576); } } while (0)
#define MOE_ISSUE1(S, KT) do { LAS unsigned char* _s = lds + (S) * MOE_STG; dma16u(TOKb + (KT) * 64, aoff, _s + adst); if (wid == 0) dma16u(TOKb + (KT) * 64, aoff2, _s + 8192); \
        const unsigned char* _w = img + (size_t)(KT) * IMG_BYTES; MOE_WPIECES(_w, _s + 9216); } while (0)
#define MOE_ISSUE2(S, IM) do { LAS unsigned char* _s = lds + (S) * IMG_BYTES; const unsigned char* _w = img + (size_t)(IM) * IMG_BYTES; MOE_WPIECES(_w, _s); } while (0)
#define MOE_DSR(dst, addr, off) asm volatile("ds_read_b128 %0, %1 offset:%2" : "=v"(dst) : "v"(addr), "n"(off) : "memory")
#define MOE_LGKM(n, X) asm volatile("s_waitcnt lgkmcnt(" #n ")" : "+v"(X), "+v"(wf[0]), "+v"(wf[1]), "+v"(wf[2]), "+v"(wf[3]) :: "memory")
    f32x4 acc[4][9];
#pragma unroll
    for (int nf = 0; nf < 4; ++nf)
#pragma unroll
        for (int tf = 0; tf < 9; ++tf) acc[nf][tf] = (f32x4){0.f, 0.f, 0.f, 0.f};
    MOE_ISSUE1(0, 0);
    MOE_ISSUE1(1, 1);
    int st = 0;
    for (int kt = 0; kt < 32; ++kt) {
        if (kt < 31) { if (wid == 0) WAIT_VM(8); else if (!late) WAIT_VM(7); else WAIT_VM(3); } else WAIT_VM(0);
        asm volatile("s_waitcnt lgkmcnt(0)" ::: "memory");
        __builtin_amdgcn_s_barrier();
        const int st2 = st == 0 ? 2 : st - 1;
        if (!late) { if (kt < 30) MOE_ISSUE1(st2, kt + 2); else if (kt == 31) MOE_ISSUE2(0, 32); }
        LAS unsigned char* S = lds + st * MOE_STG;
        bf16x8 wf[4], tq[2];
        { LAS unsigned char* wa = S + 9216 + swz64(wn * 64 + fr, fq); LAS unsigned char* ta = S + swz64(fr, fq);
          MOE_DSR(wf[0], wa, 0); MOE_DSR(wf[1], wa, 1024); MOE_DSR(wf[2], wa, 2048); MOE_DSR(wf[3], wa, 3072); MOE_DSR(tq[0], ta, 0);
#define MOE_TF(TF) do { if ((TF) < 8) { MOE_DSR(tq[((TF) + 1) & 1], ta, ((TF) + 1) * 1024); MOE_LGKM(1, tq[(TF) & 1]); } else MOE_LGKM(0, tq[(TF) & 1]); \
            _Pragma("unroll") for (int nf = 0; nf < 4; ++nf) acc[nf][TF] = MFMA16(wf[nf], tq[(TF) & 1], acc[nf][TF]); } while (0)
          MOE_TF(0); MOE_TF(1); MOE_TF(2);
          if (late) { if (kt < 30) MOE_ISSUE1(st2, kt + 2); else if (kt == 31) MOE_ISSUE2(0, 32); }
          MOE_TF(3); MOE_TF(4); MOE_TF(5); MOE_TF(6); MOE_TF(7); MOE_TF(8);
#undef MOE_TF
        }
        st = st == 2 ? 0 : st + 1;
    }
#pragma unroll
    for (int i = 0; i < 2; ++i)
#pragma unroll
        for (int tf = 0; tf < 9; ++tf) {
            float hv[4];
#pragma unroll
            for (int j = 0; j < 4; ++j) hv[j] = silu_f(acc[2 * i][tf][j]) * acc[2 * i + 1][tf][j];
            const int tok = tf * 16 + fr, hc = wn * 32 + i * 16 + 4 * fq;
            const u32x2 w = {pk_bf16(hv[0], hv[1]), pk_bf16(hv[2], hv[3])};
            *(LAS u32x2*)(lds + MOE_HT + tok * 512 + (((hc >> 3) ^ (tok & 15)) << 4) + (hc & 7) * 2) = w;
        }
#pragma unroll 1
    for (int nc = 0; nc < 2; ++nc) {
#pragma unroll
        for (int nf = 0; nf < 4; ++nf)
#pragma unroll
            for (int tf = 0; tf < 9; ++tf) acc[nf][tf] = (f32x4){0.f, 0.f, 0.f, 0.f};
        if (nc == 1) MOE_ISSUE2(0, 40);
#pragma unroll 1
        for (int kt = 0; kt < 8; ++kt) {
            WAIT_VM(0);
            asm volatile("s_waitcnt lgkmcnt(0)" ::: "memory");
            __builtin_amdgcn_s_barrier();
            if (!late && kt < 7) MOE_ISSUE2((kt + 1) & 1, 32 + nc * 8 + kt + 1);
            LAS unsigned char* S = lds + (kt & 1) * IMG_BYTES;
            bf16x8 wf[4], tq[2];
            { LAS unsigned char* wa = S + swz64(wn * 64 + fr, fq); LAS unsigned char* ta = lds + MOE_HT + fr * 512 + (((kt * 4 + fq) ^ fr) << 4); LAS unsigned char* tb = ta + 32768;
              MOE_DSR(wf[0], wa, 0); MOE_DSR(wf[1], wa, 1024); MOE_DSR(wf[2], wa, 2048); MOE_DSR(wf[3], wa, 3072); MOE_DSR(tq[0], ta, 0);
#define MOE_TF(TF) do { if ((TF) < 8) { if ((TF) + 1 < 4) MOE_DSR(tq[((TF) + 1) & 1], ta, ((TF) + 1) * 8192); else MOE_DSR(tq[((TF) + 1) & 1], tb, ((TF) + 1 - 4) * 8192); \
              MOE_LGKM(1, tq[(TF) & 1]); } else MOE_LGKM(0, tq[(TF) & 1]); \
              _Pragma("unroll") for (int nf = 0; nf < 4; ++nf) acc[nf][TF] = MFMA16(wf[nf], tq[(TF) & 1], acc[nf][TF]); } while (0)
              MOE_TF(0); MOE_TF(1); MOE_TF(2);
              if (late && kt < 7) MOE_ISSUE2((kt + 1) & 1, 32 + nc * 8 + kt + 1);
              MOE_TF(3); MOE_TF(4); MOE_TF(5); MOE_TF(6); MOE_TF(7); MOE_TF(8);
#undef MOE_TF
            }
        }
        __syncthreads();
        LAS unsigned char* W = lds + wid * 6912;
#pragma unroll
        for (int g = 0; g < 3; ++g) {
            int lz = lane; asm volatile("" : "+v"(lz));
            const int fr = lz & 15, fq = lz >> 4;
#pragma unroll
            for (int nh = 0; nh < 4; ++nh)
#pragma unroll
                for (int tl = 0; tl < 3; ++tl) {
                    const f32x4 v = acc[nh][g * 3 + tl];
                    const u32x2 w = {pk_bf16(v[0], v[1]), pk_bf16(v[2], v[3])};
                    *(LAS u32x2*)(W + (tl * 16 + fr) * 144 + nh * 32 + fq * 8) = w;
                }
#pragma unroll
            for (int it = 0; it < 6; ++it) {
                const int row = it * 8 + (lz >> 3), ch = lz & 7;
                const u32x4 v = *(LAS u32x4*)(W + row * 144 + ch * 16);
                const int ro = ((volatile LAS int*)rowout)[g * 48 + row];
                if (ro >= 0) *(u32x4*)(outbase + (size_t)ro * DM + nc * 512 + wn * 64 + ch * 8) = v;
            }
        }
        __syncthreads();
    }
#undef MOE_ISSUE1
#undef MOE_WPIECES
#undef MOE_ISSUE2
#undef MOE_DSR
#undef MOE_LGKM
}

DI void phase_moe(const Params& p0, int l, LAS unsigned char* lds) {
    const Params p = launder(p0); l = launder_s(l);
    const int* TILES = (const int*)(p.ws + WS_TILES);
    const int ntl = *((const int*)(p.ws + CTL_NTILES) + l);
    const int G = gridDim.x, bid = bid_();
    int vcu = bid;
    if (p.ph_hi - p.ph_lo > 1) {
        volatile LAS unsigned* bst = (volatile LAS unsigned*)(lds + LDS_BYTES - 16);
        const unsigned xc = bst[2]; unsigned pre = 0;
        for (unsigned j = 0; j < 16; ++j) { const unsigned c = xb_ld((unsigned*)(p.ws + WS_CTL) + XB_XCNT(j)); pre += (j < xc) ? c : 0u; }
        vcu = (int)(pre + bst[3]);
    }
    const int rows_b = l == 1 ? NLAT : NT, tiles_b = (rows_b + MOE_T - 1) / MOE_T;
    const int total = ntl + NB * tiles_b;
    const unsigned char* IMG = p.ws + WS_WIMG + (size_t)l * (NEXP + 1) * IMG_PER_E * IMG_BYTES;
    for (int u = vcu; u < total; u += G) {
        if (u < ntl) {
            const int e = __builtin_amdgcn_readfirstlane(TILES[u * 4]), r0 = __builtin_amdgcn_readfirstlane(TILES[u * 4 + 1]), nr = __builtin_amdgcn_readfirstlane(TILES[u * 4 + 2]);
            moe_unit(p, IMG + (size_t)e * IMG_PER_E * IMG_BYTES, (bf16_t*)(p.ws + WS_YSLOT), false, r0, nr, lds);
        } else {
            const int tm = u - ntl, b = tm / tiles_b, i = tm - b * tiles_b;
            const int left = rows_b - i * MOE_T;
            moe_unit(p, IMG + (size_t)NEXP * IMG_PER_E * IMG_BYTES, (bf16_t*)(p.ws + WS_YSH), true, b * NT + (l == 1 ? NCTX : 0) + i * MOE_T, left < MOE_T ? left : MOE_T, lds);
        }
    }
}

DI void phase_combine(const Params& p0, int l) {
    const Params p = launder(p0); l = launder_s(l);
    const bf16_t* X1 = (const bf16_t*)(p.ws + WS_XB); bf16_t* Xnext = (bf16_t*)(p.ws + WS_XA);
    const int lane = tid_() & 63, wid = tid_() >> 6;
    const bf16_t* YSL = (const bf16_t*)(p.ws + WS_YSLOT); const bf16_t* YSH = (const bf16_t*)(p.ws + WS_YSH);
    const float* GATE = (const float*)(p.ws + WS_GATE);
    const float* modv = (const float*)(p.ws + WS_MODV);
    const float* lg = p.ln_g + (size_t)(l * 2 + 1) * DM; const float* lb = p.ln_b + (size_t)(l * 2 + 1) * DM;
    bf16_t* H = (bf16_t*)(p.ws + WS_H);
    for (int r = bid_() * 8 + wid; r < MROWS; r += gridDim.x * 8) {
        const int b = r >= NT, pp = r - b * NT;
        if (l == 1 && pp < NCTX) continue;
        const int sel = pp < NCTX ? 2 : b;
        float gt[8];
#pragma unroll
        for (int k = 0; k < 8; ++k) gt[k] = GATE[(size_t)r * 8 + k];
        const float* g5 = modv + ((size_t)l * 3 + sel) * 6144 + 5 * 1024;
        f32x4 v[4];
        u32x4 sl[2][9], xw[2];
#pragma unroll
        for (int h = 0; h < 2; ++h) {
            const int c8 = lane * 8 + h * 512;
            sl[h][8] = *(const u32x4*)(YSH + (size_t)r * DM + c8);
#pragma unroll
            for (int k = 0; k < 8; ++k) sl[h][k] = *(const u32x4*)(YSL + ((size_t)r * 8 + k) * DM + c8);
            xw[h] = *(const u32x4*)(X1 + (size_t)r * DM + c8);
        }
#pragma unroll
        for (int i = 0; i < 4; ++i) {
            const int h = i >> 1, q = (i & 1) * 2, c = col8(lane, i);
            float f0 = bf_lo(sl[h][8][q]), f1 = bf_hi(sl[h][8][q]), f2 = bf_lo(sl[h][8][q + 1]), f3 = bf_hi(sl[h][8][q + 1]);
#pragma unroll
            for (int k = 0; k < 8; ++k) { const unsigned w0 = sl[h][k][q], w1 = sl[h][k][q + 1]; f0 += gt[k] * bf_lo(w0); f1 += gt[k] * bf_hi(w0); f2 += gt[k] * bf_lo(w1); f3 += gt[k] * bf_hi(w1); }
            const f32x4 xv = {bf_lo(xw[h][q]), bf_hi(xw[h][q]), bf_lo(xw[h][q + 1]), bf_hi(xw[h][q + 1])}, gv = *(const f32x4*)(g5 + c);
            v[i] = (f32x4){DN_ALPHA * xv[0] + gv[0] * f0, DN_ALPHA * xv[1] + gv[1] * f1, DN_ALPHA * xv[2] + gv[2] * f2, DN_ALPHA * xv[3] + gv[3] * f3};
        }
        float mu, rstd; ln_stats(v, mu, rstd);
#pragma unroll
        for (int i = 0; i < 4; ++i) {
            const int c = col8(lane, i);
            const f32x4 gg = *(const f32x4*)(lg + c), bb = *(const f32x4*)(lb + c);
#pragma unroll
            for (int j = 0; j < 4; ++j) v[i][j] = (v[i][j] - mu) * rstd * gg[j] + bb[j];
            if (l == 1) *(f32x4*)(p.out + ((size_t)b * NLAT + (pp - NCTX)) * DM + c) = v[i];
        }
        if (l == 0) {
#pragma unroll
            for (int h = 0; h < 2; ++h)
                *(u32x4*)(Xnext + (size_t)r * DM + lane * 8 + h * 512) = (u32x4){pk_bf16(v[2 * h][0], v[2 * h][1]), pk_bf16(v[2 * h][2], v[2 * h][3]), pk_bf16(v[2 * h + 1][0], v[2 * h + 1][1]), pk_bf16(v[2 * h + 1][2], v[2 * h + 1][3])};
        }
        if (l == 0) { const float* mv = modv + ((size_t)1 * 3 + sel) * 6144; modulate_store8(v, mv, mv + 1024, H + (size_t)r * DM, lane); }
    }
}

constexpr int PH_PER_LAYER = 12, N_PHASES = 3 + 2 * PH_PER_LAYER;
__global__ void __launch_bounds__(NTHREADS, 2) mega(Params p) {
    extern __shared__ __attribute__((aligned(16))) unsigned char lds_raw[];
    LAS unsigned char* lds = (LAS unsigned char*)lds_raw;
    volatile LAS unsigned* bst = (volatile LAS unsigned*)(lds + LDS_BYTES - 16);
    if (PROBE_ID != 0 && threadIdx.x == 0) { PRB_WORDS(lds)[0] = 0ull; PRB_WORDS(lds)[1] = 0ull; }
    if (threadIdx.x == 0) { bst[0] = 0u; bst[1] = 0u; const unsigned xc = xb_xcc_id(); bst[2] = xc; bst[3] = xb_add((unsigned*)(p.ws + CTL_XRANK) + xc, 1u); }
    __syncthreads();
    const int lo = p.ph_lo, hi = p.ph_hi;
    XcdBarrier bar; bar.bar = (unsigned*)(p.ws + WS_CTL); bar.x = 0; bar.st = bst;
    if (hi - lo > 1) bar = xcd_barrier_post((unsigned*)(p.ws + WS_CTL), bst);
#ifndef ONLY_PHASE
#define ONLY_PHASE -1
#endif
#define IN(k) (lo <= (k) && (k) < hi)
#define ON(pid) (ONLY_PHASE < 0 || ONLY_PHASE == (pid))
#ifndef DUP_PHASE
#define DUP_PHASE -1
#endif
#define REP(pid) for (int rep_ = 0; rep_ < ((DUP_PHASE == (pid)) ? 2 : 1); ++rep_)
#define SEAM(k) do { if (IN(k) && IN((k) + 1)) xcd_barrier(bar); } while (0)
    PRB_T0(100, lds); if (ON(0) && IN(0)) REP(0) { phase_convert(p, lds); } PRB_T1(100, lds);
    PRB_T0(101, lds); if (ON(1) && IN(1)) REP(1) phase_mod(p, lds); PRB_T1(101, lds);
    PRB_T0(201, lds); SEAM(1); PRB_T1(201, lds);
    PRB_T0(102, lds); if (ON(2) && IN(2)) REP(2) phase_ln0(p); PRB_T1(102, lds);
    PRB_T0(202, lds); SEAM(2); PRB_T1(202, lds);
    for (int l = 0; l < 2; ++l) {
        const int k0 = 3 + l * PH_PER_LAYER;
        PRB_T0(103, lds); if (ON(3) && IN(k0 + 0)) REP(3) phase_inproj(p, l, lds); PRB_T1(103, lds);
        PRB_T0(203, lds); SEAM(k0 + 0); PRB_T1(203, lds);
        PRB_T0(104, lds); if (ON(4) && IN(k0 + 1)) REP(4) phase_ret_sum_pool(p, l, lds); PRB_T1(104, lds);
        PRB_T0(204, lds); SEAM(k0 + 1); PRB_T1(204, lds);
        PRB_T0(105, lds); if (ON(5) && IN(k0 + 2)) REP(5) phase_ret_scan(p, l); PRB_T1(105, lds);
        PRB_T0(205, lds); SEAM(k0 + 2); PRB_T1(205, lds);
        PRB_T0(106, lds); if (ON(6) && IN(k0 + 3)) REP(6) { phase_attn(p, l, lds); phase_ret(p, l); } PRB_T1(106, lds);
        PRB_T0(206, lds); SEAM(k0 + 3); PRB_T1(206, lds);
        PRB_T0(113, lds); if (ON(13) && IN(k0 + 4)) REP(13) phase_mapcombine(p, l); PRB_T1(113, lds);
        PRB_T0(213, lds); SEAM(k0 + 4); PRB_T1(213, lds);
        PRB_T0(107, lds); if (ON(7) && IN(k0 + 5)) REP(7) phase_outproj(p, l, lds); PRB_T1(107, lds);
        PRB_T0(207, lds); SEAM(k0 + 5); PRB_T1(207, lds);
        PRB_T0(108, lds); if (ON(8) && IN(k0 + 6)) REP(8) phase_ln_mid(p, l); PRB_T1(108, lds);
        PRB_T0(208, lds); SEAM(k0 + 6); PRB_T1(208, lds);
        PRB_T0(109, lds); if (ON(9) && IN(k0 + 7)) REP(9) phase_router(p, l, lds); PRB_T1(109, lds);
        PRB_T0(209, lds); SEAM(k0 + 7); PRB_T1(209, lds);
        PRB_T0(110, lds); if (ON(10) && IN(k0 + 8)) REP(10) phase_topk(p, l, lds); PRB_T1(110, lds);
        PRB_T0(210, lds); SEAM(k0 + 8); PRB_T1(210, lds);
        PRB_T0(111, lds); if (ON(11) && IN(k0 + 9)) REP(11) { phase_scatter(p, l, lds); phase_convert_experts(p, l); } PRB_T1(111, lds);
        PRB_T0(211, lds); SEAM(k0 + 9); PRB_T1(211, lds);
        PRB_T0(112, lds); if (ON(12) && IN(k0 + 10)) REP(12) phase_moe(p, l, lds); PRB_T1(112, lds);
        PRB_T0(212, lds); SEAM(k0 + 10); PRB_T1(212, lds);
        PRB_T0(114, lds); if (ON(14) && IN(k0 + 11)) REP(14) phase_combine(p, l); PRB_T1(114, lds);
        if (l == 0) SEAM(k0 + 11);
    }
#undef IN
#undef SEAM
    if (PROBE_ID != 0 && threadIdx.x == 0 && blockIdx.x == 0) {
        const unsigned long long t0 = __builtin_readcyclecounter(), span = PRB_WORDS(lds)[1] * PROBE_GAIN;
        while (__builtin_readcyclecounter() - t0 < span) __builtin_amdgcn_s_sleep(8);
    }
}

extern "C" void kernel_launch(void* const* d_in, const int* in_sizes, int n_in, void* d_out, int out_size, void* d_ws, size_t ws_size, hipStream_t stream) {
    static int grid = 0;
    if (grid == 0) {
        if (n_in != 20 || ws_size < WS_END || out_size != NB * NLAT * DM) { fprintf(stderr, "kernel_launch: unexpected shapes (n_in %d, ws %zu need %zu, out %d)\n", n_in, ws_size, (size_t)WS_END, out_size); grid = -1; return; }
        int dev = 0, cus = 0, per_cu = 0;
        hipGetDevice(&dev); hipDeviceGetAttribute(&cus, hipDeviceAttributeMultiprocessorCount, dev);
        if (hipFuncSetAttribute((const void*)mega, hipFuncAttributeMaxDynamicSharedMemorySize, LDS_BYTES) != hipSuccess) { fprintf(stderr, "kernel_launch: hipFuncSetAttribute failed\n"); grid = -1; return; }
        if (hipOccupancyMaxActiveBlocksPerMultiprocessor(&per_cu, (const void*)mega, NTHREADS, LDS_BYTES) != hipSuccess || per_cu < 1) { fprintf(stderr, "kernel_launch: occupancy query says %d\n", per_cu); }
        (void)hipGetLastError();
        grid = cus > 0 ? cus : 256;
    }
    if (grid < 0) return;
    hipMemsetAsync((char*)d_ws + WS_CTL, 0, CTL_BYTES, stream);
    Params p{};
    p.x = (const float*)d_in[0]; p.c = (const float*)d_in[1]; p.ctx = (const float*)d_in[2]; p.c_ctx = (const float*)d_in[3];
    p.w_mod = (const float*)d_in[4]; p.b_mod = (const float*)d_in[5]; p.w_in = (const float*)d_in[6]; p.w_out = (const float*)d_in[7];
    p.diff_lambda = (const float*)d_in[8]; p.pool_w = (const float*)d_in[9]; p.pool_scale = (const float*)d_in[10]; p.ret_log_decay = (const float*)d_in[11];
    p.ln_g = (const float*)d_in[12]; p.ln_b = (const float*)d_in[13]; p.w_router = (const float*)d_in[14]; p.router_bias = (const float*)d_in[15];
    p.w_egu = (const float*)d_in[16]; p.w_edn = (const float*)d_in[17]; p.w_sgu = (const float*)d_in[18]; p.w_sdn = (const float*)d_in[19];
    p.out = (float*)d_out; p.ws = (unsigned char*)d_ws;
#if N_LAUNCH_PER_PHASE
    for (int k = 0; k < N_PHASES; ++k) { p.ph_lo = k; p.ph_hi = k + 1; hipLaunchKernelGGL(mega, dim3(grid), dim3(NTHREADS), LDS_BYTES, stream, p); }
#else
    p.ph_lo = 0; p.ph_hi = N_PHASES;
    hipLaunchKernelGGL(mega, dim3(grid), dim3(NTHREADS), LDS_BYTES, stream, p);
#endif
}
```
